# Optimizing an MI355X kernel written in HIP

```python
import math
import jax, jax.numpy as jnp
from jax import lax
import numpy as np

D_MODEL = 1024
BATCH = 32
SEQ = 2048
DEPTH = 1

CHUNK = 64
Q_BLOCK = 128
HEAD_DIM = 64
ROPE_THETA = 10000.0
EPS = 1e-6
DIFF_HEADS = 4
DIFF_WIDTH = DIFF_HEADS * 2 * HEAD_DIM
DSA_HEADS = 8
DSA_WIDTH = DSA_HEADS * HEAD_DIM
IDX_HEADS = 8
DSA_TOPK_MAX = 256
N_BRANCH = 2
PEER_HEADS = 8
PEER_NKEYS = 128
PEER_EXPERTS = PEER_NKEYS * PEER_NKEYS
PEER_DKEY = 256
PEER_TOPK = 16
PEER_BLOCK = 128
IN_SIZES = (
    DIFF_WIDTH,
    DIFF_WIDTH,
    DIFF_WIDTH,
    DSA_WIDTH,
    HEAD_DIM,
    HEAD_DIM,
    IDX_HEADS * HEAD_DIM,
    HEAD_DIM,
    IDX_HEADS,
    N_BRANCH * D_MODEL,
)
IN_COLS = sum(IN_SIZES)

kernel_name = "chunk_causal_hybrid_diff_dsa_peer_block"


def rmsnorm(x, g):
    x32 = x.astype(jnp.float32)
    y = x32 * lax.rsqrt(jnp.mean(x32 * x32, axis=-1, keepdims=True) + EPS)
    return (y * g.astype(jnp.float32)).astype(x.dtype)


def rope_cos_sin(positions, dim):
    inv = ROPE_THETA ** (-(jnp.arange(0, dim, 2, dtype=jnp.float32) / dim))
    ang = positions.astype(jnp.float32)[..., None] * inv
    return jnp.cos(ang), jnp.sin(ang)


def apply_rope(x, cos, sin):
    x32 = x.astype(jnp.float32)
    half = x.shape[-1] // 2
    x1, x2 = x32[..., :half], x32[..., half:]
    c = cos[:, :, None, :]
    s = sin[:, :, None, :]
    return jnp.concatenate([x1 * c - x2 * s, x2 * c + x1 * s], axis=-1).astype(x.dtype)


def diff_attention(q, k, v, lam, out_g, lambda_init):
    B, T, H, _, d = q.shape
    nb = T // Q_BLOCK
    qb = q.reshape(B, nb, Q_BLOCK, H, 2, d).transpose(1, 0, 2, 3, 4, 5)
    k_chunk = jnp.arange(T) // CHUNK
    scale = d ** -0.5

    def block(args):
        i, q_i = args
        q_chunk = (i * Q_BLOCK + jnp.arange(Q_BLOCK)) // CHUNK
        mask = k_chunk[None, :] <= q_chunk[:, None]
        s = jnp.einsum('bqhmd,bkhmd->bhmqk', q_i, k).astype(jnp.float32) * scale
        s = jnp.where(mask, s, -jnp.inf)
        p = jax.nn.softmax(s, axis=-1)
        p = p[:, :, 0] - lam * p[:, :, 1]
        return jnp.einsum('bhqk,bkhd->bqhd', p.astype(v.dtype), v)

    o = lax.map(block, (jnp.arange(nb), qb))
    o = o.transpose(1, 0, 2, 3, 4).reshape(B, T, H, 2 * d)
    o = rmsnorm(o, out_g) * (1.0 - lambda_init)
    return o.reshape(B, T, H * 2 * d)


def dsa_attention(q, k, v, q_idx, k_idx, w_idx):
    B, T, H, d = q.shape
    topk = min(DSA_TOPK_MAX, T // 4)
    nb = T // Q_BLOCK
    to_blocks = lambda a: a.reshape((B, nb, Q_BLOCK) + a.shape[2:]).swapaxes(0, 1)
    k_chunk = jnp.arange(T) // CHUNK
    scale = d ** -0.5
    idx_scale = (IDX_HEADS ** -0.5) * (HEAD_DIM ** -0.5)
    gather = jax.vmap(lambda table, idx: table[idx])

    def block(args):
        i, q_b, qi_b, wi_b = args
        q_chunk = (i * Q_BLOCK + jnp.arange(Q_BLOCK)) // CHUNK
        mask = k_chunk[None, :] <= q_chunk[:, None]
        dots = jnp.einsum('bqhd,bkd->bqhk', qi_b, k_idx).astype(jnp.float32)
        score = jnp.einsum('bqhk,bqh->bqk', jax.nn.relu(dots), wi_b.astype(jnp.float32)) * idx_scale
        score = jnp.where(mask[None], score, -jnp.inf)
        _, sel = lax.top_k(score, topk)
        valid = (sel // CHUNK) <= q_chunk[None, :, None]
        k_sel = gather(k, sel)
        v_sel = gather(v, sel)
        s = jnp.einsum('bqhd,bqkd->bqhk', q_b, k_sel).astype(jnp.float32) * scale
        s = jnp.where(valid[:, :, None, :], s, -jnp.inf)
        p = jax.nn.softmax(s, axis=-1)
        o = jnp.einsum('bqhk,bqkd->bqhd', p.astype(v.dtype), v_sel)
        return o.reshape(B, Q_BLOCK, H * d)

    o = lax.map(block, (jnp.arange(nb), to_blocks(q), to_blocks(q_idx), to_blocks(w_idx)))
    return o.swapaxes(0, 1).reshape(B, T, H * d)


def peer(h, w_q, sub_keys, expert_u, expert_v):
    B, T, D = h.shape
    n_tok = B * T
    hb = h.reshape(n_tok // PEER_BLOCK, PEER_BLOCK, D)

    def block(xb):
        q = (xb @ w_q).reshape(PEER_BLOCK, PEER_HEADS, 2, PEER_DKEY // 2)
        s = jnp.einsum('nhpd,hpkd->nhpk', q, sub_keys).astype(jnp.float32)
        v1, i1 = lax.top_k(s[:, :, 0], PEER_TOPK)
        v2, i2 = lax.top_k(s[:, :, 1], PEER_TOPK)
        cand = (v1[..., :, None] + v2[..., None, :]).reshape(PEER_BLOCK, PEER_HEADS, PEER_TOPK * PEER_TOPK)
        cidx = (i1[..., :, None] * PEER_NKEYS + i2[..., None, :]).reshape(PEER_BLOCK, PEER_HEADS, PEER_TOPK * PEER_TOPK)
        sc, pos = lax.top_k(cand, PEER_TOPK)
        eidx = jnp.take_along_axis(cidx, pos, axis=-1)
        g = jax.nn.softmax(sc, axis=-1)
        u_sel = expert_u[eidx]
        a = jax.nn.gelu(jnp.einsum('nd,nhkd->nhk', xb, u_sel), approximate=False)
        wgt = (g * a.astype(jnp.float32)).astype(xb.dtype)
        return jnp.einsum('nhk,nhkd->nd', wgt, expert_v[eidx])

    return lax.map(block, hb).reshape(B, T, D)


def setup_inputs(seed: int = 0) -> dict:
    key = jax.random.key(seed)
    ks = jax.random.split(key, 24)
    f32 = jnp.float32
    L, D = DEPTH, D_MODEL

    def nrm(k, shape, scale):
        return jax.random.normal(k, shape, f32) * scale

    def gain(k, shape):
        return 1.0 + 0.02 * jax.random.normal(k, shape, f32)

    x = nrm(ks[0], (BATCH, SEQ, D), 1.0)
    c = nrm(ks[1], (BATCH, D), 1.0)
    offs = jax.random.randint(ks[2], (BATCH, 1), 0, 64, dtype=jnp.int32) * CHUNK
    positions = offs + jnp.arange(SEQ, dtype=jnp.int32)[None, :]
    return {
        'x': x,
        'c': c,
        'positions': positions,
        'w_ada': nrm(ks[3], (L, D, 6 * D), D ** -0.5),
        'b_ada': nrm(ks[4], (L, 6 * D), 0.01),
        'norm1_g': gain(ks[5], (L, D)),
        'w_in': nrm(ks[6], (L, D, IN_COLS), D ** -0.5),
        'diff_q_g': gain(ks[7], (L, HEAD_DIM)),
        'diff_k_g': gain(ks[8], (L, HEAD_DIM)),
        'diff_lam_q1': nrm(ks[9], (L, HEAD_DIM), 0.1),
        'diff_lam_k1': nrm(ks[10], (L, HEAD_DIM), 0.1),
        'diff_lam_q2': nrm(ks[11], (L, HEAD_DIM), 0.1),
        'diff_lam_k2': nrm(ks[12], (L, HEAD_DIM), 0.1),
        'diff_out_g': gain(ks[13], (L, 2 * HEAD_DIM)),
        'dsa_q_g': gain(ks[14], (L, HEAD_DIM)),
        'dsa_k_g': gain(ks[15], (L, HEAD_DIM)),
        'w_branch_a': nrm(ks[16], (L, DIFF_WIDTH, D), DIFF_WIDTH ** -0.5),
        'w_branch_b': nrm(ks[17], (L, DSA_WIDTH, D), DSA_WIDTH ** -0.5),
        'w_out': nrm(ks[18], (L, D, D), D ** -0.5),
        'norm2_g': gain(ks[19], (L, D)),
        'peer_w_q': nrm(ks[20], (L, D, PEER_HEADS * PEER_DKEY), D ** -0.5),
        'peer_sub_keys': nrm(ks[21], (L, PEER_HEADS, 2, PEER_NKEYS, PEER_DKEY // 2), (PEER_DKEY // 2) ** -0.5),
        'peer_u': nrm(ks[22], (L, PEER_EXPERTS, D), D ** -0.5),
        'peer_v': nrm(ks[23], (L, PEER_EXPERTS, D), PEER_HEADS ** -0.5),
    }


def reference(x, c, positions, w_ada, b_ada, norm1_g, w_in, diff_q_g, diff_k_g,
              diff_lam_q1, diff_lam_k1, diff_lam_q2, diff_lam_k2, diff_out_g,
              dsa_q_g, dsa_k_g, w_branch_a, w_branch_b, w_out, norm2_g,
              peer_w_q, peer_sub_keys, peer_u, peer_v):
    B, T, D = x.shape
    cos, sin = rope_cos_sin(positions, HEAD_DIM)
    offsets = np.cumsum(IN_SIZES)[:-1].tolist()
    for l in range(DEPTH):
        lambda_init = 0.8 - 0.6 * math.exp(-0.3 * l)
        mod = jax.nn.silu(c) @ w_ada[l] + b_ada[l]
        sh1, sc1, g1, sh2, sc2, g2 = jnp.split(mod, 6, axis=-1)

        h = rmsnorm(x, norm1_g[l]) * (1.0 + sc1[:, None, :]) + sh1[:, None, :]
        proj = h @ w_in[l]
        (dq, dk, dv, sq, sk, sv, iq, ik, iw, gates) = jnp.split(proj, offsets, axis=-1)

        dq = apply_rope(rmsnorm(dq.reshape(B, T, DIFF_HEADS * 2, HEAD_DIM), diff_q_g[l]), cos, sin)
        dk = apply_rope(rmsnorm(dk.reshape(B, T, DIFF_HEADS * 2, HEAD_DIM), diff_k_g[l]), cos, sin)
        lam = (jnp.exp(jnp.sum(diff_lam_q1[l] * diff_lam_k1[l]).astype(jnp.float32))
               - jnp.exp(jnp.sum(diff_lam_q2[l] * diff_lam_k2[l]).astype(jnp.float32))
               + lambda_init)
        o_a = diff_attention(dq.reshape(B, T, DIFF_HEADS, 2, HEAD_DIM),
                             dk.reshape(B, T, DIFF_HEADS, 2, HEAD_DIM),
                             dv.reshape(B, T, DIFF_HEADS, 2 * HEAD_DIM),
                             lam, diff_out_g[l], lambda_init)

        sq = apply_rope(rmsnorm(sq.reshape(B, T, DSA_HEADS, HEAD_DIM), dsa_q_g[l]), cos, sin)
        sk = apply_rope(rmsnorm(sk.reshape(B, T, 1, HEAD_DIM), dsa_k_g[l]), cos, sin)[:, :, 0]
        iq = apply_rope(iq.reshape(B, T, IDX_HEADS, HEAD_DIM), cos, sin)
        ik = apply_rope(ik.reshape(B, T, 1, HEAD_DIM), cos, sin)[:, :, 0]
        o_b = dsa_attention(sq, sk, sv, iq, ik, iw)

        gates = jax.nn.sigmoid(gates.reshape(B, T, N_BRANCH, D))
        merged = gates[:, :, 0] * (o_a @ w_branch_a[l]) + gates[:, :, 1] * (o_b @ w_branch_b[l])
        x = x + g1[:, None, :] * (merged @ w_out[l])

        h2 = rmsnorm(x, norm2_g[l]) * (1.0 + sc2[:, None, :]) + sh2[:, None, :]
        x = x + g2[:, None, :] * peer(h2, peer_w_q[l], peer_sub_keys[l], peer_u[l], peer_v[l])
    return x
```

```cpp
#include <hip/hip_runtime.h>
#include <hip/hip_cooperative_groups.h>
#include <cstdio>
#include <cstdint>
namespace cg = cooperative_groups;

#define LAS __attribute__((address_space(3)))
#define DI __device__ __forceinline__
typedef unsigned short bf16_t;
typedef short bf16x8 __attribute__((ext_vector_type(8)));
typedef short s16x4 __attribute__((ext_vector_type(4)));
typedef float f32x2 __attribute__((ext_vector_type(2)));
typedef float f32x4 __attribute__((ext_vector_type(4)));
typedef float f32x16 __attribute__((ext_vector_type(16)));
typedef unsigned u32x2 __attribute__((ext_vector_type(2)));
typedef unsigned u32x4 __attribute__((ext_vector_type(4)));
typedef __bf16 bf16x2_t __attribute__((ext_vector_type(2)));
typedef int i32x8 __attribute__((ext_vector_type(8)));

constexpr int NB = 32, NT = 2048, DM = 1024, NTOK = NB * NT;
constexpr int NPROJ = 4864;
constexpr int WIN_COLS = 4808;
constexpr float EPS = 1e-6f;
constexpr float QSCALE = 0.125f * 1.4426950408889634f;
constexpr float USCALE = 64.f, VSCALE = 4.f;
constexpr float LAMBDA_INIT = 0.2f;
constexpr int PQ_MODE = 2;
constexpr bool F8_PQ = (PQ_MODE == 1);
constexpr bool F8_BR = false;
constexpr bool U4 = true;
constexpr float U4_STEP = 0.0657f;
constexpr bool UD8 = true;
constexpr bool V4 = true;
constexpr float V4_S = 0.098f;
constexpr float V4_WSC = 64.f;
typedef _Float16 h16x2 __attribute__((ext_vector_type(2)));
typedef _Float16 h16x4 __attribute__((ext_vector_type(4)));
typedef _Float16 h16x8 __attribute__((ext_vector_type(8)));
constexpr bool BR8 = false;
constexpr float OA_MAX = 5.0f;
constexpr bool FUSE56 = true;
constexpr bool G8 = true;
constexpr int IN_MODE = 2;
constexpr unsigned IN8_MASK = 0x7FFFFu;
constexpr int N8_IN = __builtin_popcount(IN8_MASK), NB_IN = 19 - N8_IN;

constexpr size_t MiB = 1u << 20;
constexpr size_t WS_CTL = 0;
constexpr size_t WS_MOD = 1 * MiB;
constexpr size_t WS_COS = 2 * MiB;
constexpr size_t WS_SIN = 10 * MiB;
constexpr size_t WS_WIN = 18 * MiB;
constexpr size_t WS_WBA = 28 * MiB;
constexpr size_t WS_WBB = 29 * MiB;
constexpr size_t WS_WOUT = 30 * MiB;
constexpr size_t WS_WPQ = 32 * MiB;
constexpr size_t WS_SKB = 36 * MiB;
constexpr size_t WS_UB = 40 * MiB;
constexpr size_t WS_VB = 72 * MiB;
constexpr size_t WS_H = 104 * MiB;
constexpr size_t WS_QD = 232 * MiB;
constexpr size_t WS_KD = 296 * MiB;
constexpr size_t WS_VD = 360 * MiB;
constexpr size_t WS_QS = 424 * MiB;
constexpr size_t WS_QI = 488 * MiB;
constexpr size_t WS_KS = 552 * MiB;
constexpr size_t WS_VS = 560 * MiB;
constexpr size_t WS_KI = 568 * MiB;
constexpr size_t WS_WIDX = 576 * MiB;
constexpr size_t WS_G0 = 578 * MiB;
constexpr size_t WS_G1 = 706 * MiB;
constexpr size_t WS_BM = 834 * MiB;
constexpr size_t WS_OAB = 850 * MiB;
constexpr size_t WS_END = 978 * MiB;
constexpr size_t WS_MERGED = WS_QD;
constexpr size_t WS_QP = WS_VD;
constexpr size_t WS_EIDX = 616 * MiB;
constexpr size_t WS_GW = 648 * MiB;
constexpr size_t WS_PART = WS_QP;
constexpr size_t WS_WGT = WS_MERGED;
constexpr size_t WS_WIN8 = WS_WIN + (size_t)NB_IN * 256 * 1024 * 2;
constexpr size_t WS_HF8 = WS_OAB;
constexpr size_t WS_HS1 = WS_OAB + 64 * MiB;
constexpr size_t WS_HA4 = WS_H;
constexpr size_t WS_HB4 = WS_H + 32 * MiB;
constexpr size_t WS_OBS = WS_OAB + 96 * MiB;
constexpr size_t WS_MERGED8 = WS_VD;
constexpr size_t WS_H8 = 264 * MiB;
constexpr size_t WS_HS = 328 * MiB;
constexpr int CW_UMAX = 12288;
constexpr int CW_VMAX = 12289;
constexpr int CW_WMAX = 12296;
constexpr float ASC8 = 16.f, WTOP8 = 224.f;
static_assert(WS_QP + (size_t)NTOK * 2048 * 2 <= WS_EIDX, "ws map");
static_assert(WS_GW + (size_t)NTOK * 128 * 4 <= WS_BM, "ws map");

constexpr int LDS_BYTES = 163840;

DI unsigned f2bf(float f) { unsigned u = __builtin_bit_cast(unsigned, f); return (u + 0x7fffu + ((u >> 16) & 1u)) >> 16; }
DI unsigned pk2(float lo, float hi) { f32x2 v = {lo, hi}; bf16x2_t b = __builtin_convertvector(v, bf16x2_t); return __builtin_bit_cast(unsigned, b); }
DI float bflo(unsigned p) { return __builtin_bit_cast(float, p << 16); }
DI float bfhi(unsigned p) { return __builtin_bit_cast(float, p & 0xffff0000u); }
DI float wave_sum(float v) {
#pragma unroll
    for (int o = 1; o < 64; o <<= 1) v += __shfl_xor(v, o);
    return v;
}
DI float fexp2(float x) { return __builtin_amdgcn_exp2f(x); }
DI int rank_in(unsigned mask, int pn) { return __builtin_popcount(mask & ((1u << pn) - 1u)); }
DI int kth_in(unsigned mask, int k) { int pn = 0; for (int i = 0; i < 19; ++i) { if ((mask >> i) & 1u) { if (k == 0) pn = i; --k; } } return pn; }
DI unsigned pack_fp8x4(float a, float b, float c, float d) {
    a = __builtin_amdgcn_fmed3f(a, -448.f, 448.f); b = __builtin_amdgcn_fmed3f(b, -448.f, 448.f); c = __builtin_amdgcn_fmed3f(c, -448.f, 448.f); d = __builtin_amdgcn_fmed3f(d, -448.f, 448.f);
    int w = 0; w = __builtin_amdgcn_cvt_pk_fp8_f32(a, b, w, false); w = __builtin_amdgcn_cvt_pk_fp8_f32(c, d, w, true); return (unsigned)w;
}

struct KArgs {
    const float* x; const float* c; const int* pos; const float* w_ada; const float* b_ada; const float* norm1_g; const float* w_in;
    const float* diff_q_g; const float* diff_k_g; const float* lq1; const float* lk1; const float* lq2; const float* lk2; const float* diff_out_g;
    const float* dsa_q_g; const float* dsa_k_g; const float* w_ba; const float* w_bb; const float* w_out; const float* norm2_g;
    const float* peer_wq; const float* sub_keys; const float* peer_u; const float* peer_v;
    float* out; unsigned char* ws; int ph_lo, ph_hi;
};
namespace pg8 {
#define PG8_LAS __attribute__((address_space(3)))
typedef unsigned short bf16_t;
typedef short bf16x8 __attribute__((ext_vector_type(8)));
typedef float f32x4 __attribute__((ext_vector_type(4)));
typedef unsigned u32x4 __attribute__((ext_vector_type(4)));
typedef int i32x8_t __attribute__((ext_vector_type(8)));
constexpr int BM = 256, BK = 64, HALF = 128, HTB = HALF * BK * 2  , STAGE_BYTES = 8 * HTB, NXCD = 8, WGM = 8;

__host__ __device__ __forceinline__ int lds_byte(int r, int c) { const int st = (r >> 4) * 2 + (c >> 5), rr = r & 15, cc = c & 31, ob = rr * 64 + cc * 2; return st * 1024 + (ob ^ (((ob >> 9) & 1) << 5)); }
__host__ __device__ __forceinline__ void stage_rc(int b, int& R, int& C) { const int st = b / 1024, sb = b % 1024, swz = sb ^ (((sb >> 9) & 1) << 5); R = (st >> 1) * 16 + swz / 64; C = (st & 1) * 32 + (swz % 64) / 2; }
__host__ __device__ __forceinline__ int perm32(int rho) { const int n = rho >> 4, i = rho & 15; return 8 * (i >> 2) + 4 * n + (i & 3); }

struct Unit { int pm, pn; };
struct Gemm { const bf16_t* A; const bf16_t* Bt; int M, N, K; };

struct StaticOrder {
    int nM, nN, nwg, G, c;
    __host__ __device__ void init(int M, int N, int G_, int c_) { nM = M / BM; nN = N / BM; nwg = nM * nN; G = G_; c = c_; }
    __host__ __device__ bool next(int i, Unit& u) const {
        const long L = (long)i * G + c; if (L >= nwg) return false;
        int wgid = (int)L; { const int q = nwg / NXCD, r = nwg % NXCD, xcd = wgid % NXCD, off = wgid / NXCD; wgid = (xcd < r ? xcd * (q + 1) : r * (q + 1) + (xcd - r) * q) + off; }
        const int nig = WGM * nN, gid = wgid / nig, fm = gid * WGM, gsz = (nM - fm) < WGM ? (nM - fm) : WGM;
        u.pm = fm + ((wgid % nig) % gsz); u.pn = (wgid % nig) / gsz; return true;
    }
    __device__ __forceinline__ void a_ready(const Unit&) const {}
    __device__ __forceinline__ void done(const Unit&) const {}
};

__device__ __forceinline__ unsigned cvt_pk_bf16(float lo, float hi) { unsigned r; asm volatile("v_cvt_pk_bf16_f32 %0, %1, %2" : "=v"(r) : "v"(lo), "v"(hi)); return r; }
template <class Epi, class Sched, bool ALIGN_EPI = false, bool SP2 = false, int QM = 0>
__device__ __forceinline__ void gemm_phase(PG8_LAS unsigned char* lds, const Gemm g, const Sched& S, const Epi& E) {
    constexpr bool F8 = (QM == 1);
    typedef int i32x4_t __attribute__((ext_vector_type(4)));
    const int tid = threadIdx.x, wid = __builtin_amdgcn_readfirstlane(tid >> 6), lane = tid & 63, wr = wid >> 2, wc = wid & 3, fr = lane & 15, fq = lane >> 4;
    const int K = g.K, nt = K / BK;
    unsigned voffA[2], voffB[2];
#pragma unroll
    for (int i = 0; i < 2; ++i) { int R, C; stage_rc(tid * 16 + i * 8192, R, C); const int Rb = Epi::PERM ? ((R & ~31) + perm32(R & 31)) : R;
        voffA[i] = (unsigned)(R * K + C) * 2u; voffB[i] = (unsigned)(Rb * K + C) * 2u; }
    const size_t kstep = (size_t)(BK * 2);
    const size_t hstep = (size_t)HALF * K * 2;
    const size_t tstep = 2 * hstep;
    const unsigned ldsw = (unsigned)wid * 1024u;
    const int aoff = lds_byte(wr * 64 + fr, fq * 8), boff = lds_byte(wc * 32 + fr, fq * 8);
#define PG8_SA(b, h) (((b) * 2 + (h)) * HTB)
#define PG8_SB(b, h) ((4 + (b) * 2 + (h)) * HTB)
#define PG8_STAGE(bufoff, gbase, voff) do { _Pragma("unroll") for (int _i = 0; _i < 2; ++_i) \
        __builtin_amdgcn_global_load_lds((const unsigned*)((const char*)(gbase) + (voff)[_i]), (PG8_LAS unsigned*)(lds + (bufoff) + ldsw + _i * 8192), 16, 0, 0); } while (0)
#define PG8_CAT2(x0, x1) __builtin_bit_cast(i32x8_t, __builtin_shufflevector((x0), (x1), 0, 1, 2, 3, 4, 5, 6, 7, 8, 9, 10, 11, 12, 13, 14, 15))
#define PG8_LDA(dst, b, h) do { _Pragma("unroll") for (int m = 0; m < 4; ++m) { const bf16x8 f0_ = *(const PG8_LAS bf16x8*)(lds + PG8_SA(b, h) + aoff + m * 2048), f1_ = *(const PG8_LAS bf16x8*)(lds + PG8_SA(b, h) + aoff + m * 2048 + 1024); \
        if constexpr (F8) dst##8[m] = PG8_CAT2(f0_, f1_); else { dst[m][0] = f0_; dst[m][1] = f1_; } } } while (0)
#define PG8_LDB(dst, b, h) do { _Pragma("unroll") for (int n = 0; n < 2; ++n) { const bf16x8 f0_ = *(const PG8_LAS bf16x8*)(lds + PG8_SB(b, h) + boff + n * 2048), f1_ = *(const PG8_LAS bf16x8*)(lds + PG8_SB(b, h) + boff + n * 2048 + 1024); \
        if constexpr (F8) dst##8[n] = PG8_CAT2(f0_, f1_); else { dst[n][0] = f0_; dst[n][1] = f1_; } } } while (0)
#define PG8_MMA(ai, bj, At, Bt) do { __builtin_amdgcn_s_setprio(1); _Pragma("unroll") for (int m = 0; m < 4; ++m) _Pragma("unroll") for (int n = 0; n < 2; ++n) { \
        if constexpr (F8) asm volatile("v_mfma_f32_16x16x128_f8f6f4 %0, %1, %2, %0" : "+v"(acc[ai][bj][m][n]) : "v"(Bt##8[n]), "v"(At##8[m])); \
        else if constexpr (QM == 2) { _Pragma("unroll") for (int k = 0; k < 2; ++k) acc[ai][bj][m][n] = __builtin_bit_cast(f32x4, __builtin_amdgcn_mfma_i32_16x16x64_i8(__builtin_bit_cast(i32x4_t, Bt[n][k]), __builtin_bit_cast(i32x4_t, At[m][k]), __builtin_bit_cast(i32x4_t, acc[ai][bj][m][n]), 0, 0, 0)); } \
        else { _Pragma("unroll") for (int k = 0; k < 2; ++k) acc[ai][bj][m][n] = __builtin_amdgcn_mfma_f32_16x16x32_bf16(Bt[n][k], At[m][k], acc[ai][bj][m][n], 0, 0, 0); } } __builtin_amdgcn_s_setprio(0); } while (0)
#define PG8_WAIT_V(n) asm volatile("s_waitcnt vmcnt(" #n ")" ::: "memory")
#define PG8_WAIT_L(n) asm volatile("s_waitcnt lgkmcnt(" #n ")" ::: "memory")
#define PG8_BAR __builtin_amdgcn_s_barrier()
#define PG8_SCHED __builtin_amdgcn_sched_barrier(0)
    Unit cur, nxt; int ui = 0;
    if (!S.next(0, cur)) return;
    f32x4 acc[2][2][4][2];
#pragma unroll
    for (int a = 0; a < 2; ++a)
#pragma unroll
        for (int b = 0; b < 2; ++b)
#pragma unroll
            for (int m = 0; m < 4; ++m)
#pragma unroll
                for (int n = 0; n < 2; ++n) acc[a][b][m][n] = (f32x4){0.f, 0.f, 0.f, 0.f};
    bf16x8 At[4][2], B0[2][2], B1[2][2]; i32x8_t At8[4], B08[2], B18[2];
    const char* cA = (const char*)g.A + (size_t)cur.pm * tstep; const char* cB = (const char*)g.Bt + (size_t)cur.pn * tstep;
    S.a_ready(cur);
    if constexpr (SP2) {
        PG8_STAGE(PG8_SB(0, 0), cB, voffB); PG8_STAGE(PG8_SB(0, 1), cB + hstep, voffB); PG8_STAGE(PG8_SA(0, 0), cA, voffA); PG8_STAGE(PG8_SA(0, 1), cA + hstep, voffA);
        if (wr == 1) PG8_BAR;
        PG8_WAIT_V(2); PG8_BAR;
        PG8_STAGE(PG8_SB(1, 0), cB + kstep, voffB); PG8_STAGE(PG8_SA(1, 0), cA + kstep, voffA); PG8_STAGE(PG8_SB(1, 1), cB + hstep + kstep, voffB);
        PG8_WAIT_V(6); PG8_BAR;
    } else {
        PG8_STAGE(PG8_SB(0, 0), cB, voffB); PG8_STAGE(PG8_SA(0, 0), cA, voffA); PG8_STAGE(PG8_SB(0, 1), cB + hstep, voffB); PG8_STAGE(PG8_SA(0, 1), cA + hstep, voffA);
        if (wr == 1) PG8_BAR;
        PG8_WAIT_V(4); PG8_BAR;
        PG8_STAGE(PG8_SB(1, 0), cB + kstep, voffB); PG8_STAGE(PG8_SA(1, 0), cA + kstep, voffA); PG8_STAGE(PG8_SB(1, 1), cB + hstep + kstep, voffB);
        PG8_WAIT_V(6); PG8_BAR;
    }
    for (;;) {
        const bool has_next = S.next(ui + 1, nxt);
        const char* nA = has_next ? (const char*)g.A + (size_t)nxt.pm * tstep : cA; const char* nB = has_next ? (const char*)g.Bt + (size_t)nxt.pn * tstep : cB;
#pragma unroll 1
        for (int t = 0; t < nt; t += 2) {
            if constexpr (Epi::MID) { if (t == nt / 2) E.mid(acc, cur, wr, wc, fr, fq); }
            const bool last = (t == nt - 2);
            const char* a1 = cA + (size_t)(t + 1) * kstep;
            const char* a2 = last ? nA : cA + (size_t)(t + 2) * kstep; const char* b2 = last ? nB : cB + (size_t)(t + 2) * kstep;
            const char* a3 = a2 + kstep; const char* b3 = b2 + kstep;
            if (last && has_next) S.a_ready(nxt);
            if constexpr (SP2) {
            PG8_LDB(B0, 0, 0); PG8_LDB(B1, 0, 1); PG8_SCHED; PG8_LDA(At, 0, 0); PG8_STAGE(PG8_SA(1, 1), a1 + hstep, voffA);
            PG8_WAIT_V(8); PG8_WAIT_L(0); PG8_BAR; PG8_MMA(0, 0, At, B0); PG8_MMA(0, 1, At, B1); PG8_BAR; PG8_SCHED;
            PG8_LDA(At, 0, 1); PG8_STAGE(PG8_SB(0, 0), b2, voffB); PG8_STAGE(PG8_SB(0, 1), b2 + hstep, voffB); PG8_STAGE(PG8_SA(0, 0), a2, voffA);
            PG8_WAIT_V(8); PG8_WAIT_L(0); PG8_BAR; PG8_MMA(1, 0, At, B0); PG8_MMA(1, 1, At, B1); PG8_BAR; PG8_SCHED;
            PG8_LDB(B0, 1, 0); PG8_LDB(B1, 1, 1); PG8_SCHED; PG8_LDA(At, 1, 0); PG8_STAGE(PG8_SA(0, 1), a2 + hstep, voffA);
            PG8_WAIT_V(8); PG8_WAIT_L(0); PG8_BAR; PG8_MMA(0, 0, At, B0); PG8_MMA(0, 1, At, B1); PG8_BAR; PG8_SCHED;
            PG8_LDA(At, 1, 1); PG8_STAGE(PG8_SB(1, 0), b3, voffB); PG8_STAGE(PG8_SB(1, 1), b3 + hstep, voffB); PG8_STAGE(PG8_SA(1, 0), a3, voffA);
            PG8_WAIT_V(8); PG8_WAIT_L(0); PG8_BAR; PG8_MMA(1, 0, At, B0); PG8_MMA(1, 1, At, B1); PG8_BAR; PG8_SCHED;
            } else {
            PG8_LDB(B0, 0, 0); PG8_SCHED; PG8_LDA(At, 0, 0); PG8_STAGE(PG8_SA(1, 1), a1 + hstep, voffA);
            PG8_WAIT_L(8); PG8_BAR; PG8_WAIT_L(0); PG8_MMA(0, 0, At, B0); PG8_BAR; PG8_SCHED;
            PG8_LDB(B1, 0, 1); PG8_STAGE(PG8_SB(0, 0), b2, voffB);
            PG8_BAR; PG8_WAIT_L(0); PG8_MMA(0, 1, At, B1); PG8_BAR;
            PG8_LDA(At, 0, 1); PG8_STAGE(PG8_SA(0, 0), a2, voffA);
            PG8_BAR; PG8_WAIT_L(0); PG8_MMA(1, 0, At, B0); PG8_BAR; PG8_SCHED;
            PG8_STAGE(PG8_SB(0, 1), b2 + hstep, voffB);
            PG8_WAIT_V(6); PG8_BAR; PG8_MMA(1, 1, At, B1); PG8_BAR;
            PG8_LDB(B0, 1, 0); PG8_SCHED; PG8_LDA(At, 1, 0); PG8_STAGE(PG8_SA(0, 1), a2 + hstep, voffA);
            PG8_WAIT_L(8); PG8_BAR; PG8_WAIT_L(0); PG8_MMA(0, 0, At, B0); PG8_BAR; PG8_SCHED;
            PG8_LDB(B1, 1, 1); PG8_STAGE(PG8_SB(1, 0), b3, voffB);
            PG8_BAR; PG8_WAIT_L(0); PG8_MMA(0, 1, At, B1); PG8_BAR;
            PG8_LDA(At, 1, 1); PG8_STAGE(PG8_SA(1, 0), a3, voffA);
            PG8_BAR; PG8_WAIT_L(0); PG8_MMA(1, 0, At, B0); PG8_BAR; PG8_SCHED;
            PG8_STAGE(PG8_SB(1, 1), b3 + hstep, voffB);
            PG8_WAIT_V(6); PG8_BAR; PG8_MMA(1, 1, At, B1); PG8_BAR;
            }
        }
        if constexpr (ALIGN_EPI) { if (wr == 0) PG8_BAR; }
        if constexpr (F8) asm volatile("s_nop 15\n\ts_nop 15\n\ts_nop 15");
        if constexpr (!Epi::AFTER_DRAIN) { E(acc, cur, wr, wc, fr, fq); S.done(cur); }
        if (!has_next) break;
#pragma unroll
        for (int a = 0; a < 2; ++a)
#pragma unroll
            for (int b = 0; b < 2; ++b)
#pragma unroll
                for (int m = 0; m < 4; ++m)
#pragma unroll
                    for (int n = 0; n < 2; ++n) acc[a][b][m][n] = (f32x4){0.f, 0.f, 0.f, 0.f};
        cur = nxt; cA = nA; cB = nB; ++ui;
        if constexpr (ALIGN_EPI) { if (wr == 1) PG8_BAR; }
    }
    PG8_WAIT_V(0);
    if constexpr (!ALIGN_EPI) { if (wr == 0) PG8_BAR; }
    PG8_BAR;
    if constexpr (Epi::AFTER_DRAIN) { E.fused(acc, cur, wr, wc, fr, fq, lds, wid, lane); S.done(cur); }
#undef PG8_SA
#undef PG8_SB
#undef PG8_STAGE
#undef PG8_LDA
#undef PG8_LDB
#undef PG8_MMA
#undef PG8_CAT2
#undef PG8_WAIT_V
#undef PG8_WAIT_L
#undef PG8_BAR
#undef PG8_SCHED
}
}
DI int proj_group_base(int g) {
    if (g < 8) return 64 * g;
    if (g < 16) return 512 + 64 * (g - 8);
    if (g < 24) return 1024 + 64 * (g - 16);
    if (g < 32) return 1536 + 64 * (g - 24);
    if (g < 40) return 2176 + 64 * (g - 32);
    if (g == 40) return 2048;
    if (g == 41) return 2112;
    if (g == 42) return 2688;
    if (g == 43) return 2752;
    if (g < 60) return 2760 + 64 * (g - 44);
    return 3784 + 64 * (g - 60);
}

template <int QM> struct EpiProjT {
    static constexpr bool PERM = true, AFTER_DRAIN = false, MID = false;
    bf16_t *Qd, *Kd, *Vd, *Qs, *Qi, *Ks, *Vs, *Ki, *G0, *G1; float* Widx;
    const float *cosT, *sinT;
    const float *gq, *gk, *gsq, *gsk;
    const unsigned* wm;
    const float* rs;
    __device__ __forceinline__ void operator()(const pg8::f32x4 (&acc)[2][2][4][2], const pg8::Unit& u, int wr, int wc, int fr_, int fq_) const {
        int fr = fr_, fq = fq_; asm volatile("" : "+v"(fr), "+v"(fq));
        const int g = kth_in(QM ? IN8_MASK : (~IN8_MASK & 0x7FFFFu), u.pn) * 4 + wc;
        const float asc = QM == 1 ? __builtin_bit_cast(float, *wm) * (1.f / (ASC8 * WTOP8)) : QM == 2 ? __builtin_bit_cast(float, *wm) * (1.f / 127.f) : 1.f;
        int kind; bf16_t* dst = nullptr; int ld = 512, col = 0; const float* gn = nullptr; float scale = 1.f;
        if (g < 8) { kind = 1; dst = Qd; col = 64 * g; gn = gq; scale = QSCALE; }
        else if (g < 16) { kind = 1; dst = Kd; col = 64 * (g - 8); gn = gk; }
        else if (g < 24) { kind = 0; dst = Vd; col = 64 * (g - 16); }
        else if (g < 32) { kind = 1; dst = Qs; col = 64 * (g - 24); gn = gsq; scale = QSCALE; }
        else if (g < 40) { kind = 2; dst = Qi; col = 64 * (g - 32); }
        else if (g == 40) { kind = 1; dst = Ks; ld = 64; gn = gsk; }
        else if (g == 41) { kind = 0; dst = Vs; ld = 64; }
        else if (g == 42) { kind = 2; dst = Ki; ld = 64; }
        else if (g == 43) { kind = 4; }
        else if (g < 60) { kind = 3; dst = G0; ld = 1024; col = 64 * (g - 44); }
        else { kind = 3; dst = G1; ld = 1024; col = 64 * (g - 60); }
        float gv[16];
#pragma unroll
        for (int i = 0; i < 16; ++i) gv[i] = 1.f;
        if (kind == 1) {
#pragma unroll
            for (int i = 0; i < 8; ++i) { gv[i] = gn[8 * fq + i]; gv[8 + i] = gn[32 + 8 * fq + i]; }
        }
        float rs_n = (QM == 2) ? rs[u.pm * 256 + wr * 64 + fr] : 1.f;
        f32x4 tcs[2][4];
        const bool roped = (kind == 1 || kind == 2);
#define EPI_LDTAB(i_) do { const size_t r_ = (size_t)(u.pm * 256 + ((i_) >> 2) * 128 + wr * 64 + ((i_) & 3) * 16 + fr) * 32 + 8 * fq; \
            tcs[(i_) & 1][0] = *(const f32x4*)(cosT + r_); tcs[(i_) & 1][1] = *(const f32x4*)(cosT + r_ + 4); tcs[(i_) & 1][2] = *(const f32x4*)(sinT + r_); tcs[(i_) & 1][3] = *(const f32x4*)(sinT + r_ + 4); } while (0)
        if (roped) EPI_LDTAB(0);
#define EPI_ROWS(KIND_) do { \
_Pragma("unroll") \
        for (int ai = 0; ai < 2; ++ai) \
_Pragma("unroll") \
            for (int m = 0; m < 4; ++m) { \
                const int row = u.pm * 256 + ai * 128 + wr * 64 + m * 16 + fr; \
                if ((KIND_ == 1 || KIND_ == 2) && ai * 4 + m + 1 < 8) EPI_LDTAB(ai * 4 + m + 1); \
                const float rs_c = rs_n; if (QM == 2 && ai * 4 + m + 1 < 8) rs_n = rs[u.pm * 256 + ((ai * 4 + m + 1) >> 2) * 128 + wr * 64 + ((ai * 4 + m + 1) & 3) * 16 + fr]; (void)rs_c; \
                float v[16]; \
_Pragma("unroll") \
                for (int i = 0; i < 8; ++i) { v[i] = acc[ai][0][m][i >> 2][i & 3]; v[8 + i] = acc[ai][1][m][i >> 2][i & 3]; if (QM == 1) { v[i] *= asc; v[8 + i] *= asc; } } \
                if (QM == 2) { \
                    const float rsc = rs_c * asc; \
_Pragma("unroll") \
                    for (int i = 0; i < 16; ++i) v[i] = (float)__builtin_bit_cast(int, v[i]) * rsc; \
                } \
                if (KIND_ == 1) { \
                    float ss = 0.f; \
_Pragma("unroll") \
                    for (int i = 0; i < 16; ++i) ss += v[i] * v[i]; \
                    ss += __shfl_xor(ss, 16); ss += __shfl_xor(ss, 32); \
                    const float rn = __builtin_amdgcn_rsqf(ss * (1.f / 64.f) + EPS); \
_Pragma("unroll") \
                    for (int i = 0; i < 16; ++i) v[i] = v[i] * rn * gv[i]; \
                } \
                if (KIND_ == 1 || KIND_ == 2) { \
                    const f32x4 c0 = tcs[(ai * 4 + m) & 1][0], c1 = tcs[(ai * 4 + m) & 1][1], s0 = tcs[(ai * 4 + m) & 1][2], s1 = tcs[(ai * 4 + m) & 1][3]; \
_Pragma("unroll") \
                    for (int i = 0; i < 8; ++i) { \
                        const float cc = (i < 4) ? c0[i & 3] : c1[i & 3], sn = (i < 4) ? s0[i & 3] : s1[i & 3]; \
                        const float x1 = v[i], x2 = v[8 + i]; \
                        v[i] = (x1 * cc - x2 * sn) * scale; v[8 + i] = (x2 * cc + x1 * sn) * scale; \
                    } \
                } \
                if (KIND_ == 3) { \
_Pragma("unroll") \
                    for (int i = 0; i < 16; ++i) v[i] = G8 ? __builtin_amdgcn_rcpf(__builtin_fmaf(__builtin_amdgcn_exp2f(v[i] * -1.4426950408889634f), 1.f / 255.f, 1.f / 255.f)) \
                                                           : __builtin_amdgcn_rcpf(1.f + __builtin_amdgcn_exp2f(v[i] * -1.4426950408889634f)); \
                } \
                if (KIND_ == 4) { \
                    if (fq == 0) { \
                        *(f32x4*)(Widx + (size_t)row * 8) = (f32x4){v[0], v[1], v[2], v[3]}; \
                        *(f32x4*)(Widx + (size_t)row * 8 + 4) = (f32x4){v[4], v[5], v[6], v[7]}; \
                    } \
                } else if (KIND_ == 3 && G8) { \
                    unsigned b[4] = {0u, 0u, 0u, 0u}; \
_Pragma("unroll") \
                    for (int i = 0; i < 16; ++i) b[i >> 2] = __builtin_amdgcn_cvt_pk_u8_f32(__builtin_rintf(v[i]), i & 3, b[i >> 2]); \
                    unsigned char* p = (unsigned char*)dst + (size_t)row * ld + col + 8 * fq; \
                    *(u32x2*)p = (u32x2){b[0], b[1]}; *(u32x2*)(p + 32) = (u32x2){b[2], b[3]}; \
                } else { \
                    u32x4 w0, w1; \
                    w0.x = pk2(v[0], v[1]); w0.y = pk2(v[2], v[3]); w0.z = pk2(v[4], v[5]); w0.w = pk2(v[6], v[7]); \
                    w1.x = pk2(v[8], v[9]); w1.y = pk2(v[10], v[11]); w1.z = pk2(v[12], v[13]); w1.w = pk2(v[14], v[15]); \
                    bf16_t* p = dst + (size_t)row * ld + col + 8 * fq; \
                    *(u32x4*)p = w0; *(u32x4*)(p + 32) = w1; \
                } \
                asm volatile("" ::: "memory"); __builtin_amdgcn_sched_barrier(0); \
            } \
        } while (0)
        switch (kind) { case 0: EPI_ROWS(0); break; case 1: EPI_ROWS(1); break; case 2: EPI_ROWS(2); break; case 3: EPI_ROWS(3); break; default: EPI_ROWS(4); break; }
#undef EPI_ROWS
#undef EPI_LDTAB
    }
};

template <int MODE> struct EpiGate {
    static constexpr bool PERM = true, AFTER_DRAIN = false, MID = false;
    const bf16_t* G; bf16_t* O; const unsigned* wm; unsigned char* O8; const float* rs;
    __device__ __forceinline__ void operator()(const pg8::f32x4 (&acc)[2][2][4][2], const pg8::Unit& u, int wr, int wc, int fr, int fq) const {
        const int row0 = u.pm * 256 + wr * 64 + fr, col0 = u.pn * 256 + wc * 32 + 8 * fq;
        const float sc = F8_BR ? __builtin_bit_cast(float, *wm) * (1.f / (ASC8 * WTOP8)) : 1.f;
#pragma unroll
        for (int ai = 0; ai < 2; ++ai)
#pragma unroll
            for (int m = 0; m < 4; ++m)
#pragma unroll
                for (int bj = 0; bj < 2; ++bj) {
                    const size_t off = (size_t)(row0 + ai * 128 + m * 16) * 1024 + col0 + bj * 128;
                    float r[8];
                    pg8::f32x4 c0 = acc[ai][bj][m][0], c1 = acc[ai][bj][m][1];
                    float scr = sc;
                    if (BR8 && !F8_BR) {
                        typedef int i32x4 __attribute__((ext_vector_type(4)));
                        const i32x4 i0 = __builtin_bit_cast(i32x4, c0), i1 = __builtin_bit_cast(i32x4, c1);
                        c0 = (pg8::f32x4){(float)i0[0], (float)i0[1], (float)i0[2], (float)i0[3]}; c1 = (pg8::f32x4){(float)i1[0], (float)i1[1], (float)i1[2], (float)i1[3]};
                        scr = (rs ? rs[row0 + ai * 128 + m * 16] : OA_MAX * (1.f / 127.f)) * (__builtin_bit_cast(float, *wm) * (1.f / 127.f));
                    }
                    if (G8) {
                        const u32x2 gb = *(const u32x2*)((const unsigned char*)G + off);
                        const pg8::f32x4 a0 = c0 * (scr * (1.f / 255.f)), a1 = c1 * (scr * (1.f / 255.f));
                        r[0] = (float)(gb.x & 255u) * a0[0]; r[1] = (float)((gb.x >> 8) & 255u) * a0[1]; r[2] = (float)((gb.x >> 16) & 255u) * a0[2]; r[3] = (float)(gb.x >> 24) * a0[3];
                        r[4] = (float)(gb.y & 255u) * a1[0]; r[5] = (float)((gb.y >> 8) & 255u) * a1[1]; r[6] = (float)((gb.y >> 16) & 255u) * a1[2]; r[7] = (float)(gb.y >> 24) * a1[3];
                    } else {
                    const u32x4 gw = *(const u32x4*)(G + off);
                    const pg8::f32x4 a0 = c0 * scr, a1 = c1 * scr;
                    r[0] = bflo(gw.x) * a0[0]; r[1] = bfhi(gw.x) * a0[1]; r[2] = bflo(gw.y) * a0[2]; r[3] = bfhi(gw.y) * a0[3];
                    r[4] = bflo(gw.z) * a1[0]; r[5] = bfhi(gw.z) * a1[1]; r[6] = bflo(gw.w) * a1[2]; r[7] = bfhi(gw.w) * a1[3];
                    }
                    if (MODE == 1) {
                        const u32x4 ow = *(const u32x4*)(O + off);
                        r[0] += bflo(ow.x); r[1] += bfhi(ow.x); r[2] += bflo(ow.y); r[3] += bfhi(ow.y);
                        r[4] += bflo(ow.z); r[5] += bfhi(ow.z); r[6] += bflo(ow.w); r[7] += bfhi(ow.w);
                    }
                    if (MODE == 1 && F8_BR) {
                        u32x2 w8; w8.x = pack_fp8x4(r[0] * ASC8, r[1] * ASC8, r[2] * ASC8, r[3] * ASC8); w8.y = pack_fp8x4(r[4] * ASC8, r[5] * ASC8, r[6] * ASC8, r[7] * ASC8);
                        *(u32x2*)(O8 + off) = w8;
                    } else {
                        u32x4 w; w.x = pk2(r[0], r[1]); w.y = pk2(r[2], r[3]); w.z = pk2(r[4], r[5]); w.w = pk2(r[6], r[7]);
                        *(u32x4*)(O + off) = w;
                    }
                }
    }
};

struct EpiMerged {
    static constexpr bool PERM = true, AFTER_DRAIN = false, MID = true;
    const unsigned char* G0; const unsigned char* G1; bf16_t* O;
    __device__ __forceinline__ void mid(pg8::f32x4 (&acc)[2][2][4][2], const pg8::Unit& u, int wr, int wc, int fr, int fq) const {
        int frl = fr; asm volatile("" : "+v"(frl));
        const int row0 = u.pm * 256 + wr * 64 + frl, col0 = u.pn * 256 + wc * 32 + 8 * fq;
        u32x2 gq[2][2];
#define EPI_LDG(i_) do { const unsigned o_ = (unsigned)(row0 + ((i_) >> 3) * 128 + (((i_) >> 1) & 3) * 16) * 1024u + (unsigned)(col0 + ((i_) & 1) * 128); \
            gq[(i_) & 1][0] = *(const u32x2*)(G0 + o_); gq[(i_) & 1][1] = *(const u32x2*)(G1 + o_); } while (0)
        EPI_LDG(0);
#pragma unroll
        for (int ai = 0; ai < 2; ++ai)
#pragma unroll
            for (int m = 0; m < 4; ++m)
#pragma unroll
                for (int bj = 0; bj < 2; ++bj) {
                    if (ai * 8 + m * 2 + bj + 1 < 16) EPI_LDG(ai * 8 + m * 2 + bj + 1);
                    const u32x2 ga = gq[(ai * 8 + m * 2 + bj) & 1][0], gb = gq[(ai * 8 + m * 2 + bj) & 1][1];
#pragma unroll
                    for (int e = 0; e < 8; ++e) {
                        const unsigned wa = e < 4 ? ga.x : ga.y, wb = e < 4 ? gb.x : gb.y;
                        const float g0 = (float)((wa >> (8 * (e & 3))) & 255u), g1 = fmaxf((float)((wb >> (8 * (e & 3))) & 255u), 1.f);
                        acc[ai][bj][m][e >> 2][e & 3] *= g0 * __builtin_amdgcn_rcpf(g1);
                    }
                    asm volatile("" ::: "memory");
                    __builtin_amdgcn_sched_barrier(0);
                }
#undef EPI_LDG
    }
    __device__ __forceinline__ void operator()(const pg8::f32x4 (&acc)[2][2][4][2], const pg8::Unit& u, int wr, int wc, int fr, int fq) const {
        const int row0 = u.pm * 256 + wr * 64 + fr, col0 = u.pn * 256 + wc * 32 + 8 * fq;
        u32x2 gq[2][2];
#define EPI_LDG1(i_) do { _Pragma("unroll") for (int bj = 0; bj < 2; ++bj) gq[(i_) & 1][bj] = *(const u32x2*)(G1 + (size_t)(row0 + ((i_) >> 2) * 128 + ((i_) & 3) * 16) * 1024 + col0 + bj * 128); } while (0)
        EPI_LDG1(0);
#pragma unroll
        for (int ai = 0; ai < 2; ++ai)
#pragma unroll
            for (int m = 0; m < 4; ++m) {
                if (ai * 4 + m + 1 < 8) EPI_LDG1(ai * 4 + m + 1);
#pragma unroll
                for (int bj = 0; bj < 2; ++bj) {
                    const size_t off = (size_t)(row0 + ai * 128 + m * 16) * 1024 + col0 + bj * 128;
                    const u32x2 gb = gq[(ai * 4 + m) & 1][bj];
                    float r[8];
#pragma unroll
                    for (int e = 0; e < 8; ++e) {
                        const unsigned wb = e < 4 ? gb.x : gb.y;
                        r[e] = acc[ai][bj][m][e >> 2][e & 3] * (fmaxf((float)((wb >> (8 * (e & 3))) & 255u), 1.f) * (1.f / 255.f));
                    }
                    u32x4 w; w.x = pk2(r[0], r[1]); w.y = pk2(r[2], r[3]); w.z = pk2(r[4], r[5]); w.w = pk2(r[6], r[7]);
                    *(u32x4*)(O + off) = w;
                }
            }
#undef EPI_LDG1
    }
};

struct EpiResid {
    static constexpr bool PERM = false, AFTER_DRAIN = false, MID = false;
    const float* x; const float* mod; float* out; float sc;
    __device__ __forceinline__ void operator()(const pg8::f32x4 (&acc)[2][2][4][2], const pg8::Unit& u, int wr, int wc, int fr, int fq) const {
        const int b = u.pm >> 3; const float* g1 = mod + (size_t)b * 6144 + 2048;
        const int row0 = u.pm * 256 + wr * 64 + fr, col0 = u.pn * 256 + wc * 32 + 4 * fq;
        pg8::f32x4 gv[2][2];
#pragma unroll
        for (int bj = 0; bj < 2; ++bj)
#pragma unroll
            for (int n = 0; n < 2; ++n) gv[bj][n] = *(const pg8::f32x4*)(g1 + col0 + bj * 128 + n * 16) * sc;
        pg8::f32x4 xq[2][4];
#define EPI_LDX(i_) do { _Pragma("unroll") for (int bj = 0; bj < 2; ++bj) _Pragma("unroll") for (int n = 0; n < 2; ++n) \
            xq[(i_) & 1][bj * 2 + n] = *(const pg8::f32x4*)(x + (size_t)(row0 + ((i_) >> 2) * 128 + ((i_) & 3) * 16) * 1024 + col0 + bj * 128 + n * 16); } while (0)
        EPI_LDX(0);
#pragma unroll
        for (int ai = 0; ai < 2; ++ai)
#pragma unroll
            for (int m = 0; m < 4; ++m) {
                if (ai * 4 + m + 1 < 8) EPI_LDX(ai * 4 + m + 1);
#pragma unroll
                for (int bj = 0; bj < 2; ++bj)
#pragma unroll
                    for (int n = 0; n < 2; ++n) {
                        const size_t off = (size_t)(row0 + ai * 128 + m * 16) * 1024 + col0 + bj * 128 + n * 16;
                        *(pg8::f32x4*)(out + off) = xq[(ai * 4 + m) & 1][bj * 2 + n] + gv[bj][n] * acc[ai][bj][m][n];
                    }
            }
#undef EPI_LDX
    }
};

struct EpiPlain {
    static constexpr bool PERM = true, AFTER_DRAIN = false, MID = false;
    bf16_t* O; int ldc; float sc;
    __device__ __forceinline__ void operator()(const pg8::f32x4 (&acc)[2][2][4][2], const pg8::Unit& u, int wr, int wc, int fr, int fq) const {
        const int row0 = u.pm * 256 + wr * 64 + fr, col0 = u.pn * 256 + wc * 32 + 8 * fq;
#pragma unroll
        for (int ai = 0; ai < 2; ++ai)
#pragma unroll
            for (int m = 0; m < 4; ++m)
#pragma unroll
                for (int bj = 0; bj < 2; ++bj) {
                    const pg8::f32x4 a0 = acc[ai][bj][m][0] * sc, a1 = acc[ai][bj][m][1] * sc;
                    u32x4 w; w.x = pk2(a0[0], a0[1]); w.y = pk2(a0[2], a0[3]); w.z = pk2(a1[0], a1[1]); w.w = pk2(a1[2], a1[3]);
                    *(u32x4*)(O + (size_t)(row0 + ai * 128 + m * 16) * ldc + col0 + bj * 128) = w;
                }
    }
};

struct EpiPlainI8 {
    static constexpr bool PERM = true, AFTER_DRAIN = false, MID = false;
    bf16_t* O; int ldc; const float* rs; const unsigned* wm;
    __device__ __forceinline__ void operator()(const pg8::f32x4 (&acc)[2][2][4][2], const pg8::Unit& u, int wr, int wc, int fr, int fq) const {
        typedef int i32x4 __attribute__((ext_vector_type(4)));
        const int row0 = u.pm * 256 + wr * 64 + fr, col0 = u.pn * 256 + wc * 32 + 8 * fq;
        const float cs = __builtin_bit_cast(float, *wm) * (1.f / 127.f);
        float rsv[8];
#pragma unroll
        for (int i = 0; i < 8; ++i) rsv[i] = rs[row0 + (i >> 2) * 128 + (i & 3) * 16];
#pragma unroll
        for (int ai = 0; ai < 2; ++ai)
#pragma unroll
            for (int m = 0; m < 4; ++m) {
                const int row = row0 + ai * 128 + m * 16;
                const float sc = rsv[ai * 4 + m] * cs;
#pragma unroll
                for (int bj = 0; bj < 2; ++bj) {
                    const i32x4 i0 = __builtin_bit_cast(i32x4, acc[ai][bj][m][0]), i1 = __builtin_bit_cast(i32x4, acc[ai][bj][m][1]);
                    u32x4 w; w.x = pk2((float)i0[0] * sc, (float)i0[1] * sc); w.y = pk2((float)i0[2] * sc, (float)i0[3] * sc); w.z = pk2((float)i1[0] * sc, (float)i1[1] * sc); w.w = pk2((float)i1[2] * sc, (float)i1[3] * sc);
                    *(u32x4*)(O + (size_t)row * ldc + col0 + bj * 128) = w;
                }
            }
    }
};

struct EpiProbe {
    static constexpr bool PERM = true, AFTER_DRAIN = false, MID = false;
    bf16_t* O;
    __device__ __forceinline__ void operator()(const pg8::f32x4 (&acc)[2][2][4][2], const pg8::Unit& u, int wr, int wc, int fr, int fq) const {
        const int row0 = u.pm * 256 + wr * 64 + fr, col0 = wc * 32 + 8 * fq;
#pragma unroll
        for (int ai = 0; ai < 2; ++ai)
#pragma unroll
            for (int m = 0; m < 4; ++m)
#pragma unroll
                for (int bj = 0; bj < 2; ++bj) {
                    const pg8::f32x4 a0 = acc[ai][bj][m][0], a1 = acc[ai][bj][m][1];
                    u32x4 w; w.x = pk2(a0[0], a0[1]); w.y = pk2(a0[2], a0[3]); w.z = pk2(a1[0], a1[1]); w.w = pk2(a1[2], a1[3]);
                    *(u32x4*)(O + (size_t)(row0 + ai * 128 + m * 16) * 256 + col0 + bj * 128) = w;
                }
    }
};
#define XB_TMO      128
#define XB_XCNT(j)  (256  + 64 * (j))
#define XB_XSUB(j)  (1280 + 64 * (j))
#define XB_XGEN(j)  (2304 + 64 * (j))
#define XB_TOP      3328
#define XB_TOPGEN   3392
#define XCD_BAR_WORDS 3456
#define XB_SPIN_CAP (1u << 18)

__device__ __forceinline__ unsigned xb_ld(unsigned* p)              { return __hip_atomic_load(p, __ATOMIC_RELAXED, __HIP_MEMORY_SCOPE_AGENT); }
__device__ __forceinline__ unsigned xb_add(unsigned* p, unsigned v) { return __hip_atomic_fetch_add(p, v, __ATOMIC_RELAXED, __HIP_MEMORY_SCOPE_AGENT); }
__device__ __forceinline__ unsigned xb_xcc_id() { return (unsigned)__builtin_amdgcn_s_getreg((3 << 11) | 20) & 0xFu; }
#define XB_SPIN(cond, bar) do { unsigned _sp = 0; while (cond) { __builtin_amdgcn_s_sleep(1); \
    if ((++_sp & 255u) == 0u) { if (xb_ld(&(bar)[XB_TMO])) break; if (_sp > XB_SPIN_CAP) { atomicAdd(&(bar)[XB_TMO], 1u); break; } } } } while (0)

struct XcdBarrier {
    unsigned* bar; unsigned x;
    volatile LAS unsigned* st;
};

__device__ __forceinline__ XcdBarrier xcd_barrier_post(unsigned* bar, volatile LAS unsigned* st) {
    XcdBarrier b; b.bar = bar; b.x = xb_xcc_id(); b.st = st;
    if (threadIdx.x == 0) (void)xb_add(&bar[XB_XCNT(b.x)], 1u);
    return b;
}
__device__ __forceinline__ void xcd_barrier_complete(unsigned* bar, unsigned x, unsigned& nloc, unsigned& nx) {
    const unsigned G = gridDim.x * gridDim.y * gridDim.z;
    unsigned sum, cnt, mine, sp = 0u;
    for (;;) {
        sum = 0u; cnt = 0u; mine = 0u;
#pragma unroll
        for (unsigned j = 0; j < 16; ++j) { const unsigned c = xb_ld(&bar[XB_XCNT(j)]); sum += c; cnt += (c > 0u) ? 1u : 0u; mine = (j == x) ? c : mine; }
        if (sum == G) break;
        __builtin_amdgcn_s_sleep(1);
        if ((++sp & 255u) == 0u) { if (xb_ld(&bar[XB_TMO])) break; if (sp > XB_SPIN_CAP) { atomicAdd(&bar[XB_TMO], 1u); break; } }
    }
    nloc = mine > 0u ? mine : 1u; nx = cnt > 0u ? cnt : 1u;
}

__device__ __forceinline__ void xcd_barrier(const XcdBarrier& b) {
    asm volatile("s_waitcnt vmcnt(0)" ::: "memory");
    __syncthreads();
    if (threadIdx.x == 0) {
        unsigned* bar = b.bar;
        __builtin_amdgcn_s_waitcnt(0);
        unsigned nloc = b.st[0], nx = b.st[1];
        if (nloc == 0u) { xcd_barrier_complete(bar, b.x, nloc, nx); b.st[0] = nloc; b.st[1] = nx; }
        const unsigned old = xb_add(&bar[XB_XSUB(b.x)], 1u);
        const unsigned gen = old / nloc;
        if (old + 1u == (gen + 1u) * nloc) {
            __builtin_amdgcn_fence(__ATOMIC_RELEASE, "agent");
            asm volatile("s_waitcnt vmcnt(0)" ::: "memory");
            const unsigned og = xb_add(&bar[XB_TOP], 1u);
            const unsigned tg = og / nx;
            if (og + 1u == (tg + 1u) * nx) xb_add(&bar[XB_TOPGEN], 1u);
            else XB_SPIN(xb_ld(&bar[XB_TOPGEN]) == tg, bar);
            __builtin_amdgcn_fence(__ATOMIC_ACQUIRE, "agent");
            xb_add(&bar[XB_XGEN(b.x)], 1u);
            asm volatile("s_waitcnt vmcnt(0)" ::: "memory");
        } else {
            XB_SPIN(xb_ld(&bar[XB_XGEN(b.x)]) == gen, bar);
            __builtin_amdgcn_fence(__ATOMIC_ACQUIRE, "agent");
            asm volatile("s_waitcnt vmcnt(0)" ::: "memory");
        }
    }
    __syncthreads();
}
#define LDS_WAIT() asm volatile("s_waitcnt lgkmcnt(0)" ::: "memory")
#define VM_WAIT() asm volatile("s_waitcnt vmcnt(0)" ::: "memory")

DI void transpose_item(const float* W, int N, int K, bf16_t* WT, int prow0, int lcol0, int nvalid, int k0, LAS float* scr, int lane) {
    const int cl = lane & 31;
#pragma unroll 8
    for (int i = 0; i < 32; ++i) { const int kk = 2 * i + (lane >> 5); scr[kk * 33 + cl] = (cl < nvalid) ? W[(size_t)(k0 + kk) * N + lcol0 + cl] : 0.f; }
    LDS_WAIT();
    const int c = lane & 7;
#pragma unroll
    for (int j = 0; j < 4; ++j) {
        const int n = (lane >> 3) + 8 * j; const LAS float* s = scr + (8 * c) * 33 + n;
        u32x4 o; o.x = pk2(s[0 * 33], s[1 * 33]); o.y = pk2(s[2 * 33], s[3 * 33]); o.z = pk2(s[4 * 33], s[5 * 33]); o.w = pk2(s[6 * 33], s[7 * 33]);
        *(u32x4*)(WT + (size_t)(prow0 + n) * K + k0 + 8 * c) = o;
    }
    LDS_WAIT();
}

DI unsigned pack_i8x4(float a, float b, float c, float d) {
    const int ia = (int)__builtin_rintf(fminf(fmaxf(a, -127.f), 127.f)), ib = (int)__builtin_rintf(fminf(fmaxf(b, -127.f), 127.f));
    const int ic = (int)__builtin_rintf(fminf(fmaxf(c, -127.f), 127.f)), id = (int)__builtin_rintf(fminf(fmaxf(d, -127.f), 127.f));
    return (unsigned)(ia & 255) | ((unsigned)(ib & 255) << 8) | ((unsigned)(ic & 255) << 16) | ((unsigned)(id & 255) << 24);
}
template <bool INT8 = false>
DI void transpose_item8(const float* W, int N, int K, unsigned char* WT, int prow0, int lcol0, int nvalid, int k0, float scale, LAS float* scr, int lane) {
    const int cl = lane & 31;
#pragma unroll 8
    for (int i = 0; i < 32; ++i) { const int kk = 2 * i + (lane >> 5); scr[kk * 33 + cl] = (cl < nvalid) ? W[(size_t)(k0 + kk) * N + lcol0 + cl] * scale : 0.f; }
    LDS_WAIT();
    const int c = lane & 3;
#pragma unroll
    for (int j = 0; j < 2; ++j) {
        const int n = (lane >> 2) + 16 * j; const LAS float* s = scr + (16 * c) * 33 + n;
        u32x4 o;
#pragma unroll
        for (int q = 0; q < 4; ++q) o[q] = INT8 ? pack_i8x4(s[(4 * q) * 33], s[(4 * q + 1) * 33], s[(4 * q + 2) * 33], s[(4 * q + 3) * 33]) : pack_fp8x4(s[(4 * q) * 33], s[(4 * q + 1) * 33], s[(4 * q + 2) * 33], s[(4 * q + 3) * 33]);
        *(u32x4*)(WT + (size_t)(prow0 + n) * K + k0 + 16 * c) = o;
    }
    LDS_WAIT();
}
DI void absmax_to(const float* p, size_t n, unsigned* word, size_t gtid, size_t gth, int lane) {
    float mx = 0.f;
    for (size_t i = gtid * 4; i < n; i += gth * 16) {
        f32x4 v[4];
#pragma unroll
        for (int q = 0; q < 4; ++q) { const size_t j = i + (size_t)q * gth * 4; v[q] = (j < n) ? *(const f32x4*)(p + j) : (f32x4){0.f, 0.f, 0.f, 0.f}; }
#pragma unroll
        for (int q = 0; q < 4; ++q) mx = fmaxf(fmaxf(mx, fmaxf(fabsf(v[q][0]), fabsf(v[q][1]))), fmaxf(fabsf(v[q][2]), fabsf(v[q][3])));
    }
#pragma unroll
    for (int o = 1; o < 64; o <<= 1) mx = fmaxf(mx, __shfl_xor(mx, o));
    if (lane == 0 && mx > 0.f) atomicMax(word, __builtin_bit_cast(unsigned, mx));
}
DI float wscale8(const unsigned char* ws, int which) { return WTOP8 / fmaxf(__builtin_bit_cast(float, ((const unsigned*)(ws + WS_CTL))[CW_WMAX + which]), 1e-30f); }

DI void conv_bf16(const float* src, bf16_t* dst, size_t n, size_t gtid, size_t gthreads) {
    for (size_t i = gtid * 8; i < n; i += gthreads * 8) {
        const f32x4 a = *(const f32x4*)(src + i), b = *(const f32x4*)(src + i + 4);
        u32x4 o; o.x = pk2(a[0], a[1]); o.y = pk2(a[2], a[3]); o.z = pk2(b[0], b[1]); o.w = pk2(b[2], b[3]);
        *(u32x4*)(dst + i) = o;
    }
}

DI void conv_fp8(const float* src, unsigned char* dst, size_t n, float scale, size_t gtid, size_t gthreads) {
    for (size_t i = gtid * 16; i < n; i += gthreads * 16) {
        const size_t e = i >> 10, c = i & 1023;
        u32x4 o;
#pragma unroll
        for (int q = 0; q < 4; ++q) {
            const f32x4 v = *(const f32x4*)(src + i + 4 * q) * scale;
            int w = 0; w = __builtin_amdgcn_cvt_pk_fp8_f32(v[0], v[1], w, false); w = __builtin_amdgcn_cvt_pk_fp8_f32(v[2], v[3], w, true);
            o[q] = (unsigned)w;
        }
        *(u32x4*)(dst + ((c >> 7) * 16384 + e) * 128 + (c & 127)) = o;
    }
}

DI void conv_u_i8(const float* src, unsigned char* dst, float scale, size_t gtid, size_t gthreads) {
    for (size_t i0 = gtid * 16; i0 < (size_t)16384 * 1024; i0 += gthreads * 32) {
        f32x4 v[2][4];
#pragma unroll
        for (int h = 0; h < 2; ++h)
#pragma unroll
            for (int q = 0; q < 4; ++q) v[h][q] = *(const f32x4*)(src + i0 + (size_t)h * gthreads * 16 + 4 * q);
#pragma unroll
        for (int h = 0; h < 2; ++h) {
            const size_t i = i0 + (size_t)h * gthreads * 16, e = i >> 10, c = i & 1023;
            u32x4 o;
#pragma unroll
            for (int q = 0; q < 4; ++q) { const f32x4 w = v[h][q] * scale; o[q] = pack_i8x4(w[0], w[1], w[2], w[3]); }
            *(u32x4*)(dst + ((c >> 7) * 16384 + e) * 128 + (c & 127)) = o;
        }
    }
}

DI int q4(float x) { return (int)__builtin_rintf(fminf(fmaxf(x, -8.f), 7.f)) & 15; }
DI void conv_u_i4(const float* src, unsigned char* dst, float inv_step, size_t gtid, size_t gthreads) {
    for (size_t i = gtid * 32; i < (size_t)16384 * 1024; i += gthreads * 32) {
        f32x4 v[8];
#pragma unroll
        for (int q = 0; q < 8; ++q) v[q] = *(const f32x4*)(src + i + 4 * q) * inv_step;
        u32x4 o;
#pragma unroll
        for (int j = 0; j < 4; ++j) {
            unsigned w = 0;
#pragma unroll
            for (int b = 0; b < 4; ++b) {
                if (UD8) w |= (unsigned)(q4(v[2 * j + (b >> 1)][2 * (b & 1)]) | (q4(v[2 * j + (b >> 1)][2 * (b & 1) + 1]) << 4)) << (8 * b);
                else w |= (unsigned)(q4(v[j][b]) | (q4(v[4 + j][b]) << 4)) << (8 * b);
            }
            o[j] = w;
        }
        const size_t e = i >> 10, c = i & 1023;
        *(u32x4*)(dst + ((c >> 8) * 16384 + e) * 128 + ((c & 255) >> 1)) = o;
    }
}

DI void conv_v_fp4(const float* src, unsigned char* dst, float inv_s, size_t gtid, size_t gthreads) {
    for (size_t i = gtid * 32; i < (size_t)16384 * 1024; i += gthreads * 32) {
        u32x4 o;
#pragma unroll
        for (int j = 0; j < 4; ++j) {
            f32x4 p = *(const f32x4*)(src + i + 8 * j) * inv_s, q = *(const f32x4*)(src + i + 8 * j + 4) * inv_s;
#pragma unroll
            for (int k = 0; k < 4; ++k) { p[k] = __builtin_amdgcn_fmed3f(p[k], -6.f, 6.f); q[k] = __builtin_amdgcn_fmed3f(q[k], -6.f, 6.f); }
            unsigned w = 0;
            w = __builtin_amdgcn_cvt_scalef32_pk_fp4_f32(w, p[0], p[1], 1.0f, 0); w = __builtin_amdgcn_cvt_scalef32_pk_fp4_f32(w, p[2], p[3], 1.0f, 1);
            w = __builtin_amdgcn_cvt_scalef32_pk_fp4_f32(w, q[0], q[1], 1.0f, 2); w = __builtin_amdgcn_cvt_scalef32_pk_fp4_f32(w, q[2], q[3], 1.0f, 3);
            o[j] = w;
        }
        const size_t e = i >> 10, c = i & 1023;
        *(u32x4*)(dst + ((c >> 8) * 16384 + e) * 128 + ((c & 255) >> 1)) = o;
    }
}

DI void ph_prologue(const KArgs& a, LAS unsigned char* lds, int tid, int lane, int wave, int blk, int nblk) {
    unsigned char* ws = a.ws;
    const int gw = blk * 8 + wave, ngw = nblk * 8;
    if (blk < 192) {
        LAS float* sc = (LAS float*)lds;
        for (int i = tid; i < 32 * 1024; i += 512) { const int b = i >> 10, k = i & 1023; const float v = a.c[i]; sc[k * 36 + b] = v / (1.f + __expf(-v)); }
        __syncthreads();
        float acc[32];
#pragma unroll
        for (int b = 0; b < 32; ++b) acc[b] = 0.f;
        const int cl = lane & 31, kh = lane >> 5, col = blk * 32 + cl;
#pragma unroll 8
        for (int i = 0; i < 64; ++i) {
            const int k = wave * 128 + 2 * i + kh;
            const float wv = a.w_ada[(size_t)k * 6144 + col];
            const LAS f32x4* sp = (const LAS f32x4*)(sc + k * 36);
#pragma unroll
            for (int q = 0; q < 8; ++q) { const f32x4 s4 = sp[q]; acc[4 * q] += s4[0] * wv; acc[4 * q + 1] += s4[1] * wv; acc[4 * q + 2] += s4[2] * wv; acc[4 * q + 3] += s4[3] * wv; }
        }
        __syncthreads();
        LAS float* red = (LAS float*)lds;
#pragma unroll
        for (int b = 0; b < 32; ++b) red[((wave * 2 + kh) * 32 + b) * 32 + cl] = acc[b];
        __syncthreads();
        for (int o = tid; o < 1024; o += 512) {
            float s = 0.f;
#pragma unroll
            for (int p = 0; p < 16; ++p) s += red[p * 1024 + o];
            const int b = o >> 5, c2 = o & 31;
            ((float*)(ws + WS_MOD))[(size_t)b * 6144 + blk * 32 + c2] = s + a.b_ada[blk * 32 + c2];
        }
        __syncthreads();
    }
    {
        LAS float* scr = (LAS float*)(lds + wave * 8704);
        constexpr int I_WIN = 16 * 152, I_WB = 8 * 32, I_WO = 16 * 32, I_WPQ = 16 * 64;
        constexpr int NITEMS = I_WIN + 2 * I_WB + I_WO + I_WPQ;
        for (int it = gw; it < NITEMS; it += ngw) {
            int r = it;
            if (r < I_WIN) {
                const int pb = r % 152, kb = r / 152, pn = pb >> 3, bj = (pb >> 2) & 1, wc = pb & 3, g = pn * 4 + wc;
                const int nvalid = (g == 43) ? (bj == 0 ? 8 : 0) : 32;
                if (!((IN8_MASK >> pn) & 1u)) transpose_item(a.w_in, WIN_COLS, 1024, (bf16_t*)(ws + WS_WIN), rank_in(~IN8_MASK, pn) * 256 + (pb & 7) * 32, proj_group_base(g) + 32 * bj, nvalid, kb * 64, scr, lane);
                continue;
            }
            r -= I_WIN;
            if (r < I_WB) { if (!F8_BR && !BR8) transpose_item(a.w_ba, 1024, FUSE56 ? 1024 : 512, (bf16_t*)(ws + WS_WBA), (r % 32) * 32, (r % 32) * 32, 32, (r / 32) * 64, scr, lane); continue; }
            r -= I_WB;
            if (r < I_WB) { if (!F8_BR && !BR8) transpose_item(a.w_bb, 1024, FUSE56 ? 1024 : 512, FUSE56 ? (bf16_t*)(ws + WS_WBA) + 512 : (bf16_t*)(ws + WS_WBB), (r % 32) * 32, (r % 32) * 32, 32, (r / 32) * 64, scr, lane); continue; }
            r -= I_WB;
            if (r < I_WO) { if (!F8_BR) transpose_item(a.w_out, 1024, 1024, (bf16_t*)(ws + WS_WOUT), (r % 32) * 32, (r % 32) * 32, 32, (r / 32) * 64, scr, lane); continue; }
            r -= I_WO;
            if (PQ_MODE == 0) transpose_item(a.peer_wq, 2048, 1024, (bf16_t*)(ws + WS_WPQ), (r % 64) * 32, (r % 64) * 32, 32, (r / 64) * 64, scr, lane);
        }
    }
    {
        const size_t gtid = (size_t)blk * 512 + tid, gth = (size_t)nblk * 512;
        conv_bf16(a.sub_keys, (bf16_t*)(ws + WS_SKB), (size_t)8 * 2 * 128 * 128, gtid, gth);
        if (U4) absmax_to(a.peer_u, (size_t)1 << 21, (unsigned*)(ws + WS_CTL) + CW_UMAX, gtid, gth, lane);
        else {
            float mx = 0.f;
            for (size_t i = gtid * 4; i < (size_t)16384 * 1024; i += gth * 16) {
                f32x4 v[4];
#pragma unroll
                for (int q = 0; q < 4; ++q) v[q] = *(const f32x4*)(a.peer_u + i + (size_t)q * gth * 4);
#pragma unroll
                for (int q = 0; q < 4; ++q) mx = fmaxf(fmaxf(mx, fmaxf(fabsf(v[q][0]), fabsf(v[q][1]))), fmaxf(fabsf(v[q][2]), fabsf(v[q][3])));
            }
#pragma unroll
            for (int o = 1; o < 64; o <<= 1) mx = fmaxf(mx, __shfl_xor(mx, o));
            if (lane == 0) atomicMax((unsigned*)(ws + WS_CTL) + CW_UMAX, __builtin_bit_cast(unsigned, mx));
        }
        if (PQ_MODE != 0) absmax_to(a.peer_wq, (size_t)1024 * 2048, (unsigned*)(ws + WS_CTL) + CW_WMAX + 4, gtid, gth, lane);
        if (N8_IN > 0) absmax_to(a.w_in, (size_t)1024 * WIN_COLS, (unsigned*)(ws + WS_CTL) + CW_WMAX + 0, gtid, gth, lane);
        if (F8_BR || BR8) {
            absmax_to(a.w_ba, (size_t)512 * 1024, (unsigned*)(ws + WS_CTL) + CW_WMAX + 1, gtid, gth, lane);
            absmax_to(a.w_bb, (size_t)512 * 1024, (unsigned*)(ws + WS_CTL) + CW_WMAX + 2, gtid, gth, lane);
            if (F8_BR) absmax_to(a.w_out, (size_t)1024 * 1024, (unsigned*)(ws + WS_CTL) + CW_WMAX + 3, gtid, gth, lane);
        }
        if (V4) absmax_to(a.peer_v, (size_t)1 << 21, (unsigned*)(ws + WS_CTL) + CW_VMAX, gtid, gth, lane);
        else conv_fp8(a.peer_v, ws + WS_VB, (size_t)16384 * 1024, VSCALE, gtid, gth);
        for (size_t t = gtid; t < (size_t)NTOK * 2; t += gth) {
            const int m = (int)(t >> 1), half = (int)(t & 1);
            double f = half ? 0.15915494309189535 * 0.01 : 0.15915494309189535;
            const double p = (double)a.pos[m];
            float cs[16], sn[16];
#pragma unroll
            for (int k = 0; k < 16; ++k) {
                const double rev = p * f;
                const float fr = (float)(rev - __builtin_floor(rev)) * 6.283185307179586f;
                cs[k] = cosf(fr); sn[k] = sinf(fr);
                f *= 0.7498942093324559;
            }
            float* cp = (float*)(ws + WS_COS) + (size_t)m * 32 + 16 * half; float* sp = (float*)(ws + WS_SIN) + (size_t)m * 32 + 16 * half;
#pragma unroll
            for (int k = 0; k < 4; ++k) { *(f32x4*)(cp + 4 * k) = (f32x4){cs[4 * k], cs[4 * k + 1], cs[4 * k + 2], cs[4 * k + 3]}; *(f32x4*)(sp + 4 * k) = (f32x4){sn[4 * k], sn[4 * k + 1], sn[4 * k + 2], sn[4 * k + 3]}; }
        }
    }
}

DI void ph_weights8(const KArgs& a, LAS unsigned char* lds, int lane, int wave, int blk, int nblk) {
    unsigned char* ws = a.ws;
    const int gw = blk * 8 + wave, ngw = nblk * 8;
    LAS float* scr = (LAS float*)(lds + wave * 8704);
    if (PQ_MODE != 0) {
        const float spq = wscale8(ws, 4) * (PQ_MODE == 2 ? 127.f / WTOP8 : 1.f);
        for (int r = gw; r < 16 * 64; r += ngw) transpose_item8<PQ_MODE == 2>(a.peer_wq, 2048, 1024, ws + WS_WPQ, (r % 64) * 32, (r % 64) * 32, 32, (r / 64) * 64, spq, scr, lane);
    }
    if (N8_IN > 0) {
        const float si = wscale8(ws, 0) * (IN_MODE == 2 ? 127.f / WTOP8 : 1.f);
        for (int r = gw; r < 16 * 152; r += ngw) {
            const int pb = r % 152, kb = r / 152, pn = pb >> 3, bj = (pb >> 2) & 1, wc = pb & 3, g = pn * 4 + wc;
            if ((IN8_MASK >> pn) & 1u) transpose_item8<IN_MODE == 2>(a.w_in, WIN_COLS, 1024, ws + WS_WIN8, rank_in(IN8_MASK, pn) * 256 + (pb & 7) * 32, proj_group_base(g) + 32 * bj, (g == 43) ? (bj == 0 ? 8 : 0) : 32, kb * 64, si, scr, lane);
        }
    }
    if (BR8 && !F8_BR) {
        const float sa = wscale8(ws, 1) * (127.f / WTOP8), sb = wscale8(ws, 2) * (127.f / WTOP8);
        for (int it = gw; it < 2 * 256; it += ngw) {
            const int r = it & 255;
            if (it < 256) transpose_item8<true>(a.w_ba, 1024, 512, ws + WS_WBA, (r % 32) * 32, (r % 32) * 32, 32, (r / 32) * 64, sa, scr, lane);
            else transpose_item8<true>(a.w_bb, 1024, 512, ws + WS_WBB, (r % 32) * 32, (r % 32) * 32, 32, (r / 32) * 64, sb, scr, lane);
        }
    }
    if (F8_BR) {
        const float sa = wscale8(ws, 1), sb = wscale8(ws, 2), so = wscale8(ws, 3);
        for (int it = gw; it < 2 * 256 + 512; it += ngw) {
            int r = it;
            if (r < 256) { transpose_item8(a.w_ba, 1024, 512, ws + WS_WBA, (r % 32) * 32, (r % 32) * 32, 32, (r / 32) * 64, sa, scr, lane); continue; }
            r -= 256;
            if (r < 256) { transpose_item8(a.w_bb, 1024, 512, ws + WS_WBB, (r % 32) * 32, (r % 32) * 32, 32, (r / 32) * 64, sb, scr, lane); continue; }
            r -= 256;
            transpose_item8(a.w_out, 1024, 1024, ws + WS_WOUT, (r % 32) * 32, (r % 32) * 32, 32, (r / 32) * 64, so, scr, lane);
        }
    }
}

template <bool I8, bool WB16, bool WF8, bool NIB = false>
DI void ph_norm(const float* src, const float* gain, const float* mod, int sh_off, int sc_off, bf16_t* dst, unsigned char* dstf, unsigned char* dst8, float* hs, int lane, int wave, int blk, int nblk, unsigned char* ha = nullptr, unsigned char* hb = nullptr) {
    const int gw = blk * 8 + wave, ngw = nblk * 8;
    const int rows_per = NTOK / ngw;
    for (int r0 = gw * rows_per; r0 < NTOK; r0 += ngw * rows_per) {
        const int b = r0 / NT;
        f32x4 mul[4], add[4];
#pragma unroll
        for (int j = 0; j < 4; ++j) {
            const int col = 4 * lane + 256 * j;
            const f32x4 g = *(const f32x4*)(gain + col), s = *(const f32x4*)(mod + (size_t)b * 6144 + sc_off + col);
            mul[j] = g * (s + 1.f); add[j] = *(const f32x4*)(mod + (size_t)b * 6144 + sh_off + col);
        }
        f32x4 vn[4][4];
#pragma unroll
        for (int q = 0; q < 4; ++q) {
            const f32x4* xr = (const f32x4*)(src + (size_t)(r0 + q) * 1024) + lane;
#pragma unroll
            for (int j = 0; j < 4; ++j) vn[q][j] = xr[64 * j];
        }
#pragma unroll 2
        for (int r = r0; r < r0 + rows_per; r += 4) {
            f32x4 v[4][4]; float s[4];
#pragma unroll
            for (int q = 0; q < 4; ++q)
#pragma unroll
                for (int j = 0; j < 4; ++j) v[q][j] = vn[q][j];
            if (r + 4 < r0 + rows_per) {
#pragma unroll
                for (int q = 0; q < 4; ++q) {
                    const f32x4* xr = (const f32x4*)(src + (size_t)(r + 4 + q) * 1024) + lane;
#pragma unroll
                    for (int j = 0; j < 4; ++j) vn[q][j] = xr[64 * j];
                }
            }
#pragma unroll
            for (int q = 0; q < 4; ++q) {
                s[q] = 0.f;
#pragma unroll
                for (int j = 0; j < 4; ++j) s[q] += (v[q][j][0] * v[q][j][0] + v[q][j][1] * v[q][j][1]) + (v[q][j][2] * v[q][j][2] + v[q][j][3] * v[q][j][3]);
            }
#pragma unroll
            for (int o = 1; o < 64; o <<= 1) {
#pragma unroll
                for (int q = 0; q < 4; ++q) s[q] += __shfl_xor(s[q], o);
            }
#pragma unroll
            for (int q = 0; q < 4; ++q) {
                const float rn = __builtin_amdgcn_rsqf(s[q] * (1.f / 1024.f) + EPS);
                u32x2* o = (u32x2*)(dst + (size_t)(r + q) * 1024) + lane;
                f32x4 y[4]; float am = 0.f;
#pragma unroll
                for (int j = 0; j < 4; ++j) { y[j] = v[q][j] * rn * mul[j] + add[j];
                    if (WF8) { ((unsigned*)(dstf + (size_t)(r + q) * 1024) + lane)[64 * j] = pack_fp8x4(y[j][0] * ASC8, y[j][1] * ASC8, y[j][2] * ASC8, y[j][3] * ASC8); }
                    if (WB16) { u32x2 w; w.x = pk2(y[j][0], y[j][1]); w.y = pk2(y[j][2], y[j][3]); o[64 * j] = w; }
                    if (I8) am = fmaxf(fmaxf(am, fmaxf(fabsf(y[j][0]), fabsf(y[j][1]))), fmaxf(fabsf(y[j][2]), fabsf(y[j][3]))); }
                if (I8) {
#pragma unroll
                    for (int oo = 1; oo < 64; oo <<= 1) am = fmaxf(am, __shfl_xor(am, oo));
                    am = fmaxf(am, 1e-20f);
                    const float qs = (NIB ? 119.f : 127.f) / am;
                    unsigned* o8 = (unsigned*)(dst8 + (size_t)(r + q) * 1024) + lane;
#pragma unroll
                    for (int j = 0; j < 4; ++j) {
                        o8[64 * j] = pack_i8x4(y[j][0] * qs, y[j][1] * qs, y[j][2] * qs, y[j][3] * qs);
                        if (NIB) {
                            unsigned na = 0, nb = 0;
#pragma unroll
                            for (int e = 0; e < 4; ++e) { const int qi = (int)__builtin_rintf(y[j][e] * qs); nb |= (unsigned)(qi & 15) << (4 * e); na |= (unsigned)(((qi + 8) >> 4) & 15) << (4 * e); }
                            const unsigned na2 = __shfl_xor(na, 1), nb2 = __shfl_xor(nb, 1);
                            if (!(lane & 1)) {
                                *(unsigned*)(ha + (size_t)(r + q) * 512 + 2 * lane + 128 * j) = na | (na2 << 16);
                                *(unsigned*)(hb + (size_t)(r + q) * 512 + 2 * lane + 128 * j) = nb | (nb2 << 16);
                            }
                        }
                    }
                    if (lane == 0) hs[r + q] = am * (1.f / (NIB ? 119.f : 127.f));
                }
            }
        }
    }
}
typedef short v4i16_t __attribute__((ext_vector_type(4)));
DI s16x4 tr_read(const LAS char* p) { return __builtin_bit_cast(s16x4, __builtin_amdgcn_ds_read_tr16_b64_v4i16((LAS v4i16_t*)p)); }
DI bf16x8 pack8(float x0, float x1, float x2, float x3, float x4, float x5, float x6, float x7) {
    u32x4 p; p.x = pk2(x0, x1); p.y = pk2(x2, x3); p.z = pk2(x4, x5); p.w = pk2(x6, x7); return __builtin_bit_cast(bf16x8, p);
}
#define MFMA32(a, b, c) __builtin_amdgcn_mfma_f32_32x32x16_bf16((a), (b), (c), 0, 0, 0)
#define MFMA16(a, b, c) __builtin_amdgcn_mfma_f32_16x16x32_bf16((a), (b), (c), 0, 0, 0)

DI float max3f(float a, float b, float c) { float r; asm("v_max3_f32 %0, %1, %2, %3" : "=v"(r) : "v"(a), "v"(b), "v"(c)); return r; }
template <int BP> DI int bfe1s(int w) { int r; asm("v_bfe_i32 %0, %1, %2, 1" : "=v"(r) : "v"(w), "n"(BP)); return r; }
template <int NDB, int KST, int VST, bool MASK>
DI void attn_tile(const LAS char* kb, const LAS char* vb, f32x16 (&o)[NDB], float& m, float& l, const bf16x8 (&qf)[4], unsigned mw0, unsigned mw1, int lane) {
    const int r32 = lane & 31, hi = lane >> 5;
    f32x16 p0, p1;
#pragma unroll
    for (int r = 0; r < 16; ++r) { p0[r] = 0.f; p1[r] = 0.f; }
    const LAS char* ka = kb + r32 * KST + hi * 16;
#pragma unroll
    for (int ks = 0; ks < 4; ++ks) {
        const bf16x8 a0 = *(const LAS bf16x8*)(ka + ks * 32), a1 = *(const LAS bf16x8*)(ka + 32 * KST + ks * 32);
        p0 = MFMA32(a0, qf[ks], p0); p1 = MFMA32(a1, qf[ks], p1);
    }
    float tm;
    {
        float t[16];
#pragma unroll
        for (int r = 0; r < 16; ++r) t[r] = fmaxf(p0[r], p1[r]);
        const float u0 = max3f(t[0], t[1], t[2]), u1 = max3f(t[3], t[4], t[5]), u2 = max3f(t[6], t[7], t[8]), u3 = max3f(t[9], t[10], t[11]), u4 = max3f(t[12], t[13], t[14]);
        tm = fmaxf(max3f(u0, u1, u2), max3f(u3, u4, t[15]));
    }
    tm = fmaxf(tm, __shfl_xor(tm, 32));
    const float mn = fmaxf(m, tm);
    const float alpha = fexp2(m - mn);
    float rs = 0.f;
    if (MASK) {
        const int w0 = (int)(mw0 >> (4 * hi)), w1 = (int)(mw1 >> (4 * hi));
#define ATT_MASKED(r_) { constexpr int bp = ((r_) & 3) + 8 * ((r_) >> 2); \
            p0[r_] = __builtin_bit_cast(float, __builtin_bit_cast(int, fexp2(p0[r_] - mn)) & bfe1s<bp>(w0)); \
            p1[r_] = __builtin_bit_cast(float, __builtin_bit_cast(int, fexp2(p1[r_] - mn)) & bfe1s<bp>(w1)); rs += p0[r_] + p1[r_]; }
        ATT_MASKED(0) ATT_MASKED(1) ATT_MASKED(2) ATT_MASKED(3) ATT_MASKED(4) ATT_MASKED(5) ATT_MASKED(6) ATT_MASKED(7)
        ATT_MASKED(8) ATT_MASKED(9) ATT_MASKED(10) ATT_MASKED(11) ATT_MASKED(12) ATT_MASKED(13) ATT_MASKED(14) ATT_MASKED(15)
#undef ATT_MASKED
    } else {
#pragma unroll
        for (int r = 0; r < 16; ++r) { p0[r] = fexp2(p0[r] - mn); p1[r] = fexp2(p1[r] - mn); rs += p0[r] + p1[r]; }
    }
    rs += __shfl_xor(rs, 32);
    l = l * alpha + rs; m = mn;
    if (__ballot(alpha != 1.0f)) {
#pragma unroll
        for (int db = 0; db < NDB; ++db)
#pragma unroll
            for (int r = 0; r < 16; ++r) o[db][r] *= alpha;
    }
    bf16x8 pf[4];
    pf[0] = pack8(p0[0], p0[1], p0[2], p0[3], p0[4], p0[5], p0[6], p0[7]);
    pf[1] = pack8(p0[8], p0[9], p0[10], p0[11], p0[12], p0[13], p0[14], p0[15]);
    pf[2] = pack8(p1[0], p1[1], p1[2], p1[3], p1[4], p1[5], p1[6], p1[7]);
    pf[3] = pack8(p1[8], p1[9], p1[10], p1[11], p1[12], p1[13], p1[14], p1[15]);
    const int i16 = lane & 15, q4 = i16 >> 2, pp = i16 & 3, g = lane >> 4;
    const LAS char* va = vb + (4 * (g >> 1) + q4) * VST + (16 * (g & 1) + 4 * pp) * 2;
#pragma unroll
    for (int db = 0; db < NDB; ++db)
#pragma unroll
        for (int s = 0; s < 4; ++s) {
            const s16x4 lo = tr_read(va + (16 * s) * VST + db * 64), h4 = tr_read(va + (16 * s + 8) * VST + db * 64);
            const bf16x8 vf = __builtin_shufflevector(lo, h4, 0, 1, 2, 3, 4, 5, 6, 7);
            o[db] = MFMA32(vf, pf[s], o[db]);
        }
}

DI void ph_diff_attn(const KArgs& a, LAS unsigned char* lds, int tid, int lane, int wave, int blk, int nblk) {
    unsigned char* ws = a.ws;
    const bf16_t* Qd = (const bf16_t*)(ws + WS_QD); const bf16_t* Kd = (const bf16_t*)(ws + WS_KD); const bf16_t* Vd = (const bf16_t*)(ws + WS_VD);
    bf16_t* OAB = (bf16_t*)(ws + WS_OAB);
    float lam;
    { const float d1 = wave_sum(a.lq1[lane] * a.lk1[lane]), d2 = wave_sum(a.lq2[lane] * a.lk2[lane]); lam = expf(d1) - expf(d2) + LAMBDA_INIT; }
    constexpr int KST = 272, VST = 320, KBYTES = 64 * KST, BUF = KBYTES + 64 * VST;
    const int mp = wave >> 2, qg = wave & 3, r32 = lane & 31, hi = lane >> 5;
    for (int idx = blk; idx < 2048; idx += nblk) {
        const int j = idx & 255, i = idx >> 8, pr = j & 127, half = j >> 7, kq = half * 4 + (i >> 1), qb = (i & 1) ? 15 - kq : kq;
        const int b = pr >> 2, h = pr & 3;
        const size_t rb = (size_t)b * NT;
        const int q0 = qb * 128 + 32 * qg, nT = 2 * qb + 2, myT = 2 * qb + 1 + (qg >> 1);
        bf16x8 qf[4];
        { const bf16_t* qp = Qd + (rb + q0 + r32) * 512 + h * 128 + mp * 64 + 8 * hi;
#pragma unroll
          for (int ks = 0; ks < 4; ++ks) qf[ks] = *(const bf16x8*)(qp + 16 * ks); }
        f32x16 o[4]; float m = -INFINITY, l = 0.f;
#pragma unroll
        for (int db = 0; db < 4; ++db)
#pragma unroll
            for (int r = 0; r < 16; ++r) o[db][r] = 0.f;
        const int key0 = tid >> 4, ch = tid & 15;
        const bf16_t* kg = Kd + (rb + key0) * 512 + h * 128 + ch * 8;
        const bf16_t* vg = Vd + (rb + key0) * 512 + h * 128 + ch * 8;
        const int loff = key0 * KST + ch * 16, loffv = KBYTES + key0 * VST + ch * 16;
        u32x4 sk0 = *(const u32x4*)kg, sk1 = *(const u32x4*)(kg + 32 * 512), sv0 = *(const u32x4*)vg, sv1 = *(const u32x4*)(vg + 32 * 512);
        *(LAS u32x4*)(lds + loff) = sk0; *(LAS u32x4*)(lds + loff + 32 * KST) = sk1;
        *(LAS u32x4*)(lds + loffv) = sv0; *(LAS u32x4*)(lds + loffv + 32 * VST) = sv1;
        if (nT > 1) { const size_t go = (size_t)64 * 512; sk0 = *(const u32x4*)(kg + go); sk1 = *(const u32x4*)(kg + go + 32 * 512); sv0 = *(const u32x4*)(vg + go); sv1 = *(const u32x4*)(vg + go + 32 * 512); }
        __syncthreads();
        for (int t = 0; t < nT; ++t) {
            const bool more = (t + 1 < nT), more2 = (t + 2 < nT);
            u32x4 nk0 = sk0, nk1 = sk1, nv0 = sv0, nv1 = sv1;
            if (more2) {
                const size_t go = (size_t)(t + 2) * 64 * 512;
                nk0 = *(const u32x4*)(kg + go); nk1 = *(const u32x4*)(kg + go + 32 * 512); nv0 = *(const u32x4*)(vg + go); nv1 = *(const u32x4*)(vg + go + 32 * 512);
            }
            if (t < myT) {
                const LAS char* bufp = (const LAS char*)lds + (t & 1) * BUF;
                attn_tile<4, KST, VST, false>(bufp + mp * 128, bufp + KBYTES, o, m, l, qf, 0u, 0u, lane);
            }
            if (more) {
                LAS unsigned char* nb = lds + ((t + 1) & 1) * BUF;
                *(LAS u32x4*)(nb + loff) = sk0; *(LAS u32x4*)(nb + loff + 32 * KST) = sk1;
                *(LAS u32x4*)(nb + loffv) = sv0; *(LAS u32x4*)(nb + loffv + 32 * VST) = sv1;
            }
            __syncthreads();
            sk0 = nk0; sk1 = nk1; sv0 = nv0; sv1 = nv1;
        }
        const float il = 1.f / l;
        LAS float* scr = (LAS float*)lds;
        if (mp == 1) {
#pragma unroll
            for (int db = 0; db < 4; ++db)
#pragma unroll
                for (int r = 0; r < 16; ++r) scr[((qg * 4 + db) * 16 + r) * 64 + lane] = o[db][r] * il;
        }
        __syncthreads();
        if (mp == 0) {
            float ss = 0.f;
#pragma unroll
            for (int db = 0; db < 4; ++db)
#pragma unroll
                for (int r = 0; r < 16; ++r) { const float v = o[db][r] * il - lam * scr[((qg * 4 + db) * 16 + r) * 64 + lane]; o[db][r] = v; ss += v * v; }
            ss += __shfl_xor(ss, 32);
            const float rn = __builtin_amdgcn_rsqf(ss * (1.f / 128.f) + EPS) * (1.f - LAMBDA_INIT);
            const size_t oo = (rb + q0 + r32) * (FUSE56 ? 1024 : 512) + h * 128 + 4 * hi;
            bf16_t* op = OAB + oo; unsigned char* op8 = (unsigned char*)OAB + oo;
            const float rn8 = rn * ASC8;
#pragma unroll
            for (int db = 0; db < 4; ++db)
#pragma unroll
                for (int r4 = 0; r4 < 4; ++r4) {
                    const int d0 = 32 * db + 8 * r4;
                    const f32x4 g4 = *(const f32x4*)(a.diff_out_g + d0 + 4 * hi);
                    if (BR8 && !F8_BR) { const float q8 = rn * (127.f / OA_MAX); *(unsigned*)(op8 + d0) = pack_i8x4(o[db][4 * r4] * q8 * g4[0], o[db][4 * r4 + 1] * q8 * g4[1], o[db][4 * r4 + 2] * q8 * g4[2], o[db][4 * r4 + 3] * q8 * g4[3]); }
                    else if (F8_BR) { *(unsigned*)(op8 + d0) = pack_fp8x4(o[db][4 * r4] * rn8 * g4[0], o[db][4 * r4 + 1] * rn8 * g4[1], o[db][4 * r4 + 2] * rn8 * g4[2], o[db][4 * r4 + 3] * rn8 * g4[3]); }
                    else {
                    u32x2 w; w.x = pk2(o[db][4 * r4] * rn * g4[0], o[db][4 * r4 + 1] * rn * g4[1]); w.y = pk2(o[db][4 * r4 + 2] * rn * g4[2], o[db][4 * r4 + 3] * rn * g4[3]);
                    *(u32x2*)(op + d0) = w; }
                }
        }
        __syncthreads();
    }
}

template <int VARIANT = 0>
DI void ph_dsa_attn(const KArgs& a, LAS unsigned char* lds, int tid, int lane, int wave, int blk, int nblk) {
    unsigned char* ws = a.ws;
    const bf16_t* Qs = (const bf16_t*)(ws + WS_QS); const bf16_t* Ks = (const bf16_t*)(ws + WS_KS); const bf16_t* Vs = (const bf16_t*)(ws + WS_VS);
    const unsigned* BM = (const unsigned*)(ws + WS_BM);
    bf16_t* OAB = (bf16_t*)(ws + WS_OAB);
    constexpr int KST = 144, VST = 192, KBYTES = 64 * KST, BUF = KBYTES + 64 * VST;
    const int r32 = lane & 31, hi = lane >> 5;
    for (int idx = blk; idx < 1024; idx += nblk) {
        const int j = idx & 255, i = idx >> 8, b = j >> 3, rr = j & 7, cq = (i & 1) ? 16 * (i >> 1) + 15 - rr : 16 * (i >> 1) + rr;
        const size_t rb = (size_t)b * NT;
        const int q0 = 64 * cq, nT = cq + 1;
        bf16x8 qfA[4], qfB[4];
        { const bf16_t* qp = Qs + (rb + q0 + r32) * 512 + wave * 64 + 8 * hi;
#pragma unroll
          for (int ks = 0; ks < 4; ++ks) { qfA[ks] = *(const bf16x8*)(qp + 16 * ks); qfB[ks] = *(const bf16x8*)(qp + 32 * 512 + 16 * ks); } }
        f32x16 oA[2], oB[2]; float mA = -INFINITY, lA = 0.f, mB = -INFINITY, lB = 0.f;
#pragma unroll
        for (int db = 0; db < 2; ++db)
#pragma unroll
            for (int r = 0; r < 16; ++r) { oA[db][r] = 0.f; oB[db][r] = 0.f; }
        const int key0 = tid >> 3, ch = tid & 7;
        const bf16_t* kg = Ks + (rb + key0) * 64 + ch * 8;
        const bf16_t* vg = Vs + (rb + key0) * 64 + ch * 8;
        const int loff = key0 * KST + ch * 16, loffv = KBYTES + key0 * VST + ch * 16;
        const unsigned* bmpA = BM + (rb + q0 + r32) * 64;
        const unsigned* bmpB = bmpA + 32 * 64;
        u32x4 sk0 = *(const u32x4*)kg, sv0 = *(const u32x4*)vg;
        u32x2 mwA = *(const u32x2*)bmpA, mwB = *(const u32x2*)bmpB, mnA = mwA, mnB = mwB;
        *(LAS u32x4*)(lds + loff) = sk0; *(LAS u32x4*)(lds + loffv) = sv0;
        __syncthreads();
        for (int t = 0; t < nT; ++t) {
            const bool more = (t + 1 < nT);
            if (more) {
                const size_t go = (size_t)(t + 1) * 64 * 64;
                sk0 = *(const u32x4*)(kg + go); sv0 = *(const u32x4*)(vg + go); mnA = *(const u32x2*)(bmpA + 2 * (t + 1)); mnB = *(const u32x2*)(bmpB + 2 * (t + 1));
            }
            {
                const LAS char* bufp = (const LAS char*)lds + (t & 1) * BUF;
                attn_tile<2, KST, VST, true>(bufp, bufp + KBYTES, oA, mA, lA, qfA, mwA.x, mwA.y, lane);
                attn_tile<2, KST, VST, true>(bufp, bufp + KBYTES, oB, mB, lB, qfB, mwB.x, mwB.y, lane);
            }
            if (more) {
                LAS unsigned char* nb = lds + ((t + 1) & 1) * BUF;
                *(LAS u32x4*)(nb + loff) = sk0; *(LAS u32x4*)(nb + loffv) = sv0;
                mwA = mnA; mwB = mnB;
            }
            __syncthreads();
        }
        {
            float ilA = (F8_BR ? ASC8 : 1.f) / lA, ilB = (F8_BR ? ASC8 : 1.f) / lB;
            if (BR8 && !F8_BR) {
                float mA = 0.f, mB = 0.f;
#pragma unroll
                for (int db = 0; db < 2; ++db)
#pragma unroll
                    for (int r = 0; r < 16; ++r) { mA = fmaxf(mA, fabsf(oA[db][r])); mB = fmaxf(mB, fabsf(oB[db][r])); }
                mA *= ilA; mB *= ilB;
                mA = fmaxf(mA, __shfl_xor(mA, 32)); mB = fmaxf(mB, __shfl_xor(mB, 32));
                LAS float* xm = (LAS float*)lds;
                if (hi == 0) { xm[wave * 64 + r32] = mA; xm[wave * 64 + 32 + r32] = mB; }
                __syncthreads();
                float rA = 1e-20f, rB = 1e-20f;
#pragma unroll
                for (int w8 = 0; w8 < 8; ++w8) { rA = fmaxf(rA, xm[w8 * 64 + r32]); rB = fmaxf(rB, xm[w8 * 64 + 32 + r32]); }
                __syncthreads();
                ilA *= 127.f / rA; ilB *= 127.f / rB;
                if (wave == 0 && hi == 0) { float* obs = (float*)(ws + WS_OBS); obs[rb + q0 + r32] = rA * (1.f / 127.f); obs[rb + q0 + 32 + r32] = rB * (1.f / 127.f); }
            }
            const size_t oo = FUSE56 ? (rb + q0 + r32) * 1024 + 512 + wave * 64 + 4 * hi : (size_t)NTOK * 512 + (rb + q0 + r32) * 512 + wave * 64 + 4 * hi;
            constexpr int OST = FUSE56 ? 1024 : 512;
            bf16_t* op = OAB + oo; unsigned char* op8 = (unsigned char*)OAB + oo;
#pragma unroll
            for (int db = 0; db < 2; ++db)
#pragma unroll
                for (int r4 = 0; r4 < 4; ++r4) {
                    if (BR8 && !F8_BR) {
                        *(unsigned*)(op8 + 32 * db + 8 * r4) = pack_i8x4(oA[db][4 * r4] * ilA, oA[db][4 * r4 + 1] * ilA, oA[db][4 * r4 + 2] * ilA, oA[db][4 * r4 + 3] * ilA);
                        *(unsigned*)(op8 + 32 * OST + 32 * db + 8 * r4) = pack_i8x4(oB[db][4 * r4] * ilB, oB[db][4 * r4 + 1] * ilB, oB[db][4 * r4 + 2] * ilB, oB[db][4 * r4 + 3] * ilB);
                    } else if (F8_BR) {
                        *(unsigned*)(op8 + 32 * db + 8 * r4) = pack_fp8x4(oA[db][4 * r4] * ilA, oA[db][4 * r4 + 1] * ilA, oA[db][4 * r4 + 2] * ilA, oA[db][4 * r4 + 3] * ilA);
                        *(unsigned*)(op8 + 32 * OST + 32 * db + 8 * r4) = pack_fp8x4(oB[db][4 * r4] * ilB, oB[db][4 * r4 + 1] * ilB, oB[db][4 * r4 + 2] * ilB, oB[db][4 * r4 + 3] * ilB);
                    } else {
                    u32x2 w; w.x = pk2(oA[db][4 * r4] * ilA, oA[db][4 * r4 + 1] * ilA); w.y = pk2(oA[db][4 * r4 + 2] * ilA, oA[db][4 * r4 + 3] * ilA);
                    *(u32x2*)(op + 32 * db + 8 * r4) = w;
                    u32x2 w2; w2.x = pk2(oB[db][4 * r4] * ilB, oB[db][4 * r4 + 1] * ilB); w2.y = pk2(oB[db][4 * r4 + 2] * ilB, oB[db][4 * r4 + 3] * ilB);
                    *(u32x2*)(op + 32 * OST + 32 * db + 8 * r4) = w2; }
                }
        }
    }
}

template <bool DO_SEL = true>
DI void ph_indexer(const KArgs& a, LAS unsigned char* lds, int tid, int lane, int wave, int blk, int nblk) {
    unsigned char* ws = a.ws;
    const bf16_t* Qi = (const bf16_t*)(ws + WS_QI); const bf16_t* Ki = (const bf16_t*)(ws + WS_KI); const float* Widx = (const float*)(ws + WS_WIDX);
    unsigned long long* BM = (unsigned long long*)(ws + WS_BM);
    constexpr int SCS = 2052;
    LAS float* sc = (LAS float*)lds;
    const int l15 = lane & 15, l4 = lane >> 4;
    bf16x8 qfr[8][2]; f32x4 w0, w1;
#define IDX_DECODE(idx_, b_, qi_) const int b_ = (idx_) >> 7, qi_ = (((idx_) & 127) + 8 * ((idx_) >> 8)) & 127
#define IDX_LOADQ(idx_) do { IDX_DECODE(idx_, b__, qi__); const bf16_t* qp = Qi + ((size_t)b__ * NT + 16 * qi__ + l15) * 512 + 8 * l4; \
        _Pragma("unroll") for (int h = 0; h < 8; ++h) { qfr[h][0] = *(const bf16x8*)(qp + h * 64); qfr[h][1] = *(const bf16x8*)(qp + h * 64 + 32); } \
        w0 = *(const f32x4*)(Widx + ((size_t)b__ * NT + 16 * qi__ + l15) * 8); w1 = *(const f32x4*)(Widx + ((size_t)b__ * NT + 16 * qi__ + l15) * 8 + 4); } while (0)
    if (blk < 4096) IDX_LOADQ(blk);
    for (int idx = blk; idx < 4096; idx += nblk) {
        IDX_DECODE(idx, b, qi);
        const size_t rb = (size_t)b * NT;
        const int q0 = 16 * qi, chunk = qi >> 2, nj = chunk + 1, nt16 = 4 * nj;
        constexpr float IS = 0.044194173824159216f;
        const float w[8] = {w0[0] * IS, w0[1] * IS, w0[2] * IS, w0[3] * IS, w1[0] * IS, w1[1] * IS, w1[2] * IS, w1[3] * IS};
        {
            int tile = wave;
            const bf16_t* kp = Ki + (rb + 16 * tile + l15) * 64 + 8 * l4;
            bf16x8 ka0 = *(const bf16x8*)kp, ka1 = *(const bf16x8*)(kp + 32);
            for (; tile < nt16; tile += 8) {
                const int ntile = (tile + 8 < nt16) ? tile + 8 : tile;
                const bf16_t* np = Ki + (rb + 16 * ntile + l15) * 64 + 8 * l4;
                const bf16x8 nk0 = *(const bf16x8*)np, nk1 = *(const bf16x8*)(np + 32);
                f32x4 s4 = {0.f, 0.f, 0.f, 0.f};
#pragma unroll
                for (int h = 0; h < 8; ++h) {
                    f32x4 c = {0.f, 0.f, 0.f, 0.f};
                    c = MFMA16(ka0, qfr[h][0], c); c = MFMA16(ka1, qfr[h][1], c);
#pragma unroll
                    for (int r = 0; r < 4; ++r) s4[r] += fmaxf(c[r], 0.f) * w[h];
                }
                *(LAS f32x4*)(sc + l15 * SCS + 16 * tile + 4 * l4) = s4;
                ka0 = nk0; ka1 = nk1;
            }
        }
        __syncthreads();
        if (idx + nblk < 4096) IDX_LOADQ(idx + nblk);
        if (DO_SEL) {
            const int qa = 2 * wave, qb = qa + 1;
            unsigned ua[32], ub[32];
#pragma unroll
            for (int jj = 0; jj < 32; ++jj) {
                ua[jj] = 0u; ub[jj] = 0u;
                if (jj < nj) {
                    const float sa = sc[qa * SCS + lane + 64 * jj] + 24.0f, sb = sc[qb * SCS + lane + 64 * jj] + 24.0f;
                    const unsigned ba = __builtin_bit_cast(unsigned, sa), bb = __builtin_bit_cast(unsigned, sb);
                    ua[jj] = (ba & 0x80000000u) ? ~ba : (ba | 0x80000000u); ub[jj] = (bb & 0x80000000u) ? ~bb : (bb | 0x80000000u);
                }
            }
            unsigned long long maska = 0ull, maskb = 0ull;
            if (nj <= 4) { maska = ~0ull; maskb = ~0ull; }
            else {
                unsigned pa = 0u, pb = 0u; bool da = false, db = false;
                int start = 31;
                {
                    unsigned ora = 0u, anda = ~0u, orb = 0u, andb = ~0u;
#pragma unroll
                    for (int jj = 0; jj < 32; ++jj) if (jj < nj) { ora |= ua[jj]; anda &= ua[jj]; orb |= ub[jj]; andb &= ub[jj]; }
#pragma unroll
                    for (int o = 1; o < 64; o <<= 1) { ora |= __shfl_xor(ora, o); anda &= __shfl_xor(anda, o); orb |= __shfl_xor(orb, o); andb &= __shfl_xor(andb, o); }
                    const unsigned dd = __builtin_amdgcn_readfirstlane((ora ^ anda) | (orb ^ andb));
                    start = dd ? 31 - __builtin_clz(dd) : -1;
                    const unsigned keep = (start >= 31) ? 0u : (0xFFFFFFFFu << (start + 1));
                    pa = anda & keep; pb = andb & keep;
                }
#pragma unroll 1
                for (int bit = start; bit >= 0; --bit) {
                    const unsigned ca = da ? pa : (pa | (1u << bit)), cb = db ? pb : (pb | (1u << bit));
                    int cnta = 0, cntb = 0;
#pragma unroll
                    for (int g = 0; g < 8; ++g) if (4 * g < nj) {
#pragma unroll
                        for (int jj = 0; jj < 4; ++jj) { cnta += __popcll(__ballot(ua[4 * g + jj] >= ca)); cntb += __popcll(__ballot(ub[4 * g + jj] >= cb)); }
                    }
                    if (!da && cnta >= 256) { pa = ca; da = (cnta == 256); }
                    if (!db && cntb >= 256) { pb = cb; db = (cntb == 256); }
                    if (da && db) break;
                }
                int cga = 0, cgb = 0;
#pragma unroll
                for (int g = 0; g < 8; ++g) if (4 * g < nj) {
#pragma unroll
                    for (int jj = 0; jj < 4; ++jj) { cga += __popcll(__ballot(ua[4 * g + jj] > pa)); cgb += __popcll(__ballot(ub[4 * g + jj] > pb)); }
                }
                const int needa = 256 - cga, needb = 256 - cgb; int runa = 0, runb = 0;
                const unsigned long long lt = (1ull << lane) - 1ull;
#pragma unroll
                for (int g = 0; g < 8; ++g) if (4 * g < nj) {
#pragma unroll
                    for (int jj = 0; jj < 4; ++jj) {
                        const int e = 4 * g + jj;
                        { const bool eq = (ua[e] == pa); const unsigned long long em = __ballot(eq); const int rank = runa + __popcll(em & lt);
                          const unsigned long long sb2 = __ballot((ua[e] > pa) || (eq && rank < needa)); if (lane == e) maska = sb2; runa += __popcll(em); }
                        { const bool eq = (ub[e] == pb); const unsigned long long em = __ballot(eq); const int rank = runb + __popcll(em & lt);
                          const unsigned long long sb2 = __ballot((ub[e] > pb) || (eq && rank < needb)); if (lane == e) maskb = sb2; runb += __popcll(em); }
                    }
                }
            }
            if (lane < nj) { BM[(rb + q0 + qa) * 32 + lane] = maska; BM[(rb + q0 + qb) * 32 + lane] = maskb; }
        }
        __syncthreads();
    }
#undef IDX_DECODE
#undef IDX_LOADQ
}
DI int mono_i(float f) { const int i = __builtin_bit_cast(int, f); return i ^ ((i >> 31) & 0x7fffffff); }
DI float mono_f(int i) { return __builtin_bit_cast(float, i ^ ((i >> 31) & 0x7fffffff)); }
constexpr int IMIN = (int)0x80000000;

DI void ce_desc(int& a, int& b) { const int hi = max(a, b), lo = min(a, b); a = hi; b = lo; }
template <int B, bool DESC> DI void bitonic_merge16(int (&x)[64]) {
#pragma unroll
    for (int j = 8; j > 0; j >>= 1)
#pragma unroll
        for (int i = 0; i < 16; ++i) { const int l = i ^ j; if (l > i) { if (DESC) ce_desc(x[B + i], x[B + l]); else ce_desc(x[B + l], x[B + i]); } }
}
DI void top16_of_64(int (&x)[64]) {
#pragma unroll
    for (int k = 2; k <= 16; k <<= 1)
#pragma unroll
        for (int j = k >> 1; j > 0; j >>= 1)
#pragma unroll
            for (int i = 0; i < 64; ++i) { const int l = i ^ j; if (l > i) { if ((i & k) == 0) ce_desc(x[i], x[l]); else ce_desc(x[l], x[i]); } }
#pragma unroll
    for (int i = 0; i < 16; ++i) { x[i] = max(x[i], x[16 + i]); x[32 + i] = max(x[32 + i], x[48 + i]); }
    bitonic_merge16<0, true>(x); bitonic_merge16<32, false>(x);
#pragma unroll
    for (int i = 0; i < 16; ++i) x[i] = max(x[i], x[32 + i]);
    bitonic_merge16<0, true>(x);
}

DI void ph_peer_route(const KArgs& a, LAS unsigned char* lds, int tid, int lane, int wave, int blk, int nblk) {
    unsigned char* ws = a.ws;
    const bf16_t* QP = (const bf16_t*)(ws + WS_QP); const bf16_t* SKB = (const bf16_t*)(ws + WS_SKB);
    int* EIDX = (int*)(ws + WS_EIDX); float* GW = (float*)(ws + WS_GW);
    constexpr int SST = 272, SHALF = 128 * SST;
    const int r32 = lane & 31, hi = lane >> 5;
    for (int vb = blk; vb < 256; vb += nblk) {
        const int head = vb & 7, tg = vb >> 3;
        __syncthreads();
        for (int c = tid; c < 4096; c += 512) {
            const int p = c >> 11, key = (c >> 4) & 127, chn = c & 15;
            *(LAS u32x4*)(lds + p * SHALF + key * SST + chn * 16) = *(const u32x4*)(SKB + ((size_t)(head * 2 + p) * 128 + key) * 128 + chn * 8);
        }
        __syncthreads();
        LAS int* Ll = (LAS int*)(lds + 2 * SHALF) + wave * 2048;
        for (int tile = wave; tile < 64; tile += 8) {
            const size_t n0 = (size_t)tg * 2048 + tile * 32;
#pragma unroll 1
            for (int p = 0; p < 2; ++p) {
                int hi4 = 4 * hi; asm volatile("" : "+v"(hi4));
                bf16x8 qf[8];
                { const bf16_t* qp = QP + (n0 + r32) * 2048 + head * 256 + p * 128 + 8 * hi;
#pragma unroll
                  for (int ks = 0; ks < 8; ++ks) qf[ks] = *(const bf16x8*)(qp + 16 * ks); }
                int xi[64];
#pragma unroll
                for (int mt = 0; mt < 4; ++mt) {
                    f32x16 acc;
#pragma unroll
                    for (int r = 0; r < 16; ++r) acc[r] = 0.f;
                    const LAS char* ka = (const LAS char*)lds + p * SHALF + (32 * mt + r32) * SST + hi * 16;
#pragma unroll
                    for (int ks = 0; ks < 8; ++ks) acc = MFMA32(*(const LAS bf16x8*)(ka + ks * 32), qf[ks], acc);
#pragma unroll
                    for (int r = 0; r < 16; ++r) xi[mt * 16 + r] = ((mono_i(acc[r]) & ~127) | hi4) | (32 * mt + (r & 3) + 8 * (r >> 2));
                }
                top16_of_64(xi);
                {
                    int pr[16];
#pragma unroll
                    for (int i = 0; i < 16; ++i) pr[i] = __shfl_xor(xi[15 - i], 32);
#pragma unroll
                    for (int i = 0; i < 16; ++i) xi[i] = max(xi[i], pr[i]);
                    bitonic_merge16<0, true>(xi);
                }
#pragma unroll
                for (int it = 0; it < 16; ++it) Ll[(p * 16 + it) * 64 + lane] = xi[it];
            }
            int cs[64];
            {
                int l0[16], l1[16];
#pragma unroll
                for (int k = 0; k < 16; ++k) { l0[k] = Ll[k * 64 + lane]; l1[k] = Ll[(16 + k) * 64 + lane]; }
                int nc = 0;
#pragma unroll
                for (int ra = 0; ra < 16; ++ra)
#pragma unroll
                    for (int rb2 = 0; rb2 < 16; ++rb2)
                        if ((ra + 1) * (rb2 + 1) <= 16) {
                            const float s = mono_f(l0[ra] & ~127) + mono_f(l1[rb2] & ~127);
                            cs[nc] = (mono_i(s) & ~255) | (255 - (ra * 16 + rb2)); ++nc;
                        }
#pragma unroll
                for (int k = 50; k < 64; ++k) cs[k] = IMIN;
            }
            top16_of_64(cs);
            float sv[16]; int se[16];
#pragma unroll
            for (int it = 0; it < 16; ++it) {
                const int flat = 255 - (cs[it] & 255);
                se[it] = (Ll[(flat >> 4) * 64 + lane] & 127) * 128 + (Ll[(16 + (flat & 15)) * 64 + lane] & 127);
                sv[it] = mono_f(cs[it] & ~255);
            }
            const float smax = sv[0];
            float sum = 0.f;
#pragma unroll
            for (int it = 0; it < 16; ++it) { sv[it] = __expf(sv[it] - smax); sum += sv[it]; }
            const float inv = 1.f / sum;
            if (hi == 0) {
                unsigned short* ep = (unsigned short*)EIDX + (n0 + r32) * 128 + head * 16;
                float* gp = GW + (n0 + r32) * 128 + head * 16;
#pragma unroll
                for (int k = 0; k < 4; ++k) {
                    *(u32x2*)(ep + 4 * k) = (u32x2){(unsigned)se[4 * k] | ((unsigned)se[4 * k + 1] << 16), (unsigned)se[4 * k + 2] | ((unsigned)se[4 * k + 3] << 16)};
                    *(f32x4*)(gp + 4 * k) = (f32x4){sv[4 * k] * inv, sv[4 * k + 1] * inv, sv[4 * k + 2] * inv, sv[4 * k + 3] * inv};
                }
            }
        }
    }
}

DI int dot4z(int a, int b) { int r; asm("v_dot4_i32_i8 %0, %1, %2, 0" : "=v"(r) : "v"(a), "v"(b)); return r; }
DI f32x2 fp8lo(unsigned w) { return __builtin_amdgcn_cvt_pk_f32_fp8((int)w, false); }
DI f32x2 fp8hi(unsigned w) { return __builtin_amdgcn_cvt_pk_f32_fp8((int)w, true); }
constexpr int PEER_CH = 8, PEER_NCH = NTOK / PEER_CH;
constexpr size_t SLICE_BYTES = (size_t)16384 * 128;

template <int STEP>
DI void peer_issue(const unsigned char* tb, unsigned lo16, const LAS int* et, int g, u32x4 (&tv)[16], u32x4 (&hx)[2], f32x4& xr, const unsigned char* hrow, const float* xrow, const float* hsp = nullptr) {
#pragma unroll
    for (int it = 0; it < 16; ++it) tv[it] = *(const u32x4*)(tb + ((unsigned)et[8 * it + g] + lo16));
    if (STEP == 0) { hx[0] = *(const u32x4*)hrow; if (U4) hx[1] = *(const u32x4*)(hrow + (UD8 ? (WS_HB4 - WS_HA4) : 16)); xr.x = *hsp; }
    else if (V4) xr = *(const f32x4*)xrow;
    else { const f32x2 t2 = *(const f32x2*)xrow; xr.x = t2.x; xr.y = t2.y; }
    __builtin_amdgcn_sched_barrier(0);
}

template <int STEP, bool HALFROW = false>
DI void ph_peer_slices(const KArgs& a, LAS unsigned char* lds, int lane, int wave, unsigned xcc) {
    unsigned char* ws = a.ws;
    const unsigned char* H8 = ws + WS_H8; const float* HS = (const float*)(ws + WS_HS); const unsigned char* U8 = ws + WS_UB; const unsigned char* V8 = ws + WS_VB;
    const float usc = __builtin_bit_cast(float, ((const unsigned*)(ws + WS_CTL))[CW_UMAX]) * (U4 ? (UD8 ? U4_STEP : U4_STEP * (1.f / 16.f)) : 1.f / 127.f);
    constexpr bool UQ = (STEP == 0) && U4, VQ = (STEP == 2) && V4, Q4 = UQ || VQ;
    const unsigned short* EIDX = (const unsigned short*)(ws + WS_EIDX); const float* mod = (const float*)(ws + WS_MOD);
    _Float16* PART = (_Float16*)(ws + WS_PART); const _Float16* W = (const _Float16*)(ws + WS_WGT);
    unsigned* ctr = (unsigned*)(ws + WS_CTL) + 8192 + (STEP ? 1024 : 0);
    float* out = a.out;
    LAS int* e_l = (LAS int*)(lds + wave * 16896);
    LAS _Float16* w_l = (LAS _Float16*)(e_l + 1024);
    LAS float* a_l = (LAS float*)(e_l + 2048);
    LAS float* red = a_l + 128;
    const int g = lane >> 3, s8 = lane & 7;
    for (int ds = 0; ds < (Q4 ? 4 : 8); ++ds) {
        const int s = (int)((xcc + ds) & (Q4 ? 3u : 7u));
        const unsigned char* tb = (STEP ? V8 : U8) + (size_t)s * SLICE_BYTES;
        const unsigned lo16 = (unsigned)(HALFROW ? (s8 & 3) : s8) * 16u;
        unsigned cn = 0;
        if (lane == 0) cn = __hip_atomic_fetch_add(ctr + 64 * s, 1u, __ATOMIC_RELAXED, __HIP_MEMORY_SCOPE_AGENT);
        cn = __builtin_amdgcn_readfirstlane(cn);
        u32x2 pe[4], pw[4];
        if (cn < (unsigned)PEER_NCH) {
#pragma unroll
            for (int q = 0; q < 4; ++q) { pe[q] = *(const u32x2*)(EIDX + (size_t)cn * PEER_CH * 128 + lane * 4 + 256 * q); if (STEP) pw[q] = *(const u32x2*)(W + (size_t)cn * PEER_CH * 128 + lane * 4 + 256 * q); }
        }
        for (;;) {
            const unsigned c = cn;
            if (c >= (unsigned)PEER_NCH) break;
#pragma unroll
            for (int q = 0; q < 4; ++q) { *(LAS u32x4*)(e_l + lane * 4 + 256 * q) = (u32x4){(pe[q].x & 0xffffu) << 7, (pe[q].x >> 16) << 7, (pe[q].y & 0xffffu) << 7, (pe[q].y >> 16) << 7}; if (STEP) *(LAS u32x2*)(w_l + lane * 4 + 256 * q) = pw[q]; }
            if (lane == 0) cn = __hip_atomic_fetch_add(ctr + 64 * s, 1u, __ATOMIC_RELAXED, __HIP_MEMORY_SCOPE_AGENT);
            cn = __builtin_amdgcn_readfirstlane(cn);
            if (cn < (unsigned)PEER_NCH) {
#pragma unroll
                for (int q = 0; q < 4; ++q) { pe[q] = *(const u32x2*)(EIDX + (size_t)cn * PEER_CH * 128 + lane * 4 + 256 * q); if (STEP) pw[q] = *(const u32x2*)(W + (size_t)cn * PEER_CH * 128 + lane * 4 + 256 * q); }
            }
            LDS_WAIT();
            const int n0 = (int)c * PEER_CH;
            const int b = n0 / NT;
            f32x2 gv2 = {0.f, 0.f}; f32x4 gv4 = {0.f, 0.f, 0.f, 0.f};
            if (VQ) gv4 = *(const f32x4*)(mod + (size_t)b * 6144 + 5120 + s * 256 + 4 * lane) * (1.f / V4_WSC);
            else if (STEP) gv2 = *(const f32x2*)(mod + (size_t)b * 6144 + 5120 + s * 128 + 2 * lane);
            u32x4 tvA[16], tvB[16], hA[2], hB[2]; f32x4 xA = {0.f, 0.f, 0.f, 0.f}, xB = {0.f, 0.f, 0.f, 0.f};
#define PEER_HROW(t) ((UQ && UD8) ? (ws + WS_HA4 + (size_t)(n0 + (t)) * 512 + s * 128 + s8 * 16) : (H8 + (size_t)(n0 + (t)) * 1024 + s * (UQ ? 256 : 128) + s8 * (UQ ? 32 : 16)))
#define PEER_XROW(t) (out + (size_t)(n0 + (t)) * 1024 + (VQ ? s * 256 + 4 * lane : s * 128 + 2 * lane))
#define PEER_COMPUTE(t, tv, hx, xr) do { \
            if (UQ) { \
                LAS int* redi = (LAS int*)red; \
                if (UD8) { \
                _Pragma("unroll") for (int it = 0; it < 16; ++it) {     \
                    int da = __builtin_amdgcn_sdot8((int)tv[it].x, (int)hx[0].x, 0, false), db = __builtin_amdgcn_sdot8((int)tv[it].x, (int)hx[1].x, 0, false); \
                    da = __builtin_amdgcn_sdot8((int)tv[it].y, (int)hx[0].y, da, false); db = __builtin_amdgcn_sdot8((int)tv[it].y, (int)hx[1].y, db, false); \
                    da = __builtin_amdgcn_sdot8((int)tv[it].z, (int)hx[0].z, da, false); db = __builtin_amdgcn_sdot8((int)tv[it].z, (int)hx[1].z, db, false); \
                    da = __builtin_amdgcn_sdot8((int)tv[it].w, (int)hx[0].w, da, false); db = __builtin_amdgcn_sdot8((int)tv[it].w, (int)hx[1].w, db, false); \
                    redi[it * 64 + lane] = 16 * da + db; \
                } \
                } else \
                _Pragma("unroll") for (int it = 0; it < 16; ++it) { \
                    int d0 = dot4z((int)((tv[it].x << 4) & 0xF0F0F0F0u), (int)hx[0].x), d1 = dot4z((int)((tv[it].y << 4) & 0xF0F0F0F0u), (int)hx[0].y); \
                    d0 = __builtin_amdgcn_sdot4((int)((tv[it].z << 4) & 0xF0F0F0F0u), (int)hx[0].z, d0, false); d1 = __builtin_amdgcn_sdot4((int)((tv[it].w << 4) & 0xF0F0F0F0u), (int)hx[0].w, d1, false); \
                    d0 = __builtin_amdgcn_sdot4((int)(tv[it].x & 0xF0F0F0F0u), (int)hx[1].x, d0, false); d1 = __builtin_amdgcn_sdot4((int)(tv[it].y & 0xF0F0F0F0u), (int)hx[1].y, d1, false); \
                    d0 = __builtin_amdgcn_sdot4((int)(tv[it].z & 0xF0F0F0F0u), (int)hx[1].z, d0, false); d1 = __builtin_amdgcn_sdot4((int)(tv[it].w & 0xF0F0F0F0u), (int)hx[1].w, d1, false); \
                    redi[it * 64 + lane] = d0 + d1;                      \
                } \
                LDS_WAIT(); \
                _Float16* pp = PART + ((size_t)s * NTOK + n0 + (t)) * 128; \
                { typedef int i32x4 __attribute__((ext_vector_type(4))); \
                  const i32x4 r0 = *(const LAS i32x4*)(redi + 8 * lane), r1 = *(const LAS i32x4*)(redi + 8 * lane + 4), r2 = *(const LAS i32x4*)(redi + 512 + 8 * lane), r3 = *(const LAS i32x4*)(redi + 512 + 8 * lane + 4); \
                  const float sc_ = xr.x * usc; \
                  pp[lane] = (_Float16)((float)(((r0[0] + r0[1]) + (r0[2] + r0[3])) + ((r1[0] + r1[1]) + (r1[2] + r1[3]))) * sc_); \
                  pp[64 + lane] = (_Float16)((float)(((r2[0] + r2[1]) + (r2[2] + r2[3])) + ((r3[0] + r3[1]) + (r3[2] + r3[3]))) * sc_); } \
                LDS_WAIT(); \
            } else if (STEP == 0) { \
                LAS int* redi = (LAS int*)red; \
                _Pragma("unroll") for (int it = 0; it < 16; ++it) { \
                    int d0 = dot4z((int)tv[it].x, (int)hx[0].x), d1 = dot4z((int)tv[it].y, (int)hx[0].y);        \
                    d0 = __builtin_amdgcn_sdot4((int)tv[it].z, (int)hx[0].z, d0, false); d1 = __builtin_amdgcn_sdot4((int)tv[it].w, (int)hx[0].w, d1, false); \
                    redi[it * 64 + lane] = d0 + d1;                      \
                } \
                LDS_WAIT(); \
                _Float16* pp = PART + ((size_t)s * NTOK + n0 + (t)) * 128; \
                { typedef int i32x4 __attribute__((ext_vector_type(4))); \
                  const i32x4 r0 = *(const LAS i32x4*)(redi + 8 * lane), r1 = *(const LAS i32x4*)(redi + 8 * lane + 4), r2 = *(const LAS i32x4*)(redi + 512 + 8 * lane), r3 = *(const LAS i32x4*)(redi + 512 + 8 * lane + 4); \
                  const float sc_ = xr.x * usc; \
                  pp[lane] = (_Float16)((float)(((r0[0] + r0[1]) + (r0[2] + r0[3])) + ((r1[0] + r1[1]) + (r1[2] + r1[3]))) * sc_); \
                  pp[64 + lane] = (_Float16)((float)(((r2[0] + r2[1]) + (r2[2] + r2[3])) + ((r3[0] + r3[1]) + (r3[2] + r3[3]))) * sc_); } \
                LDS_WAIT(); \
            } else if (VQ) { \
                h16x2 acc[16]; \
                _Pragma("unroll") for (int k = 0; k < 16; ++k) acc[k] = (h16x2){(_Float16)0.f, (_Float16)0.f}; \
                _Pragma("unroll") for (int it = 0; it < 16; ++it) { \
                    const _Float16 wh = w_l[(t) * 128 + 8 * it + g]; const h16x2 w2 = {wh, wh}; \
                    _Pragma("unroll") for (int k = 0; k < 4; ++k) { \
                        acc[4 * k] += __builtin_amdgcn_cvt_scalef32_pk_f16_fp4(tv[it][k], 1.0f, 0) * w2; acc[4 * k + 1] += __builtin_amdgcn_cvt_scalef32_pk_f16_fp4(tv[it][k], 1.0f, 1) * w2; \
                        acc[4 * k + 2] += __builtin_amdgcn_cvt_scalef32_pk_f16_fp4(tv[it][k], 1.0f, 2) * w2; acc[4 * k + 3] += __builtin_amdgcn_cvt_scalef32_pk_f16_fp4(tv[it][k], 1.0f, 3) * w2; } \
                } \
                LAS _Float16* redh = (LAS _Float16*)red;                  \
                LAS h16x8* rp = (LAS h16x8*)(redh + g * 256 + s8 * 32); \
                _Pragma("unroll") for (int i = 0; i < 4; ++i) rp[i] = (h16x8){acc[4 * i].x, acc[4 * i].y, acc[4 * i + 1].x, acc[4 * i + 1].y, acc[4 * i + 2].x, acc[4 * i + 2].y, acc[4 * i + 3].x, acc[4 * i + 3].y}; \
                LDS_WAIT(); \
                f32x4 sum = {0.f, 0.f, 0.f, 0.f}; \
                _Pragma("unroll") for (int q = 0; q < 8; ++q) { const h16x4 p4 = *(const LAS h16x4*)(redh + q * 256 + 4 * lane); sum += (f32x4){(float)p4.x, (float)p4.y, (float)p4.z, (float)p4.w}; } \
                *(f32x4*)(out + (size_t)(n0 + (t)) * 1024 + s * 256 + 4 * lane) = xr + gv4 * sum; \
                LDS_WAIT(); \
            } else { \
                f32x2 acc[8]; \
                _Pragma("unroll") for (int k = 0; k < 8; ++k) acc[k] = (f32x2){0.f, 0.f}; \
                _Pragma("unroll") for (int it = 0; it < 16; ++it) { \
                    const float w = (float)w_l[(t) * 128 + 8 * it + g]; \
                    acc[0] += fp8lo(tv[it].x) * w; acc[1] += fp8hi(tv[it].x) * w; acc[2] += fp8lo(tv[it].y) * w; acc[3] += fp8hi(tv[it].y) * w; \
                    acc[4] += fp8lo(tv[it].z) * w; acc[5] += fp8hi(tv[it].z) * w; acc[6] += fp8lo(tv[it].w) * w; acc[7] += fp8hi(tv[it].w) * w; \
                } \
                LAS f32x4* rp = (LAS f32x4*)(red + g * 128 + s8 * 16); \
                rp[0] = (f32x4){acc[0].x, acc[0].y, acc[1].x, acc[1].y}; rp[1] = (f32x4){acc[2].x, acc[2].y, acc[3].x, acc[3].y}; \
                rp[2] = (f32x4){acc[4].x, acc[4].y, acc[5].x, acc[5].y}; rp[3] = (f32x4){acc[6].x, acc[6].y, acc[7].x, acc[7].y}; \
                LDS_WAIT(); \
                f32x2 sum = {0.f, 0.f}; \
                _Pragma("unroll") for (int q = 0; q < 8; ++q) sum += *(const LAS f32x2*)(red + q * 128 + 2 * lane); \
                *(f32x2*)(out + (size_t)(n0 + (t)) * 1024 + s * 128 + 2 * lane) = (f32x2){xr.x, xr.y} + gv2 * sum; \
                LDS_WAIT(); \
            } \
            __builtin_amdgcn_sched_barrier(0); } while (0)
            peer_issue<STEP>(tb, lo16, e_l, g, tvA, hA, xA, PEER_HROW(0), PEER_XROW(0), HS + n0);
#pragma unroll 1
            for (int t = 0; t < PEER_CH - 2; t += 2) {
                peer_issue<STEP>(tb, lo16, e_l + (t + 1) * 128, g, tvB, hB, xB, PEER_HROW(t + 1), PEER_XROW(t + 1), HS + n0 + t + 1);
                PEER_COMPUTE(t, tvA, hA, xA);
                peer_issue<STEP>(tb, lo16, e_l + (t + 2) * 128, g, tvA, hA, xA, PEER_HROW(t + 2), PEER_XROW(t + 2), HS + n0 + t + 2);
                PEER_COMPUTE(t + 1, tvB, hB, xB);
            }
            peer_issue<STEP>(tb, lo16, e_l + (PEER_CH - 1) * 128, g, tvB, hB, xB, PEER_HROW(PEER_CH - 1), PEER_XROW(PEER_CH - 1), HS + n0 + PEER_CH - 1);
            PEER_COMPUTE(PEER_CH - 2, tvA, hA, xA);
            PEER_COMPUTE(PEER_CH - 1, tvB, hB, xB);
#undef PEER_HROW
#undef PEER_XROW
#undef PEER_COMPUTE
        }
    }
}

DI void ph_peer_combine(const KArgs& a, int tid, int blk, int nblk) {
    unsigned char* ws = a.ws;
    const _Float16* PART = (const _Float16*)(ws + WS_PART); const float* GW = (const float*)(ws + WS_GW); _Float16* W = (_Float16*)(ws + WS_WGT);
    const size_t total = (size_t)NTOK * 128 / 4;
    const float vsc = V4 ? __builtin_bit_cast(float, ((const unsigned*)(ws + WS_CTL))[CW_VMAX]) * (V4_S * V4_WSC) : 1.f / VSCALE;
    constexpr int NS = U4 ? 4 : 8;
    h16x4 pn[NS]; f32x4 gn = {0.f, 0.f, 0.f, 0.f};
    const size_t i0 = (size_t)blk * 512 + tid, st = (size_t)nblk * 512;
    if (i0 < total) {
#pragma unroll
        for (int k = 0; k < NS; ++k) pn[k] = *(const h16x4*)(PART + (size_t)k * NTOK * 128 + 4 * i0);
        gn = *(const f32x4*)(GW + 4 * i0);
    }
    for (size_t i = i0; i < total; i += st) {
        f32x4 s = {0.f, 0.f, 0.f, 0.f};
#pragma unroll
        for (int k = 0; k < NS; ++k) s += (f32x4){(float)pn[k].x, (float)pn[k].y, (float)pn[k].z, (float)pn[k].w};
        const f32x4 gq = gn;
        if (i + st < total) {
#pragma unroll
            for (int k = 0; k < NS; ++k) pn[k] = *(const h16x4*)(PART + (size_t)k * NTOK * 128 + 4 * (i + st));
            gn = *(const f32x4*)(GW + 4 * (i + st));
        }
        f32x4 r;
#pragma unroll
        for (int k = 0; k < 4; ++k) r[k] = gq[k] * 0.5f * s[k] * (1.f + erff(s[k] * 0.70710678118654752f)) * vsc;
        *(h16x4*)(W + 4 * i) = (h16x4){(_Float16)r[0], (_Float16)r[1], (_Float16)r[2], (_Float16)r[3]};
    }
}
#ifndef MK_ONE_LAUNCH
#define MK_ONE_LAUNCH 1
#endif
constexpr int N_PHASES = 12;
#ifndef MK_DUP
#define MK_DUP 0
#endif
#ifndef MK_PREFIX
#define MK_PREFIX -1
#endif
#define PROGRAM() \
    if (IN(0)) { LAUNDER ph_prologue(a, lds, tid, lane, wave, blk, nblk); } \
    SEAM(0); \
    if (IN(1)) { LAUNDER { const float um = __builtin_bit_cast(float, ((const unsigned*)(ws + WS_CTL))[CW_UMAX]); if (U4) conv_u_i4(a.peer_u, ws + WS_UB, 1.f / (U4_STEP * fmaxf(um, 1e-30f)), (size_t)blk * 512 + tid, (size_t)nblk * 512); else conv_u_i8(a.peer_u, ws + WS_UB, 127.f / fmaxf(um, 1e-30f), (size_t)blk * 512 + tid, (size_t)nblk * 512); } if (V4) { const float vm = __builtin_bit_cast(float, ((const unsigned*)(ws + WS_CTL))[CW_VMAX]); conv_v_fp4(a.peer_v, ws + WS_VB, 1.f / (V4_S * fmaxf(vm, 1e-30f)), (size_t)blk * 512 + tid, (size_t)nblk * 512); } ph_weights8(a, lds, lane, wave, blk, nblk); ph_norm<(N8_IN > 0 && IN_MODE == 2), (NB_IN > 0), (N8_IN > 0 && IN_MODE == 1)>(a.x, a.norm1_g, mod, 0, 1024, (bf16_t*)(ws + WS_H), ws + WS_HF8, ws + WS_HF8, (float*)(ws + WS_HS1), lane, wave, blk, nblk); } \
    SEAM(1); \
    if (IN(2)) { LAUNDER \
        if (N8_IN > 0) { \
            pg8::Gemm g{(const bf16_t*)(ws + WS_HF8), (const bf16_t*)(ws + WS_WIN8), NTOK, N8_IN * 256, 512}; \
            pg8::StaticOrder S; S.init(NTOK, N8_IN * 256, nblk, blk); \
            EpiProjT<IN_MODE> E{(bf16_t*)(ws + WS_QD), (bf16_t*)(ws + WS_KD), (bf16_t*)(ws + WS_VD), (bf16_t*)(ws + WS_QS), (bf16_t*)(ws + WS_QI), (bf16_t*)(ws + WS_KS), (bf16_t*)(ws + WS_VS), \
                      (bf16_t*)(ws + WS_KI), (bf16_t*)(ws + WS_G0), (bf16_t*)(ws + WS_G1), (float*)(ws + WS_WIDX), (const float*)(ws + WS_COS), (const float*)(ws + WS_SIN), \
                      a.diff_q_g, a.diff_k_g, a.dsa_q_g, a.dsa_k_g, (const unsigned*)(ws + WS_CTL) + CW_WMAX + 0, (const float*)(ws + WS_HS1)}; \
            pg8::gemm_phase<EpiProjT<IN_MODE>, pg8::StaticOrder, true, true, IN_MODE>(lds, g, S, E); \
        } \
        if (NB_IN > 0) { \
            pg8::Gemm g{(const bf16_t*)(ws + WS_H), (const bf16_t*)(ws + WS_WIN), NTOK, NB_IN * 256, 1024}; \
            pg8::StaticOrder S; S.init(NTOK, NB_IN * 256, nblk, blk); \
            EpiProjT<0> E{(bf16_t*)(ws + WS_QD), (bf16_t*)(ws + WS_KD), (bf16_t*)(ws + WS_VD), (bf16_t*)(ws + WS_QS), (bf16_t*)(ws + WS_QI), (bf16_t*)(ws + WS_KS), (bf16_t*)(ws + WS_VS), \
                      (bf16_t*)(ws + WS_KI), (bf16_t*)(ws + WS_G0), (bf16_t*)(ws + WS_G1), (float*)(ws + WS_WIDX), (const float*)(ws + WS_COS), (const float*)(ws + WS_SIN), \
                      a.diff_q_g, a.diff_k_g, a.dsa_q_g, a.dsa_k_g, nullptr, nullptr}; \
            pg8::gemm_phase<EpiProjT<0>, pg8::StaticOrder, true, true, 0>(lds, g, S, E); \
        } \
    } \
    SEAM(2); \
    if (IN(3)) { LAUNDER ph_indexer(a, lds, tid, lane, wave, blk, nblk); if (MK_DUP == 30) ph_indexer(a, lds, tid, lane, wave, blk, nblk); if (MK_DUP == 31) ph_indexer<false>(a, lds, tid, lane, wave, blk, nblk); ph_diff_attn(a, lds, tid, lane, wave, blk, nblk); } \
    SEAM(3); \
    if (IN(4)) { LAUNDER if (MK_DUP == 41) ph_dsa_attn<1>(a, lds, tid, lane, wave, blk, nblk); if (MK_DUP == 42) ph_dsa_attn<2>(a, lds, tid, lane, wave, blk, nblk); ph_dsa_attn<0>(a, lds, tid, lane, wave, blk, nblk); } \
    SEAM(4); \
    if (IN(5) && FUSE56) { LAUNDER \
        pg8::Gemm g{(const bf16_t*)(ws + WS_OAB), (const bf16_t*)(ws + WS_WBA), NTOK, 1024, 1024}; \
        pg8::StaticOrder S; S.init(NTOK, 1024, nblk, blk); \
        EpiMerged E{ws + WS_G0, ws + WS_G1, (bf16_t*)(ws + WS_MERGED)}; \
        pg8::gemm_phase<EpiMerged, pg8::StaticOrder, true, true, 0>(lds, g, S, E); \
    } \
    if (IN(5) && !FUSE56) { LAUNDER \
        pg8::Gemm g{(const bf16_t*)(ws + WS_OAB), (const bf16_t*)(ws + WS_WBA), NTOK, 1024, (F8_BR || BR8) ? 256 : 512}; \
        pg8::StaticOrder S; S.init(NTOK, 1024, nblk, blk); \
        EpiGate<0> E{(const bf16_t*)(ws + WS_G0), (bf16_t*)(ws + WS_MERGED), (const unsigned*)(ws + WS_CTL) + CW_WMAX + 1, nullptr, nullptr}; \
        pg8::gemm_phase<EpiGate<0>, pg8::StaticOrder, true, true, F8_BR ? 1 : BR8 ? 2 : 0>(lds, g, S, E); \
    } \
    SEAM(5); \
    if (IN(6) && !FUSE56) { LAUNDER \
        pg8::Gemm g{(const bf16_t*)(ws + WS_OAB + (size_t)NTOK * 512 * ((F8_BR || BR8) ? 1 : 2)), (const bf16_t*)(ws + WS_WBB), NTOK, 1024, (F8_BR || BR8) ? 256 : 512}; \
        pg8::StaticOrder S; S.init(NTOK, 1024, nblk, blk); \
        EpiGate<1> E{(const bf16_t*)(ws + WS_G1), (bf16_t*)(ws + WS_MERGED), (const unsigned*)(ws + WS_CTL) + CW_WMAX + 2, ws + WS_MERGED8, (const float*)(ws + WS_OBS)}; \
        pg8::gemm_phase<EpiGate<1>, pg8::StaticOrder, true, true, F8_BR ? 1 : BR8 ? 2 : 0>(lds, g, S, E); \
    } \
    SEAM(6); \
    if (IN(7)) { LAUNDER \
        pg8::Gemm g{(const bf16_t*)(ws + (F8_BR ? WS_MERGED8 : WS_MERGED)), (const bf16_t*)(ws + WS_WOUT), NTOK, 1024, F8_BR ? 512 : 1024}; \
        pg8::StaticOrder S; S.init(NTOK, 1024, nblk, blk); \
        EpiResid E{a.x, mod, a.out, F8_BR ? 1.f / (ASC8 * wscale8(ws, 3)) : 1.f}; \
        pg8::gemm_phase<EpiResid, pg8::StaticOrder, true, true, F8_BR ? 1 : 0>(lds, g, S, E); \
    } \
    SEAM(7); \
    if (IN(8)) { LAUNDER ph_norm<true, PQ_MODE == 0, PQ_MODE == 1, UD8>(a.out, a.norm2_g, mod, 3072, 4096, (bf16_t*)(ws + WS_H), ws + WS_H, ws + WS_H8, (float*)(ws + WS_HS), lane, wave, blk, nblk, ws + WS_HA4, ws + WS_HB4); } \
    SEAM(8); \
    if (IN(9)) { LAUNDER \
        pg8::Gemm g{(const bf16_t*)(ws + (PQ_MODE == 2 ? WS_H8 : WS_H)), (const bf16_t*)(ws + WS_WPQ), NTOK, 2048, PQ_MODE ? 512 : 1024}; \
        pg8::StaticOrder S; S.init(NTOK, 2048, nblk, blk); \
        if (PQ_MODE == 2) { EpiPlainI8 E{(bf16_t*)(ws + WS_QP), 2048, (const float*)(ws + WS_HS), (const unsigned*)(ws + WS_CTL) + CW_WMAX + 4}; pg8::gemm_phase<EpiPlainI8, pg8::StaticOrder, true, true, 2>(lds, g, S, E); } \
        else { EpiPlain E{(bf16_t*)(ws + WS_QP), 2048, F8_PQ ? 1.f / (ASC8 * wscale8(ws, 4)) : 1.f}; pg8::gemm_phase<EpiPlain, pg8::StaticOrder, true, true, (PQ_MODE == 1 ? 1 : 0)>(lds, g, S, E); } \
    } \
    SEAM(9); \
    if (IN(10)) { LAUNDER ph_peer_route(a, lds, tid, lane, wave, blk, nblk); } \
    SEAM(10); \
    if (IN(11)) { LAUNDER if (MK_DUP == 111 || MK_DUP == 112) { if (MK_DUP == 111) ph_peer_slices<0, true>(a, lds, lane, wave, xbar.x); else ph_peer_slices<0, false>(a, lds, lane, wave, xbar.x); xcd_barrier(xbar); if (tid == 0 && blk == 0) { for (int q = 0; q < 8; ++q) ((unsigned*)(ws + WS_CTL))[8192 + 64 * q] = 0u; } xcd_barrier(xbar); } ph_peer_slices<0>(a, lds, lane, wave, xbar.x); xcd_barrier(xbar); if (MK_DUP == 110) { if (tid == 0 && blk == 0) { for (int q = 0; q < 8; ++q) ((unsigned*)(ws + WS_CTL))[8192 + 64 * q] = 0u; } xcd_barrier(xbar); ph_peer_slices<0>(a, lds, lane, wave, xbar.x); xcd_barrier(xbar); } ph_peer_combine(a, tid, blk, nblk); xcd_barrier(xbar); ph_peer_slices<2>(a, lds, lane, wave, xbar.x); }
__global__ void __launch_bounds__(512, 2) mk_fwd(KArgs a) {
    extern __shared__ __attribute__((aligned(16))) unsigned char lds_raw[];
    LAS unsigned char* lds = (LAS unsigned char*)lds_raw;
    const int tid0 = threadIdx.x, wave = __builtin_amdgcn_readfirstlane(tid0 >> 6);
    const int blk = blockIdx.x, nblk = gridDim.x;
    unsigned char* ws = a.ws;
    int lo = a.ph_lo, hi = a.ph_hi;
    volatile LAS unsigned* xst = (volatile LAS unsigned*)(lds + LDS_BYTES - 64);
    if (tid0 < 2) xst[tid0] = 0u;
    __syncthreads();
    XcdBarrier xbar = xcd_barrier_post((unsigned*)(ws + WS_CTL) + 4096, xst);
#ifndef MK_ONLY
#define MK_ONLY -1
#endif
#ifndef MK_MASK
#define MK_MASK 0xFFF
#endif
#define IN(k) ((MK_ONLY < 0 || MK_ONLY == (k)) && ((MK_MASK >> (k)) & 1) && lo <= (k) && (k) < hi)
#define LAUNDER int tid_l = tid0; asm volatile("" : "+v"(tid_l)); const int tid = tid_l, lane = tid_l & 63; (void)tid; (void)lane;
#define SEAM(k) do { if (IN(k) && IN((k) + 1) && !(FUSE56 && (k) == 5)) { if ((k) == 0) cg::this_grid().sync(); else xcd_barrier(xbar); } } while (0)
    const float* mod = (const float*)(ws + WS_MOD);
#if MK_PREFIX >= 0
    hi = MK_PREFIX + 1;
    PROGRAM()
    xcd_barrier(xbar);
    hi = a.ph_hi;
#endif
    PROGRAM()
#undef IN
#undef SEAM
}

extern "C" void kernel_launch(void* const* d_in, const int* in_sizes, int n_in, void* d_out, int out_size, void* d_ws, size_t ws_size, hipStream_t stream) {
    static int grid = 0;
    if (grid == 0) {
        if (n_in != 24 || in_sizes[0] != NTOK * DM || out_size != NTOK * DM || ws_size < WS_END) {
            fprintf(stderr, "kernel_launch: unexpected problem (n_in %d, in0 %d, out %d, ws %zu)\n", n_in, n_in > 0 ? in_sizes[0] : -1, out_size, ws_size); grid = -1; return; }
        int dev = 0, cus = 0, per_cu = 0;
        if (hipGetDevice(&dev) != hipSuccess || hipDeviceGetAttribute(&cus, hipDeviceAttributeMultiprocessorCount, dev) != hipSuccess) { grid = -1; return; }
        if (hipFuncSetAttribute((const void*)mk_fwd, hipFuncAttributeMaxDynamicSharedMemorySize, LDS_BYTES) != hipSuccess) { fprintf(stderr, "kernel_launch: hipFuncSetAttribute failed\n"); grid = -1; return; }
        if (hipOccupancyMaxActiveBlocksPerMultiprocessor(&per_cu, (const void*)mk_fwd, 512, LDS_BYTES) != hipSuccess || per_cu < 1) { fprintf(stderr, "kernel_launch: occupancy query says %d\n", per_cu); }
        (void)hipGetLastError();
        grid = cus;
    }
    if (grid < 0) return;
    if (hipMemsetAsync((char*)d_ws + WS_CTL, 0, 65536, stream) != hipSuccess) { fprintf(stderr, "kernel_launch: memset of the control words failed\n"); return; }
    KArgs a{};
    const float** fp = (const float**)&a;
    for (int i = 0; i < 24; ++i) fp[i] = (const float*)d_in[i];
    a.out = (float*)d_out; a.ws = (unsigned char*)d_ws;
#if MK_ONE_LAUNCH
    a.ph_lo = 0; a.ph_hi = N_PHASES;
    void* args[] = {&a};
    hipError_t e = hipLaunchCooperativeKernel((const void*)mk_fwd, dim3(grid), dim3(512), args, LDS_BYTES, stream);
    if (e != hipSuccess) fprintf(stderr, "kernel_launch: cooperative launch failed: %s (grid %d)\n", hipGetErrorString(e), grid);
#else
    for (int p = 0; p < N_PHASES; ++p) {
        a.ph_lo = p; a.ph_hi = p + 1;
        hipLaunchKernelGGL(mk_fwd, dim3(grid), dim3(512), LDS_BYTES, stream, a);
    }
#endif
}
```

```cpp
#include <hip/hip_runtime.h>
#include <hip/hip_cooperative_groups.h>
#include <cstdio>
#include <cstdint>
namespace cg = cooperative_groups;

#define LAS __attribute__((address_space(3)))
#define DI __device__ __forceinline__
typedef unsigned short bf16_t;
typedef short bf16x8 __attribute__((ext_vector_type(8)));
typedef short s16x4 __attribute__((ext_vector_type(4)));
typedef float f32x2 __attribute__((ext_vector_type(2)));
typedef float f32x4 __attribute__((ext_vector_type(4)));
typedef float f32x16 __attribute__((ext_vector_type(16)));
typedef unsigned u32x2 __attribute__((ext_vector_type(2)));
typedef unsigned u32x4 __attribute__((ext_vector_type(4)));
typedef __bf16 bf16x2_t __attribute__((ext_vector_type(2)));
typedef int i32x8 __attribute__((ext_vector_type(8)));

constexpr int NB = 32, NT = 2048, DM = 1024, NTOK = NB * NT;
constexpr int NPROJ = 4864;
constexpr int WIN_COLS = 4808;
constexpr float EPS = 1e-6f;
constexpr float QSCALE = 0.125f * 1.4426950408889634f;
constexpr float USCALE = 64.f, VSCALE = 4.f;
constexpr float LAMBDA_INIT = 0.2f;
constexpr int PQ_MODE = 2;
constexpr bool F8_PQ = (PQ_MODE == 1);
constexpr bool F8_BR = false;
constexpr bool U4 = true;
constexpr float U4_STEP = 0.0657f;
constexpr bool UD8 = true;
constexpr bool V4 = true;
constexpr float V4_S = 0.098f;
constexpr float V4_WSC = 64.f;
typedef _Float16 h16x2 __attribute__((ext_vector_type(2)));
typedef _Float16 h16x4 __attribute__((ext_vector_type(4)));
typedef _Float16 h16x8 __attribute__((ext_vector_type(8)));
constexpr bool BR8 = false;
constexpr float OA_MAX = 5.0f;
constexpr bool F8_OUT = true;
constexpr bool FUSE56 = true;
constexpr bool G8 = true;
constexpr int IN_MODE = 2;
constexpr unsigned IN8_MASK = 0x7FFFFu;
constexpr int N8_IN = __builtin_popcount(IN8_MASK), NB_IN = 19 - N8_IN;

constexpr size_t MiB = 1u << 20;
constexpr size_t WS_CTL = 0;
constexpr size_t WS_MOD = 1 * MiB;
constexpr size_t WS_COS = 2 * MiB;
constexpr size_t WS_SIN = 10 * MiB;
constexpr size_t WS_WIN = 18 * MiB;
constexpr size_t WS_WBA = 28 * MiB;
constexpr size_t WS_WBB = 29 * MiB;
constexpr size_t WS_WOUT = 30 * MiB;
constexpr size_t WS_WPQ = 32 * MiB;
constexpr size_t WS_SKB = 36 * MiB;
constexpr size_t WS_UB = 40 * MiB;
constexpr size_t WS_VB = 72 * MiB;
constexpr size_t WS_H = 104 * MiB;
constexpr size_t WS_QD = 232 * MiB;
constexpr size_t WS_KD = 296 * MiB;
constexpr size_t WS_VD = 360 * MiB;
constexpr size_t WS_QS = 424 * MiB;
constexpr size_t WS_QI = 488 * MiB;
constexpr size_t WS_KS = 552 * MiB;
constexpr size_t WS_VS = 560 * MiB;
constexpr size_t WS_KI = 568 * MiB;
constexpr size_t WS_WIDX = 576 * MiB;
constexpr size_t WS_G0 = 578 * MiB;
constexpr size_t WS_G1 = 706 * MiB;
constexpr size_t WS_BM = 834 * MiB;
constexpr size_t WS_OAB = 850 * MiB;
constexpr size_t WS_END = 978 * MiB;
constexpr size_t WS_MERGED = WS_QD;
constexpr size_t WS_QP = WS_VD;
constexpr size_t WS_EIDX = 616 * MiB;
constexpr size_t WS_GW = 648 * MiB;
constexpr size_t WS_PART = WS_QP;
constexpr size_t WS_WGT = WS_MERGED;
constexpr size_t WS_WIN8 = WS_WIN + (size_t)NB_IN * 256 * 1024 * 2;
constexpr size_t WS_HF8 = WS_OAB;
constexpr size_t WS_HS1 = WS_OAB + 64 * MiB;
constexpr size_t WS_HA4 = WS_H;
constexpr size_t WS_HB4 = WS_H + 32 * MiB;
constexpr size_t WS_OBS = WS_OAB + 96 * MiB;
constexpr size_t WS_MERGED8 = WS_VD;
constexpr size_t WS_H8 = 264 * MiB;
constexpr size_t WS_HS = 328 * MiB;
constexpr int CW_UMAX = 12288;
constexpr int CW_VMAX = 12289;
constexpr int CW_WMAX = 12296;
constexpr float ASC8 = 16.f, WTOP8 = 224.f;
static_assert(WS_QP + (size_t)NTOK * 2048 * 2 <= WS_EIDX, "ws map");
static_assert(WS_GW + (size_t)NTOK * 128 * 4 <= WS_BM, "ws map");

constexpr int LDS_BYTES = 163840;

DI unsigned f2bf(float f) { unsigned u = __builtin_bit_cast(unsigned, f); return (u + 0x7fffu + ((u >> 16) & 1u)) >> 16; }
DI unsigned pk2(float lo, float hi) { f32x2 v = {lo, hi}; bf16x2_t b = __builtin_convertvector(v, bf16x2_t); return __builtin_bit_cast(unsigned, b); }
DI float bflo(unsigned p) { return __builtin_bit_cast(float, p << 16); }
DI float bfhi(unsigned p) { return __builtin_bit_cast(float, p & 0xffff0000u); }
DI float wave_sum(float v) {
#pragma unroll
    for (int o = 1; o < 64; o <<= 1) v += __shfl_xor(v, o);
    return v;
}
DI float fexp2(float x) { return __builtin_amdgcn_exp2f(x); }
DI int rank_in(unsigned mask, int pn) { return __builtin_popcount(mask & ((1u << pn) - 1u)); }
DI int kth_in(unsigned mask, int k) { int pn = 0; for (int i = 0; i < 19; ++i) { if ((mask >> i) & 1u) { if (k == 0) pn = i; --k; } } return pn; }
DI unsigned pack_fp8x4(float a, float b, float c, float d) {
    a = __builtin_amdgcn_fmed3f(a, -448.f, 448.f); b = __builtin_amdgcn_fmed3f(b, -448.f, 448.f); c = __builtin_amdgcn_fmed3f(c, -448.f, 448.f); d = __builtin_amdgcn_fmed3f(d, -448.f, 448.f);
    int w = 0; w = __builtin_amdgcn_cvt_pk_fp8_f32(a, b, w, false); w = __builtin_amdgcn_cvt_pk_fp8_f32(c, d, w, true); return (unsigned)w;
}

struct KArgs {
    const float* x; const float* c; const int* pos; const float* w_ada; const float* b_ada; const float* norm1_g; const float* w_in;
    const float* diff_q_g; const float* diff_k_g; const float* lq1; const float* lk1; const float* lq2; const float* lk2; const float* diff_out_g;
    const float* dsa_q_g; const float* dsa_k_g; const float* w_ba; const float* w_bb; const float* w_out; const float* norm2_g;
    const float* peer_wq; const float* sub_keys; const float* peer_u; const float* peer_v;
    float* out; unsigned char* ws; int ph_lo, ph_hi;
};
namespace pg8 {
#define PG8_LAS __attribute__((address_space(3)))
typedef unsigned short bf16_t;
typedef short bf16x8 __attribute__((ext_vector_type(8)));
typedef float f32x4 __attribute__((ext_vector_type(4)));
typedef unsigned u32x4 __attribute__((ext_vector_type(4)));
typedef int i32x8_t __attribute__((ext_vector_type(8)));
constexpr int BM = 256, BK = 64, HALF = 128, HTB = HALF * BK * 2  , STAGE_BYTES = 8 * HTB, NXCD = 8, WGM = 8;

__host__ __device__ __forceinline__ int lds_byte(int r, int c) { const int st = (r >> 4) * 2 + (c >> 5), rr = r & 15, cc = c & 31, ob = rr * 64 + cc * 2; return st * 1024 + (ob ^ (((ob >> 9) & 1) << 5)); }
__host__ __device__ __forceinline__ void stage_rc(int b, int& R, int& C) { const int st = b / 1024, sb = b % 1024, swz = sb ^ (((sb >> 9) & 1) << 5); R = (st >> 1) * 16 + swz / 64; C = (st & 1) * 32 + (swz % 64) / 2; }
__host__ __device__ __forceinline__ int perm32(int rho) { const int n = rho >> 4, i = rho & 15; return 8 * (i >> 2) + 4 * n + (i & 3); }

struct Unit { int pm, pn; };
struct Gemm { const bf16_t* A; const bf16_t* Bt; int M, N, K; };

struct StaticOrder {
    int nM, nN, nwg, G, c;
    __host__ __device__ void init(int M, int N, int G_, int c_) { nM = M / BM; nN = N / BM; nwg = nM * nN; G = G_; c = c_; }
    __host__ __device__ bool next(int i, Unit& u) const {
        const long L = (long)i * G + c; if (L >= nwg) return false;
        int wgid = (int)L; { const int q = nwg / NXCD, r = nwg % NXCD, xcd = wgid % NXCD, off = wgid / NXCD; wgid = (xcd < r ? xcd * (q + 1) : r * (q + 1) + (xcd - r) * q) + off; }
        const int nig = WGM * nN, gid = wgid / nig, fm = gid * WGM, gsz = (nM - fm) < WGM ? (nM - fm) : WGM;
        u.pm = fm + ((wgid % nig) % gsz); u.pn = (wgid % nig) / gsz; return true;
    }
    __device__ __forceinline__ void a_ready(const Unit&) const {}
    __device__ __forceinline__ void done(const Unit&) const {}
};

__device__ __forceinline__ unsigned cvt_pk_bf16(float lo, float hi) { unsigned r; asm volatile("v_cvt_pk_bf16_f32 %0, %1, %2" : "=v"(r) : "v"(lo), "v"(hi)); return r; }
template <class Epi, class Sched, bool ALIGN_EPI = false, bool SP2 = false, int QM = 0>
__device__ __forceinline__ void gemm_phase(PG8_LAS unsigned char* lds, const Gemm g, const Sched& S, const Epi& E) {
    constexpr bool F8 = (QM == 1);
    typedef int i32x4_t __attribute__((ext_vector_type(4)));
    const int tid = threadIdx.x, wid = __builtin_amdgcn_readfirstlane(tid >> 6), lane = tid & 63, wr = wid >> 2, wc = wid & 3, fr = lane & 15, fq = lane >> 4;
    const int K = g.K, nt = K / BK;
    unsigned voffA[2], voffB[2];
#pragma unroll
    for (int i = 0; i < 2; ++i) { int R, C; stage_rc(tid * 16 + i * 8192, R, C); const int Rb = Epi::PERM ? ((R & ~31) + perm32(R & 31)) : R;
        voffA[i] = (unsigned)(R * K + C) * 2u; voffB[i] = (unsigned)(Rb * K + C) * 2u; }
    const size_t kstep = (size_t)(BK * 2);
    const size_t hstep = (size_t)HALF * K * 2;
    const size_t tstep = 2 * hstep;
    const unsigned ldsw = (unsigned)wid * 1024u;
    const int aoff = lds_byte(wr * 64 + fr, fq * 8), boff = lds_byte(wc * 32 + fr, fq * 8);
#define PG8_SA(b, h) (((b) * 2 + (h)) * HTB)
#define PG8_SB(b, h) ((4 + (b) * 2 + (h)) * HTB)
#define PG8_STAGE(bufoff, gbase, voff) do { _Pragma("unroll") for (int _i = 0; _i < 2; ++_i) \
        __builtin_amdgcn_global_load_lds((const unsigned*)((const char*)(gbase) + (voff)[_i]), (PG8_LAS unsigned*)(lds + (bufoff) + ldsw + _i * 8192), 16, 0, 0); } while (0)
#define PG8_CAT2(x0, x1) __builtin_bit_cast(i32x8_t, __builtin_shufflevector((x0), (x1), 0, 1, 2, 3, 4, 5, 6, 7, 8, 9, 10, 11, 12, 13, 14, 15))
#define PG8_LDA(dst, b, h) do { _Pragma("unroll") for (int m = 0; m < 4; ++m) { const bf16x8 f0_ = *(const PG8_LAS bf16x8*)(lds + PG8_SA(b, h) + aoff + m * 2048), f1_ = *(const PG8_LAS bf16x8*)(lds + PG8_SA(b, h) + aoff + m * 2048 + 1024); \
        if constexpr (F8) dst##8[m] = PG8_CAT2(f0_, f1_); else { dst[m][0] = f0_; dst[m][1] = f1_; } } } while (0)
#define PG8_LDB(dst, b, h) do { _Pragma("unroll") for (int n = 0; n < 2; ++n) { const bf16x8 f0_ = *(const PG8_LAS bf16x8*)(lds + PG8_SB(b, h) + boff + n * 2048), f1_ = *(const PG8_LAS bf16x8*)(lds + PG8_SB(b, h) + boff + n * 2048 + 1024); \
        if constexpr (F8) dst##8[n] = PG8_CAT2(f0_, f1_); else { dst[n][0] = f0_; dst[n][1] = f1_; } } } while (0)
#define PG8_MMA(ai, bj, At, Bt) do { __builtin_amdgcn_s_setprio(1); _Pragma("unroll") for (int m = 0; m < 4; ++m) _Pragma("unroll") for (int n = 0; n < 2; ++n) { \
        if constexpr (F8) asm volatile("v_mfma_f32_16x16x128_f8f6f4 %0, %1, %2, %0" : "+v"(acc[ai][bj][m][n]) : "v"(Bt##8[n]), "v"(At##8[m])); \
        else if constexpr (QM == 2) { _Pragma("unroll") for (int k = 0; k < 2; ++k) acc[ai][bj][m][n] = __builtin_bit_cast(f32x4, __builtin_amdgcn_mfma_i32_16x16x64_i8(__builtin_bit_cast(i32x4_t, Bt[n][k]), __builtin_bit_cast(i32x4_t, At[m][k]), __builtin_bit_cast(i32x4_t, acc[ai][bj][m][n]), 0, 0, 0)); } \
        else { _Pragma("unroll") for (int k = 0; k < 2; ++k) acc[ai][bj][m][n] = __builtin_amdgcn_mfma_f32_16x16x32_bf16(Bt[n][k], At[m][k], acc[ai][bj][m][n], 0, 0, 0); } } __builtin_amdgcn_s_setprio(0); } while (0)
#define PG8_WAIT_V(n) asm volatile("s_waitcnt vmcnt(" #n ")" ::: "memory")
#define PG8_WAIT_L(n) asm volatile("s_waitcnt lgkmcnt(" #n ")" ::: "memory")
#define PG8_BAR __builtin_amdgcn_s_barrier()
#define PG8_SCHED __builtin_amdgcn_sched_barrier(0)
    Unit cur, nxt; int ui = 0;
    if (!S.next(0, cur)) return;
    f32x4 acc[2][2][4][2];
#pragma unroll
    for (int a = 0; a < 2; ++a)
#pragma unroll
        for (int b = 0; b < 2; ++b)
#pragma unroll
            for (int m = 0; m < 4; ++m)
#pragma unroll
                for (int n = 0; n < 2; ++n) acc[a][b][m][n] = (f32x4){0.f, 0.f, 0.f, 0.f};
    bf16x8 At[4][2], B0[2][2], B1[2][2]; i32x8_t At8[4], B08[2], B18[2];
    const char* cA = (const char*)g.A + (size_t)cur.pm * tstep; const char* cB = (const char*)g.Bt + (size_t)cur.pn * tstep;
    S.a_ready(cur);
    if constexpr (SP2) {
        PG8_STAGE(PG8_SB(0, 0), cB, voffB); PG8_STAGE(PG8_SB(0, 1), cB + hstep, voffB); PG8_STAGE(PG8_SA(0, 0), cA, voffA); PG8_STAGE(PG8_SA(0, 1), cA + hstep, voffA);
        if (wr == 1) PG8_BAR;
        PG8_WAIT_V(2); PG8_BAR;
        PG8_STAGE(PG8_SB(1, 0), cB + kstep, voffB); PG8_STAGE(PG8_SA(1, 0), cA + kstep, voffA); PG8_STAGE(PG8_SB(1, 1), cB + hstep + kstep, voffB);
        PG8_WAIT_V(6); PG8_BAR;
    } else {
        PG8_STAGE(PG8_SB(0, 0), cB, voffB); PG8_STAGE(PG8_SA(0, 0), cA, voffA); PG8_STAGE(PG8_SB(0, 1), cB + hstep, voffB); PG8_STAGE(PG8_SA(0, 1), cA + hstep, voffA);
        if (wr == 1) PG8_BAR;
        PG8_WAIT_V(4); PG8_BAR;
        PG8_STAGE(PG8_SB(1, 0), cB + kstep, voffB); PG8_STAGE(PG8_SA(1, 0), cA + kstep, voffA); PG8_STAGE(PG8_SB(1, 1), cB + hstep + kstep, voffB);
        PG8_WAIT_V(6); PG8_BAR;
    }
    for (;;) {
        const bool has_next = S.next(ui + 1, nxt);
        const char* nA = has_next ? (const char*)g.A + (size_t)nxt.pm * tstep : cA; const char* nB = has_next ? (const char*)g.Bt + (size_t)nxt.pn * tstep : cB;
#pragma unroll 1
        for (int t = 0; t < nt; t += 2) {
            if constexpr (Epi::MID) { if (t == nt / 2) E.mid(acc, cur, wr, wc, fr, fq); }
            const bool last = (t == nt - 2);
            const char* a1 = cA + (size_t)(t + 1) * kstep;
            const char* a2 = last ? nA : cA + (size_t)(t + 2) * kstep; const char* b2 = last ? nB : cB + (size_t)(t + 2) * kstep;
            const char* a3 = a2 + kstep; const char* b3 = b2 + kstep;
            if (last && has_next) S.a_ready(nxt);
            if constexpr (SP2) {
            PG8_LDB(B0, 0, 0); PG8_LDB(B1, 0, 1); PG8_SCHED; PG8_LDA(At, 0, 0); PG8_STAGE(PG8_SA(1, 1), a1 + hstep, voffA);
            PG8_WAIT_V(8); PG8_WAIT_L(0); PG8_BAR; PG8_MMA(0, 0, At, B0); PG8_MMA(0, 1, At, B1); PG8_BAR; PG8_SCHED;
            PG8_LDA(At, 0, 1); PG8_STAGE(PG8_SB(0, 0), b2, voffB); PG8_STAGE(PG8_SB(0, 1), b2 + hstep, voffB); PG8_STAGE(PG8_SA(0, 0), a2, voffA);
            PG8_WAIT_V(8); PG8_WAIT_L(0); PG8_BAR; PG8_MMA(1, 0, At, B0); PG8_MMA(1, 1, At, B1); PG8_BAR; PG8_SCHED;
            PG8_LDB(B0, 1, 0); PG8_LDB(B1, 1, 1); PG8_SCHED; PG8_LDA(At, 1, 0); PG8_STAGE(PG8_SA(0, 1), a2 + hstep, voffA);
            PG8_WAIT_V(8); PG8_WAIT_L(0); PG8_BAR; PG8_MMA(0, 0, At, B0); PG8_MMA(0, 1, At, B1); PG8_BAR; PG8_SCHED;
            PG8_LDA(At, 1, 1); PG8_STAGE(PG8_SB(1, 0), b3, voffB); PG8_STAGE(PG8_SB(1, 1), b3 + hstep, voffB); PG8_STAGE(PG8_SA(1, 0), a3, voffA);
            PG8_WAIT_V(8); PG8_WAIT_L(0); PG8_BAR; PG8_MMA(1, 0, At, B0); PG8_MMA(1, 1, At, B1); PG8_BAR; PG8_SCHED;
            } else {
            PG8_LDB(B0, 0, 0); PG8_SCHED; PG8_LDA(At, 0, 0); PG8_STAGE(PG8_SA(1, 1), a1 + hstep, voffA);
            PG8_WAIT_L(8); PG8_BAR; PG8_WAIT_L(0); PG8_MMA(0, 0, At, B0); PG8_BAR; PG8_SCHED;
            PG8_LDB(B1, 0, 1); PG8_STAGE(PG8_SB(0, 0), b2, voffB);
            PG8_BAR; PG8_WAIT_L(0); PG8_MMA(0, 1, At, B1); PG8_BAR;
            PG8_LDA(At, 0, 1); PG8_STAGE(PG8_SA(0, 0), a2, voffA);
            PG8_BAR; PG8_WAIT_L(0); PG8_MMA(1, 0, At, B0); PG8_BAR; PG8_SCHED;
            PG8_STAGE(PG8_SB(0, 1), b2 + hstep, voffB);
            PG8_WAIT_V(6); PG8_BAR; PG8_MMA(1, 1, At, B1); PG8_BAR;
            PG8_LDB(B0, 1, 0); PG8_SCHED; PG8_LDA(At, 1, 0); PG8_STAGE(PG8_SA(0, 1), a2 + hstep, voffA);
            PG8_WAIT_L(8); PG8_BAR; PG8_WAIT_L(0); PG8_MMA(0, 0, At, B0); PG8_BAR; PG8_SCHED;
            PG8_LDB(B1, 1, 1); PG8_STAGE(PG8_SB(1, 0), b3, voffB);
            PG8_BAR; PG8_WAIT_L(0); PG8_MMA(0, 1, At, B1); PG8_BAR;
            PG8_LDA(At, 1, 1); PG8_STAGE(PG8_SA(1, 0), a3, voffA);
            PG8_BAR; PG8_WAIT_L(0); PG8_MMA(1, 0, At, B0); PG8_BAR; PG8_SCHED;
            PG8_STAGE(PG8_SB(1, 1), b3 + hstep, voffB);
            PG8_WAIT_V(6); PG8_BAR; PG8_MMA(1, 1, At, B1); PG8_BAR;
            }
        }
        if constexpr (ALIGN_EPI) { if (wr == 0) PG8_BAR; }
        if constexpr (F8) asm volatile("s_nop 15\n\ts_nop 15\n\ts_nop 15");
        if constexpr (!Epi::AFTER_DRAIN) { E(acc, cur, wr, wc, fr, fq); S.done(cur); }
        if (!has_next) break;
#pragma unroll
        for (int a = 0; a < 2; ++a)
#pragma unroll
            for (int b = 0; b < 2; ++b)
#pragma unroll
                for (int m = 0; m < 4; ++m)
#pragma unroll
                    for (int n = 0; n < 2; ++n) acc[a][b][m][n] = (f32x4){0.f, 0.f, 0.f, 0.f};
        cur = nxt; cA = nA; cB = nB; ++ui;
        if constexpr (ALIGN_EPI) { if (wr == 1) PG8_BAR; }
    }
    PG8_WAIT_V(0);
    if constexpr (!ALIGN_EPI) { if (wr == 0) PG8_BAR; }
    PG8_BAR;
    if constexpr (Epi::AFTER_DRAIN) { E.fused(acc, cur, wr, wc, fr, fq, lds, wid, lane); S.done(cur); }
#undef PG8_SA
#undef PG8_SB
#undef PG8_STAGE
#undef PG8_LDA
#undef PG8_LDB
#undef PG8_MMA
#undef PG8_CAT2
#undef PG8_WAIT_V
#undef PG8_WAIT_L
#undef PG8_BAR
#undef PG8_SCHED
}
}
DI int proj_group_base(int g) {
    if (g < 8) return 64 * g;
    if (g < 16) return 512 + 64 * (g - 8);
    if (g < 24) return 1024 + 64 * (g - 16);
    if (g < 32) return 1536 + 64 * (g - 24);
    if (g < 40) return 2176 + 64 * (g - 32);
    if (g == 40) return 2048;
    if (g == 41) return 2112;
    if (g == 42) return 2688;
    if (g == 43) return 2752;
    if (g < 60) return 2760 + 64 * (g - 44);
    return 3784 + 64 * (g - 60);
}

template <int QM> struct EpiProjT {
    static constexpr bool PERM = true, AFTER_DRAIN = false, MID = false;
    bf16_t *Qd, *Kd, *Vd, *Qs, *Qi, *Ks, *Vs, *Ki, *G0, *G1; float* Widx;
    const float *cosT, *sinT;
    const float *gq, *gk, *gsq, *gsk;
    const unsigned* wm;
    const float* rs;
    __device__ __forceinline__ void operator()(const pg8::f32x4 (&acc)[2][2][4][2], const pg8::Unit& u, int wr, int wc, int fr, int fq) const {
        const int g = kth_in(QM ? IN8_MASK : (~IN8_MASK & 0x7FFFFu), u.pn) * 4 + wc;
        const float asc = QM == 1 ? __builtin_bit_cast(float, *wm) * (1.f / (ASC8 * WTOP8)) : QM == 2 ? __builtin_bit_cast(float, *wm) * (1.f / 127.f) : 1.f;
        int kind; bf16_t* dst = nullptr; int ld = 512, col = 0; const float* gn = nullptr; float scale = 1.f;
        if (g < 8) { kind = 1; dst = Qd; col = 64 * g; gn = gq; scale = QSCALE; }
        else if (g < 16) { kind = 1; dst = Kd; col = 64 * (g - 8); gn = gk; }
        else if (g < 24) { kind = 0; dst = Vd; col = 64 * (g - 16); }
        else if (g < 32) { kind = 1; dst = Qs; col = 64 * (g - 24); gn = gsq; scale = QSCALE; }
        else if (g < 40) { kind = 2; dst = Qi; col = 64 * (g - 32); }
        else if (g == 40) { kind = 1; dst = Ks; ld = 64; gn = gsk; }
        else if (g == 41) { kind = 0; dst = Vs; ld = 64; }
        else if (g == 42) { kind = 2; dst = Ki; ld = 64; }
        else if (g == 43) { kind = 4; }
        else if (g < 60) { kind = 3; dst = G0; ld = 1024; col = 64 * (g - 44); }
        else { kind = 3; dst = G1; ld = 1024; col = 64 * (g - 60); }
        float gv[16];
#pragma unroll
        for (int i = 0; i < 16; ++i) gv[i] = 1.f;
        if (kind == 1) {
#pragma unroll
            for (int i = 0; i < 8; ++i) { gv[i] = gn[8 * fq + i]; gv[8 + i] = gn[32 + 8 * fq + i]; }
        }
        float rsv[8];
#pragma unroll
        for (int i = 0; i < 8; ++i) rsv[i] = (QM == 2) ? rs[u.pm * 256 + (i >> 2) * 128 + wr * 64 + (i & 3) * 16 + fr] : 1.f;
        f32x4 tcs[2][4];
        const bool roped = (kind == 1 || kind == 2);
#define EPI_LDTAB(i_) do { const size_t r_ = (size_t)(u.pm * 256 + ((i_) >> 2) * 128 + wr * 64 + ((i_) & 3) * 16 + fr) * 32 + 8 * fq; \
            tcs[(i_) & 1][0] = *(const f32x4*)(cosT + r_); tcs[(i_) & 1][1] = *(const f32x4*)(cosT + r_ + 4); tcs[(i_) & 1][2] = *(const f32x4*)(sinT + r_); tcs[(i_) & 1][3] = *(const f32x4*)(sinT + r_ + 4); } while (0)
        if (roped) EPI_LDTAB(0);
#pragma unroll
        for (int ai = 0; ai < 2; ++ai)
#pragma unroll
            for (int m = 0; m < 4; ++m) {
                const int row = u.pm * 256 + ai * 128 + wr * 64 + m * 16 + fr;
                if (roped && ai * 4 + m + 1 < 8) EPI_LDTAB(ai * 4 + m + 1);
                float v[16];
#pragma unroll
                for (int i = 0; i < 8; ++i) { v[i] = acc[ai][0][m][i >> 2][i & 3]; v[8 + i] = acc[ai][1][m][i >> 2][i & 3]; if (QM == 1) { v[i] *= asc; v[8 + i] *= asc; } }
                if (QM == 2) {
                    const float rsc = rsv[ai * 4 + m] * asc;
#pragma unroll
                    for (int i = 0; i < 16; ++i) v[i] = (float)__builtin_bit_cast(int, v[i]) * rsc;
                }
                if (kind == 1) {
                    float ss = 0.f;
#pragma unroll
                    for (int i = 0; i < 16; ++i) ss += v[i] * v[i];
                    ss += __shfl_xor(ss, 16); ss += __shfl_xor(ss, 32);
                    const float rn = __builtin_amdgcn_rsqf(ss * (1.f / 64.f) + EPS);
#pragma unroll
                    for (int i = 0; i < 16; ++i) v[i] = v[i] * rn * gv[i];
                }
                if (kind == 1 || kind == 2) {
                    const f32x4 c0 = tcs[(ai * 4 + m) & 1][0], c1 = tcs[(ai * 4 + m) & 1][1], s0 = tcs[(ai * 4 + m) & 1][2], s1 = tcs[(ai * 4 + m) & 1][3];
#pragma unroll
                    for (int i = 0; i < 8; ++i) {
                        const float cc = (i < 4) ? c0[i & 3] : c1[i & 3], sn = (i < 4) ? s0[i & 3] : s1[i & 3];
                        const float x1 = v[i], x2 = v[8 + i];
                        v[i] = (x1 * cc - x2 * sn) * scale; v[8 + i] = (x2 * cc + x1 * sn) * scale;
                    }
                }
                if (kind == 3) {
#pragma unroll
                    for (int i = 0; i < 16; ++i) v[i] = G8 ? __builtin_amdgcn_rcpf(__builtin_fmaf(__builtin_amdgcn_exp2f(v[i] * -1.4426950408889634f), 1.f / 255.f, 1.f / 255.f))
                                                           : __builtin_amdgcn_rcpf(1.f + __builtin_amdgcn_exp2f(v[i] * -1.4426950408889634f));
                }
                if (kind == 4) {
                    if (fq == 0) {
                        *(f32x4*)(Widx + (size_t)row * 8) = (f32x4){v[0], v[1], v[2], v[3]};
                        *(f32x4*)(Widx + (size_t)row * 8 + 4) = (f32x4){v[4], v[5], v[6], v[7]};
                    }
                } else if (kind == 3 && G8) {
                    unsigned b[4] = {0u, 0u, 0u, 0u};
#pragma unroll
                    for (int i = 0; i < 16; ++i) b[i >> 2] = __builtin_amdgcn_cvt_pk_u8_f32(__builtin_rintf(v[i]), i & 3, b[i >> 2]);
                    unsigned char* p = (unsigned char*)dst + (size_t)row * ld + col + 8 * fq;
                    *(u32x2*)p = (u32x2){b[0], b[1]}; *(u32x2*)(p + 32) = (u32x2){b[2], b[3]};
                } else {
                    u32x4 w0, w1;
                    w0.x = pk2(v[0], v[1]); w0.y = pk2(v[2], v[3]); w0.z = pk2(v[4], v[5]); w0.w = pk2(v[6], v[7]);
                    w1.x = pk2(v[8], v[9]); w1.y = pk2(v[10], v[11]); w1.z = pk2(v[12], v[13]); w1.w = pk2(v[14], v[15]);
                    bf16_t* p = dst + (size_t)row * ld + col + 8 * fq;
                    *(u32x4*)p = w0; *(u32x4*)(p + 32) = w1;
                }
                asm volatile("" ::: "memory");
            }
#undef EPI_LDTAB
    }
};

template <int MODE> struct EpiGate {
    static constexpr bool PERM = true, AFTER_DRAIN = false, MID = false;
    const bf16_t* G; bf16_t* O; const unsigned* wm; unsigned char* O8; const float* rs;
    __device__ __forceinline__ void operator()(const pg8::f32x4 (&acc)[2][2][4][2], const pg8::Unit& u, int wr, int wc, int fr, int fq) const {
        const int row0 = u.pm * 256 + wr * 64 + fr, col0 = u.pn * 256 + wc * 32 + 8 * fq;
        const float sc = F8_BR ? __builtin_bit_cast(float, *wm) * (1.f / (ASC8 * WTOP8)) : 1.f;
#pragma unroll
        for (int ai = 0; ai < 2; ++ai)
#pragma unroll
            for (int m = 0; m < 4; ++m)
#pragma unroll
                for (int bj = 0; bj < 2; ++bj) {
                    const size_t off = (size_t)(row0 + ai * 128 + m * 16) * 1024 + col0 + bj * 128;
                    float r[8];
                    pg8::f32x4 c0 = acc[ai][bj][m][0], c1 = acc[ai][bj][m][1];
                    float scr = sc;
                    if (BR8 && !F8_BR) {
                        typedef int i32x4 __attribute__((ext_vector_type(4)));
                        const i32x4 i0 = __builtin_bit_cast(i32x4, c0), i1 = __builtin_bit_cast(i32x4, c1);
                        c0 = (pg8::f32x4){(float)i0[0], (float)i0[1], (float)i0[2], (float)i0[3]}; c1 = (pg8::f32x4){(float)i1[0], (float)i1[1], (float)i1[2], (float)i1[3]};
                        scr = (rs ? rs[row0 + ai * 128 + m * 16] : OA_MAX * (1.f / 127.f)) * (__builtin_bit_cast(float, *wm) * (1.f / 127.f));
                    }
                    if (G8) {
                        const u32x2 gb = *(const u32x2*)((const unsigned char*)G + off);
                        const pg8::f32x4 a0 = c0 * (scr * (1.f / 255.f)), a1 = c1 * (scr * (1.f / 255.f));
                        r[0] = (float)(gb.x & 255u) * a0[0]; r[1] = (float)((gb.x >> 8) & 255u) * a0[1]; r[2] = (float)((gb.x >> 16) & 255u) * a0[2]; r[3] = (float)(gb.x >> 24) * a0[3];
                        r[4] = (float)(gb.y & 255u) * a1[0]; r[5] = (float)((gb.y >> 8) & 255u) * a1[1]; r[6] = (float)((gb.y >> 16) & 255u) * a1[2]; r[7] = (float)(gb.y >> 24) * a1[3];
                    } else {
                    const u32x4 gw = *(const u32x4*)(G + off);
                    const pg8::f32x4 a0 = c0 * scr, a1 = c1 * scr;
                    r[0] = bflo(gw.x) * a0[0]; r[1] = bfhi(gw.x) * a0[1]; r[2] = bflo(gw.y) * a0[2]; r[3] = bfhi(gw.y) * a0[3];
                    r[4] = bflo(gw.z) * a1[0]; r[5] = bfhi(gw.z) * a1[1]; r[6] = bflo(gw.w) * a1[2]; r[7] = bfhi(gw.w) * a1[3];
                    }
                    if (MODE == 1) {
                        const u32x4 ow = *(const u32x4*)(O + off);
                        r[0] += bflo(ow.x); r[1] += bfhi(ow.x); r[2] += bflo(ow.y); r[3] += bfhi(ow.y);
                        r[4] += bflo(ow.z); r[5] += bfhi(ow.z); r[6] += bflo(ow.w); r[7] += bfhi(ow.w);
                    }
                    if (MODE == 1 && F8_BR) {
                        u32x2 w8; w8.x = pack_fp8x4(r[0] * ASC8, r[1] * ASC8, r[2] * ASC8, r[3] * ASC8); w8.y = pack_fp8x4(r[4] * ASC8, r[5] * ASC8, r[6] * ASC8, r[7] * ASC8);
                        *(u32x2*)(O8 + off) = w8;
                    } else {
                        u32x4 w; w.x = pk2(r[0], r[1]); w.y = pk2(r[2], r[3]); w.z = pk2(r[4], r[5]); w.w = pk2(r[6], r[7]);
                        *(u32x4*)(O + off) = w;
                    }
                }
    }
};

struct EpiMerged {
    static constexpr bool PERM = true, AFTER_DRAIN = false, MID = true;
    const unsigned char* G0; const unsigned char* G1; bf16_t* O; unsigned char* O8;
    __device__ __forceinline__ void mid(pg8::f32x4 (&acc)[2][2][4][2], const pg8::Unit& u, int wr, int wc, int fr, int fq) const {
        int frl = fr; asm volatile("" : "+v"(frl));
        const int row0 = u.pm * 256 + wr * 64 + frl, col0 = u.pn * 256 + wc * 32 + 8 * fq;
        u32x2 gq[2][2];
#define EPI_LDG(i_) do { const unsigned o_ = (unsigned)(row0 + ((i_) >> 3) * 128 + (((i_) >> 1) & 3) * 16) * 1024u + (unsigned)(col0 + ((i_) & 1) * 128); \
            gq[(i_) & 1][0] = *(const u32x2*)(G0 + o_); gq[(i_) & 1][1] = *(const u32x2*)(G1 + o_); } while (0)
        EPI_LDG(0);
#pragma unroll
        for (int ai = 0; ai < 2; ++ai)
#pragma unroll
            for (int m = 0; m < 4; ++m)
#pragma unroll
                for (int bj = 0; bj < 2; ++bj) {
                    if (ai * 8 + m * 2 + bj + 1 < 16) EPI_LDG(ai * 8 + m * 2 + bj + 1);
                    const u32x2 ga = gq[(ai * 8 + m * 2 + bj) & 1][0], gb = gq[(ai * 8 + m * 2 + bj) & 1][1];
#pragma unroll
                    for (int e = 0; e < 8; ++e) {
                        const unsigned wa = e < 4 ? ga.x : ga.y, wb = e < 4 ? gb.x : gb.y;
                        const float g0 = (float)((wa >> (8 * (e & 3))) & 255u), g1 = fmaxf((float)((wb >> (8 * (e & 3))) & 255u), 1.f);
                        acc[ai][bj][m][e >> 2][e & 3] *= g0 * __builtin_amdgcn_rcpf(g1);
                    }
                    asm volatile("" ::: "memory");
                    __builtin_amdgcn_sched_barrier(0);
                }
#undef EPI_LDG
    }
    __device__ __forceinline__ void operator()(const pg8::f32x4 (&acc)[2][2][4][2], const pg8::Unit& u, int wr, int wc, int fr, int fq) const {
        const int row0 = u.pm * 256 + wr * 64 + fr, col0 = u.pn * 256 + wc * 32 + 8 * fq;
        u32x2 gq[2][2];
#define EPI_LDG1(i_) do { _Pragma("unroll") for (int bj = 0; bj < 2; ++bj) gq[(i_) & 1][bj] = *(const u32x2*)(G1 + (size_t)(row0 + ((i_) >> 2) * 128 + ((i_) & 3) * 16) * 1024 + col0 + bj * 128); } while (0)
        EPI_LDG1(0);
#pragma unroll
        for (int ai = 0; ai < 2; ++ai)
#pragma unroll
            for (int m = 0; m < 4; ++m) {
                if (ai * 4 + m + 1 < 8) EPI_LDG1(ai * 4 + m + 1);
#pragma unroll
                for (int bj = 0; bj < 2; ++bj) {
                    const size_t off = (size_t)(row0 + ai * 128 + m * 16) * 1024 + col0 + bj * 128;
                    const u32x2 gb = gq[(ai * 4 + m) & 1][bj];
                    float r[8];
#pragma unroll
                    for (int e = 0; e < 8; ++e) {
                        const unsigned wb = e < 4 ? gb.x : gb.y;
                        r[e] = acc[ai][bj][m][e >> 2][e & 3] * (fmaxf((float)((wb >> (8 * (e & 3))) & 255u), 1.f) * (1.f / 255.f));
                    }
                    if (F8_OUT) { u32x2 w8; w8.x = pack_fp8x4(r[0] * ASC8, r[1] * ASC8, r[2] * ASC8, r[3] * ASC8); w8.y = pack_fp8x4(r[4] * ASC8, r[5] * ASC8, r[6] * ASC8, r[7] * ASC8); *(u32x2*)(O8 + off) = w8; }
                    else { u32x4 w; w.x = pk2(r[0], r[1]); w.y = pk2(r[2], r[3]); w.z = pk2(r[4], r[5]); w.w = pk2(r[6], r[7]); *(u32x4*)(O + off) = w; }
                }
            }
#undef EPI_LDG1
    }
};

struct EpiResid {
    static constexpr bool PERM = false, AFTER_DRAIN = false, MID = false;
    const float* x; const float* mod; float* out; float sc;
    __device__ __forceinline__ void operator()(const pg8::f32x4 (&acc)[2][2][4][2], const pg8::Unit& u, int wr, int wc, int fr, int fq) const {
        const int b = u.pm >> 3; const float* g1 = mod + (size_t)b * 6144 + 2048;
        const int row0 = u.pm * 256 + wr * 64 + fr, col0 = u.pn * 256 + wc * 32 + 4 * fq;
        pg8::f32x4 gv[2][2];
#pragma unroll
        for (int bj = 0; bj < 2; ++bj)
#pragma unroll
            for (int n = 0; n < 2; ++n) gv[bj][n] = *(const pg8::f32x4*)(g1 + col0 + bj * 128 + n * 16) * sc;
        pg8::f32x4 xq[2][4];
#define EPI_LDX(i_) do { _Pragma("unroll") for (int bj = 0; bj < 2; ++bj) _Pragma("unroll") for (int n = 0; n < 2; ++n) \
            xq[(i_) & 1][bj * 2 + n] = *(const pg8::f32x4*)(x + (size_t)(row0 + ((i_) >> 2) * 128 + ((i_) & 3) * 16) * 1024 + col0 + bj * 128 + n * 16); } while (0)
        EPI_LDX(0);
#pragma unroll
        for (int ai = 0; ai < 2; ++ai)
#pragma unroll
            for (int m = 0; m < 4; ++m) {
                if (ai * 4 + m + 1 < 8) EPI_LDX(ai * 4 + m + 1);
#pragma unroll
                for (int bj = 0; bj < 2; ++bj)
#pragma unroll
                    for (int n = 0; n < 2; ++n) {
                        const size_t off = (size_t)(row0 + ai * 128 + m * 16) * 1024 + col0 + bj * 128 + n * 16;
                        *(pg8::f32x4*)(out + off) = xq[(ai * 4 + m) & 1][bj * 2 + n] + gv[bj][n] * acc[ai][bj][m][n];
                    }
            }
#undef EPI_LDX
    }
};

struct EpiPlain {
    static constexpr bool PERM = true, AFTER_DRAIN = false, MID = false;
    bf16_t* O; int ldc; float sc;
    __device__ __forceinline__ void operator()(const pg8::f32x4 (&acc)[2][2][4][2], const pg8::Unit& u, int wr, int wc, int fr, int fq) const {
        const int row0 = u.pm * 256 + wr * 64 + fr, col0 = u.pn * 256 + wc * 32 + 8 * fq;
#pragma unroll
        for (int ai = 0; ai < 2; ++ai)
#pragma unroll
            for (int m = 0; m < 4; ++m)
#pragma unroll
                for (int bj = 0; bj < 2; ++bj) {
                    const pg8::f32x4 a0 = acc[ai][bj][m][0] * sc, a1 = acc[ai][bj][m][1] * sc;
                    u32x4 w; w.x = pk2(a0[0], a0[1]); w.y = pk2(a0[2], a0[3]); w.z = pk2(a1[0], a1[1]); w.w = pk2(a1[2], a1[3]);
                    *(u32x4*)(O + (size_t)(row0 + ai * 128 + m * 16) * ldc + col0 + bj * 128) = w;
                }
    }
};

struct EpiPlainI8 {
    static constexpr bool PERM = true, AFTER_DRAIN = false, MID = false;
    bf16_t* O; int ldc; const float* rs; const unsigned* wm;
    __device__ __forceinline__ void operator()(const pg8::f32x4 (&acc)[2][2][4][2], const pg8::Unit& u, int wr, int wc, int fr, int fq) const {
        typedef int i32x4 __attribute__((ext_vector_type(4)));
        const int row0 = u.pm * 256 + wr * 64 + fr, col0 = u.pn * 256 + wc * 32 + 8 * fq;
        const float cs = __builtin_bit_cast(float, *wm) * (1.f / 127.f);
        float rsv[8];
#pragma unroll
        for (int i = 0; i < 8; ++i) rsv[i] = rs[row0 + (i >> 2) * 128 + (i & 3) * 16];
#pragma unroll
        for (int ai = 0; ai < 2; ++ai)
#pragma unroll
            for (int m = 0; m < 4; ++m) {
                const int row = row0 + ai * 128 + m * 16;
                const float sc = rsv[ai * 4 + m] * cs;
#pragma unroll
                for (int bj = 0; bj < 2; ++bj) {
                    const i32x4 i0 = __builtin_bit_cast(i32x4, acc[ai][bj][m][0]), i1 = __builtin_bit_cast(i32x4, acc[ai][bj][m][1]);
                    u32x4 w; w.x = pk2((float)i0[0] * sc, (float)i0[1] * sc); w.y = pk2((float)i0[2] * sc, (float)i0[3] * sc); w.z = pk2((float)i1[0] * sc, (float)i1[1] * sc); w.w = pk2((float)i1[2] * sc, (float)i1[3] * sc);
                    *(u32x4*)(O + (size_t)row * ldc + col0 + bj * 128) = w;
                }
            }
    }
};

struct EpiProbe {
    static constexpr bool PERM = true, AFTER_DRAIN = false, MID = false;
    bf16_t* O;
    __device__ __forceinline__ void operator()(const pg8::f32x4 (&acc)[2][2][4][2], const pg8::Unit& u, int wr, int wc, int fr, int fq) const {
        const int row0 = u.pm * 256 + wr * 64 + fr, col0 = wc * 32 + 8 * fq;
#pragma unroll
        for (int ai = 0; ai < 2; ++ai)
#pragma unroll
            for (int m = 0; m < 4; ++m)
#pragma unroll
                for (int bj = 0; bj < 2; ++bj) {
                    const pg8::f32x4 a0 = acc[ai][bj][m][0], a1 = acc[ai][bj][m][1];
                    u32x4 w; w.x = pk2(a0[0], a0[1]); w.y = pk2(a0[2], a0[3]); w.z = pk2(a1[0], a1[1]); w.w = pk2(a1[2], a1[3]);
                    *(u32x4*)(O + (size_t)(row0 + ai * 128 + m * 16) * 256 + col0 + bj * 128) = w;
                }
    }
};
#define XB_TMO      128
#define XB_XCNT(j)  (256  + 64 * (j))
#define XB_XSUB(j)  (1280 + 64 * (j))
#define XB_XGEN(j)  (2304 + 64 * (j))
#define XB_TOP      3328
#define XB_TOPGEN   3392
#define XCD_BAR_WORDS 3456
#define XB_SPIN_CAP (1u << 18)

__device__ __forceinline__ unsigned xb_ld(unsigned* p)              { return __hip_atomic_load(p, __ATOMIC_RELAXED, __HIP_MEMORY_SCOPE_AGENT); }
__device__ __forceinline__ unsigned xb_add(unsigned* p, unsigned v) { return __hip_atomic_fetch_add(p, v, __ATOMIC_RELAXED, __HIP_MEMORY_SCOPE_AGENT); }
__device__ __forceinline__ unsigned xb_xcc_id() { return (unsigned)__builtin_amdgcn_s_getreg((3 << 11) | 20) & 0xFu; }
#define XB_SPIN(cond, bar) do { unsigned _sp = 0; while (cond) { __builtin_amdgcn_s_sleep(1); \
    if ((++_sp & 255u) == 0u) { if (xb_ld(&(bar)[XB_TMO])) break; if (_sp > XB_SPIN_CAP) { atomicAdd(&(bar)[XB_TMO], 1u); break; } } } } while (0)

struct XcdBarrier {
    unsigned* bar; unsigned x;
    volatile LAS unsigned* st;
};

__device__ __forceinline__ XcdBarrier xcd_barrier_post(unsigned* bar, volatile LAS unsigned* st) {
    XcdBarrier b; b.bar = bar; b.x = xb_xcc_id(); b.st = st;
    if (threadIdx.x == 0) (void)xb_add(&bar[XB_XCNT(b.x)], 1u);
    return b;
}
__device__ __forceinline__ void xcd_barrier_complete(unsigned* bar, unsigned x, unsigned& nloc, unsigned& nx) {
    const unsigned G = gridDim.x * gridDim.y * gridDim.z;
    unsigned sum, cnt, mine, sp = 0u;
    for (;;) {
        sum = 0u; cnt = 0u; mine = 0u;
#pragma unroll
        for (unsigned j = 0; j < 16; ++j) { const unsigned c = xb_ld(&bar[XB_XCNT(j)]); sum += c; cnt += (c > 0u) ? 1u : 0u; mine = (j == x) ? c : mine; }
        if (sum == G) break;
        __builtin_amdgcn_s_sleep(1);
        if ((++sp & 255u) == 0u) { if (xb_ld(&bar[XB_TMO])) break; if (sp > XB_SPIN_CAP) { atomicAdd(&bar[XB_TMO], 1u); break; } }
    }
    nloc = mine > 0u ? mine : 1u; nx = cnt > 0u ? cnt : 1u;
}

__device__ __forceinline__ void xcd_barrier(const XcdBarrier& b) {
    asm volatile("s_waitcnt vmcnt(0)" ::: "memory");
    __syncthreads();
    if (threadIdx.x == 0) {
        unsigned* bar = b.bar;
        __builtin_amdgcn_s_waitcnt(0);
        unsigned nloc = b.st[0], nx = b.st[1];
        if (nloc == 0u) { xcd_barrier_complete(bar, b.x, nloc, nx); b.st[0] = nloc; b.st[1] = nx; }
        const unsigned old = xb_add(&bar[XB_XSUB(b.x)], 1u);
        const unsigned gen = old / nloc;
        if (old + 1u == (gen + 1u) * nloc) {
            __builtin_amdgcn_fence(__ATOMIC_RELEASE, "agent");
            asm volatile("s_waitcnt vmcnt(0)" ::: "memory");
            const unsigned og = xb_add(&bar[XB_TOP], 1u);
            const unsigned tg = og / nx;
            if (og + 1u == (tg + 1u) * nx) xb_add(&bar[XB_TOPGEN], 1u);
            else XB_SPIN(xb_ld(&bar[XB_TOPGEN]) == tg, bar);
            __builtin_amdgcn_fence(__ATOMIC_ACQUIRE, "agent");
            xb_add(&bar[XB_XGEN(b.x)], 1u);
            asm volatile("s_waitcnt vmcnt(0)" ::: "memory");
        } else {
            XB_SPIN(xb_ld(&bar[XB_XGEN(b.x)]) == gen, bar);
            __builtin_amdgcn_fence(__ATOMIC_ACQUIRE, "agent");
            asm volatile("s_waitcnt vmcnt(0)" ::: "memory");
        }
    }
    __syncthreads();
}
#define LDS_WAIT() asm volatile("s_waitcnt lgkmcnt(0)" ::: "memory")
#define VM_WAIT() asm volatile("s_waitcnt vmcnt(0)" ::: "memory")

DI void transpose_item(const float* W, int N, int K, bf16_t* WT, int prow0, int lcol0, int nvalid, int k0, LAS float* scr, int lane) {
    const int cl = lane & 31;
#pragma unroll 8
    for (int i = 0; i < 32; ++i) { const int kk = 2 * i + (lane >> 5); scr[kk * 33 + cl] = (cl < nvalid) ? W[(size_t)(k0 + kk) * N + lcol0 + cl] : 0.f; }
    LDS_WAIT();
    const int c = lane & 7;
#pragma unroll
    for (int j = 0; j < 4; ++j) {
        const int n = (lane >> 3) + 8 * j; const LAS float* s = scr + (8 * c) * 33 + n;
        u32x4 o; o.x = pk2(s[0 * 33], s[1 * 33]); o.y = pk2(s[2 * 33], s[3 * 33]); o.z = pk2(s[4 * 33], s[5 * 33]); o.w = pk2(s[6 * 33], s[7 * 33]);
        *(u32x4*)(WT + (size_t)(prow0 + n) * K + k0 + 8 * c) = o;
    }
    LDS_WAIT();
}

DI unsigned pack_i8x4(float a, float b, float c, float d) {
    const int ia = (int)__builtin_rintf(fminf(fmaxf(a, -127.f), 127.f)), ib = (int)__builtin_rintf(fminf(fmaxf(b, -127.f), 127.f));
    const int ic = (int)__builtin_rintf(fminf(fmaxf(c, -127.f), 127.f)), id = (int)__builtin_rintf(fminf(fmaxf(d, -127.f), 127.f));
    return (unsigned)(ia & 255) | ((unsigned)(ib & 255) << 8) | ((unsigned)(ic & 255) << 16) | ((unsigned)(id & 255) << 24);
}
template <bool INT8 = false>
DI void transpose_item8(const float* W, int N, int K, unsigned char* WT, int prow0, int lcol0, int nvalid, int k0, float scale, LAS float* scr, int lane) {
    const int cl = lane & 31;
#pragma unroll 8
    for (int i = 0; i < 32; ++i) { const int kk = 2 * i + (lane >> 5); scr[kk * 33 + cl] = (cl < nvalid) ? W[(size_t)(k0 + kk) * N + lcol0 + cl] * scale : 0.f; }
    LDS_WAIT();
    const int c = lane & 3;
#pragma unroll
    for (int j = 0; j < 2; ++j) {
        const int n = (lane >> 2) + 16 * j; const LAS float* s = scr + (16 * c) * 33 + n;
        u32x4 o;
#pragma unroll
        for (int q = 0; q < 4; ++q) o[q] = INT8 ? pack_i8x4(s[(4 * q) * 33], s[(4 * q + 1) * 33], s[(4 * q + 2) * 33], s[(4 * q + 3) * 33]) : pack_fp8x4(s[(4 * q) * 33], s[(4 * q + 1) * 33], s[(4 * q + 2) * 33], s[(4 * q + 3) * 33]);
        *(u32x4*)(WT + (size_t)(prow0 + n) * K + k0 + 16 * c) = o;
    }
    LDS_WAIT();
}
DI void absmax_to(const float* p, size_t n, unsigned* word, size_t gtid, size_t gth, int lane) {
    float mx = 0.f;
    for (size_t i = gtid * 4; i < n; i += gth * 16) {
        f32x4 v[4];
#pragma unroll
        for (int q = 0; q < 4; ++q) { const size_t j = i + (size_t)q * gth * 4; v[q] = (j < n) ? *(const f32x4*)(p + j) : (f32x4){0.f, 0.f, 0.f, 0.f}; }
#pragma unroll
        for (int q = 0; q < 4; ++q) mx = fmaxf(fmaxf(mx, fmaxf(fabsf(v[q][0]), fabsf(v[q][1]))), fmaxf(fabsf(v[q][2]), fabsf(v[q][3])));
    }
#pragma unroll
    for (int o = 1; o < 64; o <<= 1) mx = fmaxf(mx, __shfl_xor(mx, o));
    if (lane == 0 && mx > 0.f) atomicMax(word, __builtin_bit_cast(unsigned, mx));
}
DI float wscale8(const unsigned char* ws, int which) { return WTOP8 / fmaxf(__builtin_bit_cast(float, ((const unsigned*)(ws + WS_CTL))[CW_WMAX + which]), 1e-30f); }

DI void conv_bf16(const float* src, bf16_t* dst, size_t n, size_t gtid, size_t gthreads) {
    for (size_t i = gtid * 8; i < n; i += gthreads * 8) {
        const f32x4 a = *(const f32x4*)(src + i), b = *(const f32x4*)(src + i + 4);
        u32x4 o; o.x = pk2(a[0], a[1]); o.y = pk2(a[2], a[3]); o.z = pk2(b[0], b[1]); o.w = pk2(b[2], b[3]);
        *(u32x4*)(dst + i) = o;
    }
}

DI void conv_fp8(const float* src, unsigned char* dst, size_t n, float scale, size_t gtid, size_t gthreads) {
    for (size_t i = gtid * 16; i < n; i += gthreads * 16) {
        const size_t e = i >> 10, c = i & 1023;
        u32x4 o;
#pragma unroll
        for (int q = 0; q < 4; ++q) {
            const f32x4 v = *(const f32x4*)(src + i + 4 * q) * scale;
            int w = 0; w = __builtin_amdgcn_cvt_pk_fp8_f32(v[0], v[1], w, false); w = __builtin_amdgcn_cvt_pk_fp8_f32(v[2], v[3], w, true);
            o[q] = (unsigned)w;
        }
        *(u32x4*)(dst + ((c >> 7) * 16384 + e) * 128 + (c & 127)) = o;
    }
}

DI void conv_u_i8(const float* src, unsigned char* dst, float scale, size_t gtid, size_t gthreads) {
    for (size_t i0 = gtid * 16; i0 < (size_t)16384 * 1024; i0 += gthreads * 32) {
        f32x4 v[2][4];
#pragma unroll
        for (int h = 0; h < 2; ++h)
#pragma unroll
            for (int q = 0; q < 4; ++q) v[h][q] = *(const f32x4*)(src + i0 + (size_t)h * gthreads * 16 + 4 * q);
#pragma unroll
        for (int h = 0; h < 2; ++h) {
            const size_t i = i0 + (size_t)h * gthreads * 16, e = i >> 10, c = i & 1023;
            u32x4 o;
#pragma unroll
            for (int q = 0; q < 4; ++q) { const f32x4 w = v[h][q] * scale; o[q] = pack_i8x4(w[0], w[1], w[2], w[3]); }
            *(u32x4*)(dst + ((c >> 7) * 16384 + e) * 128 + (c & 127)) = o;
        }
    }
}

DI int q4(float x) { return (int)__builtin_rintf(fminf(fmaxf(x, -8.f), 7.f)) & 15; }
DI void conv_u_i4(const float* src, unsigned char* dst, float inv_step, size_t gtid, size_t gthreads) {
    for (size_t i = gtid * 32; i < (size_t)16384 * 1024; i += gthreads * 32) {
        f32x4 v[8];
#pragma unroll
        for (int q = 0; q < 8; ++q) v[q] = *(const f32x4*)(src + i + 4 * q) * inv_step;
        u32x4 o;
#pragma unroll
        for (int j = 0; j < 4; ++j) {
            unsigned w = 0;
#pragma unroll
            for (int b = 0; b < 4; ++b) {
                if (UD8) w |= (unsigned)(q4(v[2 * j + (b >> 1)][2 * (b & 1)]) | (q4(v[2 * j + (b >> 1)][2 * (b & 1) + 1]) << 4)) << (8 * b);
                else w |= (unsigned)(q4(v[j][b]) | (q4(v[4 + j][b]) << 4)) << (8 * b);
            }
            o[j] = w;
        }
        const size_t e = i >> 10, c = i & 1023;
        *(u32x4*)(dst + ((c >> 8) * 16384 + e) * 128 + ((c & 255) >> 1)) = o;
    }
}

DI void conv_v_fp4(const float* src, unsigned char* dst, float inv_s, size_t gtid, size_t gthreads) {
    for (size_t i = gtid * 32; i < (size_t)16384 * 1024; i += gthreads * 32) {
        u32x4 o;
#pragma unroll
        for (int j = 0; j < 4; ++j) {
            f32x4 p = *(const f32x4*)(src + i + 8 * j) * inv_s, q = *(const f32x4*)(src + i + 8 * j + 4) * inv_s;
#pragma unroll
            for (int k = 0; k < 4; ++k) { p[k] = __builtin_amdgcn_fmed3f(p[k], -6.f, 6.f); q[k] = __builtin_amdgcn_fmed3f(q[k], -6.f, 6.f); }
            unsigned w = 0;
            w = __builtin_amdgcn_cvt_scalef32_pk_fp4_f32(w, p[0], p[1], 1.0f, 0); w = __builtin_amdgcn_cvt_scalef32_pk_fp4_f32(w, p[2], p[3], 1.0f, 1);
            w = __builtin_amdgcn_cvt_scalef32_pk_fp4_f32(w, q[0], q[1], 1.0f, 2); w = __builtin_amdgcn_cvt_scalef32_pk_fp4_f32(w, q[2], q[3], 1.0f, 3);
            o[j] = w;
        }
        const size_t e = i >> 10, c = i & 1023;
        *(u32x4*)(dst + ((c >> 8) * 16384 + e) * 128 + ((c & 255) >> 1)) = o;
    }
}

DI void ph_prologue(const KArgs& a, LAS unsigned char* lds, int tid, int lane, int wave, int blk, int nblk) {
    unsigned char* ws = a.ws;
    const int gw = blk * 8 + wave, ngw = nblk * 8;
    if (blk < 192) {
        LAS float* sc = (LAS float*)lds;
        for (int i = tid; i < 32 * 1024; i += 512) { const int b = i >> 10, k = i & 1023; const float v = a.c[i]; sc[k * 36 + b] = v / (1.f + __expf(-v)); }
        __syncthreads();
        float acc[32];
#pragma unroll
        for (int b = 0; b < 32; ++b) acc[b] = 0.f;
        const int cl = lane & 31, kh = lane >> 5, col = blk * 32 + cl;
#pragma unroll 8
        for (int i = 0; i < 64; ++i) {
            const int k = wave * 128 + 2 * i + kh;
            const float wv = a.w_ada[(size_t)k * 6144 + col];
            const LAS f32x4* sp = (const LAS f32x4*)(sc + k * 36);
#pragma unroll
            for (int q = 0; q < 8; ++q) { const f32x4 s4 = sp[q]; acc[4 * q] += s4[0] * wv; acc[4 * q + 1] += s4[1] * wv; acc[4 * q + 2] += s4[2] * wv; acc[4 * q + 3] += s4[3] * wv; }
        }
        __syncthreads();
        LAS float* red = (LAS float*)lds;
#pragma unroll
        for (int b = 0; b < 32; ++b) red[((wave * 2 + kh) * 32 + b) * 32 + cl] = acc[b];
        __syncthreads();
        for (int o = tid; o < 1024; o += 512) {
            float s = 0.f;
#pragma unroll
            for (int p = 0; p < 16; ++p) s += red[p * 1024 + o];
            const int b = o >> 5, c2 = o & 31;
            ((float*)(ws + WS_MOD))[(size_t)b * 6144 + blk * 32 + c2] = s + a.b_ada[blk * 32 + c2];
        }
        __syncthreads();
    }
    {
        LAS float* scr = (LAS float*)(lds + wave * 8704);
        constexpr int I_WIN = 16 * 152, I_WB = 8 * 32, I_WO = 16 * 32, I_WPQ = 16 * 64;
        constexpr int NITEMS = I_WIN + 2 * I_WB + I_WO + I_WPQ;
        for (int it = gw; it < NITEMS; it += ngw) {
            int r = it;
            if (r < I_WIN) {
                const int pb = r % 152, kb = r / 152, pn = pb >> 3, bj = (pb >> 2) & 1, wc = pb & 3, g = pn * 4 + wc;
                const int nvalid = (g == 43) ? (bj == 0 ? 8 : 0) : 32;
                if (!((IN8_MASK >> pn) & 1u)) transpose_item(a.w_in, WIN_COLS, 1024, (bf16_t*)(ws + WS_WIN), rank_in(~IN8_MASK, pn) * 256 + (pb & 7) * 32, proj_group_base(g) + 32 * bj, nvalid, kb * 64, scr, lane);
                continue;
            }
            r -= I_WIN;
            if (r < I_WB) { if (!F8_BR && !BR8) transpose_item(a.w_ba, 1024, FUSE56 ? 1024 : 512, (bf16_t*)(ws + WS_WBA), (r % 32) * 32, (r % 32) * 32, 32, (r / 32) * 64, scr, lane); continue; }
            r -= I_WB;
            if (r < I_WB) { if (!F8_BR && !BR8) transpose_item(a.w_bb, 1024, FUSE56 ? 1024 : 512, FUSE56 ? (bf16_t*)(ws + WS_WBA) + 512 : (bf16_t*)(ws + WS_WBB), (r % 32) * 32, (r % 32) * 32, 32, (r / 32) * 64, scr, lane); continue; }
            r -= I_WB;
            if (r < I_WO) { if (!F8_BR && !F8_OUT) transpose_item(a.w_out, 1024, 1024, (bf16_t*)(ws + WS_WOUT), (r % 32) * 32, (r % 32) * 32, 32, (r / 32) * 64, scr, lane); continue; }
            r -= I_WO;
            if (PQ_MODE == 0) transpose_item(a.peer_wq, 2048, 1024, (bf16_t*)(ws + WS_WPQ), (r % 64) * 32, (r % 64) * 32, 32, (r / 64) * 64, scr, lane);
        }
    }
    {
        const size_t gtid = (size_t)blk * 512 + tid, gth = (size_t)nblk * 512;
        conv_bf16(a.sub_keys, (bf16_t*)(ws + WS_SKB), (size_t)8 * 2 * 128 * 128, gtid, gth);
        if (U4) absmax_to(a.peer_u, (size_t)1 << 21, (unsigned*)(ws + WS_CTL) + CW_UMAX, gtid, gth, lane);
        else {
            float mx = 0.f;
            for (size_t i = gtid * 4; i < (size_t)16384 * 1024; i += gth * 16) {
                f32x4 v[4];
#pragma unroll
                for (int q = 0; q < 4; ++q) v[q] = *(const f32x4*)(a.peer_u + i + (size_t)q * gth * 4);
#pragma unroll
                for (int q = 0; q < 4; ++q) mx = fmaxf(fmaxf(mx, fmaxf(fabsf(v[q][0]), fabsf(v[q][1]))), fmaxf(fabsf(v[q][2]), fabsf(v[q][3])));
            }
#pragma unroll
            for (int o = 1; o < 64; o <<= 1) mx = fmaxf(mx, __shfl_xor(mx, o));
            if (lane == 0) atomicMax((unsigned*)(ws + WS_CTL) + CW_UMAX, __builtin_bit_cast(unsigned, mx));
        }
        if (PQ_MODE != 0) absmax_to(a.peer_wq, (size_t)1024 * 2048, (unsigned*)(ws + WS_CTL) + CW_WMAX + 4, gtid, gth, lane);
        if (N8_IN > 0) absmax_to(a.w_in, (size_t)1024 * WIN_COLS, (unsigned*)(ws + WS_CTL) + CW_WMAX + 0, gtid, gth, lane);
        if (F8_OUT && !F8_BR && !BR8) absmax_to(a.w_out, (size_t)1024 * 1024, (unsigned*)(ws + WS_CTL) + CW_WMAX + 3, gtid, gth, lane);
        if (F8_BR || BR8) {
            absmax_to(a.w_ba, (size_t)512 * 1024, (unsigned*)(ws + WS_CTL) + CW_WMAX + 1, gtid, gth, lane);
            absmax_to(a.w_bb, (size_t)512 * 1024, (unsigned*)(ws + WS_CTL) + CW_WMAX + 2, gtid, gth, lane);
            if (F8_BR || F8_OUT) absmax_to(a.w_out, (size_t)1024 * 1024, (unsigned*)(ws + WS_CTL) + CW_WMAX + 3, gtid, gth, lane);
        }
        if (V4) absmax_to(a.peer_v, (size_t)1 << 21, (unsigned*)(ws + WS_CTL) + CW_VMAX, gtid, gth, lane);
        else conv_fp8(a.peer_v, ws + WS_VB, (size_t)16384 * 1024, VSCALE, gtid, gth);
        for (size_t t = gtid; t < (size_t)NTOK * 2; t += gth) {
            const int m = (int)(t >> 1), half = (int)(t & 1);
            double f = half ? 0.15915494309189535 * 0.01 : 0.15915494309189535;
            const double p = (double)a.pos[m];
            float cs[16], sn[16];
#pragma unroll
            for (int k = 0; k < 16; ++k) {
                const double rev = p * f;
                const float fr = (float)(rev - __builtin_floor(rev)) * 6.283185307179586f;
                cs[k] = cosf(fr); sn[k] = sinf(fr);
                f *= 0.7498942093324559;
            }
            float* cp = (float*)(ws + WS_COS) + (size_t)m * 32 + 16 * half; float* sp = (float*)(ws + WS_SIN) + (size_t)m * 32 + 16 * half;
#pragma unroll
            for (int k = 0; k < 4; ++k) { *(f32x4*)(cp + 4 * k) = (f32x4){cs[4 * k], cs[4 * k + 1], cs[4 * k + 2], cs[4 * k + 3]}; *(f32x4*)(sp + 4 * k) = (f32x4){sn[4 * k], sn[4 * k + 1], sn[4 * k + 2], sn[4 * k + 3]}; }
        }
    }
}

DI void ph_weights8(const KArgs& a, LAS unsigned char* lds, int lane, int wave, int blk, int nblk) {
    unsigned char* ws = a.ws;
    const int gw = blk * 8 + wave, ngw = nblk * 8;
    LAS float* scr = (LAS float*)(lds + wave * 8704);
    if (PQ_MODE != 0) {
        const float spq = wscale8(ws, 4) * (PQ_MODE == 2 ? 127.f / WTOP8 : 1.f);
        for (int r = gw; r < 16 * 64; r += ngw) transpose_item8<PQ_MODE == 2>(a.peer_wq, 2048, 1024, ws + WS_WPQ, (r % 64) * 32, (r % 64) * 32, 32, (r / 64) * 64, spq, scr, lane);
    }
    if (N8_IN > 0) {
        const float si = wscale8(ws, 0) * (IN_MODE == 2 ? 127.f / WTOP8 : 1.f);
        for (int r = gw; r < 16 * 152; r += ngw) {
            const int pb = r % 152, kb = r / 152, pn = pb >> 3, bj = (pb >> 2) & 1, wc = pb & 3, g = pn * 4 + wc;
            if ((IN8_MASK >> pn) & 1u) transpose_item8<IN_MODE == 2>(a.w_in, WIN_COLS, 1024, ws + WS_WIN8, rank_in(IN8_MASK, pn) * 256 + (pb & 7) * 32, proj_group_base(g) + 32 * bj, (g == 43) ? (bj == 0 ? 8 : 0) : 32, kb * 64, si, scr, lane);
        }
    }
    if (BR8 && !F8_BR) {
        const float sa = wscale8(ws, 1) * (127.f / WTOP8), sb = wscale8(ws, 2) * (127.f / WTOP8);
        for (int it = gw; it < 2 * 256; it += ngw) {
            const int r = it & 255;
            if (it < 256) transpose_item8<true>(a.w_ba, 1024, 512, ws + WS_WBA, (r % 32) * 32, (r % 32) * 32, 32, (r / 32) * 64, sa, scr, lane);
            else transpose_item8<true>(a.w_bb, 1024, 512, ws + WS_WBB, (r % 32) * 32, (r % 32) * 32, 32, (r / 32) * 64, sb, scr, lane);
        }
    }
    if (F8_OUT && !F8_BR) {
        const float so = wscale8(ws, 3);
        for (int r = gw; r < 512; r += ngw) transpose_item8(a.w_out, 1024, 1024, ws + WS_WOUT, (r % 32) * 32, (r % 32) * 32, 32, (r / 32) * 64, so, scr, lane);
    }
    if (F8_BR) {
        const float sa = wscale8(ws, 1), sb = wscale8(ws, 2), so = wscale8(ws, 3);
        for (int it = gw; it < 2 * 256 + 512; it += ngw) {
            int r = it;
            if (r < 256) { transpose_item8(a.w_ba, 1024, 512, ws + WS_WBA, (r % 32) * 32, (r % 32) * 32, 32, (r / 32) * 64, sa, scr, lane); continue; }
            r -= 256;
            if (r < 256) { transpose_item8(a.w_bb, 1024, 512, ws + WS_WBB, (r % 32) * 32, (r % 32) * 32, 32, (r / 32) * 64, sb, scr, lane); continue; }
            r -= 256;
            transpose_item8(a.w_out, 1024, 1024, ws + WS_WOUT, (r % 32) * 32, (r % 32) * 32, 32, (r / 32) * 64, so, scr, lane);
        }
    }
}

template <bool I8, bool WB16, bool WF8, bool NIB = false>
DI void ph_norm(const float* src, const float* gain, const float* mod, int sh_off, int sc_off, bf16_t* dst, unsigned char* dstf, unsigned char* dst8, float* hs, int lane, int wave, int blk, int nblk, unsigned char* ha = nullptr, unsigned char* hb = nullptr) {
    const int gw = blk * 8 + wave, ngw = nblk * 8;
    const int rows_per = NTOK / ngw;
    for (int r0 = gw * rows_per; r0 < NTOK; r0 += ngw * rows_per) {
        const int b = r0 / NT;
        f32x4 mul[4], add[4];
#pragma unroll
        for (int j = 0; j < 4; ++j) {
            const int col = 4 * lane + 256 * j;
            const f32x4 g = *(const f32x4*)(gain + col), s = *(const f32x4*)(mod + (size_t)b * 6144 + sc_off + col);
            mul[j] = g * (s + 1.f); add[j] = *(const f32x4*)(mod + (size_t)b * 6144 + sh_off + col);
        }
        f32x4 vn[4][4];
#pragma unroll
        for (int q = 0; q < 4; ++q) {
            const f32x4* xr = (const f32x4*)(src + (size_t)(r0 + q) * 1024) + lane;
#pragma unroll
            for (int j = 0; j < 4; ++j) vn[q][j] = xr[64 * j];
        }
#pragma unroll 2
        for (int r = r0; r < r0 + rows_per; r += 4) {
            f32x4 v[4][4]; float s[4];
#pragma unroll
            for (int q = 0; q < 4; ++q)
#pragma unroll
                for (int j = 0; j < 4; ++j) v[q][j] = vn[q][j];
            if (r + 4 < r0 + rows_per) {
#pragma unroll
                for (int q = 0; q < 4; ++q) {
                    const f32x4* xr = (const f32x4*)(src + (size_t)(r + 4 + q) * 1024) + lane;
#pragma unroll
                    for (int j = 0; j < 4; ++j) vn[q][j] = xr[64 * j];
                }
            }
#pragma unroll
            for (int q = 0; q < 4; ++q) {
                s[q] = 0.f;
#pragma unroll
                for (int j = 0; j < 4; ++j) s[q] += (v[q][j][0] * v[q][j][0] + v[q][j][1] * v[q][j][1]) + (v[q][j][2] * v[q][j][2] + v[q][j][3] * v[q][j][3]);
            }
#pragma unroll
            for (int o = 1; o < 64; o <<= 1) {
#pragma unroll
                for (int q = 0; q < 4; ++q) s[q] += __shfl_xor(s[q], o);
            }
#pragma unroll
            for (int q = 0; q < 4; ++q) {
                const float rn = __builtin_amdgcn_rsqf(s[q] * (1.f / 1024.f) + EPS);
                u32x2* o = (u32x2*)(dst + (size_t)(r + q) * 1024) + lane;
                f32x4 y[4]; float am = 0.f;
#pragma unroll
                for (int j = 0; j < 4; ++j) { y[j] = v[q][j] * rn * mul[j] + add[j];
                    if (WF8) { ((unsigned*)(dstf + (size_t)(r + q) * 1024) + lane)[64 * j] = pack_fp8x4(y[j][0] * ASC8, y[j][1] * ASC8, y[j][2] * ASC8, y[j][3] * ASC8); }
                    if (WB16) { u32x2 w; w.x = pk2(y[j][0], y[j][1]); w.y = pk2(y[j][2], y[j][3]); o[64 * j] = w; }
                    if (I8) am = fmaxf(fmaxf(am, fmaxf(fabsf(y[j][0]), fabsf(y[j][1]))), fmaxf(fabsf(y[j][2]), fabsf(y[j][3]))); }
                if (I8) {
#pragma unroll
                    for (int oo = 1; oo < 64; oo <<= 1) am = fmaxf(am, __shfl_xor(am, oo));
                    am = fmaxf(am, 1e-20f);
                    const float qs = (NIB ? 119.f : 127.f) / am;
                    unsigned* o8 = (unsigned*)(dst8 + (size_t)(r + q) * 1024) + lane;
#pragma unroll
                    for (int j = 0; j < 4; ++j) {
                        o8[64 * j] = pack_i8x4(y[j][0] * qs, y[j][1] * qs, y[j][2] * qs, y[j][3] * qs);
                        if (NIB) {
                            unsigned na = 0, nb = 0;
#pragma unroll
                            for (int e = 0; e < 4; ++e) { const int qi = (int)__builtin_rintf(y[j][e] * qs); nb |= (unsigned)(qi & 15) << (4 * e); na |= (unsigned)(((qi + 8) >> 4) & 15) << (4 * e); }
                            const unsigned na2 = __shfl_xor(na, 1), nb2 = __shfl_xor(nb, 1);
                            if (!(lane & 1)) {
                                *(unsigned*)(ha + (size_t)(r + q) * 512 + 2 * lane + 128 * j) = na | (na2 << 16);
                                *(unsigned*)(hb + (size_t)(r + q) * 512 + 2 * lane + 128 * j) = nb | (nb2 << 16);
                            }
                        }
                    }
                    if (lane == 0) hs[r + q] = am * (1.f / (NIB ? 119.f : 127.f));
                }
            }
        }
    }
}
typedef short v4i16_t __attribute__((ext_vector_type(4)));
DI s16x4 tr_read(const LAS char* p) { return __builtin_bit_cast(s16x4, __builtin_amdgcn_ds_read_tr16_b64_v4i16((LAS v4i16_t*)p)); }
DI bf16x8 pack8(float x0, float x1, float x2, float x3, float x4, float x5, float x6, float x7) {
    u32x4 p; p.x = pk2(x0, x1); p.y = pk2(x2, x3); p.z = pk2(x4, x5); p.w = pk2(x6, x7); return __builtin_bit_cast(bf16x8, p);
}
#define MFMA32(a, b, c) __builtin_amdgcn_mfma_f32_32x32x16_bf16((a), (b), (c), 0, 0, 0)
#define MFMA16(a, b, c) __builtin_amdgcn_mfma_f32_16x16x32_bf16((a), (b), (c), 0, 0, 0)

DI float max3f(float a, float b, float c) { float r; asm("v_max3_f32 %0, %1, %2, %3" : "=v"(r) : "v"(a), "v"(b), "v"(c)); return r; }
template <int BP> DI int bfe1s(int w) { int r; asm("v_bfe_i32 %0, %1, %2, 1" : "=v"(r) : "v"(w), "n"(BP)); return r; }
template <int NDB, int KST, int VST, bool MASK>
DI void attn_tile(const LAS char* kb, const LAS char* vb, f32x16 (&o)[NDB], float& m, float& l, const bf16x8 (&qf)[4], unsigned mw0, unsigned mw1, int lane) {
    const int r32 = lane & 31, hi = lane >> 5;
    f32x16 p0, p1;
#pragma unroll
    for (int r = 0; r < 16; ++r) { p0[r] = 0.f; p1[r] = 0.f; }
    const LAS char* ka = kb + r32 * KST + hi * 16;
#pragma unroll
    for (int ks = 0; ks < 4; ++ks) {
        const bf16x8 a0 = *(const LAS bf16x8*)(ka + ks * 32), a1 = *(const LAS bf16x8*)(ka + 32 * KST + ks * 32);
        p0 = MFMA32(a0, qf[ks], p0); p1 = MFMA32(a1, qf[ks], p1);
    }
    float tm;
    {
        float t[16];
#pragma unroll
        for (int r = 0; r < 16; ++r) t[r] = fmaxf(p0[r], p1[r]);
        const float u0 = max3f(t[0], t[1], t[2]), u1 = max3f(t[3], t[4], t[5]), u2 = max3f(t[6], t[7], t[8]), u3 = max3f(t[9], t[10], t[11]), u4 = max3f(t[12], t[13], t[14]);
        tm = fmaxf(max3f(u0, u1, u2), max3f(u3, u4, t[15]));
    }
    tm = fmaxf(tm, __shfl_xor(tm, 32));
    const float mn = fmaxf(m, tm);
    const float alpha = fexp2(m - mn);
    float rs = 0.f;
    if (MASK) {
        const int w0 = (int)(mw0 >> (4 * hi)), w1 = (int)(mw1 >> (4 * hi));
#define ATT_MASKED(r_) { constexpr int bp = ((r_) & 3) + 8 * ((r_) >> 2); \
            p0[r_] = __builtin_bit_cast(float, __builtin_bit_cast(int, fexp2(p0[r_] - mn)) & bfe1s<bp>(w0)); \
            p1[r_] = __builtin_bit_cast(float, __builtin_bit_cast(int, fexp2(p1[r_] - mn)) & bfe1s<bp>(w1)); rs += p0[r_] + p1[r_]; }
        ATT_MASKED(0) ATT_MASKED(1) ATT_MASKED(2) ATT_MASKED(3) ATT_MASKED(4) ATT_MASKED(5) ATT_MASKED(6) ATT_MASKED(7)
        ATT_MASKED(8) ATT_MASKED(9) ATT_MASKED(10) ATT_MASKED(11) ATT_MASKED(12) ATT_MASKED(13) ATT_MASKED(14) ATT_MASKED(15)
#undef ATT_MASKED
    } else {
#pragma unroll
        for (int r = 0; r < 16; ++r) { p0[r] = fexp2(p0[r] - mn); p1[r] = fexp2(p1[r] - mn); rs += p0[r] + p1[r]; }
    }
    rs += __shfl_xor(rs, 32);
    l = l * alpha + rs; m = mn;
    if (__ballot(alpha != 1.0f)) {
#pragma unroll
        for (int db = 0; db < NDB; ++db)
#pragma unroll
            for (int r = 0; r < 16; ++r) o[db][r] *= alpha;
    }
    bf16x8 pf[4];
    pf[0] = pack8(p0[0], p0[1], p0[2], p0[3], p0[4], p0[5], p0[6], p0[7]);
    pf[1] = pack8(p0[8], p0[9], p0[10], p0[11], p0[12], p0[13], p0[14], p0[15]);
    pf[2] = pack8(p1[0], p1[1], p1[2], p1[3], p1[4], p1[5], p1[6], p1[7]);
    pf[3] = pack8(p1[8], p1[9], p1[10], p1[11], p1[12], p1[13], p1[14], p1[15]);
    const int i16 = lane & 15, q4 = i16 >> 2, pp = i16 & 3, g = lane >> 4;
    const LAS char* va = vb + (4 * (g >> 1) + q4) * VST + (16 * (g & 1) + 4 * pp) * 2;
#pragma unroll
    for (int db = 0; db < NDB; ++db)
#pragma unroll
        for (int s = 0; s < 4; ++s) {
            const s16x4 lo = tr_read(va + (16 * s) * VST + db * 64), h4 = tr_read(va + (16 * s + 8) * VST + db * 64);
            const bf16x8 vf = __builtin_shufflevector(lo, h4, 0, 1, 2, 3, 4, 5, 6, 7);
            o[db] = MFMA32(vf, pf[s], o[db]);
        }
}

DI void ph_diff_attn(const KArgs& a, LAS unsigned char* lds, int tid, int lane, int wave, int blk, int nblk) {
    unsigned char* ws = a.ws;
    const bf16_t* Qd = (const bf16_t*)(ws + WS_QD); const bf16_t* Kd = (const bf16_t*)(ws + WS_KD); const bf16_t* Vd = (const bf16_t*)(ws + WS_VD);
    bf16_t* OAB = (bf16_t*)(ws + WS_OAB);
    float lam;
    { const float d1 = wave_sum(a.lq1[lane] * a.lk1[lane]), d2 = wave_sum(a.lq2[lane] * a.lk2[lane]); lam = expf(d1) - expf(d2) + LAMBDA_INIT; }
    constexpr int KST = 272, VST = 320, KBYTES = 64 * KST, BUF = KBYTES + 64 * VST;
    const int mp = wave >> 2, qg = wave & 3, r32 = lane & 31, hi = lane >> 5;
    for (int idx = blk; idx < 2048; idx += nblk) {
        const int j = idx & 255, i = idx >> 8, pr = j & 127, half = j >> 7, kq = half * 4 + (i >> 1), qb = (i & 1) ? 15 - kq : kq;
        const int b = pr >> 2, h = pr & 3;
        const size_t rb = (size_t)b * NT;
        const int q0 = qb * 128 + 32 * qg, nT = 2 * qb + 2, myT = 2 * qb + 1 + (qg >> 1);
        bf16x8 qf[4];
        { const bf16_t* qp = Qd + (rb + q0 + r32) * 512 + h * 128 + mp * 64 + 8 * hi;
#pragma unroll
          for (int ks = 0; ks < 4; ++ks) qf[ks] = *(const bf16x8*)(qp + 16 * ks); }
        f32x16 o[4]; float m = -INFINITY, l = 0.f;
#pragma unroll
        for (int db = 0; db < 4; ++db)
#pragma unroll
            for (int r = 0; r < 16; ++r) o[db][r] = 0.f;
        const int key0 = tid >> 4, ch = tid & 15;
        const bf16_t* kg = Kd + (rb + key0) * 512 + h * 128 + ch * 8;
        const bf16_t* vg = Vd + (rb + key0) * 512 + h * 128 + ch * 8;
        const int loff = key0 * KST + ch * 16, loffv = KBYTES + key0 * VST + ch * 16;
        u32x4 sk0 = *(const u32x4*)kg, sk1 = *(const u32x4*)(kg + 32 * 512), sv0 = *(const u32x4*)vg, sv1 = *(const u32x4*)(vg + 32 * 512);
        *(LAS u32x4*)(lds + loff) = sk0; *(LAS u32x4*)(lds + loff + 32 * KST) = sk1;
        *(LAS u32x4*)(lds + loffv) = sv0; *(LAS u32x4*)(lds + loffv + 32 * VST) = sv1;
        if (nT > 1) { const size_t go = (size_t)64 * 512; sk0 = *(const u32x4*)(kg + go); sk1 = *(const u32x4*)(kg + go + 32 * 512); sv0 = *(const u32x4*)(vg + go); sv1 = *(const u32x4*)(vg + go + 32 * 512); }
        __syncthreads();
        for (int t = 0; t < nT; ++t) {
            const bool more = (t + 1 < nT), more2 = (t + 2 < nT);
            u32x4 nk0 = sk0, nk1 = sk1, nv0 = sv0, nv1 = sv1;
            if (more2) {
                const size_t go = (size_t)(t + 2) * 64 * 512;
                nk0 = *(const u32x4*)(kg + go); nk1 = *(const u32x4*)(kg + go + 32 * 512); nv0 = *(const u32x4*)(vg + go); nv1 = *(const u32x4*)(vg + go + 32 * 512);
            }
            if (t < myT) {
                const LAS char* bufp = (const LAS char*)lds + (t & 1) * BUF;
                attn_tile<4, KST, VST, false>(bufp + mp * 128, bufp + KBYTES, o, m, l, qf, 0u, 0u, lane);
            }
            if (more) {
                LAS unsigned char* nb = lds + ((t + 1) & 1) * BUF;
                *(LAS u32x4*)(nb + loff) = sk0; *(LAS u32x4*)(nb + loff + 32 * KST) = sk1;
                *(LAS u32x4*)(nb + loffv) = sv0; *(LAS u32x4*)(nb + loffv + 32 * VST) = sv1;
            }
            __syncthreads();
            sk0 = nk0; sk1 = nk1; sv0 = nv0; sv1 = nv1;
        }
        const float il = 1.f / l;
        LAS float* scr = (LAS float*)lds;
        if (mp == 1) {
#pragma unroll
            for (int db = 0; db < 4; ++db)
#pragma unroll
                for (int r = 0; r < 16; ++r) scr[((qg * 4 + db) * 16 + r) * 64 + lane] = o[db][r] * il;
        }
        __syncthreads();
        if (mp == 0) {
            float ss = 0.f;
#pragma unroll
            for (int db = 0; db < 4; ++db)
#pragma unroll
                for (int r = 0; r < 16; ++r) { const float v = o[db][r] * il - lam * scr[((qg * 4 + db) * 16 + r) * 64 + lane]; o[db][r] = v; ss += v * v; }
            ss += __shfl_xor(ss, 32);
            const float rn = __builtin_amdgcn_rsqf(ss * (1.f / 128.f) + EPS) * (1.f - LAMBDA_INIT);
            const size_t oo = (rb + q0 + r32) * (FUSE56 ? 1024 : 512) + h * 128 + 4 * hi;
            bf16_t* op = OAB + oo; unsigned char* op8 = (unsigned char*)OAB + oo;
            const float rn8 = rn * ASC8;
#pragma unroll
            for (int db = 0; db < 4; ++db)
#pragma unroll
                for (int r4 = 0; r4 < 4; ++r4) {
                    const int d0 = 32 * db + 8 * r4;
                    const f32x4 g4 = *(const f32x4*)(a.diff_out_g + d0 + 4 * hi);
                    if (BR8 && !F8_BR) { const float q8 = rn * (127.f / OA_MAX); *(unsigned*)(op8 + d0) = pack_i8x4(o[db][4 * r4] * q8 * g4[0], o[db][4 * r4 + 1] * q8 * g4[1], o[db][4 * r4 + 2] * q8 * g4[2], o[db][4 * r4 + 3] * q8 * g4[3]); }
                    else if (F8_BR) { *(unsigned*)(op8 + d0) = pack_fp8x4(o[db][4 * r4] * rn8 * g4[0], o[db][4 * r4 + 1] * rn8 * g4[1], o[db][4 * r4 + 2] * rn8 * g4[2], o[db][4 * r4 + 3] * rn8 * g4[3]); }
                    else {
                    u32x2 w; w.x = pk2(o[db][4 * r4] * rn * g4[0], o[db][4 * r4 + 1] * rn * g4[1]); w.y = pk2(o[db][4 * r4 + 2] * rn * g4[2], o[db][4 * r4 + 3] * rn * g4[3]);
                    *(u32x2*)(op + d0) = w; }
                }
        }
        __syncthreads();
    }
}

template <int VARIANT = 0>
DI void ph_dsa_attn(const KArgs& a, LAS unsigned char* lds, int tid, int lane, int wave, int blk, int nblk) {
    unsigned char* ws = a.ws;
    const bf16_t* Qs = (const bf16_t*)(ws + WS_QS); const bf16_t* Ks = (const bf16_t*)(ws + WS_KS); const bf16_t* Vs = (const bf16_t*)(ws + WS_VS);
    const unsigned* BM = (const unsigned*)(ws + WS_BM);
    bf16_t* OAB = (bf16_t*)(ws + WS_OAB);
    constexpr int KST = 144, VST = 192, KBYTES = 64 * KST, BUF = KBYTES + 64 * VST;
    const int r32 = lane & 31, hi = lane >> 5;
    for (int idx = blk; idx < 1024; idx += nblk) {
        const int j = idx & 255, i = idx >> 8, b = j >> 3, rr = j & 7, cq = (i & 1) ? 16 * (i >> 1) + 15 - rr : 16 * (i >> 1) + rr;
        const size_t rb = (size_t)b * NT;
        const int q0 = 64 * cq, nT = cq + 1;
        bf16x8 qfA[4], qfB[4];
        { const bf16_t* qp = Qs + (rb + q0 + r32) * 512 + wave * 64 + 8 * hi;
#pragma unroll
          for (int ks = 0; ks < 4; ++ks) { qfA[ks] = *(const bf16x8*)(qp + 16 * ks); qfB[ks] = *(const bf16x8*)(qp + 32 * 512 + 16 * ks); } }
        f32x16 oA[2], oB[2]; float mA = -INFINITY, lA = 0.f, mB = -INFINITY, lB = 0.f;
#pragma unroll
        for (int db = 0; db < 2; ++db)
#pragma unroll
            for (int r = 0; r < 16; ++r) { oA[db][r] = 0.f; oB[db][r] = 0.f; }
        const int key0 = tid >> 3, ch = tid & 7;
        const bf16_t* kg = Ks + (rb + key0) * 64 + ch * 8;
        const bf16_t* vg = Vs + (rb + key0) * 64 + ch * 8;
        const int loff = key0 * KST + ch * 16, loffv = KBYTES + key0 * VST + ch * 16;
        const unsigned* bmpA = BM + (rb + q0 + r32) * 64;
        const unsigned* bmpB = bmpA + 32 * 64;
        u32x4 sk0 = *(const u32x4*)kg, sv0 = *(const u32x4*)vg;
        u32x2 mwA = *(const u32x2*)bmpA, mwB = *(const u32x2*)bmpB, mnA = mwA, mnB = mwB;
        *(LAS u32x4*)(lds + loff) = sk0; *(LAS u32x4*)(lds + loffv) = sv0;
        __syncthreads();
        for (int t = 0; t < nT; ++t) {
            const bool more = (t + 1 < nT);
            if (more) {
                const size_t go = (size_t)(t + 1) * 64 * 64;
                sk0 = *(const u32x4*)(kg + go); sv0 = *(const u32x4*)(vg + go); mnA = *(const u32x2*)(bmpA + 2 * (t + 1)); mnB = *(const u32x2*)(bmpB + 2 * (t + 1));
            }
            {
                const LAS char* bufp = (const LAS char*)lds + (t & 1) * BUF;
                attn_tile<2, KST, VST, true>(bufp, bufp + KBYTES, oA, mA, lA, qfA, mwA.x, mwA.y, lane);
                attn_tile<2, KST, VST, true>(bufp, bufp + KBYTES, oB, mB, lB, qfB, mwB.x, mwB.y, lane);
            }
            if (more) {
                LAS unsigned char* nb = lds + ((t + 1) & 1) * BUF;
                *(LAS u32x4*)(nb + loff) = sk0; *(LAS u32x4*)(nb + loffv) = sv0;
                mwA = mnA; mwB = mnB;
            }
            __syncthreads();
        }
        {
            float ilA = (F8_BR ? ASC8 : 1.f) / lA, ilB = (F8_BR ? ASC8 : 1.f) / lB;
            if (BR8 && !F8_BR) {
                float mA = 0.f, mB = 0.f;
#pragma unroll
                for (int db = 0; db < 2; ++db)
#pragma unroll
                    for (int r = 0; r < 16; ++r) { mA = fmaxf(mA, fabsf(oA[db][r])); mB = fmaxf(mB, fabsf(oB[db][r])); }
                mA *= ilA; mB *= ilB;
                mA = fmaxf(mA, __shfl_xor(mA, 32)); mB = fmaxf(mB, __shfl_xor(mB, 32));
                LAS float* xm = (LAS float*)lds;
                if (hi == 0) { xm[wave * 64 + r32] = mA; xm[wave * 64 + 32 + r32] = mB; }
                __syncthreads();
                float rA = 1e-20f, rB = 1e-20f;
#pragma unroll
                for (int w8 = 0; w8 < 8; ++w8) { rA = fmaxf(rA, xm[w8 * 64 + r32]); rB = fmaxf(rB, xm[w8 * 64 + 32 + r32]); }
                __syncthreads();
                ilA *= 127.f / rA; ilB *= 127.f / rB;
                if (wave == 0 && hi == 0) { float* obs = (float*)(ws + WS_OBS); obs[rb + q0 + r32] = rA * (1.f / 127.f); obs[rb + q0 + 32 + r32] = rB * (1.f / 127.f); }
            }
            const size_t oo = FUSE56 ? (rb + q0 + r32) * 1024 + 512 + wave * 64 + 4 * hi : (size_t)NTOK * 512 + (rb + q0 + r32) * 512 + wave * 64 + 4 * hi;
            constexpr int OST = FUSE56 ? 1024 : 512;
            bf16_t* op = OAB + oo; unsigned char* op8 = (unsigned char*)OAB + oo;
#pragma unroll
            for (int db = 0; db < 2; ++db)
#pragma unroll
                for (int r4 = 0; r4 < 4; ++r4) {
                    if (BR8 && !F8_BR) {
                        *(unsigned*)(op8 + 32 * db + 8 * r4) = pack_i8x4(oA[db][4 * r4] * ilA, oA[db][4 * r4 + 1] * ilA, oA[db][4 * r4 + 2] * ilA, oA[db][4 * r4 + 3] * ilA);
                        *(unsigned*)(op8 + 32 * OST + 32 * db + 8 * r4) = pack_i8x4(oB[db][4 * r4] * ilB, oB[db][4 * r4 + 1] * ilB, oB[db][4 * r4 + 2] * ilB, oB[db][4 * r4 + 3] * ilB);
                    } else if (F8_BR) {
                        *(unsigned*)(op8 + 32 * db + 8 * r4) = pack_fp8x4(oA[db][4 * r4] * ilA, oA[db][4 * r4 + 1] * ilA, oA[db][4 * r4 + 2] * ilA, oA[db][4 * r4 + 3] * ilA);
                        *(unsigned*)(op8 + 32 * OST + 32 * db + 8 * r4) = pack_fp8x4(oB[db][4 * r4] * ilB, oB[db][4 * r4 + 1] * ilB, oB[db][4 * r4 + 2] * ilB, oB[db][4 * r4 + 3] * ilB);
                    } else {
                    u32x2 w; w.x = pk2(oA[db][4 * r4] * ilA, oA[db][4 * r4 + 1] * ilA); w.y = pk2(oA[db][4 * r4 + 2] * ilA, oA[db][4 * r4 + 3] * ilA);
                    *(u32x2*)(op + 32 * db + 8 * r4) = w;
                    u32x2 w2; w2.x = pk2(oB[db][4 * r4] * ilB, oB[db][4 * r4 + 1] * ilB); w2.y = pk2(oB[db][4 * r4 + 2] * ilB, oB[db][4 * r4 + 3] * ilB);
                    *(u32x2*)(op + 32 * OST + 32 * db + 8 * r4) = w2; }
                }
        }
    }
}

template <bool DO_SEL = true>
DI void ph_indexer(const KArgs& a, LAS unsigned char* lds, int tid, int lane, int wave, int blk, int nblk) {
    unsigned char* ws = a.ws;
    const bf16_t* Qi = (const bf16_t*)(ws + WS_QI); const bf16_t* Ki = (const bf16_t*)(ws + WS_KI); const float* Widx = (const float*)(ws + WS_WIDX);
    unsigned long long* BM = (unsigned long long*)(ws + WS_BM);
    constexpr int SCS = 2052;
    LAS float* sc = (LAS float*)lds;
    const int l15 = lane & 15, l4 = lane >> 4;
    bf16x8 qfr[8][2]; f32x4 w0, w1;
#define IDX_DECODE(idx_, b_, qi_) const int b_ = (idx_) >> 7, qi_ = (((idx_) & 127) + 8 * ((idx_) >> 8)) & 127
#define IDX_LOADQ(idx_) do { IDX_DECODE(idx_, b__, qi__); const bf16_t* qp = Qi + ((size_t)b__ * NT + 16 * qi__ + l15) * 512 + 8 * l4; \
        _Pragma("unroll") for (int h = 0; h < 8; ++h) { qfr[h][0] = *(const bf16x8*)(qp + h * 64); qfr[h][1] = *(const bf16x8*)(qp + h * 64 + 32); } \
        w0 = *(const f32x4*)(Widx + ((size_t)b__ * NT + 16 * qi__ + l15) * 8); w1 = *(const f32x4*)(Widx + ((size_t)b__ * NT + 16 * qi__ + l15) * 8 + 4); } while (0)
    if (blk < 4096) IDX_LOADQ(blk);
    for (int idx = blk; idx < 4096; idx += nblk) {
        IDX_DECODE(idx, b, qi);
        const size_t rb = (size_t)b * NT;
        const int q0 = 16 * qi, chunk = qi >> 2, nj = chunk + 1, nt16 = 4 * nj;
        constexpr float IS = 0.044194173824159216f;
        const float w[8] = {w0[0] * IS, w0[1] * IS, w0[2] * IS, w0[3] * IS, w1[0] * IS, w1[1] * IS, w1[2] * IS, w1[3] * IS};
        {
            int tile = wave;
            const bf16_t* kp = Ki + (rb + 16 * tile + l15) * 64 + 8 * l4;
            bf16x8 ka0 = *(const bf16x8*)kp, ka1 = *(const bf16x8*)(kp + 32);
            for (; tile < nt16; tile += 8) {
                const int ntile = (tile + 8 < nt16) ? tile + 8 : tile;
                const bf16_t* np = Ki + (rb + 16 * ntile + l15) * 64 + 8 * l4;
                const bf16x8 nk0 = *(const bf16x8*)np, nk1 = *(const bf16x8*)(np + 32);
                f32x4 s4 = {0.f, 0.f, 0.f, 0.f};
#pragma unroll
                for (int h = 0; h < 8; ++h) {
                    f32x4 c = {0.f, 0.f, 0.f, 0.f};
                    c = MFMA16(ka0, qfr[h][0], c); c = MFMA16(ka1, qfr[h][1], c);
#pragma unroll
                    for (int r = 0; r < 4; ++r) s4[r] += fmaxf(c[r], 0.f) * w[h];
                }
                *(LAS f32x4*)(sc + l15 * SCS + 16 * tile + 4 * l4) = s4;
                ka0 = nk0; ka1 = nk1;
            }
        }
        __syncthreads();
        if (idx + nblk < 4096) IDX_LOADQ(idx + nblk);
        if (DO_SEL) {
            const int qa = 2 * wave, qb = qa + 1;
            unsigned ua[32], ub[32];
#pragma unroll
            for (int jj = 0; jj < 32; ++jj) {
                ua[jj] = 0u; ub[jj] = 0u;
                if (jj < nj) {
                    const float sa = sc[qa * SCS + lane + 64 * jj] + 24.0f, sb = sc[qb * SCS + lane + 64 * jj] + 24.0f;
                    const unsigned ba = __builtin_bit_cast(unsigned, sa), bb = __builtin_bit_cast(unsigned, sb);
                    ua[jj] = (ba & 0x80000000u) ? ~ba : (ba | 0x80000000u); ub[jj] = (bb & 0x80000000u) ? ~bb : (bb | 0x80000000u);
                }
            }
            unsigned long long maska = 0ull, maskb = 0ull;
            if (nj <= 4) { maska = ~0ull; maskb = ~0ull; }
            else {
                unsigned pa = 0u, pb = 0u; bool da = false, db = false;
                int start = 31;
                {
                    unsigned ora = 0u, anda = ~0u, orb = 0u, andb = ~0u;
#pragma unroll
                    for (int jj = 0; jj < 32; ++jj) if (jj < nj) { ora |= ua[jj]; anda &= ua[jj]; orb |= ub[jj]; andb &= ub[jj]; }
#pragma unroll
                    for (int o = 1; o < 64; o <<= 1) { ora |= __shfl_xor(ora, o); anda &= __shfl_xor(anda, o); orb |= __shfl_xor(orb, o); andb &= __shfl_xor(andb, o); }
                    const unsigned dd = __builtin_amdgcn_readfirstlane((ora ^ anda) | (orb ^ andb));
                    start = dd ? 31 - __builtin_clz(dd) : -1;
                    const unsigned keep = (start >= 31) ? 0u : (0xFFFFFFFFu << (start + 1));
                    pa = anda & keep; pb = andb & keep;
                }
#pragma unroll 1
                for (int bit = start; bit >= 0; --bit) {
                    const unsigned ca = da ? pa : (pa | (1u << bit)), cb = db ? pb : (pb | (1u << bit));
                    int cnta = 0, cntb = 0;
#pragma unroll
                    for (int g = 0; g < 8; ++g) if (4 * g < nj) {
#pragma unroll
                        for (int jj = 0; jj < 4; ++jj) { cnta += __popcll(__ballot(ua[4 * g + jj] >= ca)); cntb += __popcll(__ballot(ub[4 * g + jj] >= cb)); }
                    }
                    if (!da && cnta >= 256) { pa = ca; da = (cnta == 256); }
                    if (!db && cntb >= 256) { pb = cb; db = (cntb == 256); }
                    if (da && db) break;
                }
                int cga = 0, cgb = 0;
#pragma unroll
                for (int g = 0; g < 8; ++g) if (4 * g < nj) {
#pragma unroll
                    for (int jj = 0; jj < 4; ++jj) { cga += __popcll(__ballot(ua[4 * g + jj] > pa)); cgb += __popcll(__ballot(ub[4 * g + jj] > pb)); }
                }
                const int needa = 256 - cga, needb = 256 - cgb; int runa = 0, runb = 0;
                const unsigned long long lt = (1ull << lane) - 1ull;
#pragma unroll
                for (int g = 0; g < 8; ++g) if (4 * g < nj) {
#pragma unroll
                    for (int jj = 0; jj < 4; ++jj) {
                        const int e = 4 * g + jj;
                        { const bool eq = (ua[e] == pa); const unsigned long long em = __ballot(eq); const int rank = runa + __popcll(em & lt);
                          const unsigned long long sb2 = __ballot((ua[e] > pa) || (eq && rank < needa)); if (lane == e) maska = sb2; runa += __popcll(em); }
                        { const bool eq = (ub[e] == pb); const unsigned long long em = __ballot(eq); const int rank = runb + __popcll(em & lt);
                          const unsigned long long sb2 = __ballot((ub[e] > pb) || (eq && rank < needb)); if (lane == e) maskb = sb2; runb += __popcll(em); }
                    }
                }
            }
            if (lane < nj) { BM[(rb + q0 + qa) * 32 + lane] = maska; BM[(rb + q0 + qb) * 32 + lane] = maskb; }
        }
        __syncthreads();
    }
#undef IDX_DECODE
#undef IDX_LOADQ
}
DI int mono_i(float f) { const int i = __builtin_bit_cast(int, f); return i ^ ((i >> 31) & 0x7fffffff); }
DI float mono_f(int i) { return __builtin_bit_cast(float, i ^ ((i >> 31) & 0x7fffffff)); }
constexpr int IMIN = (int)0x80000000;

DI void ce_desc(int& a, int& b) { const int hi = max(a, b), lo = min(a, b); a = hi; b = lo; }
template <int B, bool DESC> DI void bitonic_merge16(int (&x)[64]) {
#pragma unroll
    for (int j = 8; j > 0; j >>= 1)
#pragma unroll
        for (int i = 0; i < 16; ++i) { const int l = i ^ j; if (l > i) { if (DESC) ce_desc(x[B + i], x[B + l]); else ce_desc(x[B + l], x[B + i]); } }
}
DI void top16_of_64(int (&x)[64]) {
#pragma unroll
    for (int k = 2; k <= 16; k <<= 1)
#pragma unroll
        for (int j = k >> 1; j > 0; j >>= 1)
#pragma unroll
            for (int i = 0; i < 64; ++i) { const int l = i ^ j; if (l > i) { if ((i & k) == 0) ce_desc(x[i], x[l]); else ce_desc(x[l], x[i]); } }
#pragma unroll
    for (int i = 0; i < 16; ++i) { x[i] = max(x[i], x[16 + i]); x[32 + i] = max(x[32 + i], x[48 + i]); }
    bitonic_merge16<0, true>(x); bitonic_merge16<32, false>(x);
#pragma unroll
    for (int i = 0; i < 16; ++i) x[i] = max(x[i], x[32 + i]);
    bitonic_merge16<0, true>(x);
}

DI void ph_peer_route(const KArgs& a, LAS unsigned char* lds, int tid, int lane, int wave, int blk, int nblk) {
    unsigned char* ws = a.ws;
    const bf16_t* QP = (const bf16_t*)(ws + WS_QP); const bf16_t* SKB = (const bf16_t*)(ws + WS_SKB);
    int* EIDX = (int*)(ws + WS_EIDX); float* GW = (float*)(ws + WS_GW);
    constexpr int SST = 272, SHALF = 128 * SST;
    const int r32 = lane & 31, hi = lane >> 5;
    for (int vb = blk; vb < 256; vb += nblk) {
        const int head = vb & 7, tg = vb >> 3;
        __syncthreads();
        for (int c = tid; c < 4096; c += 512) {
            const int p = c >> 11, key = (c >> 4) & 127, chn = c & 15;
            *(LAS u32x4*)(lds + p * SHALF + key * SST + chn * 16) = *(const u32x4*)(SKB + ((size_t)(head * 2 + p) * 128 + key) * 128 + chn * 8);
        }
        __syncthreads();
        LAS int* Ll = (LAS int*)(lds + 2 * SHALF) + wave * 2048;
        for (int tile = wave; tile < 64; tile += 8) {
            const size_t n0 = (size_t)tg * 2048 + tile * 32;
#pragma unroll 1
            for (int p = 0; p < 2; ++p) {
                int hi4 = 4 * hi; asm volatile("" : "+v"(hi4));
                bf16x8 qf[8];
                { const bf16_t* qp = QP + (n0 + r32) * 2048 + head * 256 + p * 128 + 8 * hi;
#pragma unroll
                  for (int ks = 0; ks < 8; ++ks) qf[ks] = *(const bf16x8*)(qp + 16 * ks); }
                int xi[64];
#pragma unroll
                for (int mt = 0; mt < 4; ++mt) {
                    f32x16 acc;
#pragma unroll
                    for (int r = 0; r < 16; ++r) acc[r] = 0.f;
                    const LAS char* ka = (const LAS char*)lds + p * SHALF + (32 * mt + r32) * SST + hi * 16;
#pragma unroll
                    for (int ks = 0; ks < 8; ++ks) acc = MFMA32(*(const LAS bf16x8*)(ka + ks * 32), qf[ks], acc);
#pragma unroll
                    for (int r = 0; r < 16; ++r) xi[mt * 16 + r] = ((mono_i(acc[r]) & ~127) | hi4) | (32 * mt + (r & 3) + 8 * (r >> 2));
                }
                top16_of_64(xi);
                {
                    int pr[16];
#pragma unroll
                    for (int i = 0; i < 16; ++i) pr[i] = __shfl_xor(xi[15 - i], 32);
#pragma unroll
                    for (int i = 0; i < 16; ++i) xi[i] = max(xi[i], pr[i]);
                    bitonic_merge16<0, true>(xi);
                }
#pragma unroll
                for (int it = 0; it < 16; ++it) Ll[(p * 16 + it) * 64 + lane] = xi[it];
            }
            int cs[64];
            {
                int l0[16], l1[16];
#pragma unroll
                for (int k = 0; k < 16; ++k) { l0[k] = Ll[k * 64 + lane]; l1[k] = Ll[(16 + k) * 64 + lane]; }
                int nc = 0;
#pragma unroll
                for (int ra = 0; ra < 16; ++ra)
#pragma unroll
                    for (int rb2 = 0; rb2 < 16; ++rb2)
                        if ((ra + 1) * (rb2 + 1) <= 16) {
                            const float s = mono_f(l0[ra] & ~127) + mono_f(l1[rb2] & ~127);
                            cs[nc] = (mono_i(s) & ~255) | (255 - (ra * 16 + rb2)); ++nc;
                        }
#pragma unroll
                for (int k = 50; k < 64; ++k) cs[k] = IMIN;
            }
            top16_of_64(cs);
            float sv[16]; int se[16];
#pragma unroll
            for (int it = 0; it < 16; ++it) {
                const int flat = 255 - (cs[it] & 255);
                se[it] = (Ll[(flat >> 4) * 64 + lane] & 127) * 128 + (Ll[(16 + (flat & 15)) * 64 + lane] & 127);
                sv[it] = mono_f(cs[it] & ~255);
            }
            const float smax = sv[0];
            float sum = 0.f;
#pragma unroll
            for (int it = 0; it < 16; ++it) { sv[it] = __expf(sv[it] - smax); sum += sv[it]; }
            const float inv = 1.f / sum;
            if (hi == 0) {
                unsigned short* ep = (unsigned short*)EIDX + (n0 + r32) * 128 + head * 16;
                float* gp = GW + (n0 + r32) * 128 + head * 16;
#pragma unroll
                for (int k = 0; k < 4; ++k) {
                    *(u32x2*)(ep + 4 * k) = (u32x2){(unsigned)se[4 * k] | ((unsigned)se[4 * k + 1] << 16), (unsigned)se[4 * k + 2] | ((unsigned)se[4 * k + 3] << 16)};
                    *(f32x4*)(gp + 4 * k) = (f32x4){sv[4 * k] * inv, sv[4 * k + 1] * inv, sv[4 * k + 2] * inv, sv[4 * k + 3] * inv};
                }
            }
        }
    }
}

DI int dot4z(int a, int b) { int r; asm("v_dot4_i32_i8 %0, %1, %2, 0" : "=v"(r) : "v"(a), "v"(b)); return r; }
DI f32x2 fp8lo(unsigned w) { return __builtin_amdgcn_cvt_pk_f32_fp8((int)w, false); }
DI f32x2 fp8hi(unsigned w) { return __builtin_amdgcn_cvt_pk_f32_fp8((int)w, true); }
constexpr int PEER_CH = 8, PEER_NCH = NTOK / PEER_CH;
constexpr size_t SLICE_BYTES = (size_t)16384 * 128;

template <int STEP>
DI void peer_issue(const unsigned char* tb, unsigned lo16, const LAS int* et, int g, u32x4 (&tv)[16], u32x4 (&hx)[2], f32x4& xr, const unsigned char* hrow, const float* xrow, const float* hsp = nullptr) {
#pragma unroll
    for (int it = 0; it < 16; ++it) tv[it] = *(const u32x4*)(tb + ((unsigned)et[8 * it + g] + lo16));
    if (STEP == 0) { hx[0] = *(const u32x4*)hrow; if (U4) hx[1] = *(const u32x4*)(hrow + (UD8 ? (WS_HB4 - WS_HA4) : 16)); xr.x = *hsp; }
    else if (V4) xr = *(const f32x4*)xrow;
    else { const f32x2 t2 = *(const f32x2*)xrow; xr.x = t2.x; xr.y = t2.y; }
    __builtin_amdgcn_sched_barrier(0);
}

template <int STEP, bool HALFROW = false>
DI void ph_peer_slices(const KArgs& a, LAS unsigned char* lds, int lane, int wave, unsigned xcc) {
    unsigned char* ws = a.ws;
    const unsigned char* H8 = ws + WS_H8; const float* HS = (const float*)(ws + WS_HS); const unsigned char* U8 = ws + WS_UB; const unsigned char* V8 = ws + WS_VB;
    const float usc = __builtin_bit_cast(float, ((const unsigned*)(ws + WS_CTL))[CW_UMAX]) * (U4 ? (UD8 ? U4_STEP : U4_STEP * (1.f / 16.f)) : 1.f / 127.f);
    constexpr bool UQ = (STEP == 0) && U4, VQ = (STEP == 2) && V4, Q4 = UQ || VQ;
    const unsigned short* EIDX = (const unsigned short*)(ws + WS_EIDX); const float* mod = (const float*)(ws + WS_MOD);
    _Float16* PART = (_Float16*)(ws + WS_PART); const _Float16* W = (const _Float16*)(ws + WS_WGT);
    unsigned* ctr = (unsigned*)(ws + WS_CTL) + 8192 + (STEP ? 1024 : 0);
    float* out = a.out;
    LAS int* e_l = (LAS int*)(lds + wave * 16896);
    LAS _Float16* w_l = (LAS _Float16*)(e_l + 1024);
    LAS float* a_l = (LAS float*)(e_l + 2048);
    LAS float* red = a_l + 128;
    const int g = lane >> 3, s8 = lane & 7;
    for (int ds = 0; ds < (Q4 ? 4 : 8); ++ds) {
        const int s = (int)((xcc + ds) & (Q4 ? 3u : 7u));
        const unsigned char* tb = (STEP ? V8 : U8) + (size_t)s * SLICE_BYTES;
        const unsigned lo16 = (unsigned)(HALFROW ? (s8 & 3) : s8) * 16u;
        unsigned cn = 0;
        if (lane == 0) cn = __hip_atomic_fetch_add(ctr + 64 * s, 1u, __ATOMIC_RELAXED, __HIP_MEMORY_SCOPE_AGENT);
        cn = __builtin_amdgcn_readfirstlane(cn);
        u32x2 pe[4], pw[4];
        if (cn < (unsigned)PEER_NCH) {
#pragma unroll
            for (int q = 0; q < 4; ++q) { pe[q] = *(const u32x2*)(EIDX + (size_t)cn * PEER_CH * 128 + lane * 4 + 256 * q); if (STEP) pw[q] = *(const u32x2*)(W + (size_t)cn * PEER_CH * 128 + lane * 4 + 256 * q); }
        }
        for (;;) {
            const unsigned c = cn;
            if (c >= (unsigned)PEER_NCH) break;
#pragma unroll
            for (int q = 0; q < 4; ++q) { *(LAS u32x4*)(e_l + lane * 4 + 256 * q) = (u32x4){(pe[q].x & 0xffffu) << 7, (pe[q].x >> 16) << 7, (pe[q].y & 0xffffu) << 7, (pe[q].y >> 16) << 7}; if (STEP) *(LAS u32x2*)(w_l + lane * 4 + 256 * q) = pw[q]; }
            if (lane == 0) cn = __hip_atomic_fetch_add(ctr + 64 * s, 1u, __ATOMIC_RELAXED, __HIP_MEMORY_SCOPE_AGENT);
            cn = __builtin_amdgcn_readfirstlane(cn);
            if (cn < (unsigned)PEER_NCH) {
#pragma unroll
                for (int q = 0; q < 4; ++q) { pe[q] = *(const u32x2*)(EIDX + (size_t)cn * PEER_CH * 128 + lane * 4 + 256 * q); if (STEP) pw[q] = *(const u32x2*)(W + (size_t)cn * PEER_CH * 128 + lane * 4 + 256 * q); }
            }
            LDS_WAIT();
            const int n0 = (int)c * PEER_CH;
            const int b = n0 / NT;
            f32x2 gv2 = {0.f, 0.f}; f32x4 gv4 = {0.f, 0.f, 0.f, 0.f};
            if (VQ) gv4 = *(const f32x4*)(mod + (size_t)b * 6144 + 5120 + s * 256 + 4 * lane) * (1.f / V4_WSC);
            else if (STEP) gv2 = *(const f32x2*)(mod + (size_t)b * 6144 + 5120 + s * 128 + 2 * lane);
            u32x4 tvA[16], tvB[16], hA[2], hB[2]; f32x4 xA = {0.f, 0.f, 0.f, 0.f}, xB = {0.f, 0.f, 0.f, 0.f};
#define PEER_HROW(t) ((UQ && UD8) ? (ws + WS_HA4 + (size_t)(n0 + (t)) * 512 + s * 128 + s8 * 16) : (H8 + (size_t)(n0 + (t)) * 1024 + s * (UQ ? 256 : 128) + s8 * (UQ ? 32 : 16)))
#define PEER_XROW(t) (out + (size_t)(n0 + (t)) * 1024 + (VQ ? s * 256 + 4 * lane : s * 128 + 2 * lane))
#define PEER_COMPUTE(t, tv, hx, xr) do { \
            if (UQ) { \
                LAS int* redi = (LAS int*)red; \
                if (UD8) { \
                _Pragma("unroll") for (int it = 0; it < 16; ++it) {     \
                    int da = __builtin_amdgcn_sdot8((int)tv[it].x, (int)hx[0].x, 0, false), db = __builtin_amdgcn_sdot8((int)tv[it].x, (int)hx[1].x, 0, false); \
                    da = __builtin_amdgcn_sdot8((int)tv[it].y, (int)hx[0].y, da, false); db = __builtin_amdgcn_sdot8((int)tv[it].y, (int)hx[1].y, db, false); \
                    da = __builtin_amdgcn_sdot8((int)tv[it].z, (int)hx[0].z, da, false); db = __builtin_amdgcn_sdot8((int)tv[it].z, (int)hx[1].z, db, false); \
                    da = __builtin_amdgcn_sdot8((int)tv[it].w, (int)hx[0].w, da, false); db = __builtin_amdgcn_sdot8((int)tv[it].w, (int)hx[1].w, db, false); \
                    redi[it * 64 + lane] = 16 * da + db; \
                } \
                } else \
                _Pragma("unroll") for (int it = 0; it < 16; ++it) { \
                    int d0 = dot4z((int)((tv[it].x << 4) & 0xF0F0F0F0u), (int)hx[0].x), d1 = dot4z((int)((tv[it].y << 4) & 0xF0F0F0F0u), (int)hx[0].y); \
                    d0 = __builtin_amdgcn_sdot4((int)((tv[it].z << 4) & 0xF0F0F0F0u), (int)hx[0].z, d0, false); d1 = __builtin_amdgcn_sdot4((int)((tv[it].w << 4) & 0xF0F0F0F0u), (int)hx[0].w, d1, false); \
                    d0 = __builtin_amdgcn_sdot4((int)(tv[it].x & 0xF0F0F0F0u), (int)hx[1].x, d0, false); d1 = __builtin_amdgcn_sdot4((int)(tv[it].y & 0xF0F0F0F0u), (int)hx[1].y, d1, false); \
                    d0 = __builtin_amdgcn_sdot4((int)(tv[it].z & 0xF0F0F0F0u), (int)hx[1].z, d0, false); d1 = __builtin_amdgcn_sdot4((int)(tv[it].w & 0xF0F0F0F0u), (int)hx[1].w, d1, false); \
                    redi[it * 64 + lane] = d0 + d1;                      \
                } \
                LDS_WAIT(); \
                _Float16* pp = PART + ((size_t)s * NTOK + n0 + (t)) * 128; \
                { typedef int i32x4 __attribute__((ext_vector_type(4))); \
                  const i32x4 r0 = *(const LAS i32x4*)(redi + 8 * lane), r1 = *(const LAS i32x4*)(redi + 8 * lane + 4), r2 = *(const LAS i32x4*)(redi + 512 + 8 * lane), r3 = *(const LAS i32x4*)(redi + 512 + 8 * lane + 4); \
                  const float sc_ = xr.x * usc; \
                  pp[lane] = (_Float16)((float)(((r0[0] + r0[1]) + (r0[2] + r0[3])) + ((r1[0] + r1[1]) + (r1[2] + r1[3]))) * sc_); \
                  pp[64 + lane] = (_Float16)((float)(((r2[0] + r2[1]) + (r2[2] + r2[3])) + ((r3[0] + r3[1]) + (r3[2] + r3[3]))) * sc_); } \
                LDS_WAIT(); \
            } else if (STEP == 0) { \
                LAS int* redi = (LAS int*)red; \
                _Pragma("unroll") for (int it = 0; it < 16; ++it) { \
                    int d0 = dot4z((int)tv[it].x, (int)hx[0].x), d1 = dot4z((int)tv[it].y, (int)hx[0].y);        \
                    d0 = __builtin_amdgcn_sdot4((int)tv[it].z, (int)hx[0].z, d0, false); d1 = __builtin_amdgcn_sdot4((int)tv[it].w, (int)hx[0].w, d1, false); \
                    redi[it * 64 + lane] = d0 + d1;                      \
                } \
                LDS_WAIT(); \
                _Float16* pp = PART + ((size_t)s * NTOK + n0 + (t)) * 128; \
                { typedef int i32x4 __attribute__((ext_vector_type(4))); \
                  const i32x4 r0 = *(const LAS i32x4*)(redi + 8 * lane), r1 = *(const LAS i32x4*)(redi + 8 * lane + 4), r2 = *(const LAS i32x4*)(redi + 512 + 8 * lane), r3 = *(const LAS i32x4*)(redi + 512 + 8 * lane + 4); \
                  const float sc_ = xr.x * usc; \
                  pp[lane] = (_Float16)((float)(((r0[0] + r0[1]) + (r0[2] + r0[3])) + ((r1[0] + r1[1]) + (r1[2] + r1[3]))) * sc_); \
                  pp[64 + lane] = (_Float16)((float)(((r2[0] + r2[1]) + (r2[2] + r2[3])) + ((r3[0] + r3[1]) + (r3[2] + r3[3]))) * sc_); } \
                LDS_WAIT(); \
            } else if (VQ) { \
                h16x2 acc[16]; \
                _Pragma("unroll") for (int k = 0; k < 16; ++k) acc[k] = (h16x2){(_Float16)0.f, (_Float16)0.f}; \
                _Pragma("unroll") for (int it = 0; it < 16; ++it) { \
                    const _Float16 wh = w_l[(t) * 128 + 8 * it + g]; const h16x2 w2 = {wh, wh}; \
                    _Pragma("unroll") for (int k = 0; k < 4; ++k) { \
                        acc[4 * k] += __builtin_amdgcn_cvt_scalef32_pk_f16_fp4(tv[it][k], 1.0f, 0) * w2; acc[4 * k + 1] += __builtin_amdgcn_cvt_scalef32_pk_f16_fp4(tv[it][k], 1.0f, 1) * w2; \
                        acc[4 * k + 2] += __builtin_amdgcn_cvt_scalef32_pk_f16_fp4(tv[it][k], 1.0f, 2) * w2; acc[4 * k + 3] += __builtin_amdgcn_cvt_scalef32_pk_f16_fp4(tv[it][k], 1.0f, 3) * w2; } \
                } \
                LAS _Float16* redh = (LAS _Float16*)red;                  \
                LAS h16x8* rp = (LAS h16x8*)(redh + g * 256 + s8 * 32); \
                _Pragma("unroll") for (int i = 0; i < 4; ++i) rp[i] = (h16x8){acc[4 * i].x, acc[4 * i].y, acc[4 * i + 1].x, acc[4 * i + 1].y, acc[4 * i + 2].x, acc[4 * i + 2].y, acc[4 * i + 3].x, acc[4 * i + 3].y}; \
                LDS_WAIT(); \
                f32x4 sum = {0.f, 0.f, 0.f, 0.f}; \
                _Pragma("unroll") for (int q = 0; q < 8; ++q) { const h16x4 p4 = *(const LAS h16x4*)(redh + q * 256 + 4 * lane); sum += (f32x4){(float)p4.x, (float)p4.y, (float)p4.z, (float)p4.w}; } \
                *(f32x4*)(out + (size_t)(n0 + (t)) * 1024 + s * 256 + 4 * lane) = xr + gv4 * sum; \
                LDS_WAIT(); \
            } else { \
                f32x2 acc[8]; \
                _Pragma("unroll") for (int k = 0; k < 8; ++k) acc[k] = (f32x2){0.f, 0.f}; \
                _Pragma("unroll") for (int it = 0; it < 16; ++it) { \
                    const float w = (float)w_l[(t) * 128 + 8 * it + g]; \
                    acc[0] += fp8lo(tv[it].x) * w; acc[1] += fp8hi(tv[it].x) * w; acc[2] += fp8lo(tv[it].y) * w; acc[3] += fp8hi(tv[it].y) * w; \
                    acc[4] += fp8lo(tv[it].z) * w; acc[5] += fp8hi(tv[it].z) * w; acc[6] += fp8lo(tv[it].w) * w; acc[7] += fp8hi(tv[it].w) * w; \
                } \
                LAS f32x4* rp = (LAS f32x4*)(red + g * 128 + s8 * 16); \
                rp[0] = (f32x4){acc[0].x, acc[0].y, acc[1].x, acc[1].y}; rp[1] = (f32x4){acc[2].x, acc[2].y, acc[3].x, acc[3].y}; \
                rp[2] = (f32x4){acc[4].x, acc[4].y, acc[5].x, acc[5].y}; rp[3] = (f32x4){acc[6].x, acc[6].y, acc[7].x, acc[7].y}; \
                LDS_WAIT(); \
                f32x2 sum = {0.f, 0.f}; \
                _Pragma("unroll") for (int q = 0; q < 8; ++q) sum += *(const LAS f32x2*)(red + q * 128 + 2 * lane); \
                *(f32x2*)(out + (size_t)(n0 + (t)) * 1024 + s * 128 + 2 * lane) = (f32x2){xr.x, xr.y} + gv2 * sum; \
                LDS_WAIT(); \
            } \
            __builtin_amdgcn_sched_barrier(0); } while (0)
            peer_issue<STEP>(tb, lo16, e_l, g, tvA, hA, xA, PEER_HROW(0), PEER_XROW(0), HS + n0);
#pragma unroll 1
            for (int t = 0; t < PEER_CH - 2; t += 2) {
                peer_issue<STEP>(tb, lo16, e_l + (t + 1) * 128, g, tvB, hB, xB, PEER_HROW(t + 1), PEER_XROW(t + 1), HS + n0 + t + 1);
                PEER_COMPUTE(t, tvA, hA, xA);
                peer_issue<STEP>(tb, lo16, e_l + (t + 2) * 128, g, tvA, hA, xA, PEER_HROW(t + 2), PEER_XROW(t + 2), HS + n0 + t + 2);
                PEER_COMPUTE(t + 1, tvB, hB, xB);
            }
            peer_issue<STEP>(tb, lo16, e_l + (PEER_CH - 1) * 128, g, tvB, hB, xB, PEER_HROW(PEER_CH - 1), PEER_XROW(PEER_CH - 1), HS + n0 + PEER_CH - 1);
            PEER_COMPUTE(PEER_CH - 2, tvA, hA, xA);
            PEER_COMPUTE(PEER_CH - 1, tvB, hB, xB);
#undef PEER_HROW
#undef PEER_XROW
#undef PEER_COMPUTE
        }
    }
}

DI void ph_peer_combine(const KArgs& a, int tid, int blk, int nblk) {
    unsigned char* ws = a.ws;
    const _Float16* PART = (const _Float16*)(ws + WS_PART); const float* GW = (const float*)(ws + WS_GW); _Float16* W = (_Float16*)(ws + WS_WGT);
    const size_t total = (size_t)NTOK * 128 / 4;
    const float vsc = V4 ? __builtin_bit_cast(float, ((const unsigned*)(ws + WS_CTL))[CW_VMAX]) * (V4_S * V4_WSC) : 1.f / VSCALE;
    constexpr int NS = U4 ? 4 : 8;
    h16x4 pn[NS]; f32x4 gn = {0.f, 0.f, 0.f, 0.f};
    const size_t i0 = (size_t)blk * 512 + tid, st = (size_t)nblk * 512;
    if (i0 < total) {
#pragma unroll
        for (int k = 0; k < NS; ++k) pn[k] = *(const h16x4*)(PART + (size_t)k * NTOK * 128 + 4 * i0);
        gn = *(const f32x4*)(GW + 4 * i0);
    }
    for (size_t i = i0; i < total; i += st) {
        f32x4 s = {0.f, 0.f, 0.f, 0.f};
#pragma unroll
        for (int k = 0; k < NS; ++k) s += (f32x4){(float)pn[k].x, (float)pn[k].y, (float)pn[k].z, (float)pn[k].w};
        const f32x4 gq = gn;
        if (i + st < total) {
#pragma unroll
            for (int k = 0; k < NS; ++k) pn[k] = *(const h16x4*)(PART + (size_t)k * NTOK * 128 + 4 * (i + st));
            gn = *(const f32x4*)(GW + 4 * (i + st));
        }
        f32x4 r;
#pragma unroll
        for (int k = 0; k < 4; ++k) r[k] = gq[k] * 0.5f * s[k] * (1.f + erff(s[k] * 0.70710678118654752f)) * vsc;
        *(h16x4*)(W + 4 * i) = (h16x4){(_Float16)r[0], (_Float16)r[1], (_Float16)r[2], (_Float16)r[3]};
    }
}
#ifndef MK_ONE_LAUNCH
#define MK_ONE_LAUNCH 1
#endif
constexpr int N_PHASES = 12;
#ifndef MK_DUP
#define MK_DUP 0
#endif
#ifndef MK_PREFIX
#define MK_PREFIX -1
#endif
#define PROGRAM() \
    if (IN(0)) { LAUNDER ph_prologue(a, lds, tid, lane, wave, blk, nblk); } \
    SEAM(0); \
    if (IN(1)) { LAUNDER { const float um = __builtin_bit_cast(float, ((const unsigned*)(ws + WS_CTL))[CW_UMAX]); if (U4) conv_u_i4(a.peer_u, ws + WS_UB, 1.f / (U4_STEP * fmaxf(um, 1e-30f)), (size_t)blk * 512 + tid, (size_t)nblk * 512); else conv_u_i8(a.peer_u, ws + WS_UB, 127.f / fmaxf(um, 1e-30f), (size_t)blk * 512 + tid, (size_t)nblk * 512); } if (V4) { const float vm = __builtin_bit_cast(float, ((const unsigned*)(ws + WS_CTL))[CW_VMAX]); conv_v_fp4(a.peer_v, ws + WS_VB, 1.f / (V4_S * fmaxf(vm, 1e-30f)), (size_t)blk * 512 + tid, (size_t)nblk * 512); } ph_weights8(a, lds, lane, wave, blk, nblk); ph_norm<(N8_IN > 0 && IN_MODE == 2), (NB_IN > 0), (N8_IN > 0 && IN_MODE == 1)>(a.x, a.norm1_g, mod, 0, 1024, (bf16_t*)(ws + WS_H), ws + WS_HF8, ws + WS_HF8, (float*)(ws + WS_HS1), lane, wave, blk, nblk); } \
    SEAM(1); \
    if (IN(2)) { LAUNDER \
        if (N8_IN > 0) { \
            pg8::Gemm g{(const bf16_t*)(ws + WS_HF8), (const bf16_t*)(ws + WS_WIN8), NTOK, N8_IN * 256, 512}; \
            pg8::StaticOrder S; S.init(NTOK, N8_IN * 256, nblk, blk); \
            EpiProjT<IN_MODE> E{(bf16_t*)(ws + WS_QD), (bf16_t*)(ws + WS_KD), (bf16_t*)(ws + WS_VD), (bf16_t*)(ws + WS_QS), (bf16_t*)(ws + WS_QI), (bf16_t*)(ws + WS_KS), (bf16_t*)(ws + WS_VS), \
                      (bf16_t*)(ws + WS_KI), (bf16_t*)(ws + WS_G0), (bf16_t*)(ws + WS_G1), (float*)(ws + WS_WIDX), (const float*)(ws + WS_COS), (const float*)(ws + WS_SIN), \
                      a.diff_q_g, a.diff_k_g, a.dsa_q_g, a.dsa_k_g, (const unsigned*)(ws + WS_CTL) + CW_WMAX + 0, (const float*)(ws + WS_HS1)}; \
            pg8::gemm_phase<EpiProjT<IN_MODE>, pg8::StaticOrder, true, true, IN_MODE>(lds, g, S, E); \
        } \
        if (NB_IN > 0) { \
            pg8::Gemm g{(const bf16_t*)(ws + WS_H), (const bf16_t*)(ws + WS_WIN), NTOK, NB_IN * 256, 1024}; \
            pg8::StaticOrder S; S.init(NTOK, NB_IN * 256, nblk, blk); \
            EpiProjT<0> E{(bf16_t*)(ws + WS_QD), (bf16_t*)(ws + WS_KD), (bf16_t*)(ws + WS_VD), (bf16_t*)(ws + WS_QS), (bf16_t*)(ws + WS_QI), (bf16_t*)(ws + WS_KS), (bf16_t*)(ws + WS_VS), \
                      (bf16_t*)(ws + WS_KI), (bf16_t*)(ws + WS_G0), (bf16_t*)(ws + WS_G1), (float*)(ws + WS_WIDX), (const float*)(ws + WS_COS), (const float*)(ws + WS_SIN), \
                      a.diff_q_g, a.diff_k_g, a.dsa_q_g, a.dsa_k_g, nullptr, nullptr}; \
            pg8::gemm_phase<EpiProjT<0>, pg8::StaticOrder, true, true, 0>(lds, g, S, E); \
        } \
    } \
    SEAM(2); \
    if (IN(3)) { LAUNDER ph_indexer(a, lds, tid, lane, wave, blk, nblk); if (MK_DUP == 30) ph_indexer(a, lds, tid, lane, wave, blk, nblk); if (MK_DUP == 31) ph_indexer<false>(a, lds, tid, lane, wave, blk, nblk); ph_diff_attn(a, lds, tid, lane, wave, blk, nblk); } \
    SEAM(3); \
    if (IN(4)) { LAUNDER if (MK_DUP == 41) ph_dsa_attn<1>(a, lds, tid, lane, wave, blk, nblk); if (MK_DUP == 42) ph_dsa_attn<2>(a, lds, tid, lane, wave, blk, nblk); ph_dsa_attn<0>(a, lds, tid, lane, wave, blk, nblk); } \
    SEAM(4); \
    if (IN(5) && FUSE56) { LAUNDER \
        pg8::Gemm g{(const bf16_t*)(ws + WS_OAB), (const bf16_t*)(ws + WS_WBA), NTOK, 1024, 1024}; \
        pg8::StaticOrder S; S.init(NTOK, 1024, nblk, blk); \
        EpiMerged E{ws + WS_G0, ws + WS_G1, (bf16_t*)(ws + WS_MERGED), ws + WS_MERGED8}; \
        pg8::gemm_phase<EpiMerged, pg8::StaticOrder, true, true, 0>(lds, g, S, E); \
    } \
    if (IN(5) && !FUSE56) { LAUNDER \
        pg8::Gemm g{(const bf16_t*)(ws + WS_OAB), (const bf16_t*)(ws + WS_WBA), NTOK, 1024, (F8_BR || BR8) ? 256 : 512}; \
        pg8::StaticOrder S; S.init(NTOK, 1024, nblk, blk); \
        EpiGate<0> E{(const bf16_t*)(ws + WS_G0), (bf16_t*)(ws + WS_MERGED), (const unsigned*)(ws + WS_CTL) + CW_WMAX + 1, nullptr, nullptr}; \
        pg8::gemm_phase<EpiGate<0>, pg8::StaticOrder, true, true, F8_BR ? 1 : BR8 ? 2 : 0>(lds, g, S, E); \
    } \
    SEAM(5); \
    if (IN(6) && !FUSE56) { LAUNDER \
        pg8::Gemm g{(const bf16_t*)(ws + WS_OAB + (size_t)NTOK * 512 * ((F8_BR || BR8) ? 1 : 2)), (const bf16_t*)(ws + WS_WBB), NTOK, 1024, (F8_BR || BR8) ? 256 : 512}; \
        pg8::StaticOrder S; S.init(NTOK, 1024, nblk, blk); \
        EpiGate<1> E{(const bf16_t*)(ws + WS_G1), (bf16_t*)(ws + WS_MERGED), (const unsigned*)(ws + WS_CTL) + CW_WMAX + 2, ws + WS_MERGED8, (const float*)(ws + WS_OBS)}; \
        pg8::gemm_phase<EpiGate<1>, pg8::StaticOrder, true, true, F8_BR ? 1 : BR8 ? 2 : 0>(lds, g, S, E); \
    } \
    SEAM(6); \
    if (IN(7)) { LAUNDER \
        pg8::Gemm g{(const bf16_t*)(ws + ((F8_BR || F8_OUT) ? WS_MERGED8 : WS_MERGED)), (const bf16_t*)(ws + WS_WOUT), NTOK, 1024, (F8_BR || F8_OUT) ? 512 : 1024}; \
        pg8::StaticOrder S; S.init(NTOK, 1024, nblk, blk); \
        EpiResid E{a.x, mod, a.out, (F8_BR || F8_OUT) ? 1.f / (ASC8 * wscale8(ws, 3)) : 1.f}; \
        pg8::gemm_phase<EpiResid, pg8::StaticOrder, true, true, (F8_BR || F8_OUT) ? 1 : 0>(lds, g, S, E); \
    } \
    SEAM(7); \
    if (IN(8)) { LAUNDER ph_norm<true, PQ_MODE == 0, PQ_MODE == 1, UD8>(a.out, a.norm2_g, mod, 3072, 4096, (bf16_t*)(ws + WS_H), ws + WS_H, ws + WS_H8, (float*)(ws + WS_HS), lane, wave, blk, nblk, ws + WS_HA4, ws + WS_HB4); } \
    SEAM(8); \
    if (IN(9)) { LAUNDER \
        pg8::Gemm g{(const bf16_t*)(ws + (PQ_MODE == 2 ? WS_H8 : WS_H)), (const bf16_t*)(ws + WS_WPQ), NTOK, 2048, PQ_MODE ? 512 : 1024}; \
        pg8::StaticOrder S; S.init(NTOK, 2048, nblk, blk); \
        if (PQ_MODE == 2) { EpiPlainI8 E{(bf16_t*)(ws + WS_QP), 2048, (const float*)(ws + WS_HS), (const unsigned*)(ws + WS_CTL) + CW_WMAX + 4}; pg8::gemm_phase<EpiPlainI8, pg8::StaticOrder, true, true, 2>(lds, g, S, E); } \
        else { EpiPlain E{(bf16_t*)(ws + WS_QP), 2048, F8_PQ ? 1.f / (ASC8 * wscale8(ws, 4)) : 1.f}; pg8::gemm_phase<EpiPlain, pg8::StaticOrder, true, true, (PQ_MODE == 1 ? 1 : 0)>(lds, g, S, E); } \
    } \
    SEAM(9); \
    if (IN(10)) { LAUNDER ph_peer_route(a, lds, tid, lane, wave, blk, nblk); } \
    SEAM(10); \
    if (IN(11)) { LAUNDER if (MK_DUP == 111 || MK_DUP == 112) { if (MK_DUP == 111) ph_peer_slices<0, true>(a, lds, lane, wave, xbar.x); else ph_peer_slices<0, false>(a, lds, lane, wave, xbar.x); xcd_barrier(xbar); if (tid == 0 && blk == 0) { for (int q = 0; q < 8; ++q) ((unsigned*)(ws + WS_CTL))[8192 + 64 * q] = 0u; } xcd_barrier(xbar); } ph_peer_slices<0>(a, lds, lane, wave, xbar.x); xcd_barrier(xbar); if (MK_DUP == 110) { if (tid == 0 && blk == 0) { for (int q = 0; q < 8; ++q) ((unsigned*)(ws + WS_CTL))[8192 + 64 * q] = 0u; } xcd_barrier(xbar); ph_peer_slices<0>(a, lds, lane, wave, xbar.x); xcd_barrier(xbar); } ph_peer_combine(a, tid, blk, nblk); xcd_barrier(xbar); ph_peer_slices<2>(a, lds, lane, wave, xbar.x); }
__global__ void __launch_bounds__(512, 2) mk_fwd(KArgs a) {
    extern __shared__ __attribute__((aligned(16))) unsigned char lds_raw[];
    LAS unsigned char* lds = (LAS unsigned char*)lds_raw;
    const int tid0 = threadIdx.x, wave = __builtin_amdgcn_readfirstlane(tid0 >> 6);
    const int blk = blockIdx.x, nblk = gridDim.x;
    unsigned char* ws = a.ws;
    int lo = a.ph_lo, hi = a.ph_hi;
    volatile LAS unsigned* xst = (volatile LAS unsigned*)(lds + LDS_BYTES - 64);
    if (tid0 < 2) xst[tid0] = 0u;
    __syncthreads();
    XcdBarrier xbar = xcd_barrier_post((unsigned*)(ws + WS_CTL) + 4096, xst);
#ifndef MK_ONLY
#define MK_ONLY -1
#endif
#ifndef MK_MASK
#define MK_MASK 0xFFF
#endif
#define IN(k) ((MK_ONLY < 0 || MK_ONLY == (k)) && ((MK_MASK >> (k)) & 1) && lo <= (k) && (k) < hi)
#define LAUNDER int tid_l = tid0; asm volatile("" : "+v"(tid_l)); const int tid = tid_l, lane = tid_l & 63; (void)tid; (void)lane;
#define SEAM(k) do { if (IN(k) && IN((k) + 1) && !(FUSE56 && (k) == 5)) { if ((k) == 0) cg::this_grid().sync(); else xcd_barrier(xbar); } } while (0)
    const float* mod = (const float*)(ws + WS_MOD);
#if MK_PREFIX >= 0
    hi = MK_PREFIX + 1;
    PROGRAM()
    xcd_barrier(xbar);
    hi = a.ph_hi;
#endif
    PROGRAM()
#undef IN
#undef SEAM
}

extern "C" void kernel_launch(void* const* d_in, const int* in_sizes, int n_in, void* d_out, int out_size, void* d_ws, size_t ws_size, hipStream_t stream) {
    static int grid = 0;
    if (grid == 0) {
        if (n_in != 24 || in_sizes[0] != NTOK * DM || out_size != NTOK * DM || ws_size < WS_END) {
            fprintf(stderr, "kernel_launch: unexpected problem (n_in %d, in0 %d, out %d, ws %zu)\n", n_in, n_in > 0 ? in_sizes[0] : -1, out_size, ws_size); grid = -1; return; }
        int dev = 0, cus = 0, per_cu = 0;
        if (hipGetDevice(&dev) != hipSuccess || hipDeviceGetAttribute(&cus, hipDeviceAttributeMultiprocessorCount, dev) != hipSuccess) { grid = -1; return; }
        if (hipFuncSetAttribute((const void*)mk_fwd, hipFuncAttributeMaxDynamicSharedMemorySize, LDS_BYTES) != hipSuccess) { fprintf(stderr, "kernel_launch: hipFuncSetAttribute failed\n"); grid = -1; return; }
        if (hipOccupancyMaxActiveBlocksPerMultiprocessor(&per_cu, (const void*)mk_fwd, 512, LDS_BYTES) != hipSuccess || per_cu < 1) { fprintf(stderr, "kernel_launch: occupancy query says %d\n", per_cu); }
        (void)hipGetLastError();
        grid = cus;
    }
    if (grid < 0) return;
    if (hipMemsetAsync((char*)d_ws + WS_CTL, 0, 65536, stream) != hipSuccess) { fprintf(stderr, "kernel_launch: memset of the control words failed\n"); return; }
    KArgs a{};
    const float** fp = (const float**)&a;
    for (int i = 0; i < 24; ++i) fp[i] = (const float*)d_in[i];
    a.out = (float*)d_out; a.ws = (unsigned char*)d_ws;
#if MK_ONE_LAUNCH
    a.ph_lo = 0; a.ph_hi = N_PHASES;
    void* args[] = {&a};
    hipError_t e = hipLaunchCooperativeKernel((const void*)mk_fwd, dim3(grid), dim3(512), args, LDS_BYTES, stream);
    if (e != hipSuccess) fprintf(stderr, "kernel_launch: cooperative launch failed: %s (grid %d)\n", hipGetErrorString(e), grid);
#else
    for (int p = 0; p < N_PHASES; ++p) {
        a.ph_lo = p; a.ph_hi = p + 1;
        hipLaunchKernelGGL(mk_fwd, dim3(grid), dim3(512), LDS_BYTES, stream, a);
    }
#endif
}
```

```cpp
#include <hip/hip_runtime.h>
#include <hip/hip_cooperative_groups.h>
#include <cstdio>
#include <cstdint>
namespace cg = cooperative_groups;

#define LAS __attribute__((address_space(3)))
#define DI __device__ __forceinline__
typedef unsigned short bf16_t;
typedef short bf16x8 __attribute__((ext_vector_type(8)));
typedef short s16x4 __attribute__((ext_vector_type(4)));
typedef float f32x2 __attribute__((ext_vector_type(2)));
typedef float f32x4 __attribute__((ext_vector_type(4)));
typedef float f32x16 __attribute__((ext_vector_type(16)));
typedef unsigned u32x2 __attribute__((ext_vector_type(2)));
typedef unsigned u32x4 __attribute__((ext_vector_type(4)));
typedef __bf16 bf16x2_t __attribute__((ext_vector_type(2)));
typedef int i32x8 __attribute__((ext_vector_type(8)));

constexpr int NB = 32, NT = 2048, DM = 1024, NTOK = NB * NT;
constexpr int NPROJ = 4864;
constexpr int WIN_COLS = 4808;
constexpr float EPS = 1e-6f;
constexpr float QSCALE = 0.125f * 1.4426950408889634f;
constexpr float USCALE = 64.f, VSCALE = 4.f;
constexpr float LAMBDA_INIT = 0.2f;
constexpr int PQ_MODE = 2;
constexpr bool F8_PQ = (PQ_MODE == 1);
constexpr bool F8_BR = false;
constexpr bool U4 = true;
constexpr float U4_STEP = 0.0657f;
constexpr bool UD8 = true;
constexpr bool V4 = true;
constexpr float V4_S = 0.098f;
constexpr float V4_WSC = 64.f;
typedef _Float16 h16x2 __attribute__((ext_vector_type(2)));
typedef _Float16 h16x4 __attribute__((ext_vector_type(4)));
typedef _Float16 h16x8 __attribute__((ext_vector_type(8)));
constexpr bool BR8 = false;
constexpr float OA_MAX = 5.0f;
constexpr bool F8_OUT = true;
constexpr bool FUSE56 = true;
constexpr bool G8 = true;
constexpr int IN_MODE = 2;
constexpr unsigned IN8_MASK = 0x7FFFFu;
constexpr int N8_IN = __builtin_popcount(IN8_MASK), NB_IN = 19 - N8_IN;

constexpr size_t MiB = 1u << 20;
constexpr size_t WS_CTL = 0;
constexpr size_t WS_MOD = 1 * MiB;
constexpr size_t WS_COS = 2 * MiB;
constexpr size_t WS_SIN = 10 * MiB;
constexpr size_t WS_WIN = 18 * MiB;
constexpr size_t WS_WBA = 28 * MiB;
constexpr size_t WS_WBB = 29 * MiB;
constexpr size_t WS_WOUT = 30 * MiB;
constexpr size_t WS_WPQ = 32 * MiB;
constexpr size_t WS_SKB = 36 * MiB;
constexpr size_t WS_UB = 40 * MiB;
constexpr size_t WS_VB = 72 * MiB;
constexpr size_t WS_H = 104 * MiB;
constexpr size_t WS_QD = 232 * MiB;
constexpr size_t WS_KD = 296 * MiB;
constexpr size_t WS_VD = 360 * MiB;
constexpr size_t WS_QS = 424 * MiB;
constexpr size_t WS_QI = 488 * MiB;
constexpr size_t WS_KS = 552 * MiB;
constexpr size_t WS_VS = 560 * MiB;
constexpr size_t WS_KI = 568 * MiB;
constexpr size_t WS_WIDX = 576 * MiB;
constexpr size_t WS_G0 = 578 * MiB;
constexpr size_t WS_G1 = 706 * MiB;
constexpr size_t WS_BM = 834 * MiB;
constexpr size_t WS_OAB = 850 * MiB;
constexpr size_t WS_END = 978 * MiB;
constexpr size_t WS_MERGED = WS_QD;
constexpr size_t WS_QP = WS_VD;
constexpr size_t WS_EIDX = 616 * MiB;
constexpr size_t WS_GW = 648 * MiB;
constexpr size_t WS_PART = WS_QP;
constexpr size_t WS_WGT = WS_MERGED;
constexpr size_t WS_WIN8 = WS_WIN + (size_t)NB_IN * 256 * 1024 * 2;
constexpr size_t WS_HF8 = WS_OAB;
constexpr size_t WS_HS1 = WS_OAB + 64 * MiB;
constexpr size_t WS_HA4 = WS_H;
constexpr size_t WS_HB4 = WS_H + 32 * MiB;
constexpr size_t WS_OBS = WS_OAB + 96 * MiB;
constexpr size_t WS_MERGED8 = WS_VD;
constexpr size_t WS_H8 = 264 * MiB;
constexpr size_t WS_HS = 328 * MiB;
constexpr int CW_UMAX = 12288;
constexpr int CW_VMAX = 12289;
constexpr int CW_WMAX = 12296;
constexpr float ASC8 = 16.f, WTOP8 = 224.f;
static_assert(WS_QP + (size_t)NTOK * 2048 * 2 <= WS_EIDX, "ws map");
static_assert(WS_GW + (size_t)NTOK * 128 * 4 <= WS_BM, "ws map");

constexpr int LDS_BYTES = 163840;

DI unsigned f2bf(float f) { unsigned u = __builtin_bit_cast(unsigned, f); return (u + 0x7fffu + ((u >> 16) & 1u)) >> 16; }
DI unsigned pk2(float lo, float hi) { f32x2 v = {lo, hi}; bf16x2_t b = __builtin_convertvector(v, bf16x2_t); return __builtin_bit_cast(unsigned, b); }
DI float bflo(unsigned p) { return __builtin_bit_cast(float, p << 16); }
DI float bfhi(unsigned p) { return __builtin_bit_cast(float, p & 0xffff0000u); }
DI float wave_sum(float v) {
#pragma unroll
    for (int o = 1; o < 64; o <<= 1) v += __shfl_xor(v, o);
    return v;
}
DI float fexp2(float x) { return __builtin_amdgcn_exp2f(x); }
DI int rank_in(unsigned mask, int pn) { return __builtin_popcount(mask & ((1u << pn) - 1u)); }
DI int kth_in(unsigned mask, int k) { int pn = 0; for (int i = 0; i < 19; ++i) { if ((mask >> i) & 1u) { if (k == 0) pn = i; --k; } } return pn; }
DI unsigned pack_fp8x4(float a, float b, float c, float d) {
    a = __builtin_amdgcn_fmed3f(a, -448.f, 448.f); b = __builtin_amdgcn_fmed3f(b, -448.f, 448.f); c = __builtin_amdgcn_fmed3f(c, -448.f, 448.f); d = __builtin_amdgcn_fmed3f(d, -448.f, 448.f);
    int w = 0; w = __builtin_amdgcn_cvt_pk_fp8_f32(a, b, w, false); w = __builtin_amdgcn_cvt_pk_fp8_f32(c, d, w, true); return (unsigned)w;
}

struct KArgs {
    const float* x; const float* c; const int* pos; const float* w_ada; const float* b_ada; const float* norm1_g; const float* w_in;
    const float* diff_q_g; const float* diff_k_g; const float* lq1; const float* lk1; const float* lq2; const float* lk2; const float* diff_out_g;
    const float* dsa_q_g; const float* dsa_k_g; const float* w_ba; const float* w_bb; const float* w_out; const float* norm2_g;
    const float* peer_wq; const float* sub_keys; const float* peer_u; const float* peer_v;
    float* out; unsigned char* ws; int ph_lo, ph_hi;
};
namespace pg8 {
#define PG8_LAS __attribute__((address_space(3)))
typedef unsigned short bf16_t;
typedef short bf16x8 __attribute__((ext_vector_type(8)));
typedef float f32x4 __attribute__((ext_vector_type(4)));
typedef unsigned u32x4 __attribute__((ext_vector_type(4)));
typedef int i32x8_t __attribute__((ext_vector_type(8)));
constexpr int BM = 256, BK = 64, HALF = 128, HTB = HALF * BK * 2  , STAGE_BYTES = 8 * HTB, NXCD = 8, WGM = 8;

__host__ __device__ __forceinline__ int lds_byte(int r, int c) { const int st = (r >> 4) * 2 + (c >> 5), rr = r & 15, cc = c & 31, ob = rr * 64 + cc * 2; return st * 1024 + (ob ^ (((ob >> 9) & 1) << 5)); }
__host__ __device__ __forceinline__ void stage_rc(int b, int& R, int& C) { const int st = b / 1024, sb = b % 1024, swz = sb ^ (((sb >> 9) & 1) << 5); R = (st >> 1) * 16 + swz / 64; C = (st & 1) * 32 + (swz % 64) / 2; }
__host__ __device__ __forceinline__ int perm32(int rho) { const int n = rho >> 4, i = rho & 15; return 8 * (i >> 2) + 4 * n + (i & 3); }

struct Unit { int pm, pn; };
struct Gemm { const bf16_t* A; const bf16_t* Bt; int M, N, K; };

struct StaticOrder {
    int nM, nN, nwg, G, c;
    __host__ __device__ void init(int M, int N, int G_, int c_) { nM = M / BM; nN = N / BM; nwg = nM * nN; G = G_; c = c_; }
    __host__ __device__ bool next(int i, Unit& u) const {
        const long L = (long)i * G + c; if (L >= nwg) return false;
        int wgid = (int)L; { const int q = nwg / NXCD, r = nwg % NXCD, xcd = wgid % NXCD, off = wgid / NXCD; wgid = (xcd < r ? xcd * (q + 1) : r * (q + 1) + (xcd - r) * q) + off; }
        const int nig = WGM * nN, gid = wgid / nig, fm = gid * WGM, gsz = (nM - fm) < WGM ? (nM - fm) : WGM;
        u.pm = fm + ((wgid % nig) % gsz); u.pn = (wgid % nig) / gsz; return true;
    }
    __device__ __forceinline__ void a_ready(const Unit&) const {}
    __device__ __forceinline__ void done(const Unit&) const {}
};

__device__ __forceinline__ unsigned cvt_pk_bf16(float lo, float hi) { unsigned r; asm volatile("v_cvt_pk_bf16_f32 %0, %1, %2" : "=v"(r) : "v"(lo), "v"(hi)); return r; }
template <class Epi, class Sched, bool ALIGN_EPI = false, bool SP2 = false, int QM = 0>
__device__ __forceinline__ void gemm_phase(PG8_LAS unsigned char* lds, const Gemm g, const Sched& S, const Epi& E) {
    constexpr bool F8 = (QM == 1);
    typedef int i32x4_t __attribute__((ext_vector_type(4)));
    const int tid = threadIdx.x, wid = __builtin_amdgcn_readfirstlane(tid >> 6), lane = tid & 63, wr = wid >> 2, wc = wid & 3, fr = lane & 15, fq = lane >> 4;
    const int K = g.K, nt = K / BK;
    unsigned voffA[2], voffB[2];
#pragma unroll
    for (int i = 0; i < 2; ++i) { int R, C; stage_rc(tid * 16 + i * 8192, R, C); const int Rb = Epi::PERM ? ((R & ~31) + perm32(R & 31)) : R;
        voffA[i] = (unsigned)(R * K + C) * 2u; voffB[i] = (unsigned)(Rb * K + C) * 2u; }
    const size_t kstep = (size_t)(BK * 2);
    const size_t hstep = (size_t)HALF * K * 2;
    const size_t tstep = 2 * hstep;
    const unsigned ldsw = (unsigned)wid * 1024u;
    const int aoff = lds_byte(wr * 64 + fr, fq * 8), boff = lds_byte(wc * 32 + fr, fq * 8);
#define PG8_SA(b, h) (((b) * 2 + (h)) * HTB)
#define PG8_SB(b, h) ((4 + (b) * 2 + (h)) * HTB)
#define PG8_STAGE(bufoff, gbase, voff) do { _Pragma("unroll") for (int _i = 0; _i < 2; ++_i) \
        __builtin_amdgcn_global_load_lds((const unsigned*)((const char*)(gbase) + (voff)[_i]), (PG8_LAS unsigned*)(lds + (bufoff) + ldsw + _i * 8192), 16, 0, 0); } while (0)
#define PG8_CAT2(x0, x1) __builtin_bit_cast(i32x8_t, __builtin_shufflevector((x0), (x1), 0, 1, 2, 3, 4, 5, 6, 7, 8, 9, 10, 11, 12, 13, 14, 15))
#define PG8_LDA(dst, b, h) do { _Pragma("unroll") for (int m = 0; m < 4; ++m) { const bf16x8 f0_ = *(const PG8_LAS bf16x8*)(lds + PG8_SA(b, h) + aoff + m * 2048), f1_ = *(const PG8_LAS bf16x8*)(lds + PG8_SA(b, h) + aoff + m * 2048 + 1024); \
        if constexpr (F8) dst##8[m] = PG8_CAT2(f0_, f1_); else { dst[m][0] = f0_; dst[m][1] = f1_; } } } while (0)
#define PG8_LDB(dst, b, h) do { _Pragma("unroll") for (int n = 0; n < 2; ++n) { const bf16x8 f0_ = *(const PG8_LAS bf16x8*)(lds + PG8_SB(b, h) + boff + n * 2048), f1_ = *(const PG8_LAS bf16x8*)(lds + PG8_SB(b, h) + boff + n * 2048 + 1024); \
        if constexpr (F8) dst##8[n] = PG8_CAT2(f0_, f1_); else { dst[n][0] = f0_; dst[n][1] = f1_; } } } while (0)
#define PG8_MMA(ai, bj, At, Bt) do { __builtin_amdgcn_s_setprio(1); _Pragma("unroll") for (int m = 0; m < 4; ++m) _Pragma("unroll") for (int n = 0; n < 2; ++n) { \
        if constexpr (F8) asm volatile("v_mfma_f32_16x16x128_f8f6f4 %0, %1, %2, %0" : "+v"(acc[ai][bj][m][n]) : "v"(Bt##8[n]), "v"(At##8[m])); \
        else if constexpr (QM == 2) { _Pragma("unroll") for (int k = 0; k < 2; ++k) acc[ai][bj][m][n] = __builtin_bit_cast(f32x4, __builtin_amdgcn_mfma_i32_16x16x64_i8(__builtin_bit_cast(i32x4_t, Bt[n][k]), __builtin_bit_cast(i32x4_t, At[m][k]), __builtin_bit_cast(i32x4_t, acc[ai][bj][m][n]), 0, 0, 0)); } \
        else { _Pragma("unroll") for (int k = 0; k < 2; ++k) acc[ai][bj][m][n] = __builtin_amdgcn_mfma_f32_16x16x32_bf16(Bt[n][k], At[m][k], acc[ai][bj][m][n], 0, 0, 0); } } __builtin_amdgcn_s_setprio(0); } while (0)
#define PG8_WAIT_V(n) asm volatile("s_waitcnt vmcnt(" #n ")" ::: "memory")
#define PG8_WAIT_L(n) asm volatile("s_waitcnt lgkmcnt(" #n ")" ::: "memory")
#define PG8_BAR __builtin_amdgcn_s_barrier()
#define PG8_SCHED __builtin_amdgcn_sched_barrier(0)
    Unit cur, nxt; int ui = 0;
    if (!S.next(0, cur)) return;
    f32x4 acc[2][2][4][2];
#pragma unroll
    for (int a = 0; a < 2; ++a)
#pragma unroll
        for (int b = 0; b < 2; ++b)
#pragma unroll
            for (int m = 0; m < 4; ++m)
#pragma unroll
                for (int n = 0; n < 2; ++n) acc[a][b][m][n] = (f32x4){0.f, 0.f, 0.f, 0.f};
    bf16x8 At[4][2], B0[2][2], B1[2][2]; i32x8_t At8[4], B08[2], B18[2];
    const char* cA = (const char*)g.A + (size_t)cur.pm * tstep; const char* cB = (const char*)g.Bt + (size_t)cur.pn * tstep;
    S.a_ready(cur);
    if constexpr (SP2) {
        PG8_STAGE(PG8_SB(0, 0), cB, voffB); PG8_STAGE(PG8_SB(0, 1), cB + hstep, voffB); PG8_STAGE(PG8_SA(0, 0), cA, voffA); PG8_STAGE(PG8_SA(0, 1), cA + hstep, voffA);
        if (wr == 1) PG8_BAR;
        PG8_WAIT_V(2); PG8_BAR;
        PG8_STAGE(PG8_SB(1, 0), cB + kstep, voffB); PG8_STAGE(PG8_SA(1, 0), cA + kstep, voffA); PG8_STAGE(PG8_SB(1, 1), cB + hstep + kstep, voffB);
        PG8_WAIT_V(6); PG8_BAR;
    } else {
        PG8_STAGE(PG8_SB(0, 0), cB, voffB); PG8_STAGE(PG8_SA(0, 0), cA, voffA); PG8_STAGE(PG8_SB(0, 1), cB + hstep, voffB); PG8_STAGE(PG8_SA(0, 1), cA + hstep, voffA);
        if (wr == 1) PG8_BAR;
        PG8_WAIT_V(4); PG8_BAR;
        PG8_STAGE(PG8_SB(1, 0), cB + kstep, voffB); PG8_STAGE(PG8_SA(1, 0), cA + kstep, voffA); PG8_STAGE(PG8_SB(1, 1), cB + hstep + kstep, voffB);
        PG8_WAIT_V(6); PG8_BAR;
    }
    for (;;) {
        const bool has_next = S.next(ui + 1, nxt);
        const char* nA = has_next ? (const char*)g.A + (size_t)nxt.pm * tstep : cA; const char* nB = has_next ? (const char*)g.Bt + (size_t)nxt.pn * tstep : cB;
#pragma unroll 1
        for (int t = 0; t < nt; t += 2) {
            if constexpr (Epi::MID) { if (t == nt / 2) E.mid(acc, cur, wr, wc, fr, fq); }
            const bool last = (t == nt - 2);
            const char* a1 = cA + (size_t)(t + 1) * kstep;
            const char* a2 = last ? nA : cA + (size_t)(t + 2) * kstep; const char* b2 = last ? nB : cB + (size_t)(t + 2) * kstep;
            const char* a3 = a2 + kstep; const char* b3 = b2 + kstep;
            if (last && has_next) S.a_ready(nxt);
            if constexpr (SP2) {
            PG8_LDB(B0, 0, 0); PG8_LDB(B1, 0, 1); PG8_SCHED; PG8_LDA(At, 0, 0); PG8_STAGE(PG8_SA(1, 1), a1 + hstep, voffA);
            PG8_WAIT_V(8); PG8_WAIT_L(0); PG8_BAR; PG8_MMA(0, 0, At, B0); PG8_MMA(0, 1, At, B1); PG8_BAR; PG8_SCHED;
            PG8_LDA(At, 0, 1); PG8_STAGE(PG8_SB(0, 0), b2, voffB); PG8_STAGE(PG8_SB(0, 1), b2 + hstep, voffB); PG8_STAGE(PG8_SA(0, 0), a2, voffA);
            PG8_WAIT_V(8); PG8_WAIT_L(0); PG8_BAR; PG8_MMA(1, 0, At, B0); PG8_MMA(1, 1, At, B1); PG8_BAR; PG8_SCHED;
            PG8_LDB(B0, 1, 0); PG8_LDB(B1, 1, 1); PG8_SCHED; PG8_LDA(At, 1, 0); PG8_STAGE(PG8_SA(0, 1), a2 + hstep, voffA);
            PG8_WAIT_V(8); PG8_WAIT_L(0); PG8_BAR; PG8_MMA(0, 0, At, B0); PG8_MMA(0, 1, At, B1); PG8_BAR; PG8_SCHED;
            PG8_LDA(At, 1, 1); PG8_STAGE(PG8_SB(1, 0), b3, voffB); PG8_STAGE(PG8_SB(1, 1), b3 + hstep, voffB); PG8_STAGE(PG8_SA(1, 0), a3, voffA);
            PG8_WAIT_V(8); PG8_WAIT_L(0); PG8_BAR; PG8_MMA(1, 0, At, B0); PG8_MMA(1, 1, At, B1); PG8_BAR; PG8_SCHED;
            } else {
            PG8_LDB(B0, 0, 0); PG8_SCHED; PG8_LDA(At, 0, 0); PG8_STAGE(PG8_SA(1, 1), a1 + hstep, voffA);
            PG8_WAIT_L(8); PG8_BAR; PG8_WAIT_L(0); PG8_MMA(0, 0, At, B0); PG8_BAR; PG8_SCHED;
            PG8_LDB(B1, 0, 1); PG8_STAGE(PG8_SB(0, 0), b2, voffB);
            PG8_BAR; PG8_WAIT_L(0); PG8_MMA(0, 1, At, B1); PG8_BAR;
            PG8_LDA(At, 0, 1); PG8_STAGE(PG8_SA(0, 0), a2, voffA);
            PG8_BAR; PG8_WAIT_L(0); PG8_MMA(1, 0, At, B0); PG8_BAR; PG8_SCHED;
            PG8_STAGE(PG8_SB(0, 1), b2 + hstep, voffB);
            PG8_WAIT_V(6); PG8_BAR; PG8_MMA(1, 1, At, B1); PG8_BAR;
            PG8_LDB(B0, 1, 0); PG8_SCHED; PG8_LDA(At, 1, 0); PG8_STAGE(PG8_SA(0, 1), a2 + hstep, voffA);
            PG8_WAIT_L(8); PG8_BAR; PG8_WAIT_L(0); PG8_MMA(0, 0, At, B0); PG8_BAR; PG8_SCHED;
            PG8_LDB(B1, 1, 1); PG8_STAGE(PG8_SB(1, 0), b3, voffB);
            PG8_BAR; PG8_WAIT_L(0); PG8_MMA(0, 1, At, B1); PG8_BAR;
            PG8_LDA(At, 1, 1); PG8_STAGE(PG8_SA(1, 0), a3, voffA);
            PG8_BAR; PG8_WAIT_L(0); PG8_MMA(1, 0, At, B0); PG8_BAR; PG8_SCHED;
            PG8_STAGE(PG8_SB(1, 1), b3 + hstep, voffB);
            PG8_WAIT_V(6); PG8_BAR; PG8_MMA(1, 1, At, B1); PG8_BAR;
            }
        }
        if constexpr (ALIGN_EPI) { if (wr == 0) PG8_BAR; }
        if constexpr (F8) asm volatile("s_nop 15\n\ts_nop 15\n\ts_nop 15");
        if constexpr (!Epi::AFTER_DRAIN) { E(acc, cur, wr, wc, fr, fq); S.done(cur); }
        if (!has_next) break;
#pragma unroll
        for (int a = 0; a < 2; ++a)
#pragma unroll
            for (int b = 0; b < 2; ++b)
#pragma unroll
                for (int m = 0; m < 4; ++m)
#pragma unroll
                    for (int n = 0; n < 2; ++n) acc[a][b][m][n] = (f32x4){0.f, 0.f, 0.f, 0.f};
        cur = nxt; cA = nA; cB = nB; ++ui;
        if constexpr (ALIGN_EPI) { if (wr == 1) PG8_BAR; }
    }
    PG8_WAIT_V(0);
    if constexpr (!ALIGN_EPI) { if (wr == 0) PG8_BAR; }
    PG8_BAR;
    if constexpr (Epi::AFTER_DRAIN) { E.fused(acc, cur, wr, wc, fr, fq, lds, wid, lane); S.done(cur); }
#undef PG8_SA
#undef PG8_SB
#undef PG8_STAGE
#undef PG8_LDA
#undef PG8_LDB
#undef PG8_MMA
#undef PG8_CAT2
#undef PG8_WAIT_V
#undef PG8_WAIT_L
#undef PG8_BAR
#undef PG8_SCHED
}
}
DI int proj_group_base(int g) {
    if (g < 8) return 64 * g;
    if (g < 16) return 512 + 64 * (g - 8);
    if (g < 24) return 1024 + 64 * (g - 16);
    if (g < 32) return 1536 + 64 * (g - 24);
    if (g < 40) return 2176 + 64 * (g - 32);
    if (g == 40) return 2048;
    if (g == 41) return 2112;
    if (g == 42) return 2688;
    if (g == 43) return 2752;
    if (g < 60) return 2760 + 64 * (g - 44);
    return 3784 + 64 * (g - 60);
}

template <int QM> struct EpiProjT {
    static constexpr bool PERM = true, AFTER_DRAIN = false, MID = false;
    bf16_t *Qd, *Kd, *Vd, *Qs, *Qi, *Ks, *Vs, *Ki, *G0, *G1; float* Widx;
    const float *cosT, *sinT;
    const float *gq, *gk, *gsq, *gsk;
    const unsigned* wm;
    const float* rs;
    __device__ __forceinline__ void operator()(const pg8::f32x4 (&acc)[2][2][4][2], const pg8::Unit& u, int wr, int wc, int fr, int fq) const {
        const int g = kth_in(QM ? IN8_MASK : (~IN8_MASK & 0x7FFFFu), u.pn) * 4 + wc;
        const float asc = QM == 1 ? __builtin_bit_cast(float, *wm) * (1.f / (ASC8 * WTOP8)) : QM == 2 ? __builtin_bit_cast(float, *wm) * (1.f / 127.f) : 1.f;
        int kind; bf16_t* dst = nullptr; int ld = 512, col = 0; const float* gn = nullptr; float scale = 1.f;
        if (g < 8) { kind = 1; dst = Qd; col = 64 * g; gn = gq; scale = QSCALE; }
        else if (g < 16) { kind = 1; dst = Kd; col = 64 * (g - 8); gn = gk; }
        else if (g < 24) { kind = 0; dst = Vd; col = 64 * (g - 16); }
        else if (g < 32) { kind = 1; dst = Qs; col = 64 * (g - 24); gn = gsq; scale = QSCALE; }
        else if (g < 40) { kind = 2; dst = Qi; col = 64 * (g - 32); }
        else if (g == 40) { kind = 1; dst = Ks; ld = 64; gn = gsk; }
        else if (g == 41) { kind = 0; dst = Vs; ld = 64; }
        else if (g == 42) { kind = 2; dst = Ki; ld = 64; }
        else if (g == 43) { kind = 4; }
        else if (g < 60) { kind = 3; dst = G0; ld = 1024; col = 64 * (g - 44); }
        else { kind = 3; dst = G1; ld = 1024; col = 64 * (g - 60); }
        float gv[16];
#pragma unroll
        for (int i = 0; i < 16; ++i) gv[i] = 1.f;
        if (kind == 1) {
#pragma unroll
            for (int i = 0; i < 8; ++i) { gv[i] = gn[8 * fq + i]; gv[8 + i] = gn[32 + 8 * fq + i]; }
        }
        float rsv[8];
#pragma unroll
        for (int i = 0; i < 8; ++i) rsv[i] = (QM == 2) ? rs[u.pm * 256 + (i >> 2) * 128 + wr * 64 + (i & 3) * 16 + fr] : 1.f;
        f32x4 tcs[2][4];
        const bool roped = (kind == 1 || kind == 2);
#define EPI_LDTAB(i_) do { const size_t r_ = (size_t)(u.pm * 256 + ((i_) >> 2) * 128 + wr * 64 + ((i_) & 3) * 16 + fr) * 32 + 8 * fq; \
            tcs[(i_) & 1][0] = *(const f32x4*)(cosT + r_); tcs[(i_) & 1][1] = *(const f32x4*)(cosT + r_ + 4); tcs[(i_) & 1][2] = *(const f32x4*)(sinT + r_); tcs[(i_) & 1][3] = *(const f32x4*)(sinT + r_ + 4); } while (0)
        if (roped) EPI_LDTAB(0);
#pragma unroll
        for (int ai = 0; ai < 2; ++ai)
#pragma unroll
            for (int m = 0; m < 4; ++m) {
                const int row = u.pm * 256 + ai * 128 + wr * 64 + m * 16 + fr;
                if (roped && ai * 4 + m + 1 < 8) EPI_LDTAB(ai * 4 + m + 1);
                float v[16];
#pragma unroll
                for (int i = 0; i < 8; ++i) { v[i] = acc[ai][0][m][i >> 2][i & 3]; v[8 + i] = acc[ai][1][m][i >> 2][i & 3]; if (QM == 1) { v[i] *= asc; v[8 + i] *= asc; } }
                if (QM == 2) {
                    const float rsc = rsv[ai * 4 + m] * asc;
#pragma unroll
                    for (int i = 0; i < 16; ++i) v[i] = (float)__builtin_bit_cast(int, v[i]) * rsc;
                }
                if (kind == 1) {
                    float ss = 0.f;
#pragma unroll
                    for (int i = 0; i < 16; ++i) ss += v[i] * v[i];
                    ss += __shfl_xor(ss, 16); ss += __shfl_xor(ss, 32);
                    const float rn = __builtin_amdgcn_rsqf(ss * (1.f / 64.f) + EPS);
#pragma unroll
                    for (int i = 0; i < 16; ++i) v[i] = v[i] * rn * gv[i];
                }
                if (kind == 1 || kind == 2) {
                    const f32x4 c0 = tcs[(ai * 4 + m) & 1][0], c1 = tcs[(ai * 4 + m) & 1][1], s0 = tcs[(ai * 4 + m) & 1][2], s1 = tcs[(ai * 4 + m) & 1][3];
#pragma unroll
                    for (int i = 0; i < 8; ++i) {
                        const float cc = (i < 4) ? c0[i & 3] : c1[i & 3], sn = (i < 4) ? s0[i & 3] : s1[i & 3];
                        const float x1 = v[i], x2 = v[8 + i];
                        v[i] = (x1 * cc - x2 * sn) * scale; v[8 + i] = (x2 * cc + x1 * sn) * scale;
                    }
                }
                if (kind == 3) {
#pragma unroll
                    for (int i = 0; i < 16; ++i) v[i] = G8 ? __builtin_amdgcn_rcpf(__builtin_fmaf(__builtin_amdgcn_exp2f(v[i] * -1.4426950408889634f), 1.f / 255.f, 1.f / 255.f))
                                                           : __builtin_amdgcn_rcpf(1.f + __builtin_amdgcn_exp2f(v[i] * -1.4426950408889634f));
                }
                if (kind == 4) {
                    if (fq == 0) {
                        *(f32x4*)(Widx + (size_t)row * 8) = (f32x4){v[0], v[1], v[2], v[3]};
                        *(f32x4*)(Widx + (size_t)row * 8 + 4) = (f32x4){v[4], v[5], v[6], v[7]};
                    }
                } else if (kind == 3 && G8) {
                    unsigned b[4] = {0u, 0u, 0u, 0u};
#pragma unroll
                    for (int i = 0; i < 16; ++i) b[i >> 2] = __builtin_amdgcn_cvt_pk_u8_f32(__builtin_rintf(v[i]), i & 3, b[i >> 2]);
                    unsigned char* p = (unsigned char*)dst + (size_t)row * ld + col + 8 * fq;
                    *(u32x2*)p = (u32x2){b[0], b[1]}; *(u32x2*)(p + 32) = (u32x2){b[2], b[3]};
                } else {
                    u32x4 w0, w1;
                    w0.x = pk2(v[0], v[1]); w0.y = pk2(v[2], v[3]); w0.z = pk2(v[4], v[5]); w0.w = pk2(v[6], v[7]);
                    w1.x = pk2(v[8], v[9]); w1.y = pk2(v[10], v[11]); w1.z = pk2(v[12], v[13]); w1.w = pk2(v[14], v[15]);
                    bf16_t* p = dst + (size_t)row * ld + col + 8 * fq;
                    *(u32x4*)p = w0; *(u32x4*)(p + 32) = w1;
                }
                asm volatile("" ::: "memory");
            }
#undef EPI_LDTAB
    }
};

template <int MODE> struct EpiGate {
    static constexpr bool PERM = true, AFTER_DRAIN = false, MID = false;
    const bf16_t* G; bf16_t* O; const unsigned* wm; unsigned char* O8; const float* rs;
    __device__ __forceinline__ void operator()(const pg8::f32x4 (&acc)[2][2][4][2], const pg8::Unit& u, int wr, int wc, int fr, int fq) const {
        const int row0 = u.pm * 256 + wr * 64 + fr, col0 = u.pn * 256 + wc * 32 + 8 * fq;
        const float sc = F8_BR ? __builtin_bit_cast(float, *wm) * (1.f / (ASC8 * WTOP8)) : 1.f;
#pragma unroll
        for (int ai = 0; ai < 2; ++ai)
#pragma unroll
            for (int m = 0; m < 4; ++m)
#pragma unroll
                for (int bj = 0; bj < 2; ++bj) {
                    const size_t off = (size_t)(row0 + ai * 128 + m * 16) * 1024 + col0 + bj * 128;
                    float r[8];
                    pg8::f32x4 c0 = acc[ai][bj][m][0], c1 = acc[ai][bj][m][1];
                    float scr = sc;
                    if (BR8 && !F8_BR) {
                        typedef int i32x4 __attribute__((ext_vector_type(4)));
                        const i32x4 i0 = __builtin_bit_cast(i32x4, c0), i1 = __builtin_bit_cast(i32x4, c1);
                        c0 = (pg8::f32x4){(float)i0[0], (float)i0[1], (float)i0[2], (float)i0[3]}; c1 = (pg8::f32x4){(float)i1[0], (float)i1[1], (float)i1[2], (float)i1[3]};
                        scr = (rs ? rs[row0 + ai * 128 + m * 16] : OA_MAX * (1.f / 127.f)) * (__builtin_bit_cast(float, *wm) * (1.f / 127.f));
                    }
                    if (G8) {
                        const u32x2 gb = *(const u32x2*)((const unsigned char*)G + off);
                        const pg8::f32x4 a0 = c0 * (scr * (1.f / 255.f)), a1 = c1 * (scr * (1.f / 255.f));
                        r[0] = (float)(gb.x & 255u) * a0[0]; r[1] = (float)((gb.x >> 8) & 255u) * a0[1]; r[2] = (float)((gb.x >> 16) & 255u) * a0[2]; r[3] = (float)(gb.x >> 24) * a0[3];
                        r[4] = (float)(gb.y & 255u) * a1[0]; r[5] = (float)((gb.y >> 8) & 255u) * a1[1]; r[6] = (float)((gb.y >> 16) & 255u) * a1[2]; r[7] = (float)(gb.y >> 24) * a1[3];
                    } else {
                    const u32x4 gw = *(const u32x4*)(G + off);
                    const pg8::f32x4 a0 = c0 * scr, a1 = c1 * scr;
                    r[0] = bflo(gw.x) * a0[0]; r[1] = bfhi(gw.x) * a0[1]; r[2] = bflo(gw.y) * a0[2]; r[3] = bfhi(gw.y) * a0[3];
                    r[4] = bflo(gw.z) * a1[0]; r[5] = bfhi(gw.z) * a1[1]; r[6] = bflo(gw.w) * a1[2]; r[7] = bfhi(gw.w) * a1[3];
                    }
                    if (MODE == 1) {
                        const u32x4 ow = *(const u32x4*)(O + off);
                        r[0] += bflo(ow.x); r[1] += bfhi(ow.x); r[2] += bflo(ow.y); r[3] += bfhi(ow.y);
                        r[4] += bflo(ow.z); r[5] += bfhi(ow.z); r[6] += bflo(ow.w); r[7] += bfhi(ow.w);
                    }
                    if (MODE == 1 && F8_BR) {
                        u32x2 w8; w8.x = pack_fp8x4(r[0] * ASC8, r[1] * ASC8, r[2] * ASC8, r[3] * ASC8); w8.y = pack_fp8x4(r[4] * ASC8, r[5] * ASC8, r[6] * ASC8, r[7] * ASC8);
                        *(u32x2*)(O8 + off) = w8;
                    } else {
                        u32x4 w; w.x = pk2(r[0], r[1]); w.y = pk2(r[2], r[3]); w.z = pk2(r[4], r[5]); w.w = pk2(r[6], r[7]);
                        *(u32x4*)(O + off) = w;
                    }
                }
    }
};

struct EpiMerged {
    static constexpr bool PERM = true, AFTER_DRAIN = false, MID = true;
    const unsigned char* G0; const unsigned char* G1; bf16_t* O; unsigned char* O8;
    __device__ __forceinline__ void mid(pg8::f32x4 (&acc)[2][2][4][2], const pg8::Unit& u, int wr, int wc, int fr, int fq) const {
        int frl = fr; asm volatile("" : "+v"(frl));
        const int row0 = u.pm * 256 + wr * 64 + frl, col0 = u.pn * 256 + wc * 32 + 8 * fq;
        u32x2 gq[2][2];
#define EPI_LDG(i_) do { const unsigned o_ = (unsigned)(row0 + ((i_) >> 3) * 128 + (((i_) >> 1) & 3) * 16) * 1024u + (unsigned)(col0 + ((i_) & 1) * 128); \
            gq[(i_) & 1][0] = *(const u32x2*)(G0 + o_); gq[(i_) & 1][1] = *(const u32x2*)(G1 + o_); } while (0)
        EPI_LDG(0);
#pragma unroll
        for (int ai = 0; ai < 2; ++ai)
#pragma unroll
            for (int m = 0; m < 4; ++m)
#pragma unroll
                for (int bj = 0; bj < 2; ++bj) {
                    if (ai * 8 + m * 2 + bj + 1 < 16) EPI_LDG(ai * 8 + m * 2 + bj + 1);
                    const u32x2 ga = gq[(ai * 8 + m * 2 + bj) & 1][0], gb = gq[(ai * 8 + m * 2 + bj) & 1][1];
#pragma unroll
                    for (int e = 0; e < 8; ++e) {
                        const unsigned wa = e < 4 ? ga.x : ga.y, wb = e < 4 ? gb.x : gb.y;
                        const float g0 = (float)((wa >> (8 * (e & 3))) & 255u), g1 = fmaxf((float)((wb >> (8 * (e & 3))) & 255u), 1.f);
                        acc[ai][bj][m][e >> 2][e & 3] *= g0 * __builtin_amdgcn_rcpf(g1);
                    }
                    asm volatile("" ::: "memory");
                    __builtin_amdgcn_sched_barrier(0);
                }
#undef EPI_LDG
    }
    __device__ __forceinline__ void operator()(const pg8::f32x4 (&acc)[2][2][4][2], const pg8::Unit& u, int wr, int wc, int fr, int fq) const {
        const int row0 = u.pm * 256 + wr * 64 + fr, col0 = u.pn * 256 + wc * 32 + 8 * fq;
        u32x2 gq[2][2];
#define EPI_LDG1(i_) do { _Pragma("unroll") for (int bj = 0; bj < 2; ++bj) gq[(i_) & 1][bj] = *(const u32x2*)(G1 + (size_t)(row0 + ((i_) >> 2) * 128 + ((i_) & 3) * 16) * 1024 + col0 + bj * 128); } while (0)
        EPI_LDG1(0);
#pragma unroll
        for (int ai = 0; ai < 2; ++ai)
#pragma unroll
            for (int m = 0; m < 4; ++m) {
                if (ai * 4 + m + 1 < 8) EPI_LDG1(ai * 4 + m + 1);
#pragma unroll
                for (int bj = 0; bj < 2; ++bj) {
                    const size_t off = (size_t)(row0 + ai * 128 + m * 16) * 1024 + col0 + bj * 128;
                    const u32x2 gb = gq[(ai * 4 + m) & 1][bj];
                    float r[8];
#pragma unroll
                    for (int e = 0; e < 8; ++e) {
                        const unsigned wb = e < 4 ? gb.x : gb.y;
                        r[e] = acc[ai][bj][m][e >> 2][e & 3] * (fmaxf((float)((wb >> (8 * (e & 3))) & 255u), 1.f) * (1.f / 255.f));
                    }
                    if (F8_OUT) { u32x2 w8; w8.x = pack_fp8x4(r[0] * ASC8, r[1] * ASC8, r[2] * ASC8, r[3] * ASC8); w8.y = pack_fp8x4(r[4] * ASC8, r[5] * ASC8, r[6] * ASC8, r[7] * ASC8); *(u32x2*)(O8 + off) = w8; }
                    else { u32x4 w; w.x = pk2(r[0], r[1]); w.y = pk2(r[2], r[3]); w.z = pk2(r[4], r[5]); w.w = pk2(r[6], r[7]); *(u32x4*)(O + off) = w; }
                }
            }
#undef EPI_LDG1
    }
};

struct EpiResid {
    static constexpr bool PERM = false, AFTER_DRAIN = false, MID = false;
    const float* x; const float* mod; float* out; float sc;
    __device__ __forceinline__ void operator()(const pg8::f32x4 (&acc)[2][2][4][2], const pg8::Unit& u, int wr, int wc, int fr, int fq) const {
        const int b = u.pm >> 3; const float* g1 = mod + (size_t)b * 6144 + 2048;
        const int row0 = u.pm * 256 + wr * 64 + fr, col0 = u.pn * 256 + wc * 32 + 4 * fq;
        pg8::f32x4 gv[2][2];
#pragma unroll
        for (int bj = 0; bj < 2; ++bj)
#pragma unroll
            for (int n = 0; n < 2; ++n) gv[bj][n] = *(const pg8::f32x4*)(g1 + col0 + bj * 128 + n * 16) * sc;
        pg8::f32x4 xq[2][4];
#define EPI_LDX(i_) do { _Pragma("unroll") for (int bj = 0; bj < 2; ++bj) _Pragma("unroll") for (int n = 0; n < 2; ++n) \
            xq[(i_) & 1][bj * 2 + n] = *(const pg8::f32x4*)(x + (size_t)(row0 + ((i_) >> 2) * 128 + ((i_) & 3) * 16) * 1024 + col0 + bj * 128 + n * 16); } while (0)
        EPI_LDX(0);
#pragma unroll
        for (int ai = 0; ai < 2; ++ai)
#pragma unroll
            for (int m = 0; m < 4; ++m) {
                if (ai * 4 + m + 1 < 8) EPI_LDX(ai * 4 + m + 1);
#pragma unroll
                for (int bj = 0; bj < 2; ++bj)
#pragma unroll
                    for (int n = 0; n < 2; ++n) {
                        const size_t off = (size_t)(row0 + ai * 128 + m * 16) * 1024 + col0 + bj * 128 + n * 16;
                        *(pg8::f32x4*)(out + off) = xq[(ai * 4 + m) & 1][bj * 2 + n] + gv[bj][n] * acc[ai][bj][m][n];
                    }
            }
#undef EPI_LDX
    }
};

struct EpiPlain {
    static constexpr bool PERM = true, AFTER_DRAIN = false, MID = false;
    bf16_t* O; int ldc; float sc;
    __device__ __forceinline__ void operator()(const pg8::f32x4 (&acc)[2][2][4][2], const pg8::Unit& u, int wr, int wc, int fr, int fq) const {
        const int row0 = u.pm * 256 + wr * 64 + fr, col0 = u.pn * 256 + wc * 32 + 8 * fq;
#pragma unroll
        for (int ai = 0; ai < 2; ++ai)
#pragma unroll
            for (int m = 0; m < 4; ++m)
#pragma unroll
                for (int bj = 0; bj < 2; ++bj) {
                    const pg8::f32x4 a0 = acc[ai][bj][m][0] * sc, a1 = acc[ai][bj][m][1] * sc;
                    u32x4 w; w.x = pk2(a0[0], a0[1]); w.y = pk2(a0[2], a0[3]); w.z = pk2(a1[0], a1[1]); w.w = pk2(a1[2], a1[3]);
                    *(u32x4*)(O + (size_t)(row0 + ai * 128 + m * 16) * ldc + col0 + bj * 128) = w;
                }
    }
};

struct EpiPlainI8 {
    static constexpr bool PERM = true, AFTER_DRAIN = false, MID = false;
    bf16_t* O; int ldc; const float* rs; const unsigned* wm;
    __device__ __forceinline__ void operator()(const pg8::f32x4 (&acc)[2][2][4][2], const pg8::Unit& u, int wr, int wc, int fr, int fq) const {
        typedef int i32x4 __attribute__((ext_vector_type(4)));
        const int row0 = u.pm * 256 + wr * 64 + fr, col0 = u.pn * 256 + wc * 32 + 8 * fq;
        const float cs = __builtin_bit_cast(float, *wm) * (1.f / 127.f);
        float rsv[8];
#pragma unroll
        for (int i = 0; i < 8; ++i) rsv[i] = rs[row0 + (i >> 2) * 128 + (i & 3) * 16];
#pragma unroll
        for (int ai = 0; ai < 2; ++ai)
#pragma unroll
            for (int m = 0; m < 4; ++m) {
                const int row = row0 + ai * 128 + m * 16;
                const float sc = rsv[ai * 4 + m] * cs;
#pragma unroll
                for (int bj = 0; bj < 2; ++bj) {
                    const i32x4 i0 = __builtin_bit_cast(i32x4, acc[ai][bj][m][0]), i1 = __builtin_bit_cast(i32x4, acc[ai][bj][m][1]);
                    u32x4 w; w.x = pk2((float)i0[0] * sc, (float)i0[1] * sc); w.y = pk2((float)i0[2] * sc, (float)i0[3] * sc); w.z = pk2((float)i1[0] * sc, (float)i1[1] * sc); w.w = pk2((float)i1[2] * sc, (float)i1[3] * sc);
                    *(u32x4*)(O + (size_t)row * ldc + col0 + bj * 128) = w;
                }
            }
    }
};

struct EpiProbe {
    static constexpr bool PERM = true, AFTER_DRAIN = false, MID = false;
    bf16_t* O;
    __device__ __forceinline__ void operator()(const pg8::f32x4 (&acc)[2][2][4][2], const pg8::Unit& u, int wr, int wc, int fr, int fq) const {
        const int row0 = u.pm * 256 + wr * 64 + fr, col0 = wc * 32 + 8 * fq;
#pragma unroll
        for (int ai = 0; ai < 2; ++ai)
#pragma unroll
            for (int m = 0; m < 4; ++m)
#pragma unroll
                for (int bj = 0; bj < 2; ++bj) {
                    const pg8::f32x4 a0 = acc[ai][bj][m][0], a1 = acc[ai][bj][m][1];
                    u32x4 w; w.x = pk2(a0[0], a0[1]); w.y = pk2(a0[2], a0[3]); w.z = pk2(a1[0], a1[1]); w.w = pk2(a1[2], a1[3]);
                    *(u32x4*)(O + (size_t)(row0 + ai * 128 + m * 16) * 256 + col0 + bj * 128) = w;
                }
    }
};
#define XB_TMO      128
#define XB_XCNT(j)  (256  + 64 * (j))
#define XB_XSUB(j)  (1280 + 64 * (j))
#define XB_XGEN(j)  (2304 + 64 * (j))
#define XB_TOP      3328
#define XB_TOPGEN   3392
#define XCD_BAR_WORDS 3456
#define XB_SPIN_CAP (1u << 18)

__device__ __forceinline__ unsigned xb_ld(unsigned* p)              { return __hip_atomic_load(p, __ATOMIC_RELAXED, __HIP_MEMORY_SCOPE_AGENT); }
__device__ __forceinline__ unsigned xb_add(unsigned* p, unsigned v) { return __hip_atomic_fetch_add(p, v, __ATOMIC_RELAXED, __HIP_MEMORY_SCOPE_AGENT); }
__device__ __forceinline__ unsigned xb_xcc_id() { return (unsigned)__builtin_amdgcn_s_getreg((3 << 11) | 20) & 0xFu; }
#define XB_SPIN(cond, bar) do { unsigned _sp = 0; while (cond) { __builtin_amdgcn_s_sleep(1); \
    if ((++_sp & 255u) == 0u) { if (xb_ld(&(bar)[XB_TMO])) break; if (_sp > XB_SPIN_CAP) { atomicAdd(&(bar)[XB_TMO], 1u); break; } } } } while (0)

struct XcdBarrier {
    unsigned* bar; unsigned x;
    volatile LAS unsigned* st;
};

__device__ __forceinline__ XcdBarrier xcd_barrier_post(unsigned* bar, volatile LAS unsigned* st) {
    XcdBarrier b; b.bar = bar; b.x = xb_xcc_id(); b.st = st;
    if (threadIdx.x == 0) (void)xb_add(&bar[XB_XCNT(b.x)], 1u);
    return b;
}
__device__ __forceinline__ void xcd_barrier_complete(unsigned* bar, unsigned x, unsigned& nloc, unsigned& nx) {
    const unsigned G = gridDim.x * gridDim.y * gridDim.z;
    unsigned sum, cnt, mine, sp = 0u;
    for (;;) {
        sum = 0u; cnt = 0u; mine = 0u;
#pragma unroll
        for (unsigned j = 0; j < 16; ++j) { const unsigned c = xb_ld(&bar[XB_XCNT(j)]); sum += c; cnt += (c > 0u) ? 1u : 0u; mine = (j == x) ? c : mine; }
        if (sum == G) break;
        __builtin_amdgcn_s_sleep(1);
        if ((++sp & 255u) == 0u) { if (xb_ld(&bar[XB_TMO])) break; if (sp > XB_SPIN_CAP) { atomicAdd(&bar[XB_TMO], 1u); break; } }
    }
    nloc = mine > 0u ? mine : 1u; nx = cnt > 0u ? cnt : 1u;
}

__device__ __forceinline__ void xcd_barrier(const XcdBarrier& b) {
    asm volatile("s_waitcnt vmcnt(0)" ::: "memory");
    __syncthreads();
    if (threadIdx.x == 0) {
        unsigned* bar = b.bar;
        __builtin_amdgcn_s_waitcnt(0);
        unsigned nloc = b.st[0], nx = b.st[1];
        if (nloc == 0u) { xcd_barrier_complete(bar, b.x, nloc, nx); b.st[0] = nloc; b.st[1] = nx; }
        const unsigned old = xb_add(&bar[XB_XSUB(b.x)], 1u);
        const unsigned gen = old / nloc;
        if (old + 1u == (gen + 1u) * nloc) {
            __builtin_amdgcn_fence(__ATOMIC_RELEASE, "agent");
            asm volatile("s_waitcnt vmcnt(0)" ::: "memory");
            const unsigned og = xb_add(&bar[XB_TOP], 1u);
            const unsigned tg = og / nx;
            if (og + 1u == (tg + 1u) * nx) xb_add(&bar[XB_TOPGEN], 1u);
            else XB_SPIN(xb_ld(&bar[XB_TOPGEN]) == tg, bar);
            __builtin_amdgcn_fence(__ATOMIC_ACQUIRE, "agent");
            xb_add(&bar[XB_XGEN(b.x)], 1u);
            asm volatile("s_waitcnt vmcnt(0)" ::: "memory");
        } else {
            XB_SPIN(xb_ld(&bar[XB_XGEN(b.x)]) == gen, bar);
            __builtin_amdgcn_fence(__ATOMIC_ACQUIRE, "agent");
            asm volatile("s_waitcnt vmcnt(0)" ::: "memory");
        }
    }
    __syncthreads();
}
#define LDS_WAIT() asm volatile("s_waitcnt lgkmcnt(0)" ::: "memory")
#define VM_WAIT() asm volatile("s_waitcnt vmcnt(0)" ::: "memory")

DI void transpose_item(const float* W, int N, int K, bf16_t* WT, int prow0, int lcol0, int nvalid, int k0, LAS float* scr, int lane) {
    const int cl = lane & 31;
    float tw[32];
#pragma unroll
    for (int i = 0; i < 32; ++i) { const int kk = 2 * i + (lane >> 5); tw[i] = (cl < nvalid) ? W[(size_t)(k0 + kk) * N + lcol0 + cl] : 0.f; }
#pragma unroll
    for (int i = 0; i < 32; ++i) { const int kk = 2 * i + (lane >> 5); scr[kk * 33 + cl] = tw[i]; }
    LDS_WAIT();
    const int c = lane & 7;
#pragma unroll
    for (int j = 0; j < 4; ++j) {
        const int n = (lane >> 3) + 8 * j; const LAS float* s = scr + (8 * c) * 33 + n;
        u32x4 o; o.x = pk2(s[0 * 33], s[1 * 33]); o.y = pk2(s[2 * 33], s[3 * 33]); o.z = pk2(s[4 * 33], s[5 * 33]); o.w = pk2(s[6 * 33], s[7 * 33]);
        *(u32x4*)(WT + (size_t)(prow0 + n) * K + k0 + 8 * c) = o;
    }
    LDS_WAIT();
}

DI unsigned pack_i8x4(float a, float b, float c, float d) {
    const int ia = (int)__builtin_rintf(fminf(fmaxf(a, -127.f), 127.f)), ib = (int)__builtin_rintf(fminf(fmaxf(b, -127.f), 127.f));
    const int ic = (int)__builtin_rintf(fminf(fmaxf(c, -127.f), 127.f)), id = (int)__builtin_rintf(fminf(fmaxf(d, -127.f), 127.f));
    return (unsigned)(ia & 255) | ((unsigned)(ib & 255) << 8) | ((unsigned)(ic & 255) << 16) | ((unsigned)(id & 255) << 24);
}
template <bool INT8 = false>
DI void transpose_item8(const float* W, int N, int K, unsigned char* WT, int prow0, int lcol0, int nvalid, int k0, float scale, LAS float* scr, int lane) {
    const int cl = lane & 31;
    float tw[32];
#pragma unroll
    for (int i = 0; i < 32; ++i) { const int kk = 2 * i + (lane >> 5); tw[i] = (cl < nvalid) ? W[(size_t)(k0 + kk) * N + lcol0 + cl] * scale : 0.f; }
#pragma unroll
    for (int i = 0; i < 32; ++i) { const int kk = 2 * i + (lane >> 5); scr[kk * 33 + cl] = tw[i]; }
    LDS_WAIT();
    const int c = lane & 3;
#pragma unroll
    for (int j = 0; j < 2; ++j) {
        const int n = (lane >> 2) + 16 * j; const LAS float* s = scr + (16 * c) * 33 + n;
        u32x4 o;
#pragma unroll
        for (int q = 0; q < 4; ++q) o[q] = INT8 ? pack_i8x4(s[(4 * q) * 33], s[(4 * q + 1) * 33], s[(4 * q + 2) * 33], s[(4 * q + 3) * 33]) : pack_fp8x4(s[(4 * q) * 33], s[(4 * q + 1) * 33], s[(4 * q + 2) * 33], s[(4 * q + 3) * 33]);
        *(u32x4*)(WT + (size_t)(prow0 + n) * K + k0 + 16 * c) = o;
    }
    LDS_WAIT();
}
DI void absmax_to(const float* p, size_t n, unsigned* word, size_t gtid, size_t gth, int lane) {
    float mx = 0.f;
    for (size_t i = gtid * 4; i < n; i += gth * 16) {
        f32x4 v[4];
#pragma unroll
        for (int q = 0; q < 4; ++q) { const size_t j = i + (size_t)q * gth * 4; v[q] = (j < n) ? *(const f32x4*)(p + j) : (f32x4){0.f, 0.f, 0.f, 0.f}; }
#pragma unroll
        for (int q = 0; q < 4; ++q) mx = fmaxf(fmaxf(mx, fmaxf(fabsf(v[q][0]), fabsf(v[q][1]))), fmaxf(fabsf(v[q][2]), fabsf(v[q][3])));
    }
#pragma unroll
    for (int o = 1; o < 64; o <<= 1) mx = fmaxf(mx, __shfl_xor(mx, o));
    if (lane == 0 && mx > 0.f) atomicMax(word, __builtin_bit_cast(unsigned, mx));
}
DI float wscale8(const unsigned char* ws, int which) { return WTOP8 / fmaxf(__builtin_bit_cast(float, ((const unsigned*)(ws + WS_CTL))[CW_WMAX + which]), 1e-30f); }

DI void conv_bf16(const float* src, bf16_t* dst, size_t n, size_t gtid, size_t gthreads) {
    for (size_t i = gtid * 8; i < n; i += gthreads * 8) {
        const f32x4 a = *(const f32x4*)(src + i), b = *(const f32x4*)(src + i + 4);
        u32x4 o; o.x = pk2(a[0], a[1]); o.y = pk2(a[2], a[3]); o.z = pk2(b[0], b[1]); o.w = pk2(b[2], b[3]);
        *(u32x4*)(dst + i) = o;
    }
}

DI void conv_fp8(const float* src, unsigned char* dst, size_t n, float scale, size_t gtid, size_t gthreads) {
    for (size_t i = gtid * 16; i < n; i += gthreads * 16) {
        const size_t e = i >> 10, c = i & 1023;
        u32x4 o;
#pragma unroll
        for (int q = 0; q < 4; ++q) {
            const f32x4 v = *(const f32x4*)(src + i + 4 * q) * scale;
            int w = 0; w = __builtin_amdgcn_cvt_pk_fp8_f32(v[0], v[1], w, false); w = __builtin_amdgcn_cvt_pk_fp8_f32(v[2], v[3], w, true);
            o[q] = (unsigned)w;
        }
        *(u32x4*)(dst + ((c >> 7) * 16384 + e) * 128 + (c & 127)) = o;
    }
}

DI void conv_u_i8(const float* src, unsigned char* dst, float scale, size_t gtid, size_t gthreads) {
    for (size_t i0 = gtid * 16; i0 < (size_t)16384 * 1024; i0 += gthreads * 32) {
        f32x4 v[2][4];
#pragma unroll
        for (int h = 0; h < 2; ++h)
#pragma unroll
            for (int q = 0; q < 4; ++q) v[h][q] = *(const f32x4*)(src + i0 + (size_t)h * gthreads * 16 + 4 * q);
#pragma unroll
        for (int h = 0; h < 2; ++h) {
            const size_t i = i0 + (size_t)h * gthreads * 16, e = i >> 10, c = i & 1023;
            u32x4 o;
#pragma unroll
            for (int q = 0; q < 4; ++q) { const f32x4 w = v[h][q] * scale; o[q] = pack_i8x4(w[0], w[1], w[2], w[3]); }
            *(u32x4*)(dst + ((c >> 7) * 16384 + e) * 128 + (c & 127)) = o;
        }
    }
}

DI int q4(float x) { return (int)__builtin_rintf(fminf(fmaxf(x, -8.f), 7.f)) & 15; }
DI void conv_u_i4(const float* src, unsigned char* dst, float inv_step, size_t gtid, size_t gthreads) {
    for (size_t i = gtid * 32; i < (size_t)16384 * 1024; i += gthreads * 32) {
        f32x4 v[8];
#pragma unroll
        for (int q = 0; q < 8; ++q) v[q] = *(const f32x4*)(src + i + 4 * q) * inv_step;
        u32x4 o;
#pragma unroll
        for (int j = 0; j < 4; ++j) {
            unsigned w = 0;
#pragma unroll
            for (int b = 0; b < 4; ++b) {
                if (UD8) w |= (unsigned)(q4(v[2 * j + (b >> 1)][2 * (b & 1)]) | (q4(v[2 * j + (b >> 1)][2 * (b & 1) + 1]) << 4)) << (8 * b);
                else w |= (unsigned)(q4(v[j][b]) | (q4(v[4 + j][b]) << 4)) << (8 * b);
            }
            o[j] = w;
        }
        const size_t e = i >> 10, c = i & 1023;
        *(u32x4*)(dst + ((c >> 8) * 16384 + e) * 128 + ((c & 255) >> 1)) = o;
    }
}

DI void conv_v_fp4(const float* src, unsigned char* dst, float inv_s, size_t gtid, size_t gthreads) {
    for (size_t i = gtid * 32; i < (size_t)16384 * 1024; i += gthreads * 32) {
        u32x4 o;
#pragma unroll
        for (int j = 0; j < 4; ++j) {
            f32x4 p = *(const f32x4*)(src + i + 8 * j) * inv_s, q = *(const f32x4*)(src + i + 8 * j + 4) * inv_s;
#pragma unroll
            for (int k = 0; k < 4; ++k) { p[k] = __builtin_amdgcn_fmed3f(p[k], -6.f, 6.f); q[k] = __builtin_amdgcn_fmed3f(q[k], -6.f, 6.f); }
            unsigned w = 0;
            w = __builtin_amdgcn_cvt_scalef32_pk_fp4_f32(w, p[0], p[1], 1.0f, 0); w = __builtin_amdgcn_cvt_scalef32_pk_fp4_f32(w, p[2], p[3], 1.0f, 1);
            w = __builtin_amdgcn_cvt_scalef32_pk_fp4_f32(w, q[0], q[1], 1.0f, 2); w = __builtin_amdgcn_cvt_scalef32_pk_fp4_f32(w, q[2], q[3], 1.0f, 3);
            o[j] = w;
        }
        const size_t e = i >> 10, c = i & 1023;
        *(u32x4*)(dst + ((c >> 8) * 16384 + e) * 128 + ((c & 255) >> 1)) = o;
    }
}

DI void ph_prologue(const KArgs& a, LAS unsigned char* lds, int tid, int lane, int wave, int blk, int nblk) {
    unsigned char* ws = a.ws;
    const int gw = blk * 8 + wave, ngw = nblk * 8;
    if (blk < 192) {
        LAS float* sc = (LAS float*)lds;
#pragma unroll 16
        for (int i = tid; i < 32 * 1024; i += 512) { const int b = i >> 10, k = i & 1023; const float v = a.c[i]; sc[k * 36 + b] = v * __builtin_amdgcn_rcpf(1.f + __expf(-v)); }
        __syncthreads();
        float acc[32];
#pragma unroll
        for (int b = 0; b < 32; ++b) acc[b] = 0.f;
        const int cl = lane & 31, kh = lane >> 5, col = blk * 32 + cl;
#pragma unroll 16
        for (int i = 0; i < 64; ++i) {
            const int k = wave * 128 + 2 * i + kh;
            const float wv = a.w_ada[(size_t)k * 6144 + col];
            const LAS f32x4* sp = (const LAS f32x4*)(sc + k * 36);
#pragma unroll
            for (int q = 0; q < 8; ++q) { const f32x4 s4 = sp[q]; acc[4 * q] += s4[0] * wv; acc[4 * q + 1] += s4[1] * wv; acc[4 * q + 2] += s4[2] * wv; acc[4 * q + 3] += s4[3] * wv; }
        }
        __syncthreads();
        LAS float* red = (LAS float*)lds;
#pragma unroll
        for (int b = 0; b < 32; ++b) red[((wave * 2 + kh) * 32 + b) * 32 + cl] = acc[b];
        __syncthreads();
        for (int o = tid; o < 1024; o += 512) {
            float s = 0.f;
#pragma unroll
            for (int p = 0; p < 16; ++p) s += red[p * 1024 + o];
            const int b = o >> 5, c2 = o & 31;
            ((float*)(ws + WS_MOD))[(size_t)b * 6144 + blk * 32 + c2] = s + a.b_ada[blk * 32 + c2];
        }
        __syncthreads();
    }
    {
        LAS float* scr = (LAS float*)(lds + wave * 8704);
        constexpr int I_WIN = 16 * 152, I_WB = 8 * 32, I_WO = 16 * 32, I_WPQ = 16 * 64;
        constexpr int NITEMS = I_WIN + 2 * I_WB + I_WO + I_WPQ;
        for (int it = gw; it < NITEMS; it += ngw) {
            int r = it;
            if (r < I_WIN) {
                const int pb = r % 152, kb = r / 152, pn = pb >> 3, bj = (pb >> 2) & 1, wc = pb & 3, g = pn * 4 + wc;
                const int nvalid = (g == 43) ? (bj == 0 ? 8 : 0) : 32;
                if (!((IN8_MASK >> pn) & 1u)) transpose_item(a.w_in, WIN_COLS, 1024, (bf16_t*)(ws + WS_WIN), rank_in(~IN8_MASK, pn) * 256 + (pb & 7) * 32, proj_group_base(g) + 32 * bj, nvalid, kb * 64, scr, lane);
                continue;
            }
            r -= I_WIN;
            if (r < I_WB) { if (!F8_BR && !BR8) transpose_item(a.w_ba, 1024, FUSE56 ? 1024 : 512, (bf16_t*)(ws + WS_WBA), (r % 32) * 32, (r % 32) * 32, 32, (r / 32) * 64, scr, lane); continue; }
            r -= I_WB;
            if (r < I_WB) { if (!F8_BR && !BR8) transpose_item(a.w_bb, 1024, FUSE56 ? 1024 : 512, FUSE56 ? (bf16_t*)(ws + WS_WBA) + 512 : (bf16_t*)(ws + WS_WBB), (r % 32) * 32, (r % 32) * 32, 32, (r / 32) * 64, scr, lane); continue; }
            r -= I_WB;
            if (r < I_WO) { if (!F8_BR && !F8_OUT) transpose_item(a.w_out, 1024, 1024, (bf16_t*)(ws + WS_WOUT), (r % 32) * 32, (r % 32) * 32, 32, (r / 32) * 64, scr, lane); continue; }
            r -= I_WO;
            if (PQ_MODE == 0) transpose_item(a.peer_wq, 2048, 1024, (bf16_t*)(ws + WS_WPQ), (r % 64) * 32, (r % 64) * 32, 32, (r / 64) * 64, scr, lane);
        }
    }
    {
        const size_t gtid = (size_t)blk * 512 + tid, gth = (size_t)nblk * 512;
        conv_bf16(a.sub_keys, (bf16_t*)(ws + WS_SKB), (size_t)8 * 2 * 128 * 128, gtid, gth);
        if (U4) absmax_to(a.peer_u, (size_t)1 << 21, (unsigned*)(ws + WS_CTL) + CW_UMAX, gtid, gth, lane);
        else {
            float mx = 0.f;
            for (size_t i = gtid * 4; i < (size_t)16384 * 1024; i += gth * 16) {
                f32x4 v[4];
#pragma unroll
                for (int q = 0; q < 4; ++q) v[q] = *(const f32x4*)(a.peer_u + i + (size_t)q * gth * 4);
#pragma unroll
                for (int q = 0; q < 4; ++q) mx = fmaxf(fmaxf(mx, fmaxf(fabsf(v[q][0]), fabsf(v[q][1]))), fmaxf(fabsf(v[q][2]), fabsf(v[q][3])));
            }
#pragma unroll
            for (int o = 1; o < 64; o <<= 1) mx = fmaxf(mx, __shfl_xor(mx, o));
            if (lane == 0) atomicMax((unsigned*)(ws + WS_CTL) + CW_UMAX, __builtin_bit_cast(unsigned, mx));
        }
        if (PQ_MODE != 0) absmax_to(a.peer_wq, (size_t)1024 * 2048, (unsigned*)(ws + WS_CTL) + CW_WMAX + 4, gtid, gth, lane);
        if (N8_IN > 0) absmax_to(a.w_in, (size_t)1024 * WIN_COLS, (unsigned*)(ws + WS_CTL) + CW_WMAX + 0, gtid, gth, lane);
        if (F8_OUT && !F8_BR && !BR8) absmax_to(a.w_out, (size_t)1024 * 1024, (unsigned*)(ws + WS_CTL) + CW_WMAX + 3, gtid, gth, lane);
        if (F8_BR || BR8) {
            absmax_to(a.w_ba, (size_t)512 * 1024, (unsigned*)(ws + WS_CTL) + CW_WMAX + 1, gtid, gth, lane);
            absmax_to(a.w_bb, (size_t)512 * 1024, (unsigned*)(ws + WS_CTL) + CW_WMAX + 2, gtid, gth, lane);
            if (F8_BR || F8_OUT) absmax_to(a.w_out, (size_t)1024 * 1024, (unsigned*)(ws + WS_CTL) + CW_WMAX + 3, gtid, gth, lane);
        }
        if (V4) absmax_to(a.peer_v, (size_t)1 << 21, (unsigned*)(ws + WS_CTL) + CW_VMAX, gtid, gth, lane);
        else conv_fp8(a.peer_v, ws + WS_VB, (size_t)16384 * 1024, VSCALE, gtid, gth);
        for (size_t t = gtid; t < (size_t)NTOK * 2; t += gth) {
            const int m = (int)(t >> 1), half = (int)(t & 1);
            double f = half ? 0.15915494309189535 * 0.01 : 0.15915494309189535;
            const double p = (double)a.pos[m];
            float cs[16], sn[16];
#pragma unroll
            for (int k = 0; k < 16; ++k) {
                const double rev = p * f;
                const float fr = (float)(rev - __builtin_floor(rev)) * 6.283185307179586f;
                cs[k] = cosf(fr); sn[k] = sinf(fr);
                f *= 0.7498942093324559;
            }
            float* cp = (float*)(ws + WS_COS) + (size_t)m * 32 + 16 * half; float* sp = (float*)(ws + WS_SIN) + (size_t)m * 32 + 16 * half;
#pragma unroll
            for (int k = 0; k < 4; ++k) { *(f32x4*)(cp + 4 * k) = (f32x4){cs[4 * k], cs[4 * k + 1], cs[4 * k + 2], cs[4 * k + 3]}; *(f32x4*)(sp + 4 * k) = (f32x4){sn[4 * k], sn[4 * k + 1], sn[4 * k + 2], sn[4 * k + 3]}; }
        }
    }
}

DI void ph_weights8(const KArgs& a, LAS unsigned char* lds, int lane, int wave, int blk, int nblk) {
    unsigned char* ws = a.ws;
    const int gw = blk * 8 + wave, ngw = nblk * 8;
    LAS float* scr = (LAS float*)(lds + wave * 8704);
    if (PQ_MODE != 0) {
        const float spq = wscale8(ws, 4) * (PQ_MODE == 2 ? 127.f / WTOP8 : 1.f);
        for (int r = gw; r < 16 * 64; r += ngw) transpose_item8<PQ_MODE == 2>(a.peer_wq, 2048, 1024, ws + WS_WPQ, (r % 64) * 32, (r % 64) * 32, 32, (r / 64) * 64, spq, scr, lane);
    }
    if (N8_IN > 0) {
        const float si = wscale8(ws, 0) * (IN_MODE == 2 ? 127.f / WTOP8 : 1.f);
        for (int r = gw; r < 16 * 152; r += ngw) {
            const int pb = r % 152, kb = r / 152, pn = pb >> 3, bj = (pb >> 2) & 1, wc = pb & 3, g = pn * 4 + wc;
            if ((IN8_MASK >> pn) & 1u) transpose_item8<IN_MODE == 2>(a.w_in, WIN_COLS, 1024, ws + WS_WIN8, rank_in(IN8_MASK, pn) * 256 + (pb & 7) * 32, proj_group_base(g) + 32 * bj, (g == 43) ? (bj == 0 ? 8 : 0) : 32, kb * 64, si, scr, lane);
        }
    }
    if (BR8 && !F8_BR) {
        const float sa = wscale8(ws, 1) * (127.f / WTOP8), sb = wscale8(ws, 2) * (127.f / WTOP8);
        for (int it = gw; it < 2 * 256; it += ngw) {
            const int r = it & 255;
            if (it < 256) transpose_item8<true>(a.w_ba, 1024, 512, ws + WS_WBA, (r % 32) * 32, (r % 32) * 32, 32, (r / 32) * 64, sa, scr, lane);
            else transpose_item8<true>(a.w_bb, 1024, 512, ws + WS_WBB, (r % 32) * 32, (r % 32) * 32, 32, (r / 32) * 64, sb, scr, lane);
        }
    }
    if (F8_OUT && !F8_BR) {
        const float so = wscale8(ws, 3);
        for (int r = gw; r < 512; r += ngw) transpose_item8(a.w_out, 1024, 1024, ws + WS_WOUT, (r % 32) * 32, (r % 32) * 32, 32, (r / 32) * 64, so, scr, lane);
    }
    if (F8_BR) {
        const float sa = wscale8(ws, 1), sb = wscale8(ws, 2), so = wscale8(ws, 3);
        for (int it = gw; it < 2 * 256 + 512; it += ngw) {
            int r = it;
            if (r < 256) { transpose_item8(a.w_ba, 1024, 512, ws + WS_WBA, (r % 32) * 32, (r % 32) * 32, 32, (r / 32) * 64, sa, scr, lane); continue; }
            r -= 256;
            if (r < 256) { transpose_item8(a.w_bb, 1024, 512, ws + WS_WBB, (r % 32) * 32, (r % 32) * 32, 32, (r / 32) * 64, sb, scr, lane); continue; }
            r -= 256;
            transpose_item8(a.w_out, 1024, 1024, ws + WS_WOUT, (r % 32) * 32, (r % 32) * 32, 32, (r / 32) * 64, so, scr, lane);
        }
    }
}

template <bool I8, bool WB16, bool WF8, bool NIB = false>
DI void ph_norm(const float* src, const float* gain, const float* mod, int sh_off, int sc_off, bf16_t* dst, unsigned char* dstf, unsigned char* dst8, float* hs, int lane, int wave, int blk, int nblk, unsigned char* ha = nullptr, unsigned char* hb = nullptr) {
    const int gw = blk * 8 + wave, ngw = nblk * 8;
    const int rows_per = NTOK / ngw;
    for (int r0 = gw * rows_per; r0 < NTOK; r0 += ngw * rows_per) {
        const int b = r0 / NT;
        f32x4 mul[4], add[4];
#pragma unroll
        for (int j = 0; j < 4; ++j) {
            const int col = 4 * lane + 256 * j;
            const f32x4 g = *(const f32x4*)(gain + col), s = *(const f32x4*)(mod + (size_t)b * 6144 + sc_off + col);
            mul[j] = g * (s + 1.f); add[j] = *(const f32x4*)(mod + (size_t)b * 6144 + sh_off + col);
        }
        f32x4 vn[4][4];
#pragma unroll
        for (int q = 0; q < 4; ++q) {
            const f32x4* xr = (const f32x4*)(src + (size_t)(r0 + q) * 1024) + lane;
#pragma unroll
            for (int j = 0; j < 4; ++j) vn[q][j] = xr[64 * j];
        }
#pragma unroll 2
        for (int r = r0; r < r0 + rows_per; r += 4) {
            f32x4 v[4][4]; float s[4];
#pragma unroll
            for (int q = 0; q < 4; ++q)
#pragma unroll
                for (int j = 0; j < 4; ++j) v[q][j] = vn[q][j];
            if (r + 4 < r0 + rows_per) {
#pragma unroll
                for (int q = 0; q < 4; ++q) {
                    const f32x4* xr = (const f32x4*)(src + (size_t)(r + 4 + q) * 1024) + lane;
#pragma unroll
                    for (int j = 0; j < 4; ++j) vn[q][j] = xr[64 * j];
                }
            }
#pragma unroll
            for (int q = 0; q < 4; ++q) {
                s[q] = 0.f;
#pragma unroll
                for (int j = 0; j < 4; ++j) s[q] += (v[q][j][0] * v[q][j][0] + v[q][j][1] * v[q][j][1]) + (v[q][j][2] * v[q][j][2] + v[q][j][3] * v[q][j][3]);
            }
#pragma unroll
            for (int o = 1; o < 64; o <<= 1) {
#pragma unroll
                for (int q = 0; q < 4; ++q) s[q] += __shfl_xor(s[q], o);
            }
#pragma unroll
            for (int q = 0; q < 4; ++q) {
                const float rn = __builtin_amdgcn_rsqf(s[q] * (1.f / 1024.f) + EPS);
                u32x2* o = (u32x2*)(dst + (size_t)(r + q) * 1024) + lane;
                f32x4 y[4]; float am = 0.f;
#pragma unroll
                for (int j = 0; j < 4; ++j) { y[j] = v[q][j] * rn * mul[j] + add[j];
                    if (WF8) { ((unsigned*)(dstf + (size_t)(r + q) * 1024) + lane)[64 * j] = pack_fp8x4(y[j][0] * ASC8, y[j][1] * ASC8, y[j][2] * ASC8, y[j][3] * ASC8); }
                    if (WB16) { u32x2 w; w.x = pk2(y[j][0], y[j][1]); w.y = pk2(y[j][2], y[j][3]); o[64 * j] = w; }
                    if (I8) am = fmaxf(fmaxf(am, fmaxf(fabsf(y[j][0]), fabsf(y[j][1]))), fmaxf(fabsf(y[j][2]), fabsf(y[j][3]))); }
                if (I8) {
#pragma unroll
                    for (int oo = 1; oo < 64; oo <<= 1) am = fmaxf(am, __shfl_xor(am, oo));
                    am = fmaxf(am, 1e-20f);
                    const float qs = (NIB ? 119.f : 127.f) / am;
                    unsigned* o8 = (unsigned*)(dst8 + (size_t)(r + q) * 1024) + lane;
#pragma unroll
                    for (int j = 0; j < 4; ++j) {
                        o8[64 * j] = pack_i8x4(y[j][0] * qs, y[j][1] * qs, y[j][2] * qs, y[j][3] * qs);
                        if (NIB) {
                            unsigned na = 0, nb = 0;
#pragma unroll
                            for (int e = 0; e < 4; ++e) { const int qi = (int)__builtin_rintf(y[j][e] * qs); nb |= (unsigned)(qi & 15) << (4 * e); na |= (unsigned)(((qi + 8) >> 4) & 15) << (4 * e); }
                            const unsigned na2 = __shfl_xor(na, 1), nb2 = __shfl_xor(nb, 1);
                            if (!(lane & 1)) {
                                *(unsigned*)(ha + (size_t)(r + q) * 512 + 2 * lane + 128 * j) = na | (na2 << 16);
                                *(unsigned*)(hb + (size_t)(r + q) * 512 + 2 * lane + 128 * j) = nb | (nb2 << 16);
                            }
                        }
                    }
                    if (lane == 0) hs[r + q] = am * (1.f / (NIB ? 119.f : 127.f));
                }
            }
        }
    }
}
typedef short v4i16_t __attribute__((ext_vector_type(4)));
DI s16x4 tr_read(const LAS char* p) { return __builtin_bit_cast(s16x4, __builtin_amdgcn_ds_read_tr16_b64_v4i16((LAS v4i16_t*)p)); }
DI bf16x8 pack8(float x0, float x1, float x2, float x3, float x4, float x5, float x6, float x7) {
    u32x4 p; p.x = pk2(x0, x1); p.y = pk2(x2, x3); p.z = pk2(x4, x5); p.w = pk2(x6, x7); return __builtin_bit_cast(bf16x8, p);
}
#define MFMA32(a, b, c) __builtin_amdgcn_mfma_f32_32x32x16_bf16((a), (b), (c), 0, 0, 0)
#define MFMA16(a, b, c) __builtin_amdgcn_mfma_f32_16x16x32_bf16((a), (b), (c), 0, 0, 0)

DI float max3f(float a, float b, float c) { float r; asm("v_max3_f32 %0, %1, %2, %3" : "=v"(r) : "v"(a), "v"(b), "v"(c)); return r; }
template <int BP> DI int bfe1s(int w) { int r; asm("v_bfe_i32 %0, %1, %2, 1" : "=v"(r) : "v"(w), "n"(BP)); return r; }
template <int NDB, int KST, int VST, bool MASK>
DI void attn_tile(const LAS char* kb, const LAS char* vb, f32x16 (&o)[NDB], float& m, float& l, const bf16x8 (&qf)[4], unsigned mw0, unsigned mw1, int lane) {
    const int r32 = lane & 31, hi = lane >> 5;
    f32x16 p0, p1;
#pragma unroll
    for (int r = 0; r < 16; ++r) { p0[r] = 0.f; p1[r] = 0.f; }
    const LAS char* ka = kb + r32 * KST + hi * 16;
#pragma unroll
    for (int ks = 0; ks < 4; ++ks) {
        const bf16x8 a0 = *(const LAS bf16x8*)(ka + ks * 32), a1 = *(const LAS bf16x8*)(ka + 32 * KST + ks * 32);
        p0 = MFMA32(a0, qf[ks], p0); p1 = MFMA32(a1, qf[ks], p1);
    }
    float tm;
    {
        float t[16];
#pragma unroll
        for (int r = 0; r < 16; ++r) t[r] = fmaxf(p0[r], p1[r]);
        const float u0 = max3f(t[0], t[1], t[2]), u1 = max3f(t[3], t[4], t[5]), u2 = max3f(t[6], t[7], t[8]), u3 = max3f(t[9], t[10], t[11]), u4 = max3f(t[12], t[13], t[14]);
        tm = fmaxf(max3f(u0, u1, u2), max3f(u3, u4, t[15]));
    }
    tm = fmaxf(tm, __shfl_xor(tm, 32));
    const float mn = fmaxf(m, tm);
    const float alpha = fexp2(m - mn);
    float rs = 0.f;
    if (MASK) {
        const int w0 = (int)(mw0 >> (4 * hi)), w1 = (int)(mw1 >> (4 * hi));
#define ATT_MASKED(r_) { constexpr int bp = ((r_) & 3) + 8 * ((r_) >> 2); \
            p0[r_] = __builtin_bit_cast(float, __builtin_bit_cast(int, fexp2(p0[r_] - mn)) & bfe1s<bp>(w0)); \
            p1[r_] = __builtin_bit_cast(float, __builtin_bit_cast(int, fexp2(p1[r_] - mn)) & bfe1s<bp>(w1)); rs += p0[r_] + p1[r_]; }
        ATT_MASKED(0) ATT_MASKED(1) ATT_MASKED(2) ATT_MASKED(3) ATT_MASKED(4) ATT_MASKED(5) ATT_MASKED(6) ATT_MASKED(7)
        ATT_MASKED(8) ATT_MASKED(9) ATT_MASKED(10) ATT_MASKED(11) ATT_MASKED(12) ATT_MASKED(13) ATT_MASKED(14) ATT_MASKED(15)
#undef ATT_MASKED
    } else {
#pragma unroll
        for (int r = 0; r < 16; ++r) { p0[r] = fexp2(p0[r] - mn); p1[r] = fexp2(p1[r] - mn); rs += p0[r] + p1[r]; }
    }
    rs += __shfl_xor(rs, 32);
    l = l * alpha + rs; m = mn;
    if (__ballot(alpha != 1.0f)) {
#pragma unroll
        for (int db = 0; db < NDB; ++db)
#pragma unroll
            for (int r = 0; r < 16; ++r) o[db][r] *= alpha;
    }
    bf16x8 pf[4];
    pf[0] = pack8(p0[0], p0[1], p0[2], p0[3], p0[4], p0[5], p0[6], p0[7]);
    pf[1] = pack8(p0[8], p0[9], p0[10], p0[11], p0[12], p0[13], p0[14], p0[15]);
    pf[2] = pack8(p1[0], p1[1], p1[2], p1[3], p1[4], p1[5], p1[6], p1[7]);
    pf[3] = pack8(p1[8], p1[9], p1[10], p1[11], p1[12], p1[13], p1[14], p1[15]);
    const int i16 = lane & 15, q4 = i16 >> 2, pp = i16 & 3, g = lane >> 4;
    const LAS char* va = vb + (4 * (g >> 1) + q4) * VST + (16 * (g & 1) + 4 * pp) * 2;
#pragma unroll
    for (int db = 0; db < NDB; ++db)
#pragma unroll
        for (int s = 0; s < 4; ++s) {
            const s16x4 lo = tr_read(va + (16 * s) * VST + db * 64), h4 = tr_read(va + (16 * s + 8) * VST + db * 64);
            const bf16x8 vf = __builtin_shufflevector(lo, h4, 0, 1, 2, 3, 4, 5, 6, 7);
            o[db] = MFMA32(vf, pf[s], o[db]);
        }
}

DI void ph_diff_attn(const KArgs& a, LAS unsigned char* lds, int tid, int lane, int wave, int blk, int nblk) {
    unsigned char* ws = a.ws;
    const bf16_t* Qd = (const bf16_t*)(ws + WS_QD); const bf16_t* Kd = (const bf16_t*)(ws + WS_KD); const bf16_t* Vd = (const bf16_t*)(ws + WS_VD);
    bf16_t* OAB = (bf16_t*)(ws + WS_OAB);
    float lam;
    { const float d1 = wave_sum(a.lq1[lane] * a.lk1[lane]), d2 = wave_sum(a.lq2[lane] * a.lk2[lane]); lam = expf(d1) - expf(d2) + LAMBDA_INIT; }
    constexpr int KST = 272, VST = 320, KBYTES = 64 * KST, BUF = KBYTES + 64 * VST;
    const int mp = wave >> 2, qg = wave & 3, r32 = lane & 31, hi = lane >> 5;
    for (int idx = blk; idx < 2048; idx += nblk) {
        const int j = idx & 255, i = idx >> 8, pr = j & 127, half = j >> 7, kq = half * 4 + (i >> 1), qb = (i & 1) ? 15 - kq : kq;
        const int b = pr >> 2, h = pr & 3;
        const size_t rb = (size_t)b * NT;
        const int q0 = qb * 128 + 32 * qg, nT = 2 * qb + 2, myT = 2 * qb + 1 + (qg >> 1);
        bf16x8 qf[4];
        { const bf16_t* qp = Qd + (rb + q0 + r32) * 512 + h * 128 + mp * 64 + 8 * hi;
#pragma unroll
          for (int ks = 0; ks < 4; ++ks) qf[ks] = *(const bf16x8*)(qp + 16 * ks); }
        f32x16 o[4]; float m = -INFINITY, l = 0.f;
#pragma unroll
        for (int db = 0; db < 4; ++db)
#pragma unroll
            for (int r = 0; r < 16; ++r) o[db][r] = 0.f;
        const int key0 = tid >> 4, ch = tid & 15;
        const bf16_t* kg = Kd + (rb + key0) * 512 + h * 128 + ch * 8;
        const bf16_t* vg = Vd + (rb + key0) * 512 + h * 128 + ch * 8;
        const int loff = key0 * KST + ch * 16, loffv = KBYTES + key0 * VST + ch * 16;
        u32x4 sk0 = *(const u32x4*)kg, sk1 = *(const u32x4*)(kg + 32 * 512), sv0 = *(const u32x4*)vg, sv1 = *(const u32x4*)(vg + 32 * 512);
        *(LAS u32x4*)(lds + loff) = sk0; *(LAS u32x4*)(lds + loff + 32 * KST) = sk1;
        *(LAS u32x4*)(lds + loffv) = sv0; *(LAS u32x4*)(lds + loffv + 32 * VST) = sv1;
        if (nT > 1) { const size_t go = (size_t)64 * 512; sk0 = *(const u32x4*)(kg + go); sk1 = *(const u32x4*)(kg + go + 32 * 512); sv0 = *(const u32x4*)(vg + go); sv1 = *(const u32x4*)(vg + go + 32 * 512); }
        __syncthreads();
        for (int t = 0; t < nT; ++t) {
            const bool more = (t + 1 < nT), more2 = (t + 2 < nT);
            u32x4 nk0 = sk0, nk1 = sk1, nv0 = sv0, nv1 = sv1;
            if (more2) {
                const size_t go = (size_t)(t + 2) * 64 * 512;
                nk0 = *(const u32x4*)(kg + go); nk1 = *(const u32x4*)(kg + go + 32 * 512); nv0 = *(const u32x4*)(vg + go); nv1 = *(const u32x4*)(vg + go + 32 * 512);
            }
            if (t < myT) {
                const LAS char* bufp = (const LAS char*)lds + (t & 1) * BUF;
                attn_tile<4, KST, VST, false>(bufp + mp * 128, bufp + KBYTES, o, m, l, qf, 0u, 0u, lane);
            }
            if (more) {
                LAS unsigned char* nb = lds + ((t + 1) & 1) * BUF;
                *(LAS u32x4*)(nb + loff) = sk0; *(LAS u32x4*)(nb + loff + 32 * KST) = sk1;
                *(LAS u32x4*)(nb + loffv) = sv0; *(LAS u32x4*)(nb + loffv + 32 * VST) = sv1;
            }
            __syncthreads();
            sk0 = nk0; sk1 = nk1; sv0 = nv0; sv1 = nv1;
        }
        const float il = 1.f / l;
        LAS float* scr = (LAS float*)lds;
        if (mp == 1) {
#pragma unroll
            for (int db = 0; db < 4; ++db)
#pragma unroll
                for (int r = 0; r < 16; ++r) scr[((qg * 4 + db) * 16 + r) * 64 + lane] = o[db][r] * il;
        }
        __syncthreads();
        if (mp == 0) {
            float ss = 0.f;
#pragma unroll
            for (int db = 0; db < 4; ++db)
#pragma unroll
                for (int r = 0; r < 16; ++r) { const float v = o[db][r] * il - lam * scr[((qg * 4 + db) * 16 + r) * 64 + lane]; o[db][r] = v; ss += v * v; }
            ss += __shfl_xor(ss, 32);
            const float rn = __builtin_amdgcn_rsqf(ss * (1.f / 128.f) + EPS) * (1.f - LAMBDA_INIT);
            const size_t oo = (rb + q0 + r32) * (FUSE56 ? 1024 : 512) + h * 128 + 4 * hi;
            bf16_t* op = OAB + oo; unsigned char* op8 = (unsigned char*)OAB + oo;
            const float rn8 = rn * ASC8;
#pragma unroll
            for (int db = 0; db < 4; ++db)
#pragma unroll
                for (int r4 = 0; r4 < 4; ++r4) {
                    const int d0 = 32 * db + 8 * r4;
                    const f32x4 g4 = *(const f32x4*)(a.diff_out_g + d0 + 4 * hi);
                    if (BR8 && !F8_BR) { const float q8 = rn * (127.f / OA_MAX); *(unsigned*)(op8 + d0) = pack_i8x4(o[db][4 * r4] * q8 * g4[0], o[db][4 * r4 + 1] * q8 * g4[1], o[db][4 * r4 + 2] * q8 * g4[2], o[db][4 * r4 + 3] * q8 * g4[3]); }
                    else if (F8_BR) { *(unsigned*)(op8 + d0) = pack_fp8x4(o[db][4 * r4] * rn8 * g4[0], o[db][4 * r4 + 1] * rn8 * g4[1], o[db][4 * r4 + 2] * rn8 * g4[2], o[db][4 * r4 + 3] * rn8 * g4[3]); }
                    else {
                    u32x2 w; w.x = pk2(o[db][4 * r4] * rn * g4[0], o[db][4 * r4 + 1] * rn * g4[1]); w.y = pk2(o[db][4 * r4 + 2] * rn * g4[2], o[db][4 * r4 + 3] * rn * g4[3]);
                    *(u32x2*)(op + d0) = w; }
                }
        }
        __syncthreads();
    }
}

template <int VARIANT = 0>
DI void ph_dsa_attn(const KArgs& a, LAS unsigned char* lds, int tid, int lane, int wave, int blk, int nblk) {
    unsigned char* ws = a.ws;
    const bf16_t* Qs = (const bf16_t*)(ws + WS_QS); const bf16_t* Ks = (const bf16_t*)(ws + WS_KS); const bf16_t* Vs = (const bf16_t*)(ws + WS_VS);
    const unsigned* BM = (const unsigned*)(ws + WS_BM);
    bf16_t* OAB = (bf16_t*)(ws + WS_OAB);
    constexpr int KST = 144, VST = 192, KBYTES = 64 * KST, BUF = KBYTES + 64 * VST;
    const int r32 = lane & 31, hi = lane >> 5;
    for (int idx = blk; idx < 1024; idx += nblk) {
        const int j = idx & 255, i = idx >> 8, b = j >> 3, rr = j & 7, cq = (i & 1) ? 16 * (i >> 1) + 15 - rr : 16 * (i >> 1) + rr;
        const size_t rb = (size_t)b * NT;
        const int q0 = 64 * cq, nT = cq + 1;
        bf16x8 qfA[4], qfB[4];
        { const bf16_t* qp = Qs + (rb + q0 + r32) * 512 + wave * 64 + 8 * hi;
#pragma unroll
          for (int ks = 0; ks < 4; ++ks) { qfA[ks] = *(const bf16x8*)(qp + 16 * ks); qfB[ks] = *(const bf16x8*)(qp + 32 * 512 + 16 * ks); } }
        f32x16 oA[2], oB[2]; float mA = -INFINITY, lA = 0.f, mB = -INFINITY, lB = 0.f;
#pragma unroll
        for (int db = 0; db < 2; ++db)
#pragma unroll
            for (int r = 0; r < 16; ++r) { oA[db][r] = 0.f; oB[db][r] = 0.f; }
        const int key0 = tid >> 3, ch = tid & 7;
        const bf16_t* kg = Ks + (rb + key0) * 64 + ch * 8;
        const bf16_t* vg = Vs + (rb + key0) * 64 + ch * 8;
        const int loff = key0 * KST + ch * 16, loffv = KBYTES + key0 * VST + ch * 16;
        const unsigned* bmpA = BM + (rb + q0 + r32) * 64;
        const unsigned* bmpB = bmpA + 32 * 64;
        u32x4 sk0 = *(const u32x4*)kg, sv0 = *(const u32x4*)vg;
        u32x2 mwA = *(const u32x2*)bmpA, mwB = *(const u32x2*)bmpB, mnA = mwA, mnB = mwB;
        *(LAS u32x4*)(lds + loff) = sk0; *(LAS u32x4*)(lds + loffv) = sv0;
        __syncthreads();
        for (int t = 0; t < nT; ++t) {
            const bool more = (t + 1 < nT);
            if (more) {
                const size_t go = (size_t)(t + 1) * 64 * 64;
                sk0 = *(const u32x4*)(kg + go); sv0 = *(const u32x4*)(vg + go); mnA = *(const u32x2*)(bmpA + 2 * (t + 1)); mnB = *(const u32x2*)(bmpB + 2 * (t + 1));
            }
            {
                const LAS char* bufp = (const LAS char*)lds + (t & 1) * BUF;
                attn_tile<2, KST, VST, true>(bufp, bufp + KBYTES, oA, mA, lA, qfA, mwA.x, mwA.y, lane);
                attn_tile<2, KST, VST, true>(bufp, bufp + KBYTES, oB, mB, lB, qfB, mwB.x, mwB.y, lane);
            }
            if (more) {
                LAS unsigned char* nb = lds + ((t + 1) & 1) * BUF;
                *(LAS u32x4*)(nb + loff) = sk0; *(LAS u32x4*)(nb + loffv) = sv0;
                mwA = mnA; mwB = mnB;
            }
            __syncthreads();
        }
        {
            float ilA = (F8_BR ? ASC8 : 1.f) / lA, ilB = (F8_BR ? ASC8 : 1.f) / lB;
            if (BR8 && !F8_BR) {
                float mA = 0.f, mB = 0.f;
#pragma unroll
                for (int db = 0; db < 2; ++db)
#pragma unroll
                    for (int r = 0; r < 16; ++r) { mA = fmaxf(mA, fabsf(oA[db][r])); mB = fmaxf(mB, fabsf(oB[db][r])); }
                mA *= ilA; mB *= ilB;
                mA = fmaxf(mA, __shfl_xor(mA, 32)); mB = fmaxf(mB, __shfl_xor(mB, 32));
                LAS float* xm = (LAS float*)lds;
                if (hi == 0) { xm[wave * 64 + r32] = mA; xm[wave * 64 + 32 + r32] = mB; }
                __syncthreads();
                float rA = 1e-20f, rB = 1e-20f;
#pragma unroll
                for (int w8 = 0; w8 < 8; ++w8) { rA = fmaxf(rA, xm[w8 * 64 + r32]); rB = fmaxf(rB, xm[w8 * 64 + 32 + r32]); }
                __syncthreads();
                ilA *= 127.f / rA; ilB *= 127.f / rB;
                if (wave == 0 && hi == 0) { float* obs = (float*)(ws + WS_OBS); obs[rb + q0 + r32] = rA * (1.f / 127.f); obs[rb + q0 + 32 + r32] = rB * (1.f / 127.f); }
            }
            const size_t oo = FUSE56 ? (rb + q0 + r32) * 1024 + 512 + wave * 64 + 4 * hi : (size_t)NTOK * 512 + (rb + q0 + r32) * 512 + wave * 64 + 4 * hi;
            constexpr int OST = FUSE56 ? 1024 : 512;
            bf16_t* op = OAB + oo; unsigned char* op8 = (unsigned char*)OAB + oo;
#pragma unroll
            for (int db = 0; db < 2; ++db)
#pragma unroll
                for (int r4 = 0; r4 < 4; ++r4) {
                    if (BR8 && !F8_BR) {
                        *(unsigned*)(op8 + 32 * db + 8 * r4) = pack_i8x4(oA[db][4 * r4] * ilA, oA[db][4 * r4 + 1] * ilA, oA[db][4 * r4 + 2] * ilA, oA[db][4 * r4 + 3] * ilA);
                        *(unsigned*)(op8 + 32 * OST + 32 * db + 8 * r4) = pack_i8x4(oB[db][4 * r4] * ilB, oB[db][4 * r4 + 1] * ilB, oB[db][4 * r4 + 2] * ilB, oB[db][4 * r4 + 3] * ilB);
                    } else if (F8_BR) {
                        *(unsigned*)(op8 + 32 * db + 8 * r4) = pack_fp8x4(oA[db][4 * r4] * ilA, oA[db][4 * r4 + 1] * ilA, oA[db][4 * r4 + 2] * ilA, oA[db][4 * r4 + 3] * ilA);
                        *(unsigned*)(op8 + 32 * OST + 32 * db + 8 * r4) = pack_fp8x4(oB[db][4 * r4] * ilB, oB[db][4 * r4 + 1] * ilB, oB[db][4 * r4 + 2] * ilB, oB[db][4 * r4 + 3] * ilB);
                    } else {
                    u32x2 w; w.x = pk2(oA[db][4 * r4] * ilA, oA[db][4 * r4 + 1] * ilA); w.y = pk2(oA[db][4 * r4 + 2] * ilA, oA[db][4 * r4 + 3] * ilA);
                    *(u32x2*)(op + 32 * db + 8 * r4) = w;
                    u32x2 w2; w2.x = pk2(oB[db][4 * r4] * ilB, oB[db][4 * r4 + 1] * ilB); w2.y = pk2(oB[db][4 * r4 + 2] * ilB, oB[db][4 * r4 + 3] * ilB);
                    *(u32x2*)(op + 32 * OST + 32 * db + 8 * r4) = w2; }
                }
        }
    }
}

template <bool DO_SEL = true>
DI void ph_indexer(const KArgs& a, LAS unsigned char* lds, int tid, int lane, int wave, int blk, int nblk) {
    unsigned char* ws = a.ws;
    const bf16_t* Qi = (const bf16_t*)(ws + WS_QI); const bf16_t* Ki = (const bf16_t*)(ws + WS_KI); const float* Widx = (const float*)(ws + WS_WIDX);
    unsigned long long* BM = (unsigned long long*)(ws + WS_BM);
    constexpr int SCS = 2052;
    LAS float* sc = (LAS float*)lds;
    const int l15 = lane & 15, l4 = lane >> 4;
    bf16x8 qfr[8][2]; f32x4 w0, w1;
#define IDX_DECODE(idx_, b_, qi_) const int b_ = (idx_) >> 7, qi_ = (((idx_) & 127) + 8 * ((idx_) >> 8)) & 127
#define IDX_LOADQ(idx_) do { IDX_DECODE(idx_, b__, qi__); const bf16_t* qp = Qi + ((size_t)b__ * NT + 16 * qi__ + l15) * 512 + 8 * l4; \
        _Pragma("unroll") for (int h = 0; h < 8; ++h) { qfr[h][0] = *(const bf16x8*)(qp + h * 64); qfr[h][1] = *(const bf16x8*)(qp + h * 64 + 32); } \
        w0 = *(const f32x4*)(Widx + ((size_t)b__ * NT + 16 * qi__ + l15) * 8); w1 = *(const f32x4*)(Widx + ((size_t)b__ * NT + 16 * qi__ + l15) * 8 + 4); } while (0)
    if (blk < 4096) IDX_LOADQ(blk);
    for (int idx = blk; idx < 4096; idx += nblk) {
        IDX_DECODE(idx, b, qi);
        const size_t rb = (size_t)b * NT;
        const int q0 = 16 * qi, chunk = qi >> 2, nj = chunk + 1, nt16 = 4 * nj;
        constexpr float IS = 0.044194173824159216f;
        const float w[8] = {w0[0] * IS, w0[1] * IS, w0[2] * IS, w0[3] * IS, w1[0] * IS, w1[1] * IS, w1[2] * IS, w1[3] * IS};
        {
            int tile = wave;
            const bf16_t* kp = Ki + (rb + 16 * tile + l15) * 64 + 8 * l4;
            bf16x8 ka0 = *(const bf16x8*)kp, ka1 = *(const bf16x8*)(kp + 32);
            for (; tile < nt16; tile += 8) {
                const int ntile = (tile + 8 < nt16) ? tile + 8 : tile;
                const bf16_t* np = Ki + (rb + 16 * ntile + l15) * 64 + 8 * l4;
                const bf16x8 nk0 = *(const bf16x8*)np, nk1 = *(const bf16x8*)(np + 32);
                f32x4 s4 = {0.f, 0.f, 0.f, 0.f};
#pragma unroll
                for (int h = 0; h < 8; ++h) {
                    f32x4 c = {0.f, 0.f, 0.f, 0.f};
                    c = MFMA16(ka0, qfr[h][0], c); c = MFMA16(ka1, qfr[h][1], c);
#pragma unroll
                    for (int r = 0; r < 4; ++r) s4[r] += fmaxf(c[r], 0.f) * w[h];
                }
                *(LAS f32x4*)(sc + l15 * SCS + 16 * tile + 4 * l4) = s4;
                ka0 = nk0; ka1 = nk1;
            }
        }
        __syncthreads();
        if (idx + nblk < 4096) IDX_LOADQ(idx + nblk);
        if (DO_SEL) {
            const int qa = 2 * wave, qb = qa + 1;
            unsigned ua[32], ub[32];
#pragma unroll
            for (int jj = 0; jj < 32; ++jj) {
                ua[jj] = 0u; ub[jj] = 0u;
                if (jj < nj) {
                    const float sa = sc[qa * SCS + lane + 64 * jj] + 24.0f, sb = sc[qb * SCS + lane + 64 * jj] + 24.0f;
                    const unsigned ba = __builtin_bit_cast(unsigned, sa), bb = __builtin_bit_cast(unsigned, sb);
                    ua[jj] = (ba & 0x80000000u) ? ~ba : (ba | 0x80000000u); ub[jj] = (bb & 0x80000000u) ? ~bb : (bb | 0x80000000u);
                }
            }
            unsigned long long maska = 0ull, maskb = 0ull;
            if (nj <= 4) { maska = ~0ull; maskb = ~0ull; }
            else {
                unsigned pa = 0u, pb = 0u; bool da = false, db = false;
                int start = 31;
                {
                    unsigned ora = 0u, anda = ~0u, orb = 0u, andb = ~0u;
#pragma unroll
                    for (int jj = 0; jj < 32; ++jj) if (jj < nj) { ora |= ua[jj]; anda &= ua[jj]; orb |= ub[jj]; andb &= ub[jj]; }
#pragma unroll
                    for (int o = 1; o < 64; o <<= 1) { ora |= __shfl_xor(ora, o); anda &= __shfl_xor(anda, o); orb |= __shfl_xor(orb, o); andb &= __shfl_xor(andb, o); }
                    const unsigned dd = __builtin_amdgcn_readfirstlane((ora ^ anda) | (orb ^ andb));
                    start = dd ? 31 - __builtin_clz(dd) : -1;
                    const unsigned keep = (start >= 31) ? 0u : (0xFFFFFFFFu << (start + 1));
                    pa = anda & keep; pb = andb & keep;
                }
#pragma unroll 1
                for (int bit = start; bit >= 0; --bit) {
                    const unsigned ca = da ? pa : (pa | (1u << bit)), cb = db ? pb : (pb | (1u << bit));
                    int cnta = 0, cntb = 0;
#pragma unroll
                    for (int g = 0; g < 8; ++g) if (4 * g < nj) {
#pragma unroll
                        for (int jj = 0; jj < 4; ++jj) { cnta += __popcll(__ballot(ua[4 * g + jj] >= ca)); cntb += __popcll(__ballot(ub[4 * g + jj] >= cb)); }
                    }
                    if (!da && cnta >= 256) { pa = ca; da = (cnta == 256); }
                    if (!db && cntb >= 256) { pb = cb; db = (cntb == 256); }
                    if (da && db) break;
                }
                int cga = 0, cgb = 0;
#pragma unroll
                for (int g = 0; g < 8; ++g) if (4 * g < nj) {
#pragma unroll
                    for (int jj = 0; jj < 4; ++jj) { cga += __popcll(__ballot(ua[4 * g + jj] > pa)); cgb += __popcll(__ballot(ub[4 * g + jj] > pb)); }
                }
                const int needa = 256 - cga, needb = 256 - cgb; int runa = 0, runb = 0;
                const unsigned long long lt = (1ull << lane) - 1ull;
#pragma unroll
                for (int g = 0; g < 8; ++g) if (4 * g < nj) {
#pragma unroll
                    for (int jj = 0; jj < 4; ++jj) {
                        const int e = 4 * g + jj;
                        { const bool eq = (ua[e] == pa); const unsigned long long em = __ballot(eq); const int rank = runa + __popcll(em & lt);
                          const unsigned long long sb2 = __ballot((ua[e] > pa) || (eq && rank < needa)); if (lane == e) maska = sb2; runa += __popcll(em); }
                        { const bool eq = (ub[e] == pb); const unsigned long long em = __ballot(eq); const int rank = runb + __popcll(em & lt);
                          const unsigned long long sb2 = __ballot((ub[e] > pb) || (eq && rank < needb)); if (lane == e) maskb = sb2; runb += __popcll(em); }
                    }
                }
            }
            if (lane < nj) { BM[(rb + q0 + qa) * 32 + lane] = maska; BM[(rb + q0 + qb) * 32 + lane] = maskb; }
        }
        __syncthreads();
    }
#undef IDX_DECODE
#undef IDX_LOADQ
}
DI int mono_i(float f) { const int i = __builtin_bit_cast(int, f); return i ^ ((i >> 31) & 0x7fffffff); }
DI float mono_f(int i) { return __builtin_bit_cast(float, i ^ ((i >> 31) & 0x7fffffff)); }
constexpr int IMIN = (int)0x80000000;

DI void ce_desc(int& a, int& b) { const int hi = max(a, b), lo = min(a, b); a = hi; b = lo; }
template <int B, bool DESC> DI void bitonic_merge16(int (&x)[64]) {
#pragma unroll
    for (int j = 8; j > 0; j >>= 1)
#pragma unroll
        for (int i = 0; i < 16; ++i) { const int l = i ^ j; if (l > i) { if (DESC) ce_desc(x[B + i], x[B + l]); else ce_desc(x[B + l], x[B + i]); } }
}
DI void top16_of_64(int (&x)[64]) {
#pragma unroll
    for (int k = 2; k <= 16; k <<= 1)
#pragma unroll
        for (int j = k >> 1; j > 0; j >>= 1)
#pragma unroll
            for (int i = 0; i < 64; ++i) { const int l = i ^ j; if (l > i) { if ((i & k) == 0) ce_desc(x[i], x[l]); else ce_desc(x[l], x[i]); } }
#pragma unroll
    for (int i = 0; i < 16; ++i) { x[i] = max(x[i], x[16 + i]); x[32 + i] = max(x[32 + i], x[48 + i]); }
    bitonic_merge16<0, true>(x); bitonic_merge16<32, false>(x);
#pragma unroll
    for (int i = 0; i < 16; ++i) x[i] = max(x[i], x[32 + i]);
    bitonic_merge16<0, true>(x);
}

DI void ph_peer_route(const KArgs& a, LAS unsigned char* lds, int tid, int lane, int wave, int blk, int nblk) {
    unsigned char* ws = a.ws;
    const bf16_t* QP = (const bf16_t*)(ws + WS_QP); const bf16_t* SKB = (const bf16_t*)(ws + WS_SKB);
    int* EIDX = (int*)(ws + WS_EIDX); float* GW = (float*)(ws + WS_GW);
    constexpr int SST = 272, SHALF = 128 * SST;
    const int r32 = lane & 31, hi = lane >> 5;
    for (int vb = blk; vb < 256; vb += nblk) {
        const int head = vb & 7, tg = vb >> 3;
        __syncthreads();
        for (int c = tid; c < 4096; c += 512) {
            const int p = c >> 11, key = (c >> 4) & 127, chn = c & 15;
            *(LAS u32x4*)(lds + p * SHALF + key * SST + chn * 16) = *(const u32x4*)(SKB + ((size_t)(head * 2 + p) * 128 + key) * 128 + chn * 8);
        }
        __syncthreads();
        LAS int* Ll = (LAS int*)(lds + 2 * SHALF) + wave * 2048;
        for (int tile = wave; tile < 64; tile += 8) {
            const size_t n0 = (size_t)tg * 2048 + tile * 32;
#pragma unroll 1
            for (int p = 0; p < 2; ++p) {
                int hi4 = 4 * hi; asm volatile("" : "+v"(hi4));
                bf16x8 qf[8];
                { const bf16_t* qp = QP + (n0 + r32) * 2048 + head * 256 + p * 128 + 8 * hi;
#pragma unroll
                  for (int ks = 0; ks < 8; ++ks) qf[ks] = *(const bf16x8*)(qp + 16 * ks); }
                int xi[64];
#pragma unroll
                for (int mt = 0; mt < 4; ++mt) {
                    f32x16 acc;
#pragma unroll
                    for (int r = 0; r < 16; ++r) acc[r] = 0.f;
                    const LAS char* ka = (const LAS char*)lds + p * SHALF + (32 * mt + r32) * SST + hi * 16;
#pragma unroll
                    for (int ks = 0; ks < 8; ++ks) acc = MFMA32(*(const LAS bf16x8*)(ka + ks * 32), qf[ks], acc);
#pragma unroll
                    for (int r = 0; r < 16; ++r) xi[mt * 16 + r] = ((mono_i(acc[r]) & ~127) | hi4) | (32 * mt + (r & 3) + 8 * (r >> 2));
                }
                top16_of_64(xi);
                {
                    int pr[16];
#pragma unroll
                    for (int i = 0; i < 16; ++i) pr[i] = __shfl_xor(xi[15 - i], 32);
#pragma unroll
                    for (int i = 0; i < 16; ++i) xi[i] = max(xi[i], pr[i]);
                    bitonic_merge16<0, true>(xi);
                }
#pragma unroll
                for (int it = 0; it < 16; ++it) Ll[(p * 16 + it) * 64 + lane] = xi[it];
            }
            int cs[64];
            {
                int l0[16], l1[16];
#pragma unroll
                for (int k = 0; k < 16; ++k) { l0[k] = Ll[k * 64 + lane]; l1[k] = Ll[(16 + k) * 64 + lane]; }
                int nc = 0;
#pragma unroll
                for (int ra = 0; ra < 16; ++ra)
#pragma unroll
                    for (int rb2 = 0; rb2 < 16; ++rb2)
                        if ((ra + 1) * (rb2 + 1) <= 16) {
                            const float s = mono_f(l0[ra] & ~127) + mono_f(l1[rb2] & ~127);
                            cs[nc] = (mono_i(s) & ~255) | (255 - (ra * 16 + rb2)); ++nc;
                        }
#pragma unroll
                for (int k = 50; k < 64; ++k) cs[k] = IMIN;
            }
            top16_of_64(cs);
            float sv[16]; int se[16];
#pragma unroll
            for (int it = 0; it < 16; ++it) {
                const int flat = 255 - (cs[it] & 255);
                se[it] = (Ll[(flat >> 4) * 64 + lane] & 127) * 128 + (Ll[(16 + (flat & 15)) * 64 + lane] & 127);
                sv[it] = mono_f(cs[it] & ~255);
            }
            const float smax = sv[0];
            float sum = 0.f;
#pragma unroll
            for (int it = 0; it < 16; ++it) { sv[it] = __expf(sv[it] - smax); sum += sv[it]; }
            const float inv = 1.f / sum;
            if (hi == 0) {
                unsigned short* ep = (unsigned short*)EIDX + (n0 + r32) * 128 + head * 16;
                float* gp = GW + (n0 + r32) * 128 + head * 16;
#pragma unroll
                for (int k = 0; k < 4; ++k) {
                    *(u32x2*)(ep + 4 * k) = (u32x2){(unsigned)se[4 * k] | ((unsigned)se[4 * k + 1] << 16), (unsigned)se[4 * k + 2] | ((unsigned)se[4 * k + 3] << 16)};
                    *(f32x4*)(gp + 4 * k) = (f32x4){sv[4 * k] * inv, sv[4 * k + 1] * inv, sv[4 * k + 2] * inv, sv[4 * k + 3] * inv};
                }
            }
        }
    }
}

DI int dot4z(int a, int b) { int r; asm("v_dot4_i32_i8 %0, %1, %2, 0" : "=v"(r) : "v"(a), "v"(b)); return r; }
DI f32x2 fp8lo(unsigned w) { return __builtin_amdgcn_cvt_pk_f32_fp8((int)w, false); }
DI f32x2 fp8hi(unsigned w) { return __builtin_amdgcn_cvt_pk_f32_fp8((int)w, true); }
constexpr int PEER_CH = 8, PEER_NCH = NTOK / PEER_CH;
constexpr size_t SLICE_BYTES = (size_t)16384 * 128;

template <int STEP>
DI void peer_issue(const unsigned char* tb, unsigned lo16, const LAS int* et, int g, u32x4 (&tv)[16], u32x4 (&hx)[2], f32x4& xr, const unsigned char* hrow, const float* xrow, const float* hsp = nullptr) {
#pragma unroll
    for (int it = 0; it < 16; ++it) tv[it] = *(const u32x4*)(tb + ((unsigned)et[8 * it + g] + lo16));
    if (STEP == 0) { hx[0] = *(const u32x4*)hrow; if (U4) hx[1] = *(const u32x4*)(hrow + (UD8 ? (WS_HB4 - WS_HA4) : 16)); xr.x = *hsp; }
    else if (V4) xr = *(const f32x4*)xrow;
    else { const f32x2 t2 = *(const f32x2*)xrow; xr.x = t2.x; xr.y = t2.y; }
    __builtin_amdgcn_sched_barrier(0);
}

template <int STEP, bool HALFROW = false>
DI void ph_peer_slices(const KArgs& a, LAS unsigned char* lds, int lane, int wave, unsigned xcc) {
    unsigned char* ws = a.ws;
    const unsigned char* H8 = ws + WS_H8; const float* HS = (const float*)(ws + WS_HS); const unsigned char* U8 = ws + WS_UB; const unsigned char* V8 = ws + WS_VB;
    const float usc = __builtin_bit_cast(float, ((const unsigned*)(ws + WS_CTL))[CW_UMAX]) * (U4 ? (UD8 ? U4_STEP : U4_STEP * (1.f / 16.f)) : 1.f / 127.f);
    constexpr bool UQ = (STEP == 0) && U4, VQ = (STEP == 2) && V4, Q4 = UQ || VQ;
    const unsigned short* EIDX = (const unsigned short*)(ws + WS_EIDX); const float* mod = (const float*)(ws + WS_MOD);
    _Float16* PART = (_Float16*)(ws + WS_PART); const _Float16* W = (const _Float16*)(ws + WS_WGT);
    unsigned* ctr = (unsigned*)(ws + WS_CTL) + 8192 + (STEP ? 1024 : 0);
    float* out = a.out;
    LAS int* e_l = (LAS int*)(lds + wave * 16896);
    LAS _Float16* w_l = (LAS _Float16*)(e_l + 1024);
    LAS float* a_l = (LAS float*)(e_l + 2048);
    LAS float* red = a_l + 128;
    const int g = lane >> 3, s8 = lane & 7;
    for (int ds = 0; ds < (Q4 ? 4 : 8); ++ds) {
        const int s = (int)((xcc + ds) & (Q4 ? 3u : 7u));
        const unsigned char* tb = (STEP ? V8 : U8) + (size_t)s * SLICE_BYTES;
        const unsigned lo16 = (unsigned)(HALFROW ? (s8 & 3) : s8) * 16u;
        unsigned cn = 0;
        if (lane == 0) cn = __hip_atomic_fetch_add(ctr + 64 * s, 1u, __ATOMIC_RELAXED, __HIP_MEMORY_SCOPE_AGENT);
        cn = __builtin_amdgcn_readfirstlane(cn);
        u32x2 pe[4], pw[4];
        if (cn < (unsigned)PEER_NCH) {
#pragma unroll
            for (int q = 0; q < 4; ++q) { pe[q] = *(const u32x2*)(EIDX + (size_t)cn * PEER_CH * 128 + lane * 4 + 256 * q); if (STEP) pw[q] = *(const u32x2*)(W + (size_t)cn * PEER_CH * 128 + lane * 4 + 256 * q); }
        }
        for (;;) {
            const unsigned c = cn;
            if (c >= (unsigned)PEER_NCH) break;
#pragma unroll
            for (int q = 0; q < 4; ++q) { *(LAS u32x4*)(e_l + lane * 4 + 256 * q) = (u32x4){(pe[q].x & 0xffffu) << 7, (pe[q].x >> 16) << 7, (pe[q].y & 0xffffu) << 7, (pe[q].y >> 16) << 7}; if (STEP) *(LAS u32x2*)(w_l + lane * 4 + 256 * q) = pw[q]; }
            if (lane == 0) cn = __hip_atomic_fetch_add(ctr + 64 * s, 1u, __ATOMIC_RELAXED, __HIP_MEMORY_SCOPE_AGENT);
            cn = __builtin_amdgcn_readfirstlane(cn);
            if (cn < (unsigned)PEER_NCH) {
#pragma unroll
                for (int q = 0; q < 4; ++q) { pe[q] = *(const u32x2*)(EIDX + (size_t)cn * PEER_CH * 128 + lane * 4 + 256 * q); if (STEP) pw[q] = *(const u32x2*)(W + (size_t)cn * PEER_CH * 128 + lane * 4 + 256 * q); }
            }
            LDS_WAIT();
            const int n0 = (int)c * PEER_CH;
            const int b = n0 / NT;
            f32x2 gv2 = {0.f, 0.f}; f32x4 gv4 = {0.f, 0.f, 0.f, 0.f};
            if (VQ) gv4 = *(const f32x4*)(mod + (size_t)b * 6144 + 5120 + s * 256 + 4 * lane) * (1.f / V4_WSC);
            else if (STEP) gv2 = *(const f32x2*)(mod + (size_t)b * 6144 + 5120 + s * 128 + 2 * lane);
            u32x4 tvA[16], tvB[16], hA[2], hB[2]; f32x4 xA = {0.f, 0.f, 0.f, 0.f}, xB = {0.f, 0.f, 0.f, 0.f};
#define PEER_HROW(t) ((UQ && UD8) ? (ws + WS_HA4 + (size_t)(n0 + (t)) * 512 + s * 128 + s8 * 16) : (H8 + (size_t)(n0 + (t)) * 1024 + s * (UQ ? 256 : 128) + s8 * (UQ ? 32 : 16)))
#define PEER_XROW(t) (out + (size_t)(n0 + (t)) * 1024 + (VQ ? s * 256 + 4 * lane : s * 128 + 2 * lane))
#define PEER_COMPUTE(t, tv, hx, xr) do { \
            if (UQ) { \
                LAS int* redi = (LAS int*)red; \
                if (UD8) { \
                _Pragma("unroll") for (int it = 0; it < 16; ++it) {     \
                    int da = __builtin_amdgcn_sdot8((int)tv[it].x, (int)hx[0].x, 0, false), db = __builtin_amdgcn_sdot8((int)tv[it].x, (int)hx[1].x, 0, false); \
                    da = __builtin_amdgcn_sdot8((int)tv[it].y, (int)hx[0].y, da, false); db = __builtin_amdgcn_sdot8((int)tv[it].y, (int)hx[1].y, db, false); \
                    da = __builtin_amdgcn_sdot8((int)tv[it].z, (int)hx[0].z, da, false); db = __builtin_amdgcn_sdot8((int)tv[it].z, (int)hx[1].z, db, false); \
                    da = __builtin_amdgcn_sdot8((int)tv[it].w, (int)hx[0].w, da, false); db = __builtin_amdgcn_sdot8((int)tv[it].w, (int)hx[1].w, db, false); \
                    redi[it * 64 + lane] = 16 * da + db; \
                } \
                } else \
                _Pragma("unroll") for (int it = 0; it < 16; ++it) { \
                    int d0 = dot4z((int)((tv[it].x << 4) & 0xF0F0F0F0u), (int)hx[0].x), d1 = dot4z((int)((tv[it].y << 4) & 0xF0F0F0F0u), (int)hx[0].y); \
                    d0 = __builtin_amdgcn_sdot4((int)((tv[it].z << 4) & 0xF0F0F0F0u), (int)hx[0].z, d0, false); d1 = __builtin_amdgcn_sdot4((int)((tv[it].w << 4) & 0xF0F0F0F0u), (int)hx[0].w, d1, false); \
                    d0 = __builtin_amdgcn_sdot4((int)(tv[it].x & 0xF0F0F0F0u), (int)hx[1].x, d0, false); d1 = __builtin_amdgcn_sdot4((int)(tv[it].y & 0xF0F0F0F0u), (int)hx[1].y, d1, false); \
                    d0 = __builtin_amdgcn_sdot4((int)(tv[it].z & 0xF0F0F0F0u), (int)hx[1].z, d0, false); d1 = __builtin_amdgcn_sdot4((int)(tv[it].w & 0xF0F0F0F0u), (int)hx[1].w, d1, false); \
                    redi[it * 64 + lane] = d0 + d1;                      \
                } \
                LDS_WAIT(); \
                _Float16* pp = PART + ((size_t)s * NTOK + n0 + (t)) * 128; \
                { typedef int i32x4 __attribute__((ext_vector_type(4))); \
                  const i32x4 r0 = *(const LAS i32x4*)(redi + 8 * lane), r1 = *(const LAS i32x4*)(redi + 8 * lane + 4), r2 = *(const LAS i32x4*)(redi + 512 + 8 * lane), r3 = *(const LAS i32x4*)(redi + 512 + 8 * lane + 4); \
                  const float sc_ = xr.x * usc; \
                  pp[lane] = (_Float16)((float)(((r0[0] + r0[1]) + (r0[2] + r0[3])) + ((r1[0] + r1[1]) + (r1[2] + r1[3]))) * sc_); \
                  pp[64 + lane] = (_Float16)((float)(((r2[0] + r2[1]) + (r2[2] + r2[3])) + ((r3[0] + r3[1]) + (r3[2] + r3[3]))) * sc_); } \
                LDS_WAIT(); \
            } else if (STEP == 0) { \
                LAS int* redi = (LAS int*)red; \
                _Pragma("unroll") for (int it = 0; it < 16; ++it) { \
                    int d0 = dot4z((int)tv[it].x, (int)hx[0].x), d1 = dot4z((int)tv[it].y, (int)hx[0].y);        \
                    d0 = __builtin_amdgcn_sdot4((int)tv[it].z, (int)hx[0].z, d0, false); d1 = __builtin_amdgcn_sdot4((int)tv[it].w, (int)hx[0].w, d1, false); \
                    redi[it * 64 + lane] = d0 + d1;                      \
                } \
                LDS_WAIT(); \
                _Float16* pp = PART + ((size_t)s * NTOK + n0 + (t)) * 128; \
                { typedef int i32x4 __attribute__((ext_vector_type(4))); \
                  const i32x4 r0 = *(const LAS i32x4*)(redi + 8 * lane), r1 = *(const LAS i32x4*)(redi + 8 * lane + 4), r2 = *(const LAS i32x4*)(redi + 512 + 8 * lane), r3 = *(const LAS i32x4*)(redi + 512 + 8 * lane + 4); \
                  const float sc_ = xr.x * usc; \
                  pp[lane] = (_Float16)((float)(((r0[0] + r0[1]) + (r0[2] + r0[3])) + ((r1[0] + r1[1]) + (r1[2] + r1[3]))) * sc_); \
                  pp[64 + lane] = (_Float16)((float)(((r2[0] + r2[1]) + (r2[2] + r2[3])) + ((r3[0] + r3[1]) + (r3[2] + r3[3]))) * sc_); } \
                LDS_WAIT(); \
            } else if (VQ) { \
                h16x2 acc[16]; \
                _Pragma("unroll") for (int k = 0; k < 16; ++k) acc[k] = (h16x2){(_Float16)0.f, (_Float16)0.f}; \
                _Pragma("unroll") for (int it = 0; it < 16; ++it) { \
                    const _Float16 wh = w_l[(t) * 128 + 8 * it + g]; const h16x2 w2 = {wh, wh}; \
                    _Pragma("unroll") for (int k = 0; k < 4; ++k) { \
                        acc[4 * k] += __builtin_amdgcn_cvt_scalef32_pk_f16_fp4(tv[it][k], 1.0f, 0) * w2; acc[4 * k + 1] += __builtin_amdgcn_cvt_scalef32_pk_f16_fp4(tv[it][k], 1.0f, 1) * w2; \
                        acc[4 * k + 2] += __builtin_amdgcn_cvt_scalef32_pk_f16_fp4(tv[it][k], 1.0f, 2) * w2; acc[4 * k + 3] += __builtin_amdgcn_cvt_scalef32_pk_f16_fp4(tv[it][k], 1.0f, 3) * w2; } \
                } \
                LAS _Float16* redh = (LAS _Float16*)red;                  \
                LAS h16x8* rp = (LAS h16x8*)(redh + g * 256 + s8 * 32); \
                _Pragma("unroll") for (int i = 0; i < 4; ++i) rp[i] = (h16x8){acc[4 * i].x, acc[4 * i].y, acc[4 * i + 1].x, acc[4 * i + 1].y, acc[4 * i + 2].x, acc[4 * i + 2].y, acc[4 * i + 3].x, acc[4 * i + 3].y}; \
                LDS_WAIT(); \
                f32x4 sum = {0.f, 0.f, 0.f, 0.f}; \
                _Pragma("unroll") for (int q = 0; q < 8; ++q) { const h16x4 p4 = *(const LAS h16x4*)(redh + q * 256 + 4 * lane); sum += (f32x4){(float)p4.x, (float)p4.y, (float)p4.z, (float)p4.w}; } \
                *(f32x4*)(out + (size_t)(n0 + (t)) * 1024 + s * 256 + 4 * lane) = xr + gv4 * sum; \
                LDS_WAIT(); \
            } else { \
                f32x2 acc[8]; \
                _Pragma("unroll") for (int k = 0; k < 8; ++k) acc[k] = (f32x2){0.f, 0.f}; \
                _Pragma("unroll") for (int it = 0; it < 16; ++it) { \
                    const float w = (float)w_l[(t) * 128 + 8 * it + g]; \
                    acc[0] += fp8lo(tv[it].x) * w; acc[1] += fp8hi(tv[it].x) * w; acc[2] += fp8lo(tv[it].y) * w; acc[3] += fp8hi(tv[it].y) * w; \
                    acc[4] += fp8lo(tv[it].z) * w; acc[5] += fp8hi(tv[it].z) * w; acc[6] += fp8lo(tv[it].w) * w; acc[7] += fp8hi(tv[it].w) * w; \
                } \
                LAS f32x4* rp = (LAS f32x4*)(red + g * 128 + s8 * 16); \
                rp[0] = (f32x4){acc[0].x, acc[0].y, acc[1].x, acc[1].y}; rp[1] = (f32x4){acc[2].x, acc[2].y, acc[3].x, acc[3].y}; \
                rp[2] = (f32x4){acc[4].x, acc[4].y, acc[5].x, acc[5].y}; rp[3] = (f32x4){acc[6].x, acc[6].y, acc[7].x, acc[7].y}; \
                LDS_WAIT(); \
                f32x2 sum = {0.f, 0.f}; \
                _Pragma("unroll") for (int q = 0; q < 8; ++q) sum += *(const LAS f32x2*)(red + q * 128 + 2 * lane); \
                *(f32x2*)(out + (size_t)(n0 + (t)) * 1024 + s * 128 + 2 * lane) = (f32x2){xr.x, xr.y} + gv2 * sum; \
                LDS_WAIT(); \
            } \
            __builtin_amdgcn_sched_barrier(0); } while (0)
            peer_issue<STEP>(tb, lo16, e_l, g, tvA, hA, xA, PEER_HROW(0), PEER_XROW(0), HS + n0);
#pragma unroll 1
            for (int t = 0; t < PEER_CH - 2; t += 2) {
                peer_issue<STEP>(tb, lo16, e_l + (t + 1) * 128, g, tvB, hB, xB, PEER_HROW(t + 1), PEER_XROW(t + 1), HS + n0 + t + 1);
                PEER_COMPUTE(t, tvA, hA, xA);
                peer_issue<STEP>(tb, lo16, e_l + (t + 2) * 128, g, tvA, hA, xA, PEER_HROW(t + 2), PEER_XROW(t + 2), HS + n0 + t + 2);
                PEER_COMPUTE(t + 1, tvB, hB, xB);
            }
            peer_issue<STEP>(tb, lo16, e_l + (PEER_CH - 1) * 128, g, tvB, hB, xB, PEER_HROW(PEER_CH - 1), PEER_XROW(PEER_CH - 1), HS + n0 + PEER_CH - 1);
            PEER_COMPUTE(PEER_CH - 2, tvA, hA, xA);
            PEER_COMPUTE(PEER_CH - 1, tvB, hB, xB);
#undef PEER_HROW
#undef PEER_XROW
#undef PEER_COMPUTE
        }
    }
}

DI void ph_peer_combine(const KArgs& a, int tid, int blk, int nblk) {
    unsigned char* ws = a.ws;
    const _Float16* PART = (const _Float16*)(ws + WS_PART); const float* GW = (const float*)(ws + WS_GW); _Float16* W = (_Float16*)(ws + WS_WGT);
    const size_t total = (size_t)NTOK * 128 / 4;
    const float vsc = V4 ? __builtin_bit_cast(float, ((const unsigned*)(ws + WS_CTL))[CW_VMAX]) * (V4_S * V4_WSC) : 1.f / VSCALE;
    constexpr int NS = U4 ? 4 : 8;
    h16x4 pn[NS]; f32x4 gn = {0.f, 0.f, 0.f, 0.f};
    const size_t i0 = (size_t)blk * 512 + tid, st = (size_t)nblk * 512;
    if (i0 < total) {
#pragma unroll
        for (int k = 0; k < NS; ++k) pn[k] = *(const h16x4*)(PART + (size_t)k * NTOK * 128 + 4 * i0);
        gn = *(const f32x4*)(GW + 4 * i0);
    }
    for (size_t i = i0; i < total; i += st) {
        f32x4 s = {0.f, 0.f, 0.f, 0.f};
#pragma unroll
        for (int k = 0; k < NS; ++k) s += (f32x4){(float)pn[k].x, (float)pn[k].y, (float)pn[k].z, (float)pn[k].w};
        const f32x4 gq = gn;
        if (i + st < total) {
#pragma unroll
            for (int k = 0; k < NS; ++k) pn[k] = *(const h16x4*)(PART + (size_t)k * NTOK * 128 + 4 * (i + st));
            gn = *(const f32x4*)(GW + 4 * (i + st));
        }
        f32x4 r;
#pragma unroll
        for (int k = 0; k < 4; ++k) r[k] = gq[k] * 0.5f * s[k] * (1.f + erff(s[k] * 0.70710678118654752f)) * vsc;
        *(h16x4*)(W + 4 * i) = (h16x4){(_Float16)r[0], (_Float16)r[1], (_Float16)r[2], (_Float16)r[3]};
    }
}
#ifndef MK_ONE_LAUNCH
#define MK_ONE_LAUNCH 1
#endif
constexpr int N_PHASES = 12;
#ifndef MK_DUP
#define MK_DUP 0
#endif
#ifndef MK_PREFIX
#define MK_PREFIX -1
#endif
#define PROGRAM() \
    if (IN(0)) { LAUNDER ph_prologue(a, lds, tid, lane, wave, blk, nblk); } \
    SEAM(0); \
    if (IN(1)) { LAUNDER { const float um = __builtin_bit_cast(float, ((const unsigned*)(ws + WS_CTL))[CW_UMAX]); if (U4) conv_u_i4(a.peer_u, ws + WS_UB, 1.f / (U4_STEP * fmaxf(um, 1e-30f)), (size_t)blk * 512 + tid, (size_t)nblk * 512); else conv_u_i8(a.peer_u, ws + WS_UB, 127.f / fmaxf(um, 1e-30f), (size_t)blk * 512 + tid, (size_t)nblk * 512); } if (V4) { const float vm = __builtin_bit_cast(float, ((const unsigned*)(ws + WS_CTL))[CW_VMAX]); conv_v_fp4(a.peer_v, ws + WS_VB, 1.f / (V4_S * fmaxf(vm, 1e-30f)), (size_t)blk * 512 + tid, (size_t)nblk * 512); } ph_weights8(a, lds, lane, wave, blk, nblk); ph_norm<(N8_IN > 0 && IN_MODE == 2), (NB_IN > 0), (N8_IN > 0 && IN_MODE == 1)>(a.x, a.norm1_g, mod, 0, 1024, (bf16_t*)(ws + WS_H), ws + WS_HF8, ws + WS_HF8, (float*)(ws + WS_HS1), lane, wave, blk, nblk); } \
    SEAM(1); \
    if (IN(2)) { LAUNDER \
        if (N8_IN > 0) { \
            pg8::Gemm g{(const bf16_t*)(ws + WS_HF8), (const bf16_t*)(ws + WS_WIN8), NTOK, N8_IN * 256, 512}; \
            pg8::StaticOrder S; S.init(NTOK, N8_IN * 256, nblk, blk); \
            EpiProjT<IN_MODE> E{(bf16_t*)(ws + WS_QD), (bf16_t*)(ws + WS_KD), (bf16_t*)(ws + WS_VD), (bf16_t*)(ws + WS_QS), (bf16_t*)(ws + WS_QI), (bf16_t*)(ws + WS_KS), (bf16_t*)(ws + WS_VS), \
                      (bf16_t*)(ws + WS_KI), (bf16_t*)(ws + WS_G0), (bf16_t*)(ws + WS_G1), (float*)(ws + WS_WIDX), (const float*)(ws + WS_COS), (const float*)(ws + WS_SIN), \
                      a.diff_q_g, a.diff_k_g, a.dsa_q_g, a.dsa_k_g, (const unsigned*)(ws + WS_CTL) + CW_WMAX + 0, (const float*)(ws + WS_HS1)}; \
            pg8::gemm_phase<EpiProjT<IN_MODE>, pg8::StaticOrder, true, true, IN_MODE>(lds, g, S, E); \
        } \
        if (NB_IN > 0) { \
            pg8::Gemm g{(const bf16_t*)(ws + WS_H), (const bf16_t*)(ws + WS_WIN), NTOK, NB_IN * 256, 1024}; \
            pg8::StaticOrder S; S.init(NTOK, NB_IN * 256, nblk, blk); \
            EpiProjT<0> E{(bf16_t*)(ws + WS_QD), (bf16_t*)(ws + WS_KD), (bf16_t*)(ws + WS_VD), (bf16_t*)(ws + WS_QS), (bf16_t*)(ws + WS_QI), (bf16_t*)(ws + WS_KS), (bf16_t*)(ws + WS_VS), \
                      (bf16_t*)(ws + WS_KI), (bf16_t*)(ws + WS_G0), (bf16_t*)(ws + WS_G1), (float*)(ws + WS_WIDX), (const float*)(ws + WS_COS), (const float*)(ws + WS_SIN), \
                      a.diff_q_g, a.diff_k_g, a.dsa_q_g, a.dsa_k_g, nullptr, nullptr}; \
            pg8::gemm_phase<EpiProjT<0>, pg8::StaticOrder, true, true, 0>(lds, g, S, E); \
        } \
    } \
    SEAM(2); \
    if (IN(3)) { LAUNDER ph_indexer(a, lds, tid, lane, wave, blk, nblk); if (MK_DUP == 30) ph_indexer(a, lds, tid, lane, wave, blk, nblk); if (MK_DUP == 31) ph_indexer<false>(a, lds, tid, lane, wave, blk, nblk); ph_diff_attn(a, lds, tid, lane, wave, blk, nblk); } \
    SEAM(3); \
    if (IN(4)) { LAUNDER if (MK_DUP == 41) ph_dsa_attn<1>(a, lds, tid, lane, wave, blk, nblk); if (MK_DUP == 42) ph_dsa_attn<2>(a, lds, tid, lane, wave, blk, nblk); ph_dsa_attn<0>(a, lds, tid, lane, wave, blk, nblk); } \
    SEAM(4); \
    if (IN(5) && FUSE56) { LAUNDER \
        pg8::Gemm g{(const bf16_t*)(ws + WS_OAB), (const bf16_t*)(ws + WS_WBA), NTOK, 1024, 1024}; \
        pg8::StaticOrder S; S.init(NTOK, 1024, nblk, blk); \
        EpiMerged E{ws + WS_G0, ws + WS_G1, (bf16_t*)(ws + WS_MERGED), ws + WS_MERGED8}; \
        pg8::gemm_phase<EpiMerged, pg8::StaticOrder, true, true, 0>(lds, g, S, E); \
    } \
    if (IN(5) && !FUSE56) { LAUNDER \
        pg8::Gemm g{(const bf16_t*)(ws + WS_OAB), (const bf16_t*)(ws + WS_WBA), NTOK, 1024, (F8_BR || BR8) ? 256 : 512}; \
        pg8::StaticOrder S; S.init(NTOK, 1024, nblk, blk); \
        EpiGate<0> E{(const bf16_t*)(ws + WS_G0), (bf16_t*)(ws + WS_MERGED), (const unsigned*)(ws + WS_CTL) + CW_WMAX + 1, nullptr, nullptr}; \
        pg8::gemm_phase<EpiGate<0>, pg8::StaticOrder, true, true, F8_BR ? 1 : BR8 ? 2 : 0>(lds, g, S, E); \
    } \
    SEAM(5); \
    if (IN(6) && !FUSE56) { LAUNDER \
        pg8::Gemm g{(const bf16_t*)(ws + WS_OAB + (size_t)NTOK * 512 * ((F8_BR || BR8) ? 1 : 2)), (const bf16_t*)(ws + WS_WBB), NTOK, 1024, (F8_BR || BR8) ? 256 : 512}; \
        pg8::StaticOrder S; S.init(NTOK, 1024, nblk, blk); \
        EpiGate<1> E{(const bf16_t*)(ws + WS_G1), (bf16_t*)(ws + WS_MERGED), (const unsigned*)(ws + WS_CTL) + CW_WMAX + 2, ws + WS_MERGED8, (const float*)(ws + WS_OBS)}; \
        pg8::gemm_phase<EpiGate<1>, pg8::StaticOrder, true, true, F8_BR ? 1 : BR8 ? 2 : 0>(lds, g, S, E); \
    } \
    SEAM(6); \
    if (IN(7)) { LAUNDER \
        pg8::Gemm g{(const bf16_t*)(ws + ((F8_BR || F8_OUT) ? WS_MERGED8 : WS_MERGED)), (const bf16_t*)(ws + WS_WOUT), NTOK, 1024, (F8_BR || F8_OUT) ? 512 : 1024}; \
        pg8::StaticOrder S; S.init(NTOK, 1024, nblk, blk); \
        EpiResid E{a.x, mod, a.out, (F8_BR || F8_OUT) ? 1.f / (ASC8 * wscale8(ws, 3)) : 1.f}; \
        pg8::gemm_phase<EpiResid, pg8::StaticOrder, true, true, (F8_BR || F8_OUT) ? 1 : 0>(lds, g, S, E); \
    } \
    SEAM(7); \
    if (IN(8)) { LAUNDER ph_norm<true, PQ_MODE == 0, PQ_MODE == 1, UD8>(a.out, a.norm2_g, mod, 3072, 4096, (bf16_t*)(ws + WS_H), ws + WS_H, ws + WS_H8, (float*)(ws + WS_HS), lane, wave, blk, nblk, ws + WS_HA4, ws + WS_HB4); } \
    SEAM(8); \
    if (IN(9)) { LAUNDER \
        pg8::Gemm g{(const bf16_t*)(ws + (PQ_MODE == 2 ? WS_H8 : WS_H)), (const bf16_t*)(ws + WS_WPQ), NTOK, 2048, PQ_MODE ? 512 : 1024}; \
        pg8::StaticOrder S; S.init(NTOK, 2048, nblk, blk); \
        if (PQ_MODE == 2) { EpiPlainI8 E{(bf16_t*)(ws + WS_QP), 2048, (const float*)(ws + WS_HS), (const unsigned*)(ws + WS_CTL) + CW_WMAX + 4}; pg8::gemm_phase<EpiPlainI8, pg8::StaticOrder, true, true, 2>(lds, g, S, E); } \
        else { EpiPlain E{(bf16_t*)(ws + WS_QP), 2048, F8_PQ ? 1.f / (ASC8 * wscale8(ws, 4)) : 1.f}; pg8::gemm_phase<EpiPlain, pg8::StaticOrder, true, true, (PQ_MODE == 1 ? 1 : 0)>(lds, g, S, E); } \
    } \
    SEAM(9); \
    if (IN(10)) { LAUNDER ph_peer_route(a, lds, tid, lane, wave, blk, nblk); } \
    SEAM(10); \
    if (IN(11)) { LAUNDER if (MK_DUP == 111 || MK_DUP == 112) { if (MK_DUP == 111) ph_peer_slices<0, true>(a, lds, lane, wave, xbar.x); else ph_peer_slices<0, false>(a, lds, lane, wave, xbar.x); xcd_barrier(xbar); if (tid == 0 && blk == 0) { for (int q = 0; q < 8; ++q) ((unsigned*)(ws + WS_CTL))[8192 + 64 * q] = 0u; } xcd_barrier(xbar); } ph_peer_slices<0>(a, lds, lane, wave, xbar.x); xcd_barrier(xbar); if (MK_DUP == 110) { if (tid == 0 && blk == 0) { for (int q = 0; q < 8; ++q) ((unsigned*)(ws + WS_CTL))[8192 + 64 * q] = 0u; } xcd_barrier(xbar); ph_peer_slices<0>(a, lds, lane, wave, xbar.x); xcd_barrier(xbar); } ph_peer_combine(a, tid, blk, nblk); xcd_barrier(xbar); ph_peer_slices<2>(a, lds, lane, wave, xbar.x); }
__global__ void __launch_bounds__(512, 2) mk_fwd(KArgs a) {
    extern __shared__ __attribute__((aligned(16))) unsigned char lds_raw[];
    LAS unsigned char* lds = (LAS unsigned char*)lds_raw;
    const int tid0 = threadIdx.x, wave = __builtin_amdgcn_readfirstlane(tid0 >> 6);
    const int blk = blockIdx.x, nblk = gridDim.x;
    unsigned char* ws = a.ws;
    int lo = a.ph_lo, hi = a.ph_hi;
    volatile LAS unsigned* xst = (volatile LAS unsigned*)(lds + LDS_BYTES - 64);
    if (tid0 < 2) xst[tid0] = 0u;
    __syncthreads();
    XcdBarrier xbar = xcd_barrier_post((unsigned*)(ws + WS_CTL) + 4096, xst);
#ifndef MK_ONLY
#define MK_ONLY -1
#endif
#ifndef MK_MASK
#define MK_MASK 0xFFF
#endif
#define IN(k) ((MK_ONLY < 0 || MK_ONLY == (k)) && ((MK_MASK >> (k)) & 1) && lo <= (k) && (k) < hi)
#define LAUNDER int tid_l = tid0; asm volatile("" : "+v"(tid_l)); const int tid = tid_l, lane = tid_l & 63; (void)tid; (void)lane;
#define SEAM(k) do { if (IN(k) && IN((k) + 1) && !(FUSE56 && (k) == 5)) { if ((k) == 0) cg::this_grid().sync(); else xcd_barrier(xbar); } } while (0)
    const float* mod = (const float*)(ws + WS_MOD);
#if MK_PREFIX >= 0
    hi = MK_PREFIX + 1;
    PROGRAM()
    xcd_barrier(xbar);
    hi = a.ph_hi;
#endif
    PROGRAM()
#undef IN
#undef SEAM
}

extern "C" void kernel_launch(void* const* d_in, const int* in_sizes, int n_in, void* d_out, int out_size, void* d_ws, size_t ws_size, hipStream_t stream) {
    static int grid = 0;
    if (grid == 0) {
        if (n_in != 24 || in_sizes[0] != NTOK * DM || out_size != NTOK * DM || ws_size < WS_END) {
            fprintf(stderr, "kernel_launch: unexpected problem (n_in %d, in0 %d, out %d, ws %zu)\n", n_in, n_in > 0 ? in_sizes[0] : -1, out_size, ws_size); grid = -1; return; }
        int dev = 0, cus = 0, per_cu = 0;
        if (hipGetDevice(&dev) != hipSuccess || hipDeviceGetAttribute(&cus, hipDeviceAttributeMultiprocessorCount, dev) != hipSuccess) { grid = -1; return; }
        if (hipFuncSetAttribute((const void*)mk_fwd, hipFuncAttributeMaxDynamicSharedMemorySize, LDS_BYTES) != hipSuccess) { fprintf(stderr, "kernel_launch: hipFuncSetAttribute failed\n"); grid = -1; return; }
        if (hipOccupancyMaxActiveBlocksPerMultiprocessor(&per_cu, (const void*)mk_fwd, 512, LDS_BYTES) != hipSuccess || per_cu < 1) { fprintf(stderr, "kernel_launch: occupancy query says %d\n", per_cu); }
        (void)hipGetLastError();
        grid = cus;
    }
    if (grid < 0) return;
    if (hipMemsetAsync((char*)d_ws + WS_CTL, 0, 65536, stream) != hipSuccess) { fprintf(stderr, "kernel_launch: memset of the control words failed\n"); return; }
    KArgs a{};
    const float** fp = (const float**)&a;
    for (int i = 0; i < 24; ++i) fp[i] = (const float*)d_in[i];
    a.out = (float*)d_out; a.ws = (unsigned char*)d_ws;
#if MK_ONE_LAUNCH
    a.ph_lo = 0; a.ph_hi = N_PHASES;
    void* args[] = {&a};
    hipError_t e = hipLaunchCooperativeKernel((const void*)mk_fwd, dim3(grid), dim3(512), args, LDS_BYTES, stream);
    if (e != hipSuccess) fprintf(stderr, "kernel_launch: cooperative launch failed: %s (grid %d)\n", hipGetErrorString(e), grid);
#else
    for (int p = 0; p < N_PHASES; ++p) {
        a.ph_lo = p; a.ph_hi = p + 1;
        hipLaunchKernelGGL(mk_fwd, dim3(grid), dim3(512), LDS_BYTES, stream, a);
    }
#endif
}
```

```cpp
#include <hip/hip_runtime.h>
#include <hip/hip_cooperative_groups.h>
#include <cstdio>
#include <cstdint>
namespace cg = cooperative_groups;

#define LAS __attribute__((address_space(3)))
#define DI __device__ __forceinline__
typedef unsigned short bf16_t;
typedef short bf16x8 __attribute__((ext_vector_type(8)));
typedef short s16x4 __attribute__((ext_vector_type(4)));
typedef float f32x2 __attribute__((ext_vector_type(2)));
typedef float f32x4 __attribute__((ext_vector_type(4)));
typedef float f32x16 __attribute__((ext_vector_type(16)));
typedef unsigned u32x2 __attribute__((ext_vector_type(2)));
typedef unsigned u32x4 __attribute__((ext_vector_type(4)));
typedef __bf16 bf16x2_t __attribute__((ext_vector_type(2)));
typedef int i32x8 __attribute__((ext_vector_type(8)));

constexpr int NB = 32, NT = 2048, DM = 1024, NTOK = NB * NT;
constexpr int NPROJ = 4864;
constexpr int WIN_COLS = 4808;
constexpr float EPS = 1e-6f;
constexpr float QSCALE = 0.125f * 1.4426950408889634f;
constexpr float USCALE = 64.f, VSCALE = 4.f;
constexpr float LAMBDA_INIT = 0.2f;
constexpr int PQ_MODE = 2;
constexpr bool F8_PQ = (PQ_MODE == 1);
constexpr bool F8_BR = false;
constexpr bool U4 = true;
constexpr float U4_STEP = 0.0657f;
constexpr bool UD8 = true;
constexpr bool V4 = true;
constexpr float V4_S = 0.098f;
constexpr float V4_WSC = 64.f;
typedef _Float16 h16x2 __attribute__((ext_vector_type(2)));
typedef _Float16 h16x4 __attribute__((ext_vector_type(4)));
typedef _Float16 h16x8 __attribute__((ext_vector_type(8)));
constexpr bool BR8 = false;
constexpr float OA_MAX = 5.0f;
constexpr bool F8_OUT = true;
constexpr bool FUSE56 = true;
constexpr bool G8 = true;
constexpr int IN_MODE = 2;
constexpr unsigned IN8_MASK = 0x7FFFFu;
constexpr int N8_IN = __builtin_popcount(IN8_MASK), NB_IN = 19 - N8_IN;

constexpr size_t MiB = 1u << 20;
constexpr size_t WS_CTL = 0;
constexpr size_t WS_MOD = 1 * MiB;
constexpr size_t WS_COS = 2 * MiB;
constexpr size_t WS_SIN = 10 * MiB;
constexpr size_t WS_WIN = 18 * MiB;
constexpr size_t WS_WBA = 28 * MiB;
constexpr size_t WS_WBB = 29 * MiB;
constexpr size_t WS_WOUT = 30 * MiB;
constexpr size_t WS_WPQ = 32 * MiB;
constexpr size_t WS_SKB = 36 * MiB;
constexpr size_t WS_UB = 40 * MiB;
constexpr size_t WS_VB = 72 * MiB;
constexpr size_t WS_H = 104 * MiB;
constexpr size_t WS_QD = 232 * MiB;
constexpr size_t WS_KD = 296 * MiB;
constexpr size_t WS_VD = 360 * MiB;
constexpr size_t WS_QS = 424 * MiB;
constexpr size_t WS_QI = 488 * MiB;
constexpr size_t WS_KS = 552 * MiB;
constexpr size_t WS_VS = 560 * MiB;
constexpr size_t WS_KI = 568 * MiB;
constexpr size_t WS_WIDX = 576 * MiB;
constexpr size_t WS_G0 = 578 * MiB;
constexpr size_t WS_G1 = 706 * MiB;
constexpr size_t WS_BM = 834 * MiB;
constexpr size_t WS_OAB = 850 * MiB;
constexpr size_t WS_END = 978 * MiB;
constexpr size_t WS_MERGED = WS_QD;
constexpr size_t WS_QP = WS_VD;
constexpr size_t WS_EIDX = 616 * MiB;
constexpr size_t WS_GW = 648 * MiB;
constexpr size_t WS_PART = WS_QP;
constexpr size_t WS_WGT = WS_MERGED;
constexpr size_t WS_WIN8 = WS_WIN + (size_t)NB_IN * 256 * 1024 * 2;
constexpr size_t WS_HF8 = WS_OAB;
constexpr size_t WS_HS1 = WS_OAB + 64 * MiB;
constexpr size_t WS_HA4 = WS_H;
constexpr size_t WS_HB4 = WS_H + 32 * MiB;
constexpr size_t WS_OBS = WS_OAB + 96 * MiB;
constexpr size_t WS_MERGED8 = WS_VD;
constexpr size_t WS_H8 = 264 * MiB;
constexpr size_t WS_HS = 328 * MiB;
constexpr int CW_UMAX = 12288;
constexpr int CW_VMAX = 12289;
constexpr int CW_WMAX = 12296;
constexpr float ASC8 = 16.f, WTOP8 = 224.f;
static_assert(WS_QP + (size_t)NTOK * 2048 * 2 <= WS_EIDX, "ws map");
static_assert(WS_GW + (size_t)NTOK * 128 * 4 <= WS_BM, "ws map");

constexpr int LDS_BYTES = 163840;

DI unsigned f2bf(float f) { unsigned u = __builtin_bit_cast(unsigned, f); return (u + 0x7fffu + ((u >> 16) & 1u)) >> 16; }
DI unsigned pk2(float lo, float hi) { f32x2 v = {lo, hi}; bf16x2_t b = __builtin_convertvector(v, bf16x2_t); return __builtin_bit_cast(unsigned, b); }
DI float bflo(unsigned p) { return __builtin_bit_cast(float, p << 16); }
DI float bfhi(unsigned p) { return __builtin_bit_cast(float, p & 0xffff0000u); }
DI float wave_sum(float v) {
#pragma unroll
    for (int o = 1; o < 64; o <<= 1) v += __shfl_xor(v, o);
    return v;
}
DI float fexp2(float x) { return __builtin_amdgcn_exp2f(x); }
DI int rank_in(unsigned mask, int pn) { return __builtin_popcount(mask & ((1u << pn) - 1u)); }
DI int kth_in(unsigned mask, int k) { int pn = 0; for (int i = 0; i < 19; ++i) { if ((mask >> i) & 1u) { if (k == 0) pn = i; --k; } } return pn; }
DI unsigned pack_fp8x4(float a, float b, float c, float d) {
    a = __builtin_amdgcn_fmed3f(a, -448.f, 448.f); b = __builtin_amdgcn_fmed3f(b, -448.f, 448.f); c = __builtin_amdgcn_fmed3f(c, -448.f, 448.f); d = __builtin_amdgcn_fmed3f(d, -448.f, 448.f);
    int w = 0; w = __builtin_amdgcn_cvt_pk_fp8_f32(a, b, w, false); w = __builtin_amdgcn_cvt_pk_fp8_f32(c, d, w, true); return (unsigned)w;
}

struct KArgs {
    const float* x; const float* c; const int* pos; const float* w_ada; const float* b_ada; const float* norm1_g; const float* w_in;
    const float* diff_q_g; const float* diff_k_g; const float* lq1; const float* lk1; const float* lq2; const float* lk2; const float* diff_out_g;
    const float* dsa_q_g; const float* dsa_k_g; const float* w_ba; const float* w_bb; const float* w_out; const float* norm2_g;
    const float* peer_wq; const float* sub_keys; const float* peer_u; const float* peer_v;
    float* out; unsigned char* ws; int ph_lo, ph_hi;
};
namespace pg8 {
#define PG8_LAS __attribute__((address_space(3)))
typedef unsigned short bf16_t;
typedef short bf16x8 __attribute__((ext_vector_type(8)));
typedef float f32x4 __attribute__((ext_vector_type(4)));
typedef unsigned u32x4 __attribute__((ext_vector_type(4)));
typedef int i32x8_t __attribute__((ext_vector_type(8)));
constexpr int BM = 256, BK = 64, HALF = 128, HTB = HALF * BK * 2  , STAGE_BYTES = 8 * HTB, NXCD = 8, WGM = 8;

__host__ __device__ __forceinline__ int lds_byte(int r, int c) { const int st = (r >> 4) * 2 + (c >> 5), rr = r & 15, cc = c & 31, ob = rr * 64 + cc * 2; return st * 1024 + (ob ^ (((ob >> 9) & 1) << 5)); }
__host__ __device__ __forceinline__ void stage_rc(int b, int& R, int& C) { const int st = b / 1024, sb = b % 1024, swz = sb ^ (((sb >> 9) & 1) << 5); R = (st >> 1) * 16 + swz / 64; C = (st & 1) * 32 + (swz % 64) / 2; }
__host__ __device__ __forceinline__ int perm32(int rho) { const int n = rho >> 4, i = rho & 15; return 8 * (i >> 2) + 4 * n + (i & 3); }

struct Unit { int pm, pn; };
struct Gemm { const bf16_t* A; const bf16_t* Bt; int M, N, K; };

struct StaticOrder {
    int nM, nN, nwg, G, c;
    __host__ __device__ void init(int M, int N, int G_, int c_) { nM = M / BM; nN = N / BM; nwg = nM * nN; G = G_; c = c_; }
    __host__ __device__ bool next(int i, Unit& u) const {
        const long L = (long)i * G + c; if (L >= nwg) return false;
        int wgid = (int)L; { const int q = nwg / NXCD, r = nwg % NXCD, xcd = wgid % NXCD, off = wgid / NXCD; wgid = (xcd < r ? xcd * (q + 1) : r * (q + 1) + (xcd - r) * q) + off; }
        const int nig = WGM * nN, gid = wgid / nig, fm = gid * WGM, gsz = (nM - fm) < WGM ? (nM - fm) : WGM;
        u.pm = fm + ((wgid % nig) % gsz); u.pn = (wgid % nig) / gsz; return true;
    }
    __device__ __forceinline__ void a_ready(const Unit&) const {}
    __device__ __forceinline__ void done(const Unit&) const {}
};

__device__ __forceinline__ unsigned cvt_pk_bf16(float lo, float hi) { unsigned r; asm volatile("v_cvt_pk_bf16_f32 %0, %1, %2" : "=v"(r) : "v"(lo), "v"(hi)); return r; }
template <class Epi, class Sched, bool ALIGN_EPI = false, bool SP2 = false, int QM = 0>
__device__ __forceinline__ void gemm_phase(PG8_LAS unsigned char* lds, const Gemm g, const Sched& S, const Epi& E) {
    constexpr bool F8 = (QM == 1);
    typedef int i32x4_t __attribute__((ext_vector_type(4)));
    const int tid = threadIdx.x, wid = __builtin_amdgcn_readfirstlane(tid >> 6), lane = tid & 63, wr = wid >> 2, wc = wid & 3, fr = lane & 15, fq = lane >> 4;
    const int K = g.K, nt = K / BK;
    unsigned voffA[2], voffB[2];
#pragma unroll
    for (int i = 0; i < 2; ++i) { int R, C; stage_rc(tid * 16 + i * 8192, R, C); const int Rb = Epi::PERM ? ((R & ~31) + perm32(R & 31)) : R;
        voffA[i] = (unsigned)(R * K + C) * 2u; voffB[i] = (unsigned)(Rb * K + C) * 2u; }
    const size_t kstep = (size_t)(BK * 2);
    const size_t hstep = (size_t)HALF * K * 2;
    const size_t tstep = 2 * hstep;
    const unsigned ldsw = (unsigned)wid * 1024u;
    const int aoff = lds_byte(wr * 64 + fr, fq * 8), boff = lds_byte(wc * 32 + fr, fq * 8);
#define PG8_SA(b, h) (((b) * 2 + (h)) * HTB)
#define PG8_SB(b, h) ((4 + (b) * 2 + (h)) * HTB)
#define PG8_STAGE(bufoff, gbase, voff) do { _Pragma("unroll") for (int _i = 0; _i < 2; ++_i) \
        __builtin_amdgcn_global_load_lds((const unsigned*)((const char*)(gbase) + (voff)[_i]), (PG8_LAS unsigned*)(lds + (bufoff) + ldsw + _i * 8192), 16, 0, 0); } while (0)
#define PG8_CAT2(x0, x1) __builtin_bit_cast(i32x8_t, __builtin_shufflevector((x0), (x1), 0, 1, 2, 3, 4, 5, 6, 7, 8, 9, 10, 11, 12, 13, 14, 15))
#define PG8_LDA(dst, b, h) do { _Pragma("unroll") for (int m = 0; m < 4; ++m) { const bf16x8 f0_ = *(const PG8_LAS bf16x8*)(lds + PG8_SA(b, h) + aoff + m * 2048), f1_ = *(const PG8_LAS bf16x8*)(lds + PG8_SA(b, h) + aoff + m * 2048 + 1024); \
        if constexpr (F8) dst##8[m] = PG8_CAT2(f0_, f1_); else { dst[m][0] = f0_; dst[m][1] = f1_; } } } while (0)
#define PG8_LDB(dst, b, h) do { _Pragma("unroll") for (int n = 0; n < 2; ++n) { const bf16x8 f0_ = *(const PG8_LAS bf16x8*)(lds + PG8_SB(b, h) + boff + n * 2048), f1_ = *(const PG8_LAS bf16x8*)(lds + PG8_SB(b, h) + boff + n * 2048 + 1024); \
        if constexpr (F8) dst##8[n] = PG8_CAT2(f0_, f1_); else { dst[n][0] = f0_; dst[n][1] = f1_; } } } while (0)
#define PG8_MMA(ai, bj, At, Bt) do { __builtin_amdgcn_s_setprio(1); _Pragma("unroll") for (int m = 0; m < 4; ++m) _Pragma("unroll") for (int n = 0; n < 2; ++n) { \
        if constexpr (F8) asm volatile("v_mfma_f32_16x16x128_f8f6f4 %0, %1, %2, %0" : "+v"(acc[ai][bj][m][n]) : "v"(Bt##8[n]), "v"(At##8[m])); \
        else if constexpr (QM == 2) { _Pragma("unroll") for (int k = 0; k < 2; ++k) acc[ai][bj][m][n] = __builtin_bit_cast(f32x4, __builtin_amdgcn_mfma_i32_16x16x64_i8(__builtin_bit_cast(i32x4_t, Bt[n][k]), __builtin_bit_cast(i32x4_t, At[m][k]), __builtin_bit_cast(i32x4_t, acc[ai][bj][m][n]), 0, 0, 0)); } \
        else { _Pragma("unroll") for (int k = 0; k < 2; ++k) acc[ai][bj][m][n] = __builtin_amdgcn_mfma_f32_16x16x32_bf16(Bt[n][k], At[m][k], acc[ai][bj][m][n], 0, 0, 0); } } __builtin_amdgcn_s_setprio(0); } while (0)
#define PG8_WAIT_V(n) asm volatile("s_waitcnt vmcnt(" #n ")" ::: "memory")
#define PG8_WAIT_L(n) asm volatile("s_waitcnt lgkmcnt(" #n ")" ::: "memory")
#define PG8_BAR __builtin_amdgcn_s_barrier()
#define PG8_SCHED __builtin_amdgcn_sched_barrier(0)
    Unit cur, nxt; int ui = 0;
    if (!S.next(0, cur)) return;
    f32x4 acc[2][2][4][2];
#pragma unroll
    for (int a = 0; a < 2; ++a)
#pragma unroll
        for (int b = 0; b < 2; ++b)
#pragma unroll
            for (int m = 0; m < 4; ++m)
#pragma unroll
                for (int n = 0; n < 2; ++n) acc[a][b][m][n] = (f32x4){0.f, 0.f, 0.f, 0.f};
    bf16x8 At[4][2], B0[2][2], B1[2][2]; i32x8_t At8[4], B08[2], B18[2];
    const char* cA = (const char*)g.A + (size_t)cur.pm * tstep; const char* cB = (const char*)g.Bt + (size_t)cur.pn * tstep;
    S.a_ready(cur);
    if constexpr (SP2) {
        PG8_STAGE(PG8_SB(0, 0), cB, voffB); PG8_STAGE(PG8_SB(0, 1), cB + hstep, voffB); PG8_STAGE(PG8_SA(0, 0), cA, voffA); PG8_STAGE(PG8_SA(0, 1), cA + hstep, voffA);
        if (wr == 1) PG8_BAR;
        PG8_WAIT_V(2); PG8_BAR;
        PG8_STAGE(PG8_SB(1, 0), cB + kstep, voffB); PG8_STAGE(PG8_SA(1, 0), cA + kstep, voffA); PG8_STAGE(PG8_SB(1, 1), cB + hstep + kstep, voffB);
        PG8_WAIT_V(6); PG8_BAR;
    } else {
        PG8_STAGE(PG8_SB(0, 0), cB, voffB); PG8_STAGE(PG8_SA(0, 0), cA, voffA); PG8_STAGE(PG8_SB(0, 1), cB + hstep, voffB); PG8_STAGE(PG8_SA(0, 1), cA + hstep, voffA);
        if (wr == 1) PG8_BAR;
        PG8_WAIT_V(4); PG8_BAR;
        PG8_STAGE(PG8_SB(1, 0), cB + kstep, voffB); PG8_STAGE(PG8_SA(1, 0), cA + kstep, voffA); PG8_STAGE(PG8_SB(1, 1), cB + hstep + kstep, voffB);
        PG8_WAIT_V(6); PG8_BAR;
    }
    for (;;) {
        const bool has_next = S.next(ui + 1, nxt);
        const char* nA = has_next ? (const char*)g.A + (size_t)nxt.pm * tstep : cA; const char* nB = has_next ? (const char*)g.Bt + (size_t)nxt.pn * tstep : cB;
#pragma unroll 1
        for (int t = 0; t < nt; t += 2) {
            if constexpr (Epi::MID) { if (t == nt / 2) E.mid(acc, cur, wr, wc, fr, fq); }
            const bool last = (t == nt - 2);
            const char* a1 = cA + (size_t)(t + 1) * kstep;
            const char* a2 = last ? nA : cA + (size_t)(t + 2) * kstep; const char* b2 = last ? nB : cB + (size_t)(t + 2) * kstep;
            const char* a3 = a2 + kstep; const char* b3 = b2 + kstep;
            if (last && has_next) S.a_ready(nxt);
            if constexpr (SP2) {
            PG8_LDB(B0, 0, 0); PG8_LDB(B1, 0, 1); PG8_SCHED; PG8_LDA(At, 0, 0); PG8_STAGE(PG8_SA(1, 1), a1 + hstep, voffA);
            PG8_WAIT_V(8); PG8_WAIT_L(0); PG8_BAR; PG8_MMA(0, 0, At, B0); PG8_MMA(0, 1, At, B1); PG8_BAR; PG8_SCHED;
            PG8_LDA(At, 0, 1); PG8_STAGE(PG8_SB(0, 0), b2, voffB); PG8_STAGE(PG8_SB(0, 1), b2 + hstep, voffB); PG8_STAGE(PG8_SA(0, 0), a2, voffA);
            PG8_WAIT_V(8); PG8_WAIT_L(0); PG8_BAR; PG8_MMA(1, 0, At, B0); PG8_MMA(1, 1, At, B1); PG8_BAR; PG8_SCHED;
            PG8_LDB(B0, 1, 0); PG8_LDB(B1, 1, 1); PG8_SCHED; PG8_LDA(At, 1, 0); PG8_STAGE(PG8_SA(0, 1), a2 + hstep, voffA);
            PG8_WAIT_V(8); PG8_WAIT_L(0); PG8_BAR; PG8_MMA(0, 0, At, B0); PG8_MMA(0, 1, At, B1); PG8_BAR; PG8_SCHED;
            PG8_LDA(At, 1, 1); PG8_STAGE(PG8_SB(1, 0), b3, voffB); PG8_STAGE(PG8_SB(1, 1), b3 + hstep, voffB); PG8_STAGE(PG8_SA(1, 0), a3, voffA);
            PG8_WAIT_V(8); PG8_WAIT_L(0); PG8_BAR; PG8_MMA(1, 0, At, B0); PG8_MMA(1, 1, At, B1); PG8_BAR; PG8_SCHED;
            } else {
            PG8_LDB(B0, 0, 0); PG8_SCHED; PG8_LDA(At, 0, 0); PG8_STAGE(PG8_SA(1, 1), a1 + hstep, voffA);
            PG8_WAIT_L(8); PG8_BAR; PG8_WAIT_L(0); PG8_MMA(0, 0, At, B0); PG8_BAR; PG8_SCHED;
            PG8_LDB(B1, 0, 1); PG8_STAGE(PG8_SB(0, 0), b2, voffB);
            PG8_BAR; PG8_WAIT_L(0); PG8_MMA(0, 1, At, B1); PG8_BAR;
            PG8_LDA(At, 0, 1); PG8_STAGE(PG8_SA(0, 0), a2, voffA);
            PG8_BAR; PG8_WAIT_L(0); PG8_MMA(1, 0, At, B0); PG8_BAR; PG8_SCHED;
            PG8_STAGE(PG8_SB(0, 1), b2 + hstep, voffB);
            PG8_WAIT_V(6); PG8_BAR; PG8_MMA(1, 1, At, B1); PG8_BAR;
            PG8_LDB(B0, 1, 0); PG8_SCHED; PG8_LDA(At, 1, 0); PG8_STAGE(PG8_SA(0, 1), a2 + hstep, voffA);
            PG8_WAIT_L(8); PG8_BAR; PG8_WAIT_L(0); PG8_MMA(0, 0, At, B0); PG8_BAR; PG8_SCHED;
            PG8_LDB(B1, 1, 1); PG8_STAGE(PG8_SB(1, 0), b3, voffB);
            PG8_BAR; PG8_WAIT_L(0); PG8_MMA(0, 1, At, B1); PG8_BAR;
            PG8_LDA(At, 1, 1); PG8_STAGE(PG8_SA(1, 0), a3, voffA);
            PG8_BAR; PG8_WAIT_L(0); PG8_MMA(1, 0, At, B0); PG8_BAR; PG8_SCHED;
            PG8_STAGE(PG8_SB(1, 1), b3 + hstep, voffB);
            PG8_WAIT_V(6); PG8_BAR; PG8_MMA(1, 1, At, B1); PG8_BAR;
            }
        }
        if constexpr (ALIGN_EPI) { if (wr == 0) PG8_BAR; }
        if constexpr (F8) asm volatile("s_nop 15\n\ts_nop 15\n\ts_nop 15");
        if constexpr (!Epi::AFTER_DRAIN) { E(acc, cur, wr, wc, fr, fq); S.done(cur); }
        if (!has_next) break;
#pragma unroll
        for (int a = 0; a < 2; ++a)
#pragma unroll
            for (int b = 0; b < 2; ++b)
#pragma unroll
                for (int m = 0; m < 4; ++m)
#pragma unroll
                    for (int n = 0; n < 2; ++n) acc[a][b][m][n] = (f32x4){0.f, 0.f, 0.f, 0.f};
        cur = nxt; cA = nA; cB = nB; ++ui;
        if constexpr (ALIGN_EPI) { if (wr == 1) PG8_BAR; }
    }
    PG8_WAIT_V(0);
    if constexpr (!ALIGN_EPI) { if (wr == 0) PG8_BAR; }
    PG8_BAR;
    if constexpr (Epi::AFTER_DRAIN) { E.fused(acc, cur, wr, wc, fr, fq, lds, wid, lane); S.done(cur); }
#undef PG8_SA
#undef PG8_SB
#undef PG8_STAGE
#undef PG8_LDA
#undef PG8_LDB
#undef PG8_MMA
#undef PG8_CAT2
#undef PG8_WAIT_V
#undef PG8_WAIT_L
#undef PG8_BAR
#undef PG8_SCHED
}
}
DI int proj_group_base(int g) {
    if (g < 8) return 64 * g;
    if (g < 16) return 512 + 64 * (g - 8);
    if (g < 24) return 1024 + 64 * (g - 16);
    if (g < 32) return 1536 + 64 * (g - 24);
    if (g < 40) return 2176 + 64 * (g - 32);
    if (g == 40) return 2048;
    if (g == 41) return 2112;
    if (g == 42) return 2688;
    if (g == 43) return 2752;
    if (g < 60) return 2760 + 64 * (g - 44);
    return 3784 + 64 * (g - 60);
}

template <int QM> struct EpiProjT {
    static constexpr bool PERM = true, AFTER_DRAIN = false, MID = false;
    bf16_t *Qd, *Kd, *Vd, *Qs, *Qi, *Ks, *Vs, *Ki, *G0, *G1; float* Widx;
    const float *cosT, *sinT;
    const float *gq, *gk, *gsq, *gsk;
    const unsigned* wm;
    const float* rs;
    __device__ __forceinline__ void operator()(const pg8::f32x4 (&acc)[2][2][4][2], const pg8::Unit& u, int wr, int wc, int fr, int fq) const {
        const int g = kth_in(QM ? IN8_MASK : (~IN8_MASK & 0x7FFFFu), u.pn) * 4 + wc;
        const float asc = QM == 1 ? __builtin_bit_cast(float, *wm) * (1.f / (ASC8 * WTOP8)) : QM == 2 ? __builtin_bit_cast(float, *wm) * (1.f / 127.f) : 1.f;
        int kind; bf16_t* dst = nullptr; int ld = 512, col = 0; const float* gn = nullptr; float scale = 1.f;
        if (g < 8) { kind = 1; dst = Qd; col = 64 * g; gn = gq; scale = QSCALE; }
        else if (g < 16) { kind = 1; dst = Kd; col = 64 * (g - 8); gn = gk; }
        else if (g < 24) { kind = 0; dst = Vd; col = 64 * (g - 16); }
        else if (g < 32) { kind = 1; dst = Qs; col = 64 * (g - 24); gn = gsq; scale = QSCALE; }
        else if (g < 40) { kind = 2; dst = Qi; col = 64 * (g - 32); }
        else if (g == 40) { kind = 1; dst = Ks; ld = 64; gn = gsk; }
        else if (g == 41) { kind = 0; dst = Vs; ld = 64; }
        else if (g == 42) { kind = 2; dst = Ki; ld = 64; }
        else if (g == 43) { kind = 4; }
        else if (g < 60) { kind = 3; dst = G0; ld = 1024; col = 64 * (g - 44); }
        else { kind = 3; dst = G1; ld = 1024; col = 64 * (g - 60); }
        float gv[16];
#pragma unroll
        for (int i = 0; i < 16; ++i) gv[i] = 1.f;
        if (kind == 1) {
#pragma unroll
            for (int i = 0; i < 8; ++i) { gv[i] = gn[8 * fq + i]; gv[8 + i] = gn[32 + 8 * fq + i]; }
        }
        float rsv[8];
#pragma unroll
        for (int i = 0; i < 8; ++i) rsv[i] = (QM == 2) ? rs[u.pm * 256 + (i >> 2) * 128 + wr * 64 + (i & 3) * 16 + fr] : 1.f;
        f32x4 tcs[2][4];
        const bool roped = (kind == 1 || kind == 2);
#define EPI_LDTAB(i_) do { const size_t r_ = (size_t)(u.pm * 256 + ((i_) >> 2) * 128 + wr * 64 + ((i_) & 3) * 16 + fr) * 32 + 8 * fq; \
            tcs[(i_) & 1][0] = *(const f32x4*)(cosT + r_); tcs[(i_) & 1][1] = *(const f32x4*)(cosT + r_ + 4); tcs[(i_) & 1][2] = *(const f32x4*)(sinT + r_); tcs[(i_) & 1][3] = *(const f32x4*)(sinT + r_ + 4); } while (0)
        if (roped) EPI_LDTAB(0);
#pragma unroll
        for (int ai = 0; ai < 2; ++ai)
#pragma unroll
            for (int m = 0; m < 4; ++m) {
                const int row = u.pm * 256 + ai * 128 + wr * 64 + m * 16 + fr;
                if (roped && ai * 4 + m + 1 < 8) EPI_LDTAB(ai * 4 + m + 1);
                float v[16];
#pragma unroll
                for (int i = 0; i < 8; ++i) { v[i] = acc[ai][0][m][i >> 2][i & 3]; v[8 + i] = acc[ai][1][m][i >> 2][i & 3]; if (QM == 1) { v[i] *= asc; v[8 + i] *= asc; } }
                if (QM == 2) {
                    const float rsc = rsv[ai * 4 + m] * asc;
#pragma unroll
                    for (int i = 0; i < 16; ++i) v[i] = (float)__builtin_bit_cast(int, v[i]) * rsc;
                }
                if (kind == 1) {
                    float ss = 0.f;
#pragma unroll
                    for (int i = 0; i < 16; ++i) ss += v[i] * v[i];
                    ss += __shfl_xor(ss, 16); ss += __shfl_xor(ss, 32);
                    const float rn = __builtin_amdgcn_rsqf(ss * (1.f / 64.f) + EPS);
#pragma unroll
                    for (int i = 0; i < 16; ++i) v[i] = v[i] * rn * gv[i];
                }
                if (kind == 1 || kind == 2) {
                    const f32x4 c0 = tcs[(ai * 4 + m) & 1][0], c1 = tcs[(ai * 4 + m) & 1][1], s0 = tcs[(ai * 4 + m) & 1][2], s1 = tcs[(ai * 4 + m) & 1][3];
#pragma unroll
                    for (int i = 0; i < 8; ++i) {
                        const float cc = (i < 4) ? c0[i & 3] : c1[i & 3], sn = (i < 4) ? s0[i & 3] : s1[i & 3];
                        const float x1 = v[i], x2 = v[8 + i];
                        v[i] = (x1 * cc - x2 * sn) * scale; v[8 + i] = (x2 * cc + x1 * sn) * scale;
                    }
                }
                if (kind == 3) {
#pragma unroll
                    for (int i = 0; i < 16; ++i) v[i] = G8 ? __builtin_amdgcn_rcpf(__builtin_fmaf(__builtin_amdgcn_exp2f(v[i] * -1.4426950408889634f), 1.f / 255.f, 1.f / 255.f))
                                                           : __builtin_amdgcn_rcpf(1.f + __builtin_amdgcn_exp2f(v[i] * -1.4426950408889634f));
                }
                if (kind == 4) {
                    if (fq == 0) {
                        *(f32x4*)(Widx + (size_t)row * 8) = (f32x4){v[0], v[1], v[2], v[3]};
                        *(f32x4*)(Widx + (size_t)row * 8 + 4) = (f32x4){v[4], v[5], v[6], v[7]};
                    }
                } else if (kind == 3 && G8) {
                    unsigned b[4] = {0u, 0u, 0u, 0u};
#pragma unroll
                    for (int i = 0; i < 16; ++i) b[i >> 2] = __builtin_amdgcn_cvt_pk_u8_f32(__builtin_rintf(v[i]), i & 3, b[i >> 2]);
                    unsigned char* p = (unsigned char*)dst + (size_t)row * ld + col + 8 * fq;
                    *(u32x2*)p = (u32x2){b[0], b[1]}; *(u32x2*)(p + 32) = (u32x2){b[2], b[3]};
                } else {
                    u32x4 w0, w1;
                    w0.x = pk2(v[0], v[1]); w0.y = pk2(v[2], v[3]); w0.z = pk2(v[4], v[5]); w0.w = pk2(v[6], v[7]);
                    w1.x = pk2(v[8], v[9]); w1.y = pk2(v[10], v[11]); w1.z = pk2(v[12], v[13]); w1.w = pk2(v[14], v[15]);
                    bf16_t* p = dst + (size_t)row * ld + col + 8 * fq;
                    *(u32x4*)p = w0; *(u32x4*)(p + 32) = w1;
                }
                asm volatile("" ::: "memory");
            }
#undef EPI_LDTAB
    }
};

template <int MODE> struct EpiGate {
    static constexpr bool PERM = true, AFTER_DRAIN = false, MID = false;
    const bf16_t* G; bf16_t* O; const unsigned* wm; unsigned char* O8; const float* rs;
    __device__ __forceinline__ void operator()(const pg8::f32x4 (&acc)[2][2][4][2], const pg8::Unit& u, int wr, int wc, int fr, int fq) const {
        const int row0 = u.pm * 256 + wr * 64 + fr, col0 = u.pn * 256 + wc * 32 + 8 * fq;
        const float sc = F8_BR ? __builtin_bit_cast(float, *wm) * (1.f / (ASC8 * WTOP8)) : 1.f;
#pragma unroll
        for (int ai = 0; ai < 2; ++ai)
#pragma unroll
            for (int m = 0; m < 4; ++m)
#pragma unroll
                for (int bj = 0; bj < 2; ++bj) {
                    const size_t off = (size_t)(row0 + ai * 128 + m * 16) * 1024 + col0 + bj * 128;
                    float r[8];
                    pg8::f32x4 c0 = acc[ai][bj][m][0], c1 = acc[ai][bj][m][1];
                    float scr = sc;
                    if (BR8 && !F8_BR) {
                        typedef int i32x4 __attribute__((ext_vector_type(4)));
                        const i32x4 i0 = __builtin_bit_cast(i32x4, c0), i1 = __builtin_bit_cast(i32x4, c1);
                        c0 = (pg8::f32x4){(float)i0[0], (float)i0[1], (float)i0[2], (float)i0[3]}; c1 = (pg8::f32x4){(float)i1[0], (float)i1[1], (float)i1[2], (float)i1[3]};
                        scr = (rs ? rs[row0 + ai * 128 + m * 16] : OA_MAX * (1.f / 127.f)) * (__builtin_bit_cast(float, *wm) * (1.f / 127.f));
                    }
                    if (G8) {
                        const u32x2 gb = *(const u32x2*)((const unsigned char*)G + off);
                        const pg8::f32x4 a0 = c0 * (scr * (1.f / 255.f)), a1 = c1 * (scr * (1.f / 255.f));
                        r[0] = (float)(gb.x & 255u) * a0[0]; r[1] = (float)((gb.x >> 8) & 255u) * a0[1]; r[2] = (float)((gb.x >> 16) & 255u) * a0[2]; r[3] = (float)(gb.x >> 24) * a0[3];
                        r[4] = (float)(gb.y & 255u) * a1[0]; r[5] = (float)((gb.y >> 8) & 255u) * a1[1]; r[6] = (float)((gb.y >> 16) & 255u) * a1[2]; r[7] = (float)(gb.y >> 24) * a1[3];
                    } else {
                    const u32x4 gw = *(const u32x4*)(G + off);
                    const pg8::f32x4 a0 = c0 * scr, a1 = c1 * scr;
                    r[0] = bflo(gw.x) * a0[0]; r[1] = bfhi(gw.x) * a0[1]; r[2] = bflo(gw.y) * a0[2]; r[3] = bfhi(gw.y) * a0[3];
                    r[4] = bflo(gw.z) * a1[0]; r[5] = bfhi(gw.z) * a1[1]; r[6] = bflo(gw.w) * a1[2]; r[7] = bfhi(gw.w) * a1[3];
                    }
                    if (MODE == 1) {
                        const u32x4 ow = *(const u32x4*)(O + off);
                        r[0] += bflo(ow.x); r[1] += bfhi(ow.x); r[2] += bflo(ow.y); r[3] += bfhi(ow.y);
                        r[4] += bflo(ow.z); r[5] += bfhi(ow.z); r[6] += bflo(ow.w); r[7] += bfhi(ow.w);
                    }
                    if (MODE == 1 && F8_BR) {
                        u32x2 w8; w8.x = pack_fp8x4(r[0] * ASC8, r[1] * ASC8, r[2] * ASC8, r[3] * ASC8); w8.y = pack_fp8x4(r[4] * ASC8, r[5] * ASC8, r[6] * ASC8, r[7] * ASC8);
                        *(u32x2*)(O8 + off) = w8;
                    } else {
                        u32x4 w; w.x = pk2(r[0], r[1]); w.y = pk2(r[2], r[3]); w.z = pk2(r[4], r[5]); w.w = pk2(r[6], r[7]);
                        *(u32x4*)(O + off) = w;
                    }
                }
    }
};

struct EpiMerged {
    static constexpr bool PERM = true, AFTER_DRAIN = false, MID = true;
    const unsigned char* G0; const unsigned char* G1; bf16_t* O; unsigned char* O8;
    __device__ __forceinline__ void mid(pg8::f32x4 (&acc)[2][2][4][2], const pg8::Unit& u, int wr, int wc, int fr, int fq) const {
        int frl = fr; asm volatile("" : "+v"(frl));
        const int row0 = u.pm * 256 + wr * 64 + frl, col0 = u.pn * 256 + wc * 32 + 8 * fq;
        u32x2 gq[2][2];
#define EPI_LDG(i_) do { const unsigned o_ = (unsigned)(row0 + ((i_) >> 3) * 128 + (((i_) >> 1) & 3) * 16) * 1024u + (unsigned)(col0 + ((i_) & 1) * 128); \
            gq[(i_) & 1][0] = *(const u32x2*)(G0 + o_); gq[(i_) & 1][1] = *(const u32x2*)(G1 + o_); } while (0)
        EPI_LDG(0);
#pragma unroll
        for (int ai = 0; ai < 2; ++ai)
#pragma unroll
            for (int m = 0; m < 4; ++m)
#pragma unroll
                for (int bj = 0; bj < 2; ++bj) {
                    if (ai * 8 + m * 2 + bj + 1 < 16) EPI_LDG(ai * 8 + m * 2 + bj + 1);
                    const u32x2 ga = gq[(ai * 8 + m * 2 + bj) & 1][0], gb = gq[(ai * 8 + m * 2 + bj) & 1][1];
#pragma unroll
                    for (int e = 0; e < 8; ++e) {
                        const unsigned wa = e < 4 ? ga.x : ga.y, wb = e < 4 ? gb.x : gb.y;
                        const float g0 = (float)((wa >> (8 * (e & 3))) & 255u), g1 = fmaxf((float)((wb >> (8 * (e & 3))) & 255u), 1.f);
                        acc[ai][bj][m][e >> 2][e & 3] *= g0 * __builtin_amdgcn_rcpf(g1);
                    }
                    asm volatile("" ::: "memory");
                    __builtin_amdgcn_sched_barrier(0);
                }
#undef EPI_LDG
    }
    __device__ __forceinline__ void operator()(const pg8::f32x4 (&acc)[2][2][4][2], const pg8::Unit& u, int wr, int wc, int fr, int fq) const {
        const int row0 = u.pm * 256 + wr * 64 + fr, col0 = u.pn * 256 + wc * 32 + 8 * fq;
        u32x2 gq[2][2];
#define EPI_LDG1(i_) do { _Pragma("unroll") for (int bj = 0; bj < 2; ++bj) gq[(i_) & 1][bj] = *(const u32x2*)(G1 + (size_t)(row0 + ((i_) >> 2) * 128 + ((i_) & 3) * 16) * 1024 + col0 + bj * 128); } while (0)
        EPI_LDG1(0);
#pragma unroll
        for (int ai = 0; ai < 2; ++ai)
#pragma unroll
            for (int m = 0; m < 4; ++m) {
                if (ai * 4 + m + 1 < 8) EPI_LDG1(ai * 4 + m + 1);
#pragma unroll
                for (int bj = 0; bj < 2; ++bj) {
                    const size_t off = (size_t)(row0 + ai * 128 + m * 16) * 1024 + col0 + bj * 128;
                    const u32x2 gb = gq[(ai * 4 + m) & 1][bj];
                    float r[8];
#pragma unroll
                    for (int e = 0; e < 8; ++e) {
                        const unsigned wb = e < 4 ? gb.x : gb.y;
                        r[e] = acc[ai][bj][m][e >> 2][e & 3] * (fmaxf((float)((wb >> (8 * (e & 3))) & 255u), 1.f) * (1.f / 255.f));
                    }
                    if (F8_OUT) { u32x2 w8; w8.x = pack_fp8x4(r[0] * ASC8, r[1] * ASC8, r[2] * ASC8, r[3] * ASC8); w8.y = pack_fp8x4(r[4] * ASC8, r[5] * ASC8, r[6] * ASC8, r[7] * ASC8); *(u32x2*)(O8 + off) = w8; }
                    else { u32x4 w; w.x = pk2(r[0], r[1]); w.y = pk2(r[2], r[3]); w.z = pk2(r[4], r[5]); w.w = pk2(r[6], r[7]); *(u32x4*)(O + off) = w; }
                }
            }
#undef EPI_LDG1
    }
};

struct EpiResid {
    static constexpr bool PERM = false, AFTER_DRAIN = false, MID = false;
    const float* x; const float* mod; float* out; float sc;
    __device__ __forceinline__ void operator()(const pg8::f32x4 (&acc)[2][2][4][2], const pg8::Unit& u, int wr, int wc, int fr, int fq) const {
        const int b = u.pm >> 3; const float* g1 = mod + (size_t)b * 6144 + 2048;
        const int row0 = u.pm * 256 + wr * 64 + fr, col0 = u.pn * 256 + wc * 32 + 4 * fq;
        pg8::f32x4 gv[2][2];
#pragma unroll
        for (int bj = 0; bj < 2; ++bj)
#pragma unroll
            for (int n = 0; n < 2; ++n) gv[bj][n] = *(const pg8::f32x4*)(g1 + col0 + bj * 128 + n * 16) * sc;
        pg8::f32x4 xq[2][4];
#define EPI_LDX(i_) do { _Pragma("unroll") for (int bj = 0; bj < 2; ++bj) _Pragma("unroll") for (int n = 0; n < 2; ++n) \
            xq[(i_) & 1][bj * 2 + n] = *(const pg8::f32x4*)(x + (size_t)(row0 + ((i_) >> 2) * 128 + ((i_) & 3) * 16) * 1024 + col0 + bj * 128 + n * 16); } while (0)
        EPI_LDX(0);
#pragma unroll
        for (int ai = 0; ai < 2; ++ai)
#pragma unroll
            for (int m = 0; m < 4; ++m) {
                if (ai * 4 + m + 1 < 8) EPI_LDX(ai * 4 + m + 1);
#pragma unroll
                for (int bj = 0; bj < 2; ++bj)
#pragma unroll
                    for (int n = 0; n < 2; ++n) {
                        const size_t off = (size_t)(row0 + ai * 128 + m * 16) * 1024 + col0 + bj * 128 + n * 16;
                        *(pg8::f32x4*)(out + off) = xq[(ai * 4 + m) & 1][bj * 2 + n] + gv[bj][n] * acc[ai][bj][m][n];
                    }
            }
#undef EPI_LDX
    }
};

struct EpiPlain {
    static constexpr bool PERM = true, AFTER_DRAIN = false, MID = false;
    bf16_t* O; int ldc; float sc;
    __device__ __forceinline__ void operator()(const pg8::f32x4 (&acc)[2][2][4][2], const pg8::Unit& u, int wr, int wc, int fr, int fq) const {
        const int row0 = u.pm * 256 + wr * 64 + fr, col0 = u.pn * 256 + wc * 32 + 8 * fq;
#pragma unroll
        for (int ai = 0; ai < 2; ++ai)
#pragma unroll
            for (int m = 0; m < 4; ++m)
#pragma unroll
                for (int bj = 0; bj < 2; ++bj) {
                    const pg8::f32x4 a0 = acc[ai][bj][m][0] * sc, a1 = acc[ai][bj][m][1] * sc;
                    u32x4 w; w.x = pk2(a0[0], a0[1]); w.y = pk2(a0[2], a0[3]); w.z = pk2(a1[0], a1[1]); w.w = pk2(a1[2], a1[3]);
                    *(u32x4*)(O + (size_t)(row0 + ai * 128 + m * 16) * ldc + col0 + bj * 128) = w;
                }
    }
};

struct EpiPlainI8 {
    static constexpr bool PERM = true, AFTER_DRAIN = false, MID = false;
    bf16_t* O; int ldc; const float* rs; const unsigned* wm;
    __device__ __forceinline__ void operator()(const pg8::f32x4 (&acc)[2][2][4][2], const pg8::Unit& u, int wr, int wc, int fr, int fq) const {
        typedef int i32x4 __attribute__((ext_vector_type(4)));
        const int row0 = u.pm * 256 + wr * 64 + fr, col0 = u.pn * 256 + wc * 32 + 8 * fq;
        const float cs = __builtin_bit_cast(float, *wm) * (1.f / 127.f);
        float rsv[8];
#pragma unroll
        for (int i = 0; i < 8; ++i) rsv[i] = rs[row0 + (i >> 2) * 128 + (i & 3) * 16];
#pragma unroll
        for (int ai = 0; ai < 2; ++ai)
#pragma unroll
            for (int m = 0; m < 4; ++m) {
                const int row = row0 + ai * 128 + m * 16;
                const float sc = rsv[ai * 4 + m] * cs;
#pragma unroll
                for (int bj = 0; bj < 2; ++bj) {
                    const i32x4 i0 = __builtin_bit_cast(i32x4, acc[ai][bj][m][0]), i1 = __builtin_bit_cast(i32x4, acc[ai][bj][m][1]);
                    u32x4 w; w.x = pk2((float)i0[0] * sc, (float)i0[1] * sc); w.y = pk2((float)i0[2] * sc, (float)i0[3] * sc); w.z = pk2((float)i1[0] * sc, (float)i1[1] * sc); w.w = pk2((float)i1[2] * sc, (float)i1[3] * sc);
                    *(u32x4*)(O + (size_t)row * ldc + col0 + bj * 128) = w;
                }
            }
    }
};

struct EpiProbe {
    static constexpr bool PERM = true, AFTER_DRAIN = false, MID = false;
    bf16_t* O;
    __device__ __forceinline__ void operator()(const pg8::f32x4 (&acc)[2][2][4][2], const pg8::Unit& u, int wr, int wc, int fr, int fq) const {
        const int row0 = u.pm * 256 + wr * 64 + fr, col0 = wc * 32 + 8 * fq;
#pragma unroll
        for (int ai = 0; ai < 2; ++ai)
#pragma unroll
            for (int m = 0; m < 4; ++m)
#pragma unroll
                for (int bj = 0; bj < 2; ++bj) {
                    const pg8::f32x4 a0 = acc[ai][bj][m][0], a1 = acc[ai][bj][m][1];
                    u32x4 w; w.x = pk2(a0[0], a0[1]); w.y = pk2(a0[2], a0[3]); w.z = pk2(a1[0], a1[1]); w.w = pk2(a1[2], a1[3]);
                    *(u32x4*)(O + (size_t)(row0 + ai * 128 + m * 16) * 256 + col0 + bj * 128) = w;
                }
    }
};
#define XB_TMO      128
#define XB_XCNT(j)  (256  + 64 * (j))
#define XB_XSUB(j)  (1280 + 64 * (j))
#define XB_XGEN(j)  (2304 + 64 * (j))
#define XB_TOP      3328
#define XB_TOPGEN   3392
#define XCD_BAR_WORDS 3456
#define XB_SPIN_CAP (1u << 18)

__device__ __forceinline__ unsigned xb_ld(unsigned* p)              { return __hip_atomic_load(p, __ATOMIC_RELAXED, __HIP_MEMORY_SCOPE_AGENT); }
__device__ __forceinline__ unsigned xb_add(unsigned* p, unsigned v) { return __hip_atomic_fetch_add(p, v, __ATOMIC_RELAXED, __HIP_MEMORY_SCOPE_AGENT); }
__device__ __forceinline__ unsigned xb_xcc_id() { return (unsigned)__builtin_amdgcn_s_getreg((3 << 11) | 20) & 0xFu; }
#define XB_SPIN(cond, bar) do { unsigned _sp = 0; while (cond) { __builtin_amdgcn_s_sleep(1); \
    if ((++_sp & 255u) == 0u) { if (xb_ld(&(bar)[XB_TMO])) break; if (_sp > XB_SPIN_CAP) { atomicAdd(&(bar)[XB_TMO], 1u); break; } } } } while (0)

struct XcdBarrier {
    unsigned* bar; unsigned x;
    volatile LAS unsigned* st;
};

__device__ __forceinline__ XcdBarrier xcd_barrier_post(unsigned* bar, volatile LAS unsigned* st) {
    XcdBarrier b; b.bar = bar; b.x = xb_xcc_id(); b.st = st;
    if (threadIdx.x == 0) (void)xb_add(&bar[XB_XCNT(b.x)], 1u);
    return b;
}
__device__ __forceinline__ void xcd_barrier_complete(unsigned* bar, unsigned x, unsigned& nloc, unsigned& nx) {
    const unsigned G = gridDim.x * gridDim.y * gridDim.z;
    unsigned sum, cnt, mine, sp = 0u;
    for (;;) {
        sum = 0u; cnt = 0u; mine = 0u;
#pragma unroll
        for (unsigned j = 0; j < 16; ++j) { const unsigned c = xb_ld(&bar[XB_XCNT(j)]); sum += c; cnt += (c > 0u) ? 1u : 0u; mine = (j == x) ? c : mine; }
        if (sum == G) break;
        __builtin_amdgcn_s_sleep(1);
        if ((++sp & 255u) == 0u) { if (xb_ld(&bar[XB_TMO])) break; if (sp > XB_SPIN_CAP) { atomicAdd(&bar[XB_TMO], 1u); break; } }
    }
    nloc = mine > 0u ? mine : 1u; nx = cnt > 0u ? cnt : 1u;
}

__device__ __forceinline__ void xcd_barrier(const XcdBarrier& b) {
    asm volatile("s_waitcnt vmcnt(0)" ::: "memory");
    __syncthreads();
    if (threadIdx.x == 0) {
        unsigned* bar = b.bar;
        __builtin_amdgcn_s_waitcnt(0);
        unsigned nloc = b.st[0], nx = b.st[1];
        if (nloc == 0u) { xcd_barrier_complete(bar, b.x, nloc, nx); b.st[0] = nloc; b.st[1] = nx; }
        const unsigned old = xb_add(&bar[XB_XSUB(b.x)], 1u);
        const unsigned gen = old / nloc;
        if (old + 1u == (gen + 1u) * nloc) {
            __builtin_amdgcn_fence(__ATOMIC_RELEASE, "agent");
            asm volatile("s_waitcnt vmcnt(0)" ::: "memory");
            const unsigned og = xb_add(&bar[XB_TOP], 1u);
            const unsigned tg = og / nx;
            if (og + 1u == (tg + 1u) * nx) xb_add(&bar[XB_TOPGEN], 1u);
            else XB_SPIN(xb_ld(&bar[XB_TOPGEN]) == tg, bar);
            __builtin_amdgcn_fence(__ATOMIC_ACQUIRE, "agent");
            xb_add(&bar[XB_XGEN(b.x)], 1u);
            asm volatile("s_waitcnt vmcnt(0)" ::: "memory");
        } else {
            XB_SPIN(xb_ld(&bar[XB_XGEN(b.x)]) == gen, bar);
            __builtin_amdgcn_fence(__ATOMIC_ACQUIRE, "agent");
            asm volatile("s_waitcnt vmcnt(0)" ::: "memory");
        }
    }
    __syncthreads();
}
#define LDS_WAIT() asm volatile("s_waitcnt lgkmcnt(0)" ::: "memory")
#define VM_WAIT() asm volatile("s_waitcnt vmcnt(0)" ::: "memory")

DI void transpose_item(const float* W, int N, int K, bf16_t* WT, int prow0, int lcol0, int nvalid, int k0, LAS float* scr, int lane) {
    const int cl = lane & 31;
    float tw[32];
#pragma unroll
    for (int i = 0; i < 32; ++i) { const int kk = 2 * i + (lane >> 5); tw[i] = (cl < nvalid) ? W[(size_t)(k0 + kk) * N + lcol0 + cl] : 0.f; }
#pragma unroll
    for (int i = 0; i < 32; ++i) { const int kk = 2 * i + (lane >> 5); scr[kk * 33 + cl] = tw[i]; }
    LDS_WAIT();
    const int c = lane & 7;
#pragma unroll
    for (int j = 0; j < 4; ++j) {
        const int n = (lane >> 3) + 8 * j; const LAS float* s = scr + (8 * c) * 33 + n;
        u32x4 o; o.x = pk2(s[0 * 33], s[1 * 33]); o.y = pk2(s[2 * 33], s[3 * 33]); o.z = pk2(s[4 * 33], s[5 * 33]); o.w = pk2(s[6 * 33], s[7 * 33]);
        *(u32x4*)(WT + (size_t)(prow0 + n) * K + k0 + 8 * c) = o;
    }
    LDS_WAIT();
}

DI unsigned pack_i8x4(float a, float b, float c, float d) {
    const int ia = (int)__builtin_rintf(fminf(fmaxf(a, -127.f), 127.f)), ib = (int)__builtin_rintf(fminf(fmaxf(b, -127.f), 127.f));
    const int ic = (int)__builtin_rintf(fminf(fmaxf(c, -127.f), 127.f)), id = (int)__builtin_rintf(fminf(fmaxf(d, -127.f), 127.f));
    return (unsigned)(ia & 255) | ((unsigned)(ib & 255) << 8) | ((unsigned)(ic & 255) << 16) | ((unsigned)(id & 255) << 24);
}
template <bool INT8 = false>
DI void transpose_item8(const float* W, int N, int K, unsigned char* WT, int prow0, int lcol0, int nvalid, int k0, float scale, LAS float* scr, int lane) {
    const int cl = lane & 31;
    float tw[32];
#pragma unroll
    for (int i = 0; i < 32; ++i) { const int kk = 2 * i + (lane >> 5); tw[i] = (cl < nvalid) ? W[(size_t)(k0 + kk) * N + lcol0 + cl] * scale : 0.f; }
#pragma unroll
    for (int i = 0; i < 32; ++i) { const int kk = 2 * i + (lane >> 5); scr[kk * 33 + cl] = tw[i]; }
    LDS_WAIT();
    const int c = lane & 3;
#pragma unroll
    for (int j = 0; j < 2; ++j) {
        const int n = (lane >> 2) + 16 * j; const LAS float* s = scr + (16 * c) * 33 + n;
        u32x4 o;
#pragma unroll
        for (int q = 0; q < 4; ++q) o[q] = INT8 ? pack_i8x4(s[(4 * q) * 33], s[(4 * q + 1) * 33], s[(4 * q + 2) * 33], s[(4 * q + 3) * 33]) : pack_fp8x4(s[(4 * q) * 33], s[(4 * q + 1) * 33], s[(4 * q + 2) * 33], s[(4 * q + 3) * 33]);
        *(u32x4*)(WT + (size_t)(prow0 + n) * K + k0 + 16 * c) = o;
    }
    LDS_WAIT();
}
DI void absmax_to(const float* p, size_t n, unsigned* word, size_t gtid, size_t gth, int lane) {
    float mx = 0.f;
    for (size_t i = gtid * 4; i < n; i += gth * 16) {
        f32x4 v[4];
#pragma unroll
        for (int q = 0; q < 4; ++q) { const size_t j = i + (size_t)q * gth * 4; v[q] = (j < n) ? *(const f32x4*)(p + j) : (f32x4){0.f, 0.f, 0.f, 0.f}; }
#pragma unroll
        for (int q = 0; q < 4; ++q) mx = fmaxf(fmaxf(mx, fmaxf(fabsf(v[q][0]), fabsf(v[q][1]))), fmaxf(fabsf(v[q][2]), fabsf(v[q][3])));
    }
#pragma unroll
    for (int o = 1; o < 64; o <<= 1) mx = fmaxf(mx, __shfl_xor(mx, o));
    if (lane == 0 && mx > 0.f) atomicMax(word, __builtin_bit_cast(unsigned, mx));
}
DI float wscale8(const unsigned char* ws, int which) { return WTOP8 / fmaxf(__builtin_bit_cast(float, ((const unsigned*)(ws + WS_CTL))[CW_WMAX + which]), 1e-30f); }

DI void conv_bf16(const float* src, bf16_t* dst, size_t n, size_t gtid, size_t gthreads) {
    for (size_t i = gtid * 8; i < n; i += gthreads * 8) {
        const f32x4 a = *(const f32x4*)(src + i), b = *(const f32x4*)(src + i + 4);
        u32x4 o; o.x = pk2(a[0], a[1]); o.y = pk2(a[2], a[3]); o.z = pk2(b[0], b[1]); o.w = pk2(b[2], b[3]);
        *(u32x4*)(dst + i) = o;
    }
}

DI void conv_fp8(const float* src, unsigned char* dst, size_t n, float scale, size_t gtid, size_t gthreads) {
    for (size_t i = gtid * 16; i < n; i += gthreads * 16) {
        const size_t e = i >> 10, c = i & 1023;
        u32x4 o;
#pragma unroll
        for (int q = 0; q < 4; ++q) {
            const f32x4 v = *(const f32x4*)(src + i + 4 * q) * scale;
            int w = 0; w = __builtin_amdgcn_cvt_pk_fp8_f32(v[0], v[1], w, false); w = __builtin_amdgcn_cvt_pk_fp8_f32(v[2], v[3], w, true);
            o[q] = (unsigned)w;
        }
        *(u32x4*)(dst + ((c >> 7) * 16384 + e) * 128 + (c & 127)) = o;
    }
}

DI void conv_u_i8(const float* src, unsigned char* dst, float scale, size_t gtid, size_t gthreads) {
    for (size_t i0 = gtid * 16; i0 < (size_t)16384 * 1024; i0 += gthreads * 32) {
        f32x4 v[2][4];
#pragma unroll
        for (int h = 0; h < 2; ++h)
#pragma unroll
            for (int q = 0; q < 4; ++q) v[h][q] = *(const f32x4*)(src + i0 + (size_t)h * gthreads * 16 + 4 * q);
#pragma unroll
        for (int h = 0; h < 2; ++h) {
            const size_t i = i0 + (size_t)h * gthreads * 16, e = i >> 10, c = i & 1023;
            u32x4 o;
#pragma unroll
            for (int q = 0; q < 4; ++q) { const f32x4 w = v[h][q] * scale; o[q] = pack_i8x4(w[0], w[1], w[2], w[3]); }
            *(u32x4*)(dst + ((c >> 7) * 16384 + e) * 128 + (c & 127)) = o;
        }
    }
}

DI int q4(float x) { return (int)__builtin_rintf(fminf(fmaxf(x, -8.f), 7.f)) & 15; }
DI void conv_u_i4(const float* src, unsigned char* dst, float inv_step, size_t gtid, size_t gthreads) {
    for (size_t i = gtid * 32; i < (size_t)16384 * 1024; i += gthreads * 32) {
        f32x4 v[8];
#pragma unroll
        for (int q = 0; q < 8; ++q) v[q] = *(const f32x4*)(src + i + 4 * q) * inv_step;
        u32x4 o;
#pragma unroll
        for (int j = 0; j < 4; ++j) {
            unsigned w = 0;
#pragma unroll
            for (int b = 0; b < 4; ++b) {
                if (UD8) w |= (unsigned)(q4(v[2 * j + (b >> 1)][2 * (b & 1)]) | (q4(v[2 * j + (b >> 1)][2 * (b & 1) + 1]) << 4)) << (8 * b);
                else w |= (unsigned)(q4(v[j][b]) | (q4(v[4 + j][b]) << 4)) << (8 * b);
            }
            o[j] = w;
        }
        const size_t e = i >> 10, c = i & 1023;
        *(u32x4*)(dst + ((c >> 8) * 16384 + e) * 128 + ((c & 255) >> 1)) = o;
    }
}

DI void conv_v_fp4(const float* src, unsigned char* dst, float inv_s, size_t gtid, size_t gthreads) {
    for (size_t i = gtid * 32; i < (size_t)16384 * 1024; i += gthreads * 32) {
        u32x4 o;
#pragma unroll
        for (int j = 0; j < 4; ++j) {
            f32x4 p = *(const f32x4*)(src + i + 8 * j) * inv_s, q = *(const f32x4*)(src + i + 8 * j + 4) * inv_s;
#pragma unroll
            for (int k = 0; k < 4; ++k) { p[k] = __builtin_amdgcn_fmed3f(p[k], -6.f, 6.f); q[k] = __builtin_amdgcn_fmed3f(q[k], -6.f, 6.f); }
            unsigned w = 0;
            w = __builtin_amdgcn_cvt_scalef32_pk_fp4_f32(w, p[0], p[1], 1.0f, 0); w = __builtin_amdgcn_cvt_scalef32_pk_fp4_f32(w, p[2], p[3], 1.0f, 1);
            w = __builtin_amdgcn_cvt_scalef32_pk_fp4_f32(w, q[0], q[1], 1.0f, 2); w = __builtin_amdgcn_cvt_scalef32_pk_fp4_f32(w, q[2], q[3], 1.0f, 3);
            o[j] = w;
        }
        const size_t e = i >> 10, c = i & 1023;
        *(u32x4*)(dst + ((c >> 8) * 16384 + e) * 128 + ((c & 255) >> 1)) = o;
    }
}

DI void ph_prologue(const KArgs& a, LAS unsigned char* lds, int tid, int lane, int wave, int blk, int nblk) {
    unsigned char* ws = a.ws;
    const int gw = blk * 8 + wave, ngw = nblk * 8;
    if (blk < 192) {
        LAS float* sc = (LAS float*)lds;
#pragma unroll 16
        for (int i = tid; i < 32 * 1024; i += 512) { const int b = i >> 10, k = i & 1023; const float v = a.c[i]; sc[k * 36 + b] = v * __builtin_amdgcn_rcpf(1.f + __expf(-v)); }
        __syncthreads();
        float acc[32];
#pragma unroll
        for (int b = 0; b < 32; ++b) acc[b] = 0.f;
        const int cl = lane & 31, kh = lane >> 5, col = blk * 32 + cl;
#pragma unroll 16
        for (int i = 0; i < 64; ++i) {
            const int k = wave * 128 + 2 * i + kh;
            const float wv = a.w_ada[(size_t)k * 6144 + col];
            const LAS f32x4* sp = (const LAS f32x4*)(sc + k * 36);
#pragma unroll
            for (int q = 0; q < 8; ++q) { const f32x4 s4 = sp[q]; acc[4 * q] += s4[0] * wv; acc[4 * q + 1] += s4[1] * wv; acc[4 * q + 2] += s4[2] * wv; acc[4 * q + 3] += s4[3] * wv; }
        }
        __syncthreads();
        LAS float* red = (LAS float*)lds;
#pragma unroll
        for (int b = 0; b < 32; ++b) red[((wave * 2 + kh) * 32 + b) * 32 + cl] = acc[b];
        __syncthreads();
        for (int o = tid; o < 1024; o += 512) {
            float s = 0.f;
#pragma unroll
            for (int p = 0; p < 16; ++p) s += red[p * 1024 + o];
            const int b = o >> 5, c2 = o & 31;
            ((float*)(ws + WS_MOD))[(size_t)b * 6144 + blk * 32 + c2] = s + a.b_ada[blk * 32 + c2];
        }
        __syncthreads();
    }
    {
        LAS float* scr = (LAS float*)(lds + wave * 8704);
        constexpr int I_WIN = 16 * 152, I_WB = 8 * 32, I_WO = 16 * 32, I_WPQ = 16 * 64;
        constexpr int NITEMS = I_WIN + 2 * I_WB + I_WO + I_WPQ;
        for (int it = gw; it < NITEMS; it += ngw) {
            int r = it;
            if (r < I_WIN) {
                const int pb = r % 152, kb = r / 152, pn = pb >> 3, bj = (pb >> 2) & 1, wc = pb & 3, g = pn * 4 + wc;
                const int nvalid = (g == 43) ? (bj == 0 ? 8 : 0) : 32;
                if (!((IN8_MASK >> pn) & 1u)) transpose_item(a.w_in, WIN_COLS, 1024, (bf16_t*)(ws + WS_WIN), rank_in(~IN8_MASK, pn) * 256 + (pb & 7) * 32, proj_group_base(g) + 32 * bj, nvalid, kb * 64, scr, lane);
                continue;
            }
            r -= I_WIN;
            if (r < I_WB) { if (!F8_BR && !BR8) transpose_item(a.w_ba, 1024, FUSE56 ? 1024 : 512, (bf16_t*)(ws + WS_WBA), (r % 32) * 32, (r % 32) * 32, 32, (r / 32) * 64, scr, lane); continue; }
            r -= I_WB;
            if (r < I_WB) { if (!F8_BR && !BR8) transpose_item(a.w_bb, 1024, FUSE56 ? 1024 : 512, FUSE56 ? (bf16_t*)(ws + WS_WBA) + 512 : (bf16_t*)(ws + WS_WBB), (r % 32) * 32, (r % 32) * 32, 32, (r / 32) * 64, scr, lane); continue; }
            r -= I_WB;
            if (r < I_WO) { if (!F8_BR && !F8_OUT) transpose_item(a.w_out, 1024, 1024, (bf16_t*)(ws + WS_WOUT), (r % 32) * 32, (r % 32) * 32, 32, (r / 32) * 64, scr, lane); continue; }
            r -= I_WO;
            if (PQ_MODE == 0) transpose_item(a.peer_wq, 2048, 1024, (bf16_t*)(ws + WS_WPQ), (r % 64) * 32, (r % 64) * 32, 32, (r / 64) * 64, scr, lane);
        }
    }
    {
        const size_t gtid = (size_t)blk * 512 + tid, gth = (size_t)nblk * 512;
        conv_bf16(a.sub_keys, (bf16_t*)(ws + WS_SKB), (size_t)8 * 2 * 128 * 128, gtid, gth);
        if (U4) absmax_to(a.peer_u, (size_t)1 << 21, (unsigned*)(ws + WS_CTL) + CW_UMAX, gtid, gth, lane);
        else {
            float mx = 0.f;
            for (size_t i = gtid * 4; i < (size_t)16384 * 1024; i += gth * 16) {
                f32x4 v[4];
#pragma unroll
                for (int q = 0; q < 4; ++q) v[q] = *(const f32x4*)(a.peer_u + i + (size_t)q * gth * 4);
#pragma unroll
                for (int q = 0; q < 4; ++q) mx = fmaxf(fmaxf(mx, fmaxf(fabsf(v[q][0]), fabsf(v[q][1]))), fmaxf(fabsf(v[q][2]), fabsf(v[q][3])));
            }
#pragma unroll
            for (int o = 1; o < 64; o <<= 1) mx = fmaxf(mx, __shfl_xor(mx, o));
            if (lane == 0) atomicMax((unsigned*)(ws + WS_CTL) + CW_UMAX, __builtin_bit_cast(unsigned, mx));
        }
        if (PQ_MODE != 0) absmax_to(a.peer_wq, (size_t)1024 * 2048, (unsigned*)(ws + WS_CTL) + CW_WMAX + 4, gtid, gth, lane);
        if (N8_IN > 0) absmax_to(a.w_in, (size_t)1024 * WIN_COLS, (unsigned*)(ws + WS_CTL) + CW_WMAX + 0, gtid, gth, lane);
        if (F8_OUT && !F8_BR && !BR8) absmax_to(a.w_out, (size_t)1024 * 1024, (unsigned*)(ws + WS_CTL) + CW_WMAX + 3, gtid, gth, lane);
        if (F8_BR || BR8) {
            absmax_to(a.w_ba, (size_t)512 * 1024, (unsigned*)(ws + WS_CTL) + CW_WMAX + 1, gtid, gth, lane);
            absmax_to(a.w_bb, (size_t)512 * 1024, (unsigned*)(ws + WS_CTL) + CW_WMAX + 2, gtid, gth, lane);
            if (F8_BR || F8_OUT) absmax_to(a.w_out, (size_t)1024 * 1024, (unsigned*)(ws + WS_CTL) + CW_WMAX + 3, gtid, gth, lane);
        }
        if (V4) absmax_to(a.peer_v, (size_t)1 << 21, (unsigned*)(ws + WS_CTL) + CW_VMAX, gtid, gth, lane);
        else conv_fp8(a.peer_v, ws + WS_VB, (size_t)16384 * 1024, VSCALE, gtid, gth);
        for (size_t t = gtid; t < (size_t)NTOK * 2; t += gth) {
            const int m = (int)(t >> 1), half = (int)(t & 1);
            double f = half ? 0.15915494309189535 * 0.01 : 0.15915494309189535;
            const double p = (double)a.pos[m];
            float cs[16], sn[16];
#pragma unroll
            for (int k = 0; k < 16; ++k) {
                const double rev = p * f;
                const float fr = (float)(rev - __builtin_floor(rev)) * 6.283185307179586f;
                cs[k] = cosf(fr); sn[k] = sinf(fr);
                f *= 0.7498942093324559;
            }
            float* cp = (float*)(ws + WS_COS) + (size_t)m * 32 + 16 * half; float* sp = (float*)(ws + WS_SIN) + (size_t)m * 32 + 16 * half;
#pragma unroll
            for (int k = 0; k < 4; ++k) { *(f32x4*)(cp + 4 * k) = (f32x4){cs[4 * k], cs[4 * k + 1], cs[4 * k + 2], cs[4 * k + 3]}; *(f32x4*)(sp + 4 * k) = (f32x4){sn[4 * k], sn[4 * k + 1], sn[4 * k + 2], sn[4 * k + 3]}; }
        }
    }
}

DI void ph_weights8(const KArgs& a, LAS unsigned char* lds, int lane, int wave, int blk, int nblk) {
    unsigned char* ws = a.ws;
    const int gw = blk * 8 + wave, ngw = nblk * 8;
    LAS float* scr = (LAS float*)(lds + wave * 8704);
    if (PQ_MODE != 0) {
        const float spq = wscale8(ws, 4) * (PQ_MODE == 2 ? 127.f / WTOP8 : 1.f);
        for (int r = gw; r < 16 * 64; r += ngw) transpose_item8<PQ_MODE == 2>(a.peer_wq, 2048, 1024, ws + WS_WPQ, (r % 64) * 32, (r % 64) * 32, 32, (r / 64) * 64, spq, scr, lane);
    }
    if (N8_IN > 0) {
        const float si = wscale8(ws, 0) * (IN_MODE == 2 ? 127.f / WTOP8 : 1.f);
        for (int r = gw; r < 16 * 152; r += ngw) {
            const int pb = r % 152, kb = r / 152, pn = pb >> 3, bj = (pb >> 2) & 1, wc = pb & 3, g = pn * 4 + wc;
            if ((IN8_MASK >> pn) & 1u) transpose_item8<IN_MODE == 2>(a.w_in, WIN_COLS, 1024, ws + WS_WIN8, rank_in(IN8_MASK, pn) * 256 + (pb & 7) * 32, proj_group_base(g) + 32 * bj, (g == 43) ? (bj == 0 ? 8 : 0) : 32, kb * 64, si, scr, lane);
        }
    }
    if (BR8 && !F8_BR) {
        const float sa = wscale8(ws, 1) * (127.f / WTOP8), sb = wscale8(ws, 2) * (127.f / WTOP8);
        for (int it = gw; it < 2 * 256; it += ngw) {
            const int r = it & 255;
            if (it < 256) transpose_item8<true>(a.w_ba, 1024, 512, ws + WS_WBA, (r % 32) * 32, (r % 32) * 32, 32, (r / 32) * 64, sa, scr, lane);
            else transpose_item8<true>(a.w_bb, 1024, 512, ws + WS_WBB, (r % 32) * 32, (r % 32) * 32, 32, (r / 32) * 64, sb, scr, lane);
        }
    }
    if (F8_OUT && !F8_BR) {
        const float so = wscale8(ws, 3);
        for (int r = gw; r < 512; r += ngw) transpose_item8(a.w_out, 1024, 1024, ws + WS_WOUT, (r % 32) * 32, (r % 32) * 32, 32, (r / 32) * 64, so, scr, lane);
    }
    if (F8_BR) {
        const float sa = wscale8(ws, 1), sb = wscale8(ws, 2), so = wscale8(ws, 3);
        for (int it = gw; it < 2 * 256 + 512; it += ngw) {
            int r = it;
            if (r < 256) { transpose_item8(a.w_ba, 1024, 512, ws + WS_WBA, (r % 32) * 32, (r % 32) * 32, 32, (r / 32) * 64, sa, scr, lane); continue; }
            r -= 256;
            if (r < 256) { transpose_item8(a.w_bb, 1024, 512, ws + WS_WBB, (r % 32) * 32, (r % 32) * 32, 32, (r / 32) * 64, sb, scr, lane); continue; }
            r -= 256;
            transpose_item8(a.w_out, 1024, 1024, ws + WS_WOUT, (r % 32) * 32, (r % 32) * 32, 32, (r / 32) * 64, so, scr, lane);
        }
    }
}

template <bool I8, bool WB16, bool WF8, bool NIB = false>
DI void ph_norm(const float* src, const float* gain, const float* mod, int sh_off, int sc_off, bf16_t* dst, unsigned char* dstf, unsigned char* dst8, float* hs, int lane, int wave, int blk, int nblk, unsigned char* ha = nullptr, unsigned char* hb = nullptr) {
    const int gw = blk * 8 + wave, ngw = nblk * 8;
    const int rows_per = NTOK / ngw;
    for (int r0 = gw * rows_per; r0 < NTOK; r0 += ngw * rows_per) {
        const int b = r0 / NT;
        f32x4 mul[4], add[4];
#pragma unroll
        for (int j = 0; j < 4; ++j) {
            const int col = 4 * lane + 256 * j;
            const f32x4 g = *(const f32x4*)(gain + col), s = *(const f32x4*)(mod + (size_t)b * 6144 + sc_off + col);
            mul[j] = g * (s + 1.f); add[j] = *(const f32x4*)(mod + (size_t)b * 6144 + sh_off + col);
        }
        f32x4 vn[4][4];
#pragma unroll
        for (int q = 0; q < 4; ++q) {
            const f32x4* xr = (const f32x4*)(src + (size_t)(r0 + q) * 1024) + lane;
#pragma unroll
            for (int j = 0; j < 4; ++j) vn[q][j] = xr[64 * j];
        }
#pragma unroll 2
        for (int r = r0; r < r0 + rows_per; r += 4) {
            f32x4 v[4][4]; float s[4];
#pragma unroll
            for (int q = 0; q < 4; ++q)
#pragma unroll
                for (int j = 0; j < 4; ++j) v[q][j] = vn[q][j];
            if (r + 4 < r0 + rows_per) {
#pragma unroll
                for (int q = 0; q < 4; ++q) {
                    const f32x4* xr = (const f32x4*)(src + (size_t)(r + 4 + q) * 1024) + lane;
#pragma unroll
                    for (int j = 0; j < 4; ++j) vn[q][j] = xr[64 * j];
                }
            }
#pragma unroll
            for (int q = 0; q < 4; ++q) {
                s[q] = 0.f;
#pragma unroll
                for (int j = 0; j < 4; ++j) s[q] += (v[q][j][0] * v[q][j][0] + v[q][j][1] * v[q][j][1]) + (v[q][j][2] * v[q][j][2] + v[q][j][3] * v[q][j][3]);
            }
#pragma unroll
            for (int o = 1; o < 64; o <<= 1) {
#pragma unroll
                for (int q = 0; q < 4; ++q) s[q] += __shfl_xor(s[q], o);
            }
#pragma unroll
            for (int q = 0; q < 4; ++q) {
                const float rn = __builtin_amdgcn_rsqf(s[q] * (1.f / 1024.f) + EPS);
                u32x2* o = (u32x2*)(dst + (size_t)(r + q) * 1024) + lane;
                f32x4 y[4]; float am = 0.f;
#pragma unroll
                for (int j = 0; j < 4; ++j) { y[j] = v[q][j] * rn * mul[j] + add[j];
                    if (WF8) { ((unsigned*)(dstf + (size_t)(r + q) * 1024) + lane)[64 * j] = pack_fp8x4(y[j][0] * ASC8, y[j][1] * ASC8, y[j][2] * ASC8, y[j][3] * ASC8); }
                    if (WB16) { u32x2 w; w.x = pk2(y[j][0], y[j][1]); w.y = pk2(y[j][2], y[j][3]); o[64 * j] = w; }
                    if (I8) am = fmaxf(fmaxf(am, fmaxf(fabsf(y[j][0]), fabsf(y[j][1]))), fmaxf(fabsf(y[j][2]), fabsf(y[j][3]))); }
                if (I8) {
#pragma unroll
                    for (int oo = 1; oo < 64; oo <<= 1) am = fmaxf(am, __shfl_xor(am, oo));
                    am = fmaxf(am, 1e-20f);
                    const float qs = (NIB ? 119.f : 127.f) / am;
                    unsigned* o8 = (unsigned*)(dst8 + (size_t)(r + q) * 1024) + lane;
#pragma unroll
                    for (int j = 0; j < 4; ++j) {
                        o8[64 * j] = pack_i8x4(y[j][0] * qs, y[j][1] * qs, y[j][2] * qs, y[j][3] * qs);
                        if (NIB) {
                            unsigned na = 0, nb = 0;
#pragma unroll
                            for (int e = 0; e < 4; ++e) { const int qi = (int)__builtin_rintf(y[j][e] * qs); nb |= (unsigned)(qi & 15) << (4 * e); na |= (unsigned)(((qi + 8) >> 4) & 15) << (4 * e); }
                            const unsigned na2 = __shfl_xor(na, 1), nb2 = __shfl_xor(nb, 1);
                            if (!(lane & 1)) {
                                *(unsigned*)(ha + (size_t)(r + q) * 512 + 2 * lane + 128 * j) = na | (na2 << 16);
                                *(unsigned*)(hb + (size_t)(r + q) * 512 + 2 * lane + 128 * j) = nb | (nb2 << 16);
                            }
                        }
                    }
                    if (lane == 0) hs[r + q] = am * (1.f / (NIB ? 119.f : 127.f));
                }
            }
        }
    }
}
typedef short v4i16_t __attribute__((ext_vector_type(4)));
DI s16x4 tr_read(const LAS char* p) { return __builtin_bit_cast(s16x4, __builtin_amdgcn_ds_read_tr16_b64_v4i16((LAS v4i16_t*)p)); }
DI bf16x8 pack8(float x0, float x1, float x2, float x3, float x4, float x5, float x6, float x7) {
    u32x4 p; p.x = pk2(x0, x1); p.y = pk2(x2, x3); p.z = pk2(x4, x5); p.w = pk2(x6, x7); return __builtin_bit_cast(bf16x8, p);
}
#define MFMA32(a, b, c) __builtin_amdgcn_mfma_f32_32x32x16_bf16((a), (b), (c), 0, 0, 0)
#define MFMA16(a, b, c) __builtin_amdgcn_mfma_f32_16x16x32_bf16((a), (b), (c), 0, 0, 0)

DI float max3f(float a, float b, float c) { float r; asm("v_max3_f32 %0, %1, %2, %3" : "=v"(r) : "v"(a), "v"(b), "v"(c)); return r; }
template <int BP> DI int bfe1s(int w) { int r; asm("v_bfe_i32 %0, %1, %2, 1" : "=v"(r) : "v"(w), "n"(BP)); return r; }
template <int NDB, int KST, int VST, bool MASK>
DI void attn_tile(const LAS char* kb, const LAS char* vb, f32x16 (&o)[NDB], float& m, float& l, const bf16x8 (&qf)[4], unsigned mw0, unsigned mw1, int lane) {
    const int r32 = lane & 31, hi = lane >> 5;
    f32x16 p0, p1;
#pragma unroll
    for (int r = 0; r < 16; ++r) { p0[r] = 0.f; p1[r] = 0.f; }
    const LAS char* ka = kb + r32 * KST + hi * 16;
#pragma unroll
    for (int ks = 0; ks < 4; ++ks) {
        const bf16x8 a0 = *(const LAS bf16x8*)(ka + ks * 32), a1 = *(const LAS bf16x8*)(ka + 32 * KST + ks * 32);
        p0 = MFMA32(a0, qf[ks], p0); p1 = MFMA32(a1, qf[ks], p1);
    }
    float tm;
    {
        float t[16];
#pragma unroll
        for (int r = 0; r < 16; ++r) t[r] = fmaxf(p0[r], p1[r]);
        const float u0 = max3f(t[0], t[1], t[2]), u1 = max3f(t[3], t[4], t[5]), u2 = max3f(t[6], t[7], t[8]), u3 = max3f(t[9], t[10], t[11]), u4 = max3f(t[12], t[13], t[14]);
        tm = fmaxf(max3f(u0, u1, u2), max3f(u3, u4, t[15]));
    }
    tm = fmaxf(tm, __shfl_xor(tm, 32));
    const float mn = fmaxf(m, tm);
    const float alpha = fexp2(m - mn);
    float rs = 0.f;
    if (MASK) {
        const int w0 = (int)(mw0 >> (4 * hi)), w1 = (int)(mw1 >> (4 * hi));
#define ATT_MASKED(r_) { constexpr int bp = ((r_) & 3) + 8 * ((r_) >> 2); \
            p0[r_] = __builtin_bit_cast(float, __builtin_bit_cast(int, fexp2(p0[r_] - mn)) & bfe1s<bp>(w0)); \
            p1[r_] = __builtin_bit_cast(float, __builtin_bit_cast(int, fexp2(p1[r_] - mn)) & bfe1s<bp>(w1)); rs += p0[r_] + p1[r_]; }
        ATT_MASKED(0) ATT_MASKED(1) ATT_MASKED(2) ATT_MASKED(3) ATT_MASKED(4) ATT_MASKED(5) ATT_MASKED(6) ATT_MASKED(7)
        ATT_MASKED(8) ATT_MASKED(9) ATT_MASKED(10) ATT_MASKED(11) ATT_MASKED(12) ATT_MASKED(13) ATT_MASKED(14) ATT_MASKED(15)
#undef ATT_MASKED
    } else {
#pragma unroll
        for (int r = 0; r < 16; ++r) { p0[r] = fexp2(p0[r] - mn); p1[r] = fexp2(p1[r] - mn); rs += p0[r] + p1[r]; }
    }
    rs += __shfl_xor(rs, 32);
    l = l * alpha + rs; m = mn;
    if (__ballot(alpha != 1.0f)) {
#pragma unroll
        for (int db = 0; db < NDB; ++db)
#pragma unroll
            for (int r = 0; r < 16; ++r) o[db][r] *= alpha;
    }
    bf16x8 pf[4];
    pf[0] = pack8(p0[0], p0[1], p0[2], p0[3], p0[4], p0[5], p0[6], p0[7]);
    pf[1] = pack8(p0[8], p0[9], p0[10], p0[11], p0[12], p0[13], p0[14], p0[15]);
    pf[2] = pack8(p1[0], p1[1], p1[2], p1[3], p1[4], p1[5], p1[6], p1[7]);
    pf[3] = pack8(p1[8], p1[9], p1[10], p1[11], p1[12], p1[13], p1[14], p1[15]);
    const int i16 = lane & 15, q4 = i16 >> 2, pp = i16 & 3, g = lane >> 4;
    const LAS char* va = vb + (4 * (g >> 1) + q4) * VST + (16 * (g & 1) + 4 * pp) * 2;
#pragma unroll
    for (int db = 0; db < NDB; ++db)
#pragma unroll
        for (int s = 0; s < 4; ++s) {
            const s16x4 lo = tr_read(va + (16 * s) * VST + db * 64), h4 = tr_read(va + (16 * s + 8) * VST + db * 64);
            const bf16x8 vf = __builtin_shufflevector(lo, h4, 0, 1, 2, 3, 4, 5, 6, 7);
            o[db] = MFMA32(vf, pf[s], o[db]);
        }
}

DI void ph_diff_attn(const KArgs& a, LAS unsigned char* lds, int tid, int lane, int wave, int blk, int nblk) {
    unsigned char* ws = a.ws;
    const bf16_t* Qd = (const bf16_t*)(ws + WS_QD); const bf16_t* Kd = (const bf16_t*)(ws + WS_KD); const bf16_t* Vd = (const bf16_t*)(ws + WS_VD);
    bf16_t* OAB = (bf16_t*)(ws + WS_OAB);
    float lam;
    { const float d1 = wave_sum(a.lq1[lane] * a.lk1[lane]), d2 = wave_sum(a.lq2[lane] * a.lk2[lane]); lam = expf(d1) - expf(d2) + LAMBDA_INIT; }
    constexpr int KST = 272, VST = 320, KBYTES = 64 * KST, BUF = KBYTES + 64 * VST;
    const int mp = wave >> 2, qg = wave & 3, r32 = lane & 31, hi = lane >> 5;
    for (int idx = blk; idx < 2048; idx += nblk) {
        const int j = idx & 255, i = idx >> 8, pr = j & 127, half = j >> 7, kq = half * 4 + (i >> 1), qb = (i & 1) ? 15 - kq : kq;
        const int b = pr >> 2, h = pr & 3;
        const size_t rb = (size_t)b * NT;
        const int q0 = qb * 128 + 32 * qg, nT = 2 * qb + 2, myT = 2 * qb + 1 + (qg >> 1);
        bf16x8 qf[4];
        { const bf16_t* qp = Qd + (rb + q0 + r32) * 512 + h * 128 + mp * 64 + 8 * hi;
#pragma unroll
          for (int ks = 0; ks < 4; ++ks) qf[ks] = *(const bf16x8*)(qp + 16 * ks); }
        f32x16 o[4]; float m = -INFINITY, l = 0.f;
#pragma unroll
        for (int db = 0; db < 4; ++db)
#pragma unroll
            for (int r = 0; r < 16; ++r) o[db][r] = 0.f;
        const int key0 = tid >> 4, ch = tid & 15;
        const bf16_t* kg = Kd + (rb + key0) * 512 + h * 128 + ch * 8;
        const bf16_t* vg = Vd + (rb + key0) * 512 + h * 128 + ch * 8;
        const int loff = key0 * KST + ch * 16, loffv = KBYTES + key0 * VST + ch * 16;
        u32x4 sk0 = *(const u32x4*)kg, sk1 = *(const u32x4*)(kg + 32 * 512), sv0 = *(const u32x4*)vg, sv1 = *(const u32x4*)(vg + 32 * 512);
        *(LAS u32x4*)(lds + loff) = sk0; *(LAS u32x4*)(lds + loff + 32 * KST) = sk1;
        *(LAS u32x4*)(lds + loffv) = sv0; *(LAS u32x4*)(lds + loffv + 32 * VST) = sv1;
        if (nT > 1) { const size_t go = (size_t)64 * 512; sk0 = *(const u32x4*)(kg + go); sk1 = *(const u32x4*)(kg + go + 32 * 512); sv0 = *(const u32x4*)(vg + go); sv1 = *(const u32x4*)(vg + go + 32 * 512); }
        __syncthreads();
        for (int t = 0; t < nT; ++t) {
            const bool more = (t + 1 < nT), more2 = (t + 2 < nT);
            u32x4 nk0 = sk0, nk1 = sk1, nv0 = sv0, nv1 = sv1;
            if (more2) {
                const size_t go = (size_t)(t + 2) * 64 * 512;
                nk0 = *(const u32x4*)(kg + go); nk1 = *(const u32x4*)(kg + go + 32 * 512); nv0 = *(const u32x4*)(vg + go); nv1 = *(const u32x4*)(vg + go + 32 * 512);
            }
            if (t < myT) {
                const LAS char* bufp = (const LAS char*)lds + (t & 1) * BUF;
                attn_tile<4, KST, VST, false>(bufp + mp * 128, bufp + KBYTES, o, m, l, qf, 0u, 0u, lane);
            }
            if (more) {
                LAS unsigned char* nb = lds + ((t + 1) & 1) * BUF;
                *(LAS u32x4*)(nb + loff) = sk0; *(LAS u32x4*)(nb + loff + 32 * KST) = sk1;
                *(LAS u32x4*)(nb + loffv) = sv0; *(LAS u32x4*)(nb + loffv + 32 * VST) = sv1;
            }
            __syncthreads();
            sk0 = nk0; sk1 = nk1; sv0 = nv0; sv1 = nv1;
        }
        const float il = 1.f / l;
        LAS float* scr = (LAS float*)lds;
        if (mp == 1) {
#pragma unroll
            for (int db = 0; db < 4; ++db)
#pragma unroll
                for (int r = 0; r < 16; ++r) scr[((qg * 4 + db) * 16 + r) * 64 + lane] = o[db][r] * il;
        }
        __syncthreads();
        if (mp == 0) {
            float ss = 0.f;
#pragma unroll
            for (int db = 0; db < 4; ++db)
#pragma unroll
                for (int r = 0; r < 16; ++r) { const float v = o[db][r] * il - lam * scr[((qg * 4 + db) * 16 + r) * 64 + lane]; o[db][r] = v; ss += v * v; }
            ss += __shfl_xor(ss, 32);
            const float rn = __builtin_amdgcn_rsqf(ss * (1.f / 128.f) + EPS) * (1.f - LAMBDA_INIT);
            const size_t oo = (rb + q0 + r32) * (FUSE56 ? 1024 : 512) + h * 128 + 4 * hi;
            bf16_t* op = OAB + oo; unsigned char* op8 = (unsigned char*)OAB + oo;
            const float rn8 = rn * ASC8;
            f32x4 gall[16];
#pragma unroll
            for (int i = 0; i < 16; ++i) gall[i] = *(const f32x4*)(a.diff_out_g + 32 * (i >> 2) + 8 * (i & 3) + 4 * hi);
#pragma unroll
            for (int db = 0; db < 4; ++db)
#pragma unroll
                for (int r4 = 0; r4 < 4; ++r4) {
                    const int d0 = 32 * db + 8 * r4;
                    const f32x4 g4 = gall[db * 4 + r4];
                    if (BR8 && !F8_BR) { const float q8 = rn * (127.f / OA_MAX); *(unsigned*)(op8 + d0) = pack_i8x4(o[db][4 * r4] * q8 * g4[0], o[db][4 * r4 + 1] * q8 * g4[1], o[db][4 * r4 + 2] * q8 * g4[2], o[db][4 * r4 + 3] * q8 * g4[3]); }
                    else if (F8_BR) { *(unsigned*)(op8 + d0) = pack_fp8x4(o[db][4 * r4] * rn8 * g4[0], o[db][4 * r4 + 1] * rn8 * g4[1], o[db][4 * r4 + 2] * rn8 * g4[2], o[db][4 * r4 + 3] * rn8 * g4[3]); }
                    else {
                    u32x2 w; w.x = pk2(o[db][4 * r4] * rn * g4[0], o[db][4 * r4 + 1] * rn * g4[1]); w.y = pk2(o[db][4 * r4 + 2] * rn * g4[2], o[db][4 * r4 + 3] * rn * g4[3]);
                    *(u32x2*)(op + d0) = w; }
                }
        }
        __syncthreads();
    }
}

template <int VARIANT = 0>
DI void ph_dsa_attn(const KArgs& a, LAS unsigned char* lds, int tid, int lane, int wave, int blk, int nblk) {
    unsigned char* ws = a.ws;
    const bf16_t* Qs = (const bf16_t*)(ws + WS_QS); const bf16_t* Ks = (const bf16_t*)(ws + WS_KS); const bf16_t* Vs = (const bf16_t*)(ws + WS_VS);
    const unsigned* BM = (const unsigned*)(ws + WS_BM);
    bf16_t* OAB = (bf16_t*)(ws + WS_OAB);
    constexpr int KST = 144, VST = 192, KBYTES = 64 * KST, BUF = KBYTES + 64 * VST;
    const int r32 = lane & 31, hi = lane >> 5;
    for (int idx = blk; idx < 1024; idx += nblk) {
        const int j = idx & 255, i = idx >> 8, b = j >> 3, rr = j & 7, cq = (i & 1) ? 16 * (i >> 1) + 15 - rr : 16 * (i >> 1) + rr;
        const size_t rb = (size_t)b * NT;
        const int q0 = 64 * cq, nT = cq + 1;
        bf16x8 qfA[4], qfB[4];
        { const bf16_t* qp = Qs + (rb + q0 + r32) * 512 + wave * 64 + 8 * hi;
#pragma unroll
          for (int ks = 0; ks < 4; ++ks) { qfA[ks] = *(const bf16x8*)(qp + 16 * ks); qfB[ks] = *(const bf16x8*)(qp + 32 * 512 + 16 * ks); } }
        f32x16 oA[2], oB[2]; float mA = -INFINITY, lA = 0.f, mB = -INFINITY, lB = 0.f;
#pragma unroll
        for (int db = 0; db < 2; ++db)
#pragma unroll
            for (int r = 0; r < 16; ++r) { oA[db][r] = 0.f; oB[db][r] = 0.f; }
        const int key0 = tid >> 3, ch = tid & 7;
        const bf16_t* kg = Ks + (rb + key0) * 64 + ch * 8;
        const bf16_t* vg = Vs + (rb + key0) * 64 + ch * 8;
        const int loff = key0 * KST + ch * 16, loffv = KBYTES + key0 * VST + ch * 16;
        const unsigned* bmpA = BM + (rb + q0 + r32) * 64;
        const unsigned* bmpB = bmpA + 32 * 64;
        u32x4 sk0 = *(const u32x4*)kg, sv0 = *(const u32x4*)vg;
        u32x2 mwA = *(const u32x2*)bmpA, mwB = *(const u32x2*)bmpB, mnA = mwA, mnB = mwB;
        *(LAS u32x4*)(lds + loff) = sk0; *(LAS u32x4*)(lds + loffv) = sv0;
        __syncthreads();
        for (int t = 0; t < nT; ++t) {
            const bool more = (t + 1 < nT);
            if (more) {
                const size_t go = (size_t)(t + 1) * 64 * 64;
                sk0 = *(const u32x4*)(kg + go); sv0 = *(const u32x4*)(vg + go); mnA = *(const u32x2*)(bmpA + 2 * (t + 1)); mnB = *(const u32x2*)(bmpB + 2 * (t + 1));
            }
            {
                const LAS char* bufp = (const LAS char*)lds + (t & 1) * BUF;
                attn_tile<2, KST, VST, true>(bufp, bufp + KBYTES, oA, mA, lA, qfA, mwA.x, mwA.y, lane);
                attn_tile<2, KST, VST, true>(bufp, bufp + KBYTES, oB, mB, lB, qfB, mwB.x, mwB.y, lane);
            }
            if (more) {
                LAS unsigned char* nb = lds + ((t + 1) & 1) * BUF;
                *(LAS u32x4*)(nb + loff) = sk0; *(LAS u32x4*)(nb + loffv) = sv0;
                mwA = mnA; mwB = mnB;
            }
            __syncthreads();
        }
        {
            float ilA = (F8_BR ? ASC8 : 1.f) / lA, ilB = (F8_BR ? ASC8 : 1.f) / lB;
            if (BR8 && !F8_BR) {
                float mA = 0.f, mB = 0.f;
#pragma unroll
                for (int db = 0; db < 2; ++db)
#pragma unroll
                    for (int r = 0; r < 16; ++r) { mA = fmaxf(mA, fabsf(oA[db][r])); mB = fmaxf(mB, fabsf(oB[db][r])); }
                mA *= ilA; mB *= ilB;
                mA = fmaxf(mA, __shfl_xor(mA, 32)); mB = fmaxf(mB, __shfl_xor(mB, 32));
                LAS float* xm = (LAS float*)lds;
                if (hi == 0) { xm[wave * 64 + r32] = mA; xm[wave * 64 + 32 + r32] = mB; }
                __syncthreads();
                float rA = 1e-20f, rB = 1e-20f;
#pragma unroll
                for (int w8 = 0; w8 < 8; ++w8) { rA = fmaxf(rA, xm[w8 * 64 + r32]); rB = fmaxf(rB, xm[w8 * 64 + 32 + r32]); }
                __syncthreads();
                ilA *= 127.f / rA; ilB *= 127.f / rB;
                if (wave == 0 && hi == 0) { float* obs = (float*)(ws + WS_OBS); obs[rb + q0 + r32] = rA * (1.f / 127.f); obs[rb + q0 + 32 + r32] = rB * (1.f / 127.f); }
            }
            const size_t oo = FUSE56 ? (rb + q0 + r32) * 1024 + 512 + wave * 64 + 4 * hi : (size_t)NTOK * 512 + (rb + q0 + r32) * 512 + wave * 64 + 4 * hi;
            constexpr int OST = FUSE56 ? 1024 : 512;
            bf16_t* op = OAB + oo; unsigned char* op8 = (unsigned char*)OAB + oo;
#pragma unroll
            for (int db = 0; db < 2; ++db)
#pragma unroll
                for (int r4 = 0; r4 < 4; ++r4) {
                    if (BR8 && !F8_BR) {
                        *(unsigned*)(op8 + 32 * db + 8 * r4) = pack_i8x4(oA[db][4 * r4] * ilA, oA[db][4 * r4 + 1] * ilA, oA[db][4 * r4 + 2] * ilA, oA[db][4 * r4 + 3] * ilA);
                        *(unsigned*)(op8 + 32 * OST + 32 * db + 8 * r4) = pack_i8x4(oB[db][4 * r4] * ilB, oB[db][4 * r4 + 1] * ilB, oB[db][4 * r4 + 2] * ilB, oB[db][4 * r4 + 3] * ilB);
                    } else if (F8_BR) {
                        *(unsigned*)(op8 + 32 * db + 8 * r4) = pack_fp8x4(oA[db][4 * r4] * ilA, oA[db][4 * r4 + 1] * ilA, oA[db][4 * r4 + 2] * ilA, oA[db][4 * r4 + 3] * ilA);
                        *(unsigned*)(op8 + 32 * OST + 32 * db + 8 * r4) = pack_fp8x4(oB[db][4 * r4] * ilB, oB[db][4 * r4 + 1] * ilB, oB[db][4 * r4 + 2] * ilB, oB[db][4 * r4 + 3] * ilB);
                    } else {
                    u32x2 w; w.x = pk2(oA[db][4 * r4] * ilA, oA[db][4 * r4 + 1] * ilA); w.y = pk2(oA[db][4 * r4 + 2] * ilA, oA[db][4 * r4 + 3] * ilA);
                    *(u32x2*)(op + 32 * db + 8 * r4) = w;
                    u32x2 w2; w2.x = pk2(oB[db][4 * r4] * ilB, oB[db][4 * r4 + 1] * ilB); w2.y = pk2(oB[db][4 * r4 + 2] * ilB, oB[db][4 * r4 + 3] * ilB);
                    *(u32x2*)(op + 32 * OST + 32 * db + 8 * r4) = w2; }
                }
        }
    }
}

template <bool DO_SEL = true>
DI void ph_indexer(const KArgs& a, LAS unsigned char* lds, int tid, int lane, int wave, int blk, int nblk) {
    unsigned char* ws = a.ws;
    const bf16_t* Qi = (const bf16_t*)(ws + WS_QI); const bf16_t* Ki = (const bf16_t*)(ws + WS_KI); const float* Widx = (const float*)(ws + WS_WIDX);
    unsigned long long* BM = (unsigned long long*)(ws + WS_BM);
    constexpr int SCS = 2052;
    LAS float* sc = (LAS float*)lds;
    const int l15 = lane & 15, l4 = lane >> 4;
    bf16x8 qfr[8][2]; f32x4 w0, w1;
#define IDX_DECODE(idx_, b_, qi_) const int b_ = (idx_) >> 7, qi_ = (((idx_) & 127) + 8 * ((idx_) >> 8)) & 127
#define IDX_LOADQ(idx_) do { IDX_DECODE(idx_, b__, qi__); const bf16_t* qp = Qi + ((size_t)b__ * NT + 16 * qi__ + l15) * 512 + 8 * l4; \
        _Pragma("unroll") for (int h = 0; h < 8; ++h) { qfr[h][0] = *(const bf16x8*)(qp + h * 64); qfr[h][1] = *(const bf16x8*)(qp + h * 64 + 32); } \
        w0 = *(const f32x4*)(Widx + ((size_t)b__ * NT + 16 * qi__ + l15) * 8); w1 = *(const f32x4*)(Widx + ((size_t)b__ * NT + 16 * qi__ + l15) * 8 + 4); } while (0)
    if (blk < 4096) IDX_LOADQ(blk);
    for (int idx = blk; idx < 4096; idx += nblk) {
        IDX_DECODE(idx, b, qi);
        const size_t rb = (size_t)b * NT;
        const int q0 = 16 * qi, chunk = qi >> 2, nj = chunk + 1, nt16 = 4 * nj;
        constexpr float IS = 0.044194173824159216f;
        const float w[8] = {w0[0] * IS, w0[1] * IS, w0[2] * IS, w0[3] * IS, w1[0] * IS, w1[1] * IS, w1[2] * IS, w1[3] * IS};
        {
            int tile = wave;
            const bf16_t* kp = Ki + (rb + 16 * tile + l15) * 64 + 8 * l4;
            bf16x8 ka0 = *(const bf16x8*)kp, ka1 = *(const bf16x8*)(kp + 32);
            for (; tile < nt16; tile += 8) {
                const int ntile = (tile + 8 < nt16) ? tile + 8 : tile;
                const bf16_t* np = Ki + (rb + 16 * ntile + l15) * 64 + 8 * l4;
                const bf16x8 nk0 = *(const bf16x8*)np, nk1 = *(const bf16x8*)(np + 32);
                f32x4 s4 = {0.f, 0.f, 0.f, 0.f};
#pragma unroll
                for (int h = 0; h < 8; ++h) {
                    f32x4 c = {0.f, 0.f, 0.f, 0.f};
                    c = MFMA16(ka0, qfr[h][0], c); c = MFMA16(ka1, qfr[h][1], c);
#pragma unroll
                    for (int r = 0; r < 4; ++r) s4[r] += fmaxf(c[r], 0.f) * w[h];
                }
                *(LAS f32x4*)(sc + l15 * SCS + 16 * tile + 4 * l4) = s4;
                ka0 = nk0; ka1 = nk1;
            }
        }
        __syncthreads();
        if (idx + nblk < 4096) IDX_LOADQ(idx + nblk);
        if (DO_SEL) {
            const int qa = 2 * wave, qb = qa + 1;
            unsigned ua[32], ub[32];
#pragma unroll
            for (int jj = 0; jj < 32; ++jj) {
                ua[jj] = 0u; ub[jj] = 0u;
                if (jj < nj) {
                    const float sa = sc[qa * SCS + lane + 64 * jj] + 24.0f, sb = sc[qb * SCS + lane + 64 * jj] + 24.0f;
                    const unsigned ba = __builtin_bit_cast(unsigned, sa), bb = __builtin_bit_cast(unsigned, sb);
                    ua[jj] = (ba & 0x80000000u) ? ~ba : (ba | 0x80000000u); ub[jj] = (bb & 0x80000000u) ? ~bb : (bb | 0x80000000u);
                }
            }
            unsigned long long maska = 0ull, maskb = 0ull;
            if (nj <= 4) { maska = ~0ull; maskb = ~0ull; }
            else {
                unsigned pa = 0u, pb = 0u; bool da = false, db = false;
                int start = 31;
                {
                    unsigned ora = 0u, anda = ~0u, orb = 0u, andb = ~0u;
#pragma unroll
                    for (int jj = 0; jj < 32; ++jj) if (jj < nj) { ora |= ua[jj]; anda &= ua[jj]; orb |= ub[jj]; andb &= ub[jj]; }
#pragma unroll
                    for (int o = 1; o < 64; o <<= 1) { ora |= __shfl_xor(ora, o); anda &= __shfl_xor(anda, o); orb |= __shfl_xor(orb, o); andb &= __shfl_xor(andb, o); }
                    const unsigned dd = __builtin_amdgcn_readfirstlane((ora ^ anda) | (orb ^ andb));
                    start = dd ? 31 - __builtin_clz(dd) : -1;
                    const unsigned keep = (start >= 31) ? 0u : (0xFFFFFFFFu << (start + 1));
                    pa = anda & keep; pb = andb & keep;
                }
#pragma unroll 1
                for (int bit = start; bit >= 0; --bit) {
                    const unsigned ca = da ? pa : (pa | (1u << bit)), cb = db ? pb : (pb | (1u << bit));
                    int cnta = 0, cntb = 0;
#pragma unroll
                    for (int g = 0; g < 8; ++g) if (4 * g < nj) {
#pragma unroll
                        for (int jj = 0; jj < 4; ++jj) { cnta += __popcll(__ballot(ua[4 * g + jj] >= ca)); cntb += __popcll(__ballot(ub[4 * g + jj] >= cb)); }
                    }
                    if (!da && cnta >= 256) { pa = ca; da = (cnta == 256); }
                    if (!db && cntb >= 256) { pb = cb; db = (cntb == 256); }
                    if (da && db) break;
                }
                int cga = 0, cgb = 0;
#pragma unroll
                for (int g = 0; g < 8; ++g) if (4 * g < nj) {
#pragma unroll
                    for (int jj = 0; jj < 4; ++jj) { cga += __popcll(__ballot(ua[4 * g + jj] > pa)); cgb += __popcll(__ballot(ub[4 * g + jj] > pb)); }
                }
                const int needa = 256 - cga, needb = 256 - cgb; int runa = 0, runb = 0;
                const unsigned long long lt = (1ull << lane) - 1ull;
#pragma unroll
                for (int g = 0; g < 8; ++g) if (4 * g < nj) {
#pragma unroll
                    for (int jj = 0; jj < 4; ++jj) {
                        const int e = 4 * g + jj;
                        { const bool eq = (ua[e] == pa); const unsigned long long em = __ballot(eq); const int rank = runa + __popcll(em & lt);
                          const unsigned long long sb2 = __ballot((ua[e] > pa) || (eq && rank < needa)); if (lane == e) maska = sb2; runa += __popcll(em); }
                        { const bool eq = (ub[e] == pb); const unsigned long long em = __ballot(eq); const int rank = runb + __popcll(em & lt);
                          const unsigned long long sb2 = __ballot((ub[e] > pb) || (eq && rank < needb)); if (lane == e) maskb = sb2; runb += __popcll(em); }
                    }
                }
            }
            if (lane < nj) { BM[(rb + q0 + qa) * 32 + lane] = maska; BM[(rb + q0 + qb) * 32 + lane] = maskb; }
        }
        __syncthreads();
    }
#undef IDX_DECODE
#undef IDX_LOADQ
}
DI int mono_i(float f) { const int i = __builtin_bit_cast(int, f); return i ^ ((i >> 31) & 0x7fffffff); }
DI float mono_f(int i) { return __builtin_bit_cast(float, i ^ ((i >> 31) & 0x7fffffff)); }
constexpr int IMIN = (int)0x80000000;

DI void ce_desc(int& a, int& b) { const int hi = max(a, b), lo = min(a, b); a = hi; b = lo; }
template <int B, bool DESC> DI void bitonic_merge16(int (&x)[64]) {
#pragma unroll
    for (int j = 8; j > 0; j >>= 1)
#pragma unroll
        for (int i = 0; i < 16; ++i) { const int l = i ^ j; if (l > i) { if (DESC) ce_desc(x[B + i], x[B + l]); else ce_desc(x[B + l], x[B + i]); } }
}
DI void top16_of_64(int (&x)[64]) {
#pragma unroll
    for (int k = 2; k <= 16; k <<= 1)
#pragma unroll
        for (int j = k >> 1; j > 0; j >>= 1)
#pragma unroll
            for (int i = 0; i < 64; ++i) { const int l = i ^ j; if (l > i) { if ((i & k) == 0) ce_desc(x[i], x[l]); else ce_desc(x[l], x[i]); } }
#pragma unroll
    for (int i = 0; i < 16; ++i) { x[i] = max(x[i], x[16 + i]); x[32 + i] = max(x[32 + i], x[48 + i]); }
    bitonic_merge16<0, true>(x); bitonic_merge16<32, false>(x);
#pragma unroll
    for (int i = 0; i < 16; ++i) x[i] = max(x[i], x[32 + i]);
    bitonic_merge16<0, true>(x);
}

DI void ph_peer_route(const KArgs& a, LAS unsigned char* lds, int tid, int lane, int wave, int blk, int nblk) {
    unsigned char* ws = a.ws;
    const bf16_t* QP = (const bf16_t*)(ws + WS_QP); const bf16_t* SKB = (const bf16_t*)(ws + WS_SKB);
    int* EIDX = (int*)(ws + WS_EIDX); float* GW = (float*)(ws + WS_GW);
    constexpr int SST = 272, SHALF = 128 * SST;
    const int r32 = lane & 31, hi = lane >> 5;
    for (int vb = blk; vb < 256; vb += nblk) {
        const int head = vb & 7, tg = vb >> 3;
        __syncthreads();
        for (int c = tid; c < 4096; c += 512) {
            const int p = c >> 11, key = (c >> 4) & 127, chn = c & 15;
            *(LAS u32x4*)(lds + p * SHALF + key * SST + chn * 16) = *(const u32x4*)(SKB + ((size_t)(head * 2 + p) * 128 + key) * 128 + chn * 8);
        }
        __syncthreads();
        LAS int* Ll = (LAS int*)(lds + 2 * SHALF) + wave * 2048;
        for (int tile = wave; tile < 64; tile += 8) {
            const size_t n0 = (size_t)tg * 2048 + tile * 32;
#pragma unroll 1
            for (int p = 0; p < 2; ++p) {
                int hi4 = 4 * hi; asm volatile("" : "+v"(hi4));
                bf16x8 qf[8];
                { const bf16_t* qp = QP + (n0 + r32) * 2048 + head * 256 + p * 128 + 8 * hi;
#pragma unroll
                  for (int ks = 0; ks < 8; ++ks) qf[ks] = *(const bf16x8*)(qp + 16 * ks); }
                int xi[64];
#pragma unroll
                for (int mt = 0; mt < 4; ++mt) {
                    f32x16 acc;
#pragma unroll
                    for (int r = 0; r < 16; ++r) acc[r] = 0.f;
                    const LAS char* ka = (const LAS char*)lds + p * SHALF + (32 * mt + r32) * SST + hi * 16;
#pragma unroll
                    for (int ks = 0; ks < 8; ++ks) acc = MFMA32(*(const LAS bf16x8*)(ka + ks * 32), qf[ks], acc);
#pragma unroll
                    for (int r = 0; r < 16; ++r) xi[mt * 16 + r] = ((mono_i(acc[r]) & ~127) | hi4) | (32 * mt + (r & 3) + 8 * (r >> 2));
                }
                top16_of_64(xi);
                {
                    int pr[16];
#pragma unroll
                    for (int i = 0; i < 16; ++i) pr[i] = __shfl_xor(xi[15 - i], 32);
#pragma unroll
                    for (int i = 0; i < 16; ++i) xi[i] = max(xi[i], pr[i]);
                    bitonic_merge16<0, true>(xi);
                }
#pragma unroll
                for (int it = 0; it < 16; ++it) Ll[(p * 16 + it) * 64 + lane] = xi[it];
            }
            int cs[64];
            {
                int l0[16], l1[16];
#pragma unroll
                for (int k = 0; k < 16; ++k) { l0[k] = Ll[k * 64 + lane]; l1[k] = Ll[(16 + k) * 64 + lane]; }
                int nc = 0;
#pragma unroll
                for (int ra = 0; ra < 16; ++ra)
#pragma unroll
                    for (int rb2 = 0; rb2 < 16; ++rb2)
                        if ((ra + 1) * (rb2 + 1) <= 16) {
                            const float s = mono_f(l0[ra] & ~127) + mono_f(l1[rb2] & ~127);
                            cs[nc] = (mono_i(s) & ~255) | (255 - (ra * 16 + rb2)); ++nc;
                        }
#pragma unroll
                for (int k = 50; k < 64; ++k) cs[k] = IMIN;
            }
            top16_of_64(cs);
            float sv[16]; int se[16];
#pragma unroll
            for (int it = 0; it < 16; ++it) {
                const int flat = 255 - (cs[it] & 255);
                se[it] = (Ll[(flat >> 4) * 64 + lane] & 127) * 128 + (Ll[(16 + (flat & 15)) * 64 + lane] & 127);
                sv[it] = mono_f(cs[it] & ~255);
            }
            const float smax = sv[0];
            float sum = 0.f;
#pragma unroll
            for (int it = 0; it < 16; ++it) { sv[it] = __expf(sv[it] - smax); sum += sv[it]; }
            const float inv = 1.f / sum;
            if (hi == 0) {
                unsigned short* ep = (unsigned short*)EIDX + (n0 + r32) * 128 + head * 16;
                float* gp = GW + (n0 + r32) * 128 + head * 16;
#pragma unroll
                for (int k = 0; k < 4; ++k) {
                    *(u32x2*)(ep + 4 * k) = (u32x2){(unsigned)se[4 * k] | ((unsigned)se[4 * k + 1] << 16), (unsigned)se[4 * k + 2] | ((unsigned)se[4 * k + 3] << 16)};
                    *(f32x4*)(gp + 4 * k) = (f32x4){sv[4 * k] * inv, sv[4 * k + 1] * inv, sv[4 * k + 2] * inv, sv[4 * k + 3] * inv};
                }
            }
        }
    }
}

DI int dot4z(int a, int b) { int r; asm("v_dot4_i32_i8 %0, %1, %2, 0" : "=v"(r) : "v"(a), "v"(b)); return r; }
DI f32x2 fp8lo(unsigned w) { return __builtin_amdgcn_cvt_pk_f32_fp8((int)w, false); }
DI f32x2 fp8hi(unsigned w) { return __builtin_amdgcn_cvt_pk_f32_fp8((int)w, true); }
constexpr int PEER_CH = 8, PEER_NCH = NTOK / PEER_CH;
constexpr size_t SLICE_BYTES = (size_t)16384 * 128;

template <int STEP>
DI void peer_issue(const unsigned char* tb, unsigned lo16, const LAS int* et, int g, u32x4 (&tv)[16], u32x4 (&hx)[2], f32x4& xr, const unsigned char* hrow, const float* xrow, const float* hsp = nullptr) {
#pragma unroll
    for (int it = 0; it < 16; ++it) tv[it] = *(const u32x4*)(tb + ((unsigned)et[8 * it + g] + lo16));
    if (STEP == 0) { hx[0] = *(const u32x4*)hrow; if (U4) hx[1] = *(const u32x4*)(hrow + (UD8 ? (WS_HB4 - WS_HA4) : 16)); xr.x = *hsp; }
    else if (V4) xr = *(const f32x4*)xrow;
    else { const f32x2 t2 = *(const f32x2*)xrow; xr.x = t2.x; xr.y = t2.y; }
    __builtin_amdgcn_sched_barrier(0);
}

template <int STEP, bool HALFROW = false>
DI void ph_peer_slices(const KArgs& a, LAS unsigned char* lds, int lane, int wave, unsigned xcc) {
    unsigned char* ws = a.ws;
    const unsigned char* H8 = ws + WS_H8; const float* HS = (const float*)(ws + WS_HS); const unsigned char* U8 = ws + WS_UB; const unsigned char* V8 = ws + WS_VB;
    const float usc = __builtin_bit_cast(float, ((const unsigned*)(ws + WS_CTL))[CW_UMAX]) * (U4 ? (UD8 ? U4_STEP : U4_STEP * (1.f / 16.f)) : 1.f / 127.f);
    constexpr bool UQ = (STEP == 0) && U4, VQ = (STEP == 2) && V4, Q4 = UQ || VQ;
    const unsigned short* EIDX = (const unsigned short*)(ws + WS_EIDX); const float* mod = (const float*)(ws + WS_MOD);
    _Float16* PART = (_Float16*)(ws + WS_PART); const _Float16* W = (const _Float16*)(ws + WS_WGT);
    unsigned* ctr = (unsigned*)(ws + WS_CTL) + 8192 + (STEP ? 1024 : 0);
    float* out = a.out;
    LAS int* e_l = (LAS int*)(lds + wave * 16896);
    LAS _Float16* w_l = (LAS _Float16*)(e_l + 1024);
    LAS float* a_l = (LAS float*)(e_l + 2048);
    LAS float* red = a_l + 128;
    const int g = lane >> 3, s8 = lane & 7;
    for (int ds = 0; ds < (Q4 ? 4 : 8); ++ds) {
        const int s = (int)((xcc + ds) & (Q4 ? 3u : 7u));
        const unsigned char* tb = (STEP ? V8 : U8) + (size_t)s * SLICE_BYTES;
        const unsigned lo16 = (unsigned)(HALFROW ? (s8 & 3) : s8) * 16u;
        unsigned cn = 0;
        if (lane == 0) cn = __hip_atomic_fetch_add(ctr + 64 * s, 1u, __ATOMIC_RELAXED, __HIP_MEMORY_SCOPE_AGENT);
        cn = __builtin_amdgcn_readfirstlane(cn);
        u32x2 pe[4], pw[4];
        if (cn < (unsigned)PEER_NCH) {
#pragma unroll
            for (int q = 0; q < 4; ++q) { pe[q] = *(const u32x2*)(EIDX + (size_t)cn * PEER_CH * 128 + lane * 4 + 256 * q); if (STEP) pw[q] = *(const u32x2*)(W + (size_t)cn * PEER_CH * 128 + lane * 4 + 256 * q); }
        }
        for (;;) {
            const unsigned c = cn;
            if (c >= (unsigned)PEER_NCH) break;
#pragma unroll
            for (int q = 0; q < 4; ++q) { *(LAS u32x4*)(e_l + lane * 4 + 256 * q) = (u32x4){(pe[q].x & 0xffffu) << 7, (pe[q].x >> 16) << 7, (pe[q].y & 0xffffu) << 7, (pe[q].y >> 16) << 7}; if (STEP) *(LAS u32x2*)(w_l + lane * 4 + 256 * q) = pw[q]; }
            if (lane == 0) cn = __hip_atomic_fetch_add(ctr + 64 * s, 1u, __ATOMIC_RELAXED, __HIP_MEMORY_SCOPE_AGENT);
            cn = __builtin_amdgcn_readfirstlane(cn);
            if (cn < (unsigned)PEER_NCH) {
#pragma unroll
                for (int q = 0; q < 4; ++q) { pe[q] = *(const u32x2*)(EIDX + (size_t)cn * PEER_CH * 128 + lane * 4 + 256 * q); if (STEP) pw[q] = *(const u32x2*)(W + (size_t)cn * PEER_CH * 128 + lane * 4 + 256 * q); }
            }
            LDS_WAIT();
            const int n0 = (int)c * PEER_CH;
            const int b = n0 / NT;
            f32x2 gv2 = {0.f, 0.f}; f32x4 gv4 = {0.f, 0.f, 0.f, 0.f};
            if (VQ) gv4 = *(const f32x4*)(mod + (size_t)b * 6144 + 5120 + s * 256 + 4 * lane) * (1.f / V4_WSC);
            else if (STEP) gv2 = *(const f32x2*)(mod + (size_t)b * 6144 + 5120 + s * 128 + 2 * lane);
            u32x4 tvA[16], tvB[16], hA[2], hB[2]; f32x4 xA = {0.f, 0.f, 0.f, 0.f}, xB = {0.f, 0.f, 0.f, 0.f};
#define PEER_HROW(t) ((UQ && UD8) ? (ws + WS_HA4 + (size_t)(n0 + (t)) * 512 + s * 128 + s8 * 16) : (H8 + (size_t)(n0 + (t)) * 1024 + s * (UQ ? 256 : 128) + s8 * (UQ ? 32 : 16)))
#define PEER_XROW(t) (out + (size_t)(n0 + (t)) * 1024 + (VQ ? s * 256 + 4 * lane : s * 128 + 2 * lane))
#define PEER_COMPUTE(t, tv, hx, xr) do { \
            if (UQ) { \
                LAS int* redi = (LAS int*)red; \
                if (UD8) { \
                _Pragma("unroll") for (int it = 0; it < 16; ++it) {     \
                    int da = __builtin_amdgcn_sdot8((int)tv[it].x, (int)hx[0].x, 0, false), db = __builtin_amdgcn_sdot8((int)tv[it].x, (int)hx[1].x, 0, false); \
                    da = __builtin_amdgcn_sdot8((int)tv[it].y, (int)hx[0].y, da, false); db = __builtin_amdgcn_sdot8((int)tv[it].y, (int)hx[1].y, db, false); \
                    da = __builtin_amdgcn_sdot8((int)tv[it].z, (int)hx[0].z, da, false); db = __builtin_amdgcn_sdot8((int)tv[it].z, (int)hx[1].z, db, false); \
                    da = __builtin_amdgcn_sdot8((int)tv[it].w, (int)hx[0].w, da, false); db = __builtin_amdgcn_sdot8((int)tv[it].w, (int)hx[1].w, db, false); \
                    redi[it * 64 + lane] = 16 * da + db; \
                } \
                } else \
                _Pragma("unroll") for (int it = 0; it < 16; ++it) { \
                    int d0 = dot4z((int)((tv[it].x << 4) & 0xF0F0F0F0u), (int)hx[0].x), d1 = dot4z((int)((tv[it].y << 4) & 0xF0F0F0F0u), (int)hx[0].y); \
                    d0 = __builtin_amdgcn_sdot4((int)((tv[it].z << 4) & 0xF0F0F0F0u), (int)hx[0].z, d0, false); d1 = __builtin_amdgcn_sdot4((int)((tv[it].w << 4) & 0xF0F0F0F0u), (int)hx[0].w, d1, false); \
                    d0 = __builtin_amdgcn_sdot4((int)(tv[it].x & 0xF0F0F0F0u), (int)hx[1].x, d0, false); d1 = __builtin_amdgcn_sdot4((int)(tv[it].y & 0xF0F0F0F0u), (int)hx[1].y, d1, false); \
                    d0 = __builtin_amdgcn_sdot4((int)(tv[it].z & 0xF0F0F0F0u), (int)hx[1].z, d0, false); d1 = __builtin_amdgcn_sdot4((int)(tv[it].w & 0xF0F0F0F0u), (int)hx[1].w, d1, false); \
                    redi[it * 64 + lane] = d0 + d1;                      \
                } \
                LDS_WAIT(); \
                _Float16* pp = PART + ((size_t)s * NTOK + n0 + (t)) * 128; \
                { typedef int i32x4 __attribute__((ext_vector_type(4))); \
                  const i32x4 r0 = *(const LAS i32x4*)(redi + 8 * lane), r1 = *(const LAS i32x4*)(redi + 8 * lane + 4), r2 = *(const LAS i32x4*)(redi + 512 + 8 * lane), r3 = *(const LAS i32x4*)(redi + 512 + 8 * lane + 4); \
                  const float sc_ = xr.x * usc; \
                  pp[lane] = (_Float16)((float)(((r0[0] + r0[1]) + (r0[2] + r0[3])) + ((r1[0] + r1[1]) + (r1[2] + r1[3]))) * sc_); \
                  pp[64 + lane] = (_Float16)((float)(((r2[0] + r2[1]) + (r2[2] + r2[3])) + ((r3[0] + r3[1]) + (r3[2] + r3[3]))) * sc_); } \
                LDS_WAIT(); \
            } else if (STEP == 0) { \
                LAS int* redi = (LAS int*)red; \
                _Pragma("unroll") for (int it = 0; it < 16; ++it) { \
                    int d0 = dot4z((int)tv[it].x, (int)hx[0].x), d1 = dot4z((int)tv[it].y, (int)hx[0].y);        \
                    d0 = __builtin_amdgcn_sdot4((int)tv[it].z, (int)hx[0].z, d0, false); d1 = __builtin_amdgcn_sdot4((int)tv[it].w, (int)hx[0].w, d1, false); \
                    redi[it * 64 + lane] = d0 + d1;                      \
                } \
                LDS_WAIT(); \
                _Float16* pp = PART + ((size_t)s * NTOK + n0 + (t)) * 128; \
                { typedef int i32x4 __attribute__((ext_vector_type(4))); \
                  const i32x4 r0 = *(const LAS i32x4*)(redi + 8 * lane), r1 = *(const LAS i32x4*)(redi + 8 * lane + 4), r2 = *(const LAS i32x4*)(redi + 512 + 8 * lane), r3 = *(const LAS i32x4*)(redi + 512 + 8 * lane + 4); \
                  const float sc_ = xr.x * usc; \
                  pp[lane] = (_Float16)((float)(((r0[0] + r0[1]) + (r0[2] + r0[3])) + ((r1[0] + r1[1]) + (r1[2] + r1[3]))) * sc_); \
                  pp[64 + lane] = (_Float16)((float)(((r2[0] + r2[1]) + (r2[2] + r2[3])) + ((r3[0] + r3[1]) + (r3[2] + r3[3]))) * sc_); } \
                LDS_WAIT(); \
            } else if (VQ) { \
                h16x2 acc[16]; \
                _Pragma("unroll") for (int k = 0; k < 16; ++k) acc[k] = (h16x2){(_Float16)0.f, (_Float16)0.f}; \
                _Pragma("unroll") for (int it = 0; it < 16; ++it) { \
                    const _Float16 wh = w_l[(t) * 128 + 8 * it + g]; const h16x2 w2 = {wh, wh}; \
                    _Pragma("unroll") for (int k = 0; k < 4; ++k) { \
                        acc[4 * k] += __builtin_amdgcn_cvt_scalef32_pk_f16_fp4(tv[it][k], 1.0f, 0) * w2; acc[4 * k + 1] += __builtin_amdgcn_cvt_scalef32_pk_f16_fp4(tv[it][k], 1.0f, 1) * w2; \
                        acc[4 * k + 2] += __builtin_amdgcn_cvt_scalef32_pk_f16_fp4(tv[it][k], 1.0f, 2) * w2; acc[4 * k + 3] += __builtin_amdgcn_cvt_scalef32_pk_f16_fp4(tv[it][k], 1.0f, 3) * w2; } \
                } \
                LAS _Float16* redh = (LAS _Float16*)red;                  \
                LAS h16x8* rp = (LAS h16x8*)(redh + g * 256 + s8 * 32); \
                _Pragma("unroll") for (int i = 0; i < 4; ++i) rp[i] = (h16x8){acc[4 * i].x, acc[4 * i].y, acc[4 * i + 1].x, acc[4 * i + 1].y, acc[4 * i + 2].x, acc[4 * i + 2].y, acc[4 * i + 3].x, acc[4 * i + 3].y}; \
                LDS_WAIT(); \
                f32x4 sum = {0.f, 0.f, 0.f, 0.f}; \
                _Pragma("unroll") for (int q = 0; q < 8; ++q) { const h16x4 p4 = *(const LAS h16x4*)(redh + q * 256 + 4 * lane); sum += (f32x4){(float)p4.x, (float)p4.y, (float)p4.z, (float)p4.w}; } \
                *(f32x4*)(out + (size_t)(n0 + (t)) * 1024 + s * 256 + 4 * lane) = xr + gv4 * sum; \
                LDS_WAIT(); \
            } else { \
                f32x2 acc[8]; \
                _Pragma("unroll") for (int k = 0; k < 8; ++k) acc[k] = (f32x2){0.f, 0.f}; \
                _Pragma("unroll") for (int it = 0; it < 16; ++it) { \
                    const float w = (float)w_l[(t) * 128 + 8 * it + g]; \
                    acc[0] += fp8lo(tv[it].x) * w; acc[1] += fp8hi(tv[it].x) * w; acc[2] += fp8lo(tv[it].y) * w; acc[3] += fp8hi(tv[it].y) * w; \
                    acc[4] += fp8lo(tv[it].z) * w; acc[5] += fp8hi(tv[it].z) * w; acc[6] += fp8lo(tv[it].w) * w; acc[7] += fp8hi(tv[it].w) * w; \
                } \
                LAS f32x4* rp = (LAS f32x4*)(red + g * 128 + s8 * 16); \
                rp[0] = (f32x4){acc[0].x, acc[0].y, acc[1].x, acc[1].y}; rp[1] = (f32x4){acc[2].x, acc[2].y, acc[3].x, acc[3].y}; \
                rp[2] = (f32x4){acc[4].x, acc[4].y, acc[5].x, acc[5].y}; rp[3] = (f32x4){acc[6].x, acc[6].y, acc[7].x, acc[7].y}; \
                LDS_WAIT(); \
                f32x2 sum = {0.f, 0.f}; \
                _Pragma("unroll") for (int q = 0; q < 8; ++q) sum += *(const LAS f32x2*)(red + q * 128 + 2 * lane); \
                *(f32x2*)(out + (size_t)(n0 + (t)) * 1024 + s * 128 + 2 * lane) = (f32x2){xr.x, xr.y} + gv2 * sum; \
                LDS_WAIT(); \
            } \
            __builtin_amdgcn_sched_barrier(0); } while (0)
            peer_issue<STEP>(tb, lo16, e_l, g, tvA, hA, xA, PEER_HROW(0), PEER_XROW(0), HS + n0);
#pragma unroll 1
            for (int t = 0; t < PEER_CH - 2; t += 2) {
                peer_issue<STEP>(tb, lo16, e_l + (t + 1) * 128, g, tvB, hB, xB, PEER_HROW(t + 1), PEER_XROW(t + 1), HS + n0 + t + 1);
                PEER_COMPUTE(t, tvA, hA, xA);
                peer_issue<STEP>(tb, lo16, e_l + (t + 2) * 128, g, tvA, hA, xA, PEER_HROW(t + 2), PEER_XROW(t + 2), HS + n0 + t + 2);
                PEER_COMPUTE(t + 1, tvB, hB, xB);
            }
            peer_issue<STEP>(tb, lo16, e_l + (PEER_CH - 1) * 128, g, tvB, hB, xB, PEER_HROW(PEER_CH - 1), PEER_XROW(PEER_CH - 1), HS + n0 + PEER_CH - 1);
            PEER_COMPUTE(PEER_CH - 2, tvA, hA, xA);
            PEER_COMPUTE(PEER_CH - 1, tvB, hB, xB);
#undef PEER_HROW
#undef PEER_XROW
#undef PEER_COMPUTE
        }
    }
}

DI void ph_peer_combine(const KArgs& a, int tid, int blk, int nblk) {
    unsigned char* ws = a.ws;
    const _Float16* PART = (const _Float16*)(ws + WS_PART); const float* GW = (const float*)(ws + WS_GW); _Float16* W = (_Float16*)(ws + WS_WGT);
    const size_t total = (size_t)NTOK * 128 / 4;
    const float vsc = V4 ? __builtin_bit_cast(float, ((const unsigned*)(ws + WS_CTL))[CW_VMAX]) * (V4_S * V4_WSC) : 1.f / VSCALE;
    constexpr int NS = U4 ? 4 : 8;
    h16x4 pn[NS]; f32x4 gn = {0.f, 0.f, 0.f, 0.f};
    const size_t i0 = (size_t)blk * 512 + tid, st = (size_t)nblk * 512;
    if (i0 < total) {
#pragma unroll
        for (int k = 0; k < NS; ++k) pn[k] = *(const h16x4*)(PART + (size_t)k * NTOK * 128 + 4 * i0);
        gn = *(const f32x4*)(GW + 4 * i0);
    }
    for (size_t i = i0; i < total; i += st) {
        f32x4 s = {0.f, 0.f, 0.f, 0.f};
#pragma unroll
        for (int k = 0; k < NS; ++k) s += (f32x4){(float)pn[k].x, (float)pn[k].y, (float)pn[k].z, (float)pn[k].w};
        const f32x4 gq = gn;
        if (i + st < total) {
#pragma unroll
            for (int k = 0; k < NS; ++k) pn[k] = *(const h16x4*)(PART + (size_t)k * NTOK * 128 + 4 * (i + st));
            gn = *(const f32x4*)(GW + 4 * (i + st));
        }
        f32x4 r;
#pragma unroll
        for (int k = 0; k < 4; ++k) r[k] = gq[k] * 0.5f * s[k] * (1.f + erff(s[k] * 0.70710678118654752f)) * vsc;
        *(h16x4*)(W + 4 * i) = (h16x4){(_Float16)r[0], (_Float16)r[1], (_Float16)r[2], (_Float16)r[3]};
    }
}
#ifndef MK_ONE_LAUNCH
#define MK_ONE_LAUNCH 1
#endif
constexpr int N_PHASES = 12;
#ifndef MK_DUP
#define MK_DUP 0
#endif
#ifndef MK_PREFIX
#define MK_PREFIX -1
#endif
#define PROGRAM() \
    if (IN(0)) { LAUNDER ph_prologue(a, lds, tid, lane, wave, blk, nblk); } \
    SEAM(0); \
    if (IN(1)) { LAUNDER { const float um = __builtin_bit_cast(float, ((const unsigned*)(ws + WS_CTL))[CW_UMAX]); if (U4) conv_u_i4(a.peer_u, ws + WS_UB, 1.f / (U4_STEP * fmaxf(um, 1e-30f)), (size_t)blk * 512 + tid, (size_t)nblk * 512); else conv_u_i8(a.peer_u, ws + WS_UB, 127.f / fmaxf(um, 1e-30f), (size_t)blk * 512 + tid, (size_t)nblk * 512); } if (V4) { const float vm = __builtin_bit_cast(float, ((const unsigned*)(ws + WS_CTL))[CW_VMAX]); conv_v_fp4(a.peer_v, ws + WS_VB, 1.f / (V4_S * fmaxf(vm, 1e-30f)), (size_t)blk * 512 + tid, (size_t)nblk * 512); } ph_weights8(a, lds, lane, wave, blk, nblk); ph_norm<(N8_IN > 0 && IN_MODE == 2), (NB_IN > 0), (N8_IN > 0 && IN_MODE == 1)>(a.x, a.norm1_g, mod, 0, 1024, (bf16_t*)(ws + WS_H), ws + WS_HF8, ws + WS_HF8, (float*)(ws + WS_HS1), lane, wave, blk, nblk); } \
    SEAM(1); \
    if (IN(2)) { LAUNDER \
        if (N8_IN > 0) { \
            pg8::Gemm g{(const bf16_t*)(ws + WS_HF8), (const bf16_t*)(ws + WS_WIN8), NTOK, N8_IN * 256, 512}; \
            pg8::StaticOrder S; S.init(NTOK, N8_IN * 256, nblk, blk); \
            EpiProjT<IN_MODE> E{(bf16_t*)(ws + WS_QD), (bf16_t*)(ws + WS_KD), (bf16_t*)(ws + WS_VD), (bf16_t*)(ws + WS_QS), (bf16_t*)(ws + WS_QI), (bf16_t*)(ws + WS_KS), (bf16_t*)(ws + WS_VS), \
                      (bf16_t*)(ws + WS_KI), (bf16_t*)(ws + WS_G0), (bf16_t*)(ws + WS_G1), (float*)(ws + WS_WIDX), (const float*)(ws + WS_COS), (const float*)(ws + WS_SIN), \
                      a.diff_q_g, a.diff_k_g, a.dsa_q_g, a.dsa_k_g, (const unsigned*)(ws + WS_CTL) + CW_WMAX + 0, (const float*)(ws + WS_HS1)}; \
            pg8::gemm_phase<EpiProjT<IN_MODE>, pg8::StaticOrder, true, true, IN_MODE>(lds, g, S, E); \
        } \
        if (NB_IN > 0) { \
            pg8::Gemm g{(const bf16_t*)(ws + WS_H), (const bf16_t*)(ws + WS_WIN), NTOK, NB_IN * 256, 1024}; \
            pg8::StaticOrder S; S.init(NTOK, NB_IN * 256, nblk, blk); \
            EpiProjT<0> E{(bf16_t*)(ws + WS_QD), (bf16_t*)(ws + WS_KD), (bf16_t*)(ws + WS_VD), (bf16_t*)(ws + WS_QS), (bf16_t*)(ws + WS_QI), (bf16_t*)(ws + WS_KS), (bf16_t*)(ws + WS_VS), \
                      (bf16_t*)(ws + WS_KI), (bf16_t*)(ws + WS_G0), (bf16_t*)(ws + WS_G1), (float*)(ws + WS_WIDX), (const float*)(ws + WS_COS), (const float*)(ws + WS_SIN), \
                      a.diff_q_g, a.diff_k_g, a.dsa_q_g, a.dsa_k_g, nullptr, nullptr}; \
            pg8::gemm_phase<EpiProjT<0>, pg8::StaticOrder, true, true, 0>(lds, g, S, E); \
        } \
    } \
    SEAM(2); \
    if (IN(3)) { LAUNDER ph_indexer(a, lds, tid, lane, wave, blk, nblk); if (MK_DUP == 30) ph_indexer(a, lds, tid, lane, wave, blk, nblk); if (MK_DUP == 31) ph_indexer<false>(a, lds, tid, lane, wave, blk, nblk); ph_diff_attn(a, lds, tid, lane, wave, blk, nblk); } \
    SEAM(3); \
    if (IN(4)) { LAUNDER if (MK_DUP == 41) ph_dsa_attn<1>(a, lds, tid, lane, wave, blk, nblk); if (MK_DUP == 42) ph_dsa_attn<2>(a, lds, tid, lane, wave, blk, nblk); ph_dsa_attn<0>(a, lds, tid, lane, wave, blk, nblk); } \
    SEAM(4); \
    if (IN(5) && FUSE56) { LAUNDER \
        pg8::Gemm g{(const bf16_t*)(ws + WS_OAB), (const bf16_t*)(ws + WS_WBA), NTOK, 1024, 1024}; \
        pg8::StaticOrder S; S.init(NTOK, 1024, nblk, blk); \
        EpiMerged E{ws + WS_G0, ws + WS_G1, (bf16_t*)(ws + WS_MERGED), ws + WS_MERGED8}; \
        pg8::gemm_phase<EpiMerged, pg8::StaticOrder, true, true, 0>(lds, g, S, E); \
    } \
    if (IN(5) && !FUSE56) { LAUNDER \
        pg8::Gemm g{(const bf16_t*)(ws + WS_OAB), (const bf16_t*)(ws + WS_WBA), NTOK, 1024, (F8_BR || BR8) ? 256 : 512}; \
        pg8::StaticOrder S; S.init(NTOK, 1024, nblk, blk); \
        EpiGate<0> E{(const bf16_t*)(ws + WS_G0), (bf16_t*)(ws + WS_MERGED), (const unsigned*)(ws + WS_CTL) + CW_WMAX + 1, nullptr, nullptr}; \
        pg8::gemm_phase<EpiGate<0>, pg8::StaticOrder, true, true, F8_BR ? 1 : BR8 ? 2 : 0>(lds, g, S, E); \
    } \
    SEAM(5); \
    if (IN(6) && !FUSE56) { LAUNDER \
        pg8::Gemm g{(const bf16_t*)(ws + WS_OAB + (size_t)NTOK * 512 * ((F8_BR || BR8) ? 1 : 2)), (const bf16_t*)(ws + WS_WBB), NTOK, 1024, (F8_BR || BR8) ? 256 : 512}; \
        pg8::StaticOrder S; S.init(NTOK, 1024, nblk, blk); \
        EpiGate<1> E{(const bf16_t*)(ws + WS_G1), (bf16_t*)(ws + WS_MERGED), (const unsigned*)(ws + WS_CTL) + CW_WMAX + 2, ws + WS_MERGED8, (const float*)(ws + WS_OBS)}; \
        pg8::gemm_phase<EpiGate<1>, pg8::StaticOrder, true, true, F8_BR ? 1 : BR8 ? 2 : 0>(lds, g, S, E); \
    } \
    SEAM(6); \
    if (IN(7)) { LAUNDER \
        pg8::Gemm g{(const bf16_t*)(ws + ((F8_BR || F8_OUT) ? WS_MERGED8 : WS_MERGED)), (const bf16_t*)(ws + WS_WOUT), NTOK, 1024, (F8_BR || F8_OUT) ? 512 : 1024}; \
        pg8::StaticOrder S; S.init(NTOK, 1024, nblk, blk); \
        EpiResid E{a.x, mod, a.out, (F8_BR || F8_OUT) ? 1.f / (ASC8 * wscale8(ws, 3)) : 1.f}; \
        pg8::gemm_phase<EpiResid, pg8::StaticOrder, true, true, (F8_BR || F8_OUT) ? 1 : 0>(lds, g, S, E); \
    } \
    SEAM(7); \
    if (IN(8)) { LAUNDER ph_norm<true, PQ_MODE == 0, PQ_MODE == 1, UD8>(a.out, a.norm2_g, mod, 3072, 4096, (bf16_t*)(ws + WS_H), ws + WS_H, ws + WS_H8, (float*)(ws + WS_HS), lane, wave, blk, nblk, ws + WS_HA4, ws + WS_HB4); } \
    SEAM(8); \
    if (IN(9)) { LAUNDER \
        pg8::Gemm g{(const bf16_t*)(ws + (PQ_MODE == 2 ? WS_H8 : WS_H)), (const bf16_t*)(ws + WS_WPQ), NTOK, 2048, PQ_MODE ? 512 : 1024}; \
        pg8::StaticOrder S; S.init(NTOK, 2048, nblk, blk); \
        if (PQ_MODE == 2) { EpiPlainI8 E{(bf16_t*)(ws + WS_QP), 2048, (const float*)(ws + WS_HS), (const unsigned*)(ws + WS_CTL) + CW_WMAX + 4}; pg8::gemm_phase<EpiPlainI8, pg8::StaticOrder, true, true, 2>(lds, g, S, E); } \
        else { EpiPlain E{(bf16_t*)(ws + WS_QP), 2048, F8_PQ ? 1.f / (ASC8 * wscale8(ws, 4)) : 1.f}; pg8::gemm_phase<EpiPlain, pg8::StaticOrder, true, true, (PQ_MODE == 1 ? 1 : 0)>(lds, g, S, E); } \
    } \
    SEAM(9); \
    if (IN(10)) { LAUNDER ph_peer_route(a, lds, tid, lane, wave, blk, nblk); } \
    SEAM(10); \
    if (IN(11)) { LAUNDER if (MK_DUP == 111 || MK_DUP == 112) { if (MK_DUP == 111) ph_peer_slices<0, true>(a, lds, lane, wave, xbar.x); else ph_peer_slices<0, false>(a, lds, lane, wave, xbar.x); xcd_barrier(xbar); if (tid == 0 && blk == 0) { for (int q = 0; q < 8; ++q) ((unsigned*)(ws + WS_CTL))[8192 + 64 * q] = 0u; } xcd_barrier(xbar); } ph_peer_slices<0>(a, lds, lane, wave, xbar.x); xcd_barrier(xbar); if (MK_DUP == 110) { if (tid == 0 && blk == 0) { for (int q = 0; q < 8; ++q) ((unsigned*)(ws + WS_CTL))[8192 + 64 * q] = 0u; } xcd_barrier(xbar); ph_peer_slices<0>(a, lds, lane, wave, xbar.x); xcd_barrier(xbar); } ph_peer_combine(a, tid, blk, nblk); xcd_barrier(xbar); ph_peer_slices<2>(a, lds, lane, wave, xbar.x); }
__global__ void __launch_bounds__(512, 2) mk_fwd(KArgs a) {
    extern __shared__ __attribute__((aligned(16))) unsigned char lds_raw[];
    LAS unsigned char* lds = (LAS unsigned char*)lds_raw;
    const int tid0 = threadIdx.x, wave = __builtin_amdgcn_readfirstlane(tid0 >> 6);
    const int blk = blockIdx.x, nblk = gridDim.x;
    unsigned char* ws = a.ws;
    int lo = a.ph_lo, hi = a.ph_hi;
    volatile LAS unsigned* xst = (volatile LAS unsigned*)(lds + LDS_BYTES - 64);
    if (tid0 < 2) xst[tid0] = 0u;
    __syncthreads();
    XcdBarrier xbar = xcd_barrier_post((unsigned*)(ws + WS_CTL) + 4096, xst);
#ifndef MK_ONLY
#define MK_ONLY -1
#endif
#ifndef MK_MASK
#define MK_MASK 0xFFF
#endif
#define IN(k) ((MK_ONLY < 0 || MK_ONLY == (k)) && ((MK_MASK >> (k)) & 1) && lo <= (k) && (k) < hi)
#define LAUNDER int tid_l = tid0; asm volatile("" : "+v"(tid_l)); const int tid = tid_l, lane = tid_l & 63; (void)tid; (void)lane;
#define SEAM(k) do { if (IN(k) && IN((k) + 1) && !(FUSE56 && (k) == 5)) { if ((k) == 0) cg::this_grid().sync(); else xcd_barrier(xbar); } } while (0)
    const float* mod = (const float*)(ws + WS_MOD);
#if MK_PREFIX >= 0
    hi = MK_PREFIX + 1;
    PROGRAM()
    xcd_barrier(xbar);
    hi = a.ph_hi;
#endif
    PROGRAM()
#undef IN
#undef SEAM
}

extern "C" void kernel_launch(void* const* d_in, const int* in_sizes, int n_in, void* d_out, int out_size, void* d_ws, size_t ws_size, hipStream_t stream) {
    static int grid = 0;
    if (grid == 0) {
        if (n_in != 24 || in_sizes[0] != NTOK * DM || out_size != NTOK * DM || ws_size < WS_END) {
            fprintf(stderr, "kernel_launch: unexpected problem (n_in %d, in0 %d, out %d, ws %zu)\n", n_in, n_in > 0 ? in_sizes[0] : -1, out_size, ws_size); grid = -1; return; }
        int dev = 0, cus = 0, per_cu = 0;
        if (hipGetDevice(&dev) != hipSuccess || hipDeviceGetAttribute(&cus, hipDeviceAttributeMultiprocessorCount, dev) != hipSuccess) { grid = -1; return; }
        if (hipFuncSetAttribute((const void*)mk_fwd, hipFuncAttributeMaxDynamicSharedMemorySize, LDS_BYTES) != hipSuccess) { fprintf(stderr, "kernel_launch: hipFuncSetAttribute failed\n"); grid = -1; return; }
        if (hipOccupancyMaxActiveBlocksPerMultiprocessor(&per_cu, (const void*)mk_fwd, 512, LDS_BYTES) != hipSuccess || per_cu < 1) { fprintf(stderr, "kernel_launch: occupancy query says %d\n", per_cu); }
        (void)hipGetLastError();
        grid = cus;
    }
    if (grid < 0) return;
    if (hipMemsetAsync((char*)d_ws + WS_CTL, 0, 65536, stream) != hipSuccess) { fprintf(stderr, "kernel_launch: memset of the control words failed\n"); return; }
    KArgs a{};
    const float** fp = (const float**)&a;
    for (int i = 0; i < 24; ++i) fp[i] = (const float*)d_in[i];
    a.out = (float*)d_out; a.ws = (unsigned char*)d_ws;
#if MK_ONE_LAUNCH
    a.ph_lo = 0; a.ph_hi = N_PHASES;
    void* args[] = {&a};
    hipError_t e = hipLaunchCooperativeKernel((const void*)mk_fwd, dim3(grid), dim3(512), args, LDS_BYTES, stream);
    if (e != hipSuccess) fprintf(stderr, "kernel_launch: cooperative launch failed: %s (grid %d)\n", hipGetErrorString(e), grid);
#else
    for (int p = 0; p < N_PHASES; ++p) {
        a.ph_lo = p; a.ph_hi = p + 1;
        hipLaunchKernelGGL(mk_fwd, dim3(grid), dim3(512), LDS_BYTES, stream, a);
    }
#endif
}
```

```cpp
#include <hip/hip_runtime.h>
#include <hip/hip_cooperative_groups.h>
#include <cstdio>
#include <cstdint>
namespace cg = cooperative_groups;

#define LAS __attribute__((address_space(3)))
#define DI __device__ __forceinline__
typedef unsigned short bf16_t;
typedef short bf16x8 __attribute__((ext_vector_type(8)));
typedef short s16x4 __attribute__((ext_vector_type(4)));
typedef float f32x2 __attribute__((ext_vector_type(2)));
typedef float f32x4 __attribute__((ext_vector_type(4)));
typedef float f32x16 __attribute__((ext_vector_type(16)));
typedef unsigned u32x2 __attribute__((ext_vector_type(2)));
typedef unsigned u32x4 __attribute__((ext_vector_type(4)));
typedef __bf16 bf16x2_t __attribute__((ext_vector_type(2)));
typedef int i32x8 __attribute__((ext_vector_type(8)));

constexpr int NB = 32, NT = 2048, DM = 1024, NTOK = NB * NT;
constexpr int NPROJ = 4864;
constexpr int WIN_COLS = 4808;
constexpr float EPS = 1e-6f;
constexpr float QSCALE = 0.125f * 1.4426950408889634f;
constexpr float USCALE = 64.f, VSCALE = 4.f;
constexpr float LAMBDA_INIT = 0.2f;
constexpr int PQ_MODE = 2;
constexpr bool F8_PQ = (PQ_MODE == 1);
constexpr bool F8_BR = false;
constexpr bool U4 = true;
constexpr float U4_STEP = 0.0657f;
constexpr bool UD8 = true;
constexpr bool V4 = true;
constexpr float V4_S = 0.098f;
constexpr float V4_WSC = 64.f;
typedef _Float16 h16x2 __attribute__((ext_vector_type(2)));
typedef _Float16 h16x4 __attribute__((ext_vector_type(4)));
typedef _Float16 h16x8 __attribute__((ext_vector_type(8)));
constexpr bool BR8 = false;
constexpr float OA_MAX = 5.0f;
constexpr bool F8_OUT = true;
constexpr bool FUSE56 = true;
constexpr bool G8 = true;
constexpr int IN_MODE = 2;
constexpr unsigned IN8_MASK = 0x7FFFFu;
constexpr int N8_IN = __builtin_popcount(IN8_MASK), NB_IN = 19 - N8_IN;

constexpr size_t MiB = 1u << 20;
constexpr size_t WS_CTL = 0;
constexpr size_t WS_MOD = 1 * MiB;
constexpr size_t WS_COS = 2 * MiB;
constexpr size_t WS_SIN = 10 * MiB;
constexpr size_t WS_WIN = 18 * MiB;
constexpr size_t WS_WBA = 28 * MiB;
constexpr size_t WS_WBB = 29 * MiB;
constexpr size_t WS_WOUT = 30 * MiB;
constexpr size_t WS_WPQ = 32 * MiB;
constexpr size_t WS_SKB = 36 * MiB;
constexpr size_t WS_UB = 40 * MiB;
constexpr size_t WS_VB = 72 * MiB;
constexpr size_t WS_H = 104 * MiB;
constexpr size_t WS_QD = 232 * MiB;
constexpr size_t WS_KD = 296 * MiB;
constexpr size_t WS_VD = 360 * MiB;
constexpr size_t WS_QS = 424 * MiB;
constexpr size_t WS_QI = 488 * MiB;
constexpr size_t WS_KS = 552 * MiB;
constexpr size_t WS_VS = 560 * MiB;
constexpr size_t WS_KI = 568 * MiB;
constexpr size_t WS_WIDX = 576 * MiB;
constexpr size_t WS_G0 = 578 * MiB;
constexpr size_t WS_G1 = 706 * MiB;
constexpr size_t WS_BM = 834 * MiB;
constexpr size_t WS_OAB = 850 * MiB;
constexpr size_t WS_END = 978 * MiB;
constexpr size_t WS_MERGED = WS_QD;
constexpr size_t WS_QP = WS_VD;
constexpr size_t WS_EIDX = 616 * MiB;
constexpr size_t WS_GW = 648 * MiB;
constexpr size_t WS_PART = WS_QP;
constexpr size_t WS_WGT = WS_MERGED;
constexpr size_t WS_WIN8 = WS_WIN + (size_t)NB_IN * 256 * 1024 * 2;
constexpr size_t WS_HF8 = WS_OAB;
constexpr size_t WS_HS1 = WS_OAB + 64 * MiB;
constexpr size_t WS_HA4 = WS_H;
constexpr size_t WS_HB4 = WS_H + 32 * MiB;
constexpr size_t WS_OBS = WS_OAB + 96 * MiB;
constexpr size_t WS_MERGED8 = WS_VD;
constexpr size_t WS_H8 = 264 * MiB;
constexpr size_t WS_HS = 328 * MiB;
constexpr int CW_UMAX = 12288;
constexpr int CW_VMAX = 12288 + 32;
constexpr int CW_WMAX = 12288 + 64;
constexpr float ASC8 = 16.f, WTOP8 = 224.f;
static_assert(WS_QP + (size_t)NTOK * 2048 * 2 <= WS_EIDX, "ws map");
static_assert(WS_GW + (size_t)NTOK * 128 * 4 <= WS_BM, "ws map");

constexpr int LDS_BYTES = 163840;

DI unsigned f2bf(float f) { unsigned u = __builtin_bit_cast(unsigned, f); return (u + 0x7fffu + ((u >> 16) & 1u)) >> 16; }
DI unsigned pk2(float lo, float hi) { f32x2 v = {lo, hi}; bf16x2_t b = __builtin_convertvector(v, bf16x2_t); return __builtin_bit_cast(unsigned, b); }
DI float bflo(unsigned p) { return __builtin_bit_cast(float, p << 16); }
DI float bfhi(unsigned p) { return __builtin_bit_cast(float, p & 0xffff0000u); }
DI float wave_sum(float v) {
#pragma unroll
    for (int o = 1; o < 64; o <<= 1) v += __shfl_xor(v, o);
    return v;
}
DI float fexp2(float x) { return __builtin_amdgcn_exp2f(x); }
DI int rank_in(unsigned mask, int pn) { return __builtin_popcount(mask & ((1u << pn) - 1u)); }
DI int kth_in(unsigned mask, int k) { int pn = 0; for (int i = 0; i < 19; ++i) { if ((mask >> i) & 1u) { if (k == 0) pn = i; --k; } } return pn; }
DI unsigned pack_fp8x4(float a, float b, float c, float d) {
    a = __builtin_amdgcn_fmed3f(a, -448.f, 448.f); b = __builtin_amdgcn_fmed3f(b, -448.f, 448.f); c = __builtin_amdgcn_fmed3f(c, -448.f, 448.f); d = __builtin_amdgcn_fmed3f(d, -448.f, 448.f);
    int w = 0; w = __builtin_amdgcn_cvt_pk_fp8_f32(a, b, w, false); w = __builtin_amdgcn_cvt_pk_fp8_f32(c, d, w, true); return (unsigned)w;
}

struct KArgs {
    const float* x; const float* c; const int* pos; const float* w_ada; const float* b_ada; const float* norm1_g; const float* w_in;
    const float* diff_q_g; const float* diff_k_g; const float* lq1; const float* lk1; const float* lq2; const float* lk2; const float* diff_out_g;
    const float* dsa_q_g; const float* dsa_k_g; const float* w_ba; const float* w_bb; const float* w_out; const float* norm2_g;
    const float* peer_wq; const float* sub_keys; const float* peer_u; const float* peer_v;
    float* out; unsigned char* ws; int ph_lo, ph_hi;
};
namespace pg8 {
#define PG8_LAS __attribute__((address_space(3)))
typedef unsigned short bf16_t;
typedef short bf16x8 __attribute__((ext_vector_type(8)));
typedef float f32x4 __attribute__((ext_vector_type(4)));
typedef unsigned u32x4 __attribute__((ext_vector_type(4)));
typedef int i32x8_t __attribute__((ext_vector_type(8)));
constexpr int BM = 256, BK = 64, HALF = 128, HTB = HALF * BK * 2  , STAGE_BYTES = 8 * HTB, NXCD = 8, WGM = 8;

__host__ __device__ __forceinline__ int lds_byte(int r, int c) { const int st = (r >> 4) * 2 + (c >> 5), rr = r & 15, cc = c & 31, ob = rr * 64 + cc * 2; return st * 1024 + (ob ^ (((ob >> 9) & 1) << 5)); }
__host__ __device__ __forceinline__ void stage_rc(int b, int& R, int& C) { const int st = b / 1024, sb = b % 1024, swz = sb ^ (((sb >> 9) & 1) << 5); R = (st >> 1) * 16 + swz / 64; C = (st & 1) * 32 + (swz % 64) / 2; }
__host__ __device__ __forceinline__ int perm32(int rho) { const int n = rho >> 4, i = rho & 15; return 8 * (i >> 2) + 4 * n + (i & 3); }

struct Unit { int pm, pn; };
struct Gemm { const bf16_t* A; const bf16_t* Bt; int M, N, K; };

struct StaticOrder {
    int nM, nN, nwg, G, c;
    __host__ __device__ void init(int M, int N, int G_, int c_) { nM = M / BM; nN = N / BM; nwg = nM * nN; G = G_; c = c_; }
    __host__ __device__ bool next(int i, Unit& u) const {
        const long L = (long)i * G + c; if (L >= nwg) return false;
        int wgid = (int)L; { const int q = nwg / NXCD, r = nwg % NXCD, xcd = wgid % NXCD, off = wgid / NXCD; wgid = (xcd < r ? xcd * (q + 1) : r * (q + 1) + (xcd - r) * q) + off; }
        const int nig = WGM * nN, gid = wgid / nig, fm = gid * WGM, gsz = (nM - fm) < WGM ? (nM - fm) : WGM;
        u.pm = fm + ((wgid % nig) % gsz); u.pn = (wgid % nig) / gsz; return true;
    }
    __device__ __forceinline__ void a_ready(const Unit&) const {}
    __device__ __forceinline__ void done(const Unit&) const {}
};

__device__ __forceinline__ unsigned cvt_pk_bf16(float lo, float hi) { unsigned r; asm volatile("v_cvt_pk_bf16_f32 %0, %1, %2" : "=v"(r) : "v"(lo), "v"(hi)); return r; }
template <class Epi, class Sched, bool ALIGN_EPI = false, bool SP2 = false, int QM = 0>
__device__ __forceinline__ void gemm_phase(PG8_LAS unsigned char* lds, const Gemm g, const Sched& S, const Epi& E) {
    constexpr bool F8 = (QM == 1);
    typedef int i32x4_t __attribute__((ext_vector_type(4)));
    const int tid = threadIdx.x, wid = __builtin_amdgcn_readfirstlane(tid >> 6), lane = tid & 63, wr = wid >> 2, wc = wid & 3, fr = lane & 15, fq = lane >> 4;
    const int K = g.K, nt = K / BK;
    unsigned voffA[2], voffB[2];
#pragma unroll
    for (int i = 0; i < 2; ++i) { int R, C; stage_rc(tid * 16 + i * 8192, R, C); const int Rb = Epi::PERM ? ((R & ~31) + perm32(R & 31)) : R;
        voffA[i] = (unsigned)(R * K + C) * 2u; voffB[i] = (unsigned)(Rb * K + C) * 2u; }
    const size_t kstep = (size_t)(BK * 2);
    const size_t hstep = (size_t)HALF * K * 2;
    const size_t tstep = 2 * hstep;
    const unsigned ldsw = (unsigned)wid * 1024u;
    const int aoff = lds_byte(wr * 64 + fr, fq * 8), boff = lds_byte(wc * 32 + fr, fq * 8);
#define PG8_SA(b, h) (((b) * 2 + (h)) * HTB)
#define PG8_SB(b, h) ((4 + (b) * 2 + (h)) * HTB)
#define PG8_STAGE(bufoff, gbase, voff) do { _Pragma("unroll") for (int _i = 0; _i < 2; ++_i) \
        __builtin_amdgcn_global_load_lds((const unsigned*)((const char*)(gbase) + (voff)[_i]), (PG8_LAS unsigned*)(lds + (bufoff) + ldsw + _i * 8192), 16, 0, 0); } while (0)
#define PG8_CAT2(x0, x1) __builtin_bit_cast(i32x8_t, __builtin_shufflevector((x0), (x1), 0, 1, 2, 3, 4, 5, 6, 7, 8, 9, 10, 11, 12, 13, 14, 15))
#define PG8_LDA(dst, b, h) do { _Pragma("unroll") for (int m = 0; m < 4; ++m) { const bf16x8 f0_ = *(const PG8_LAS bf16x8*)(lds + PG8_SA(b, h) + aoff + m * 2048), f1_ = *(const PG8_LAS bf16x8*)(lds + PG8_SA(b, h) + aoff + m * 2048 + 1024); \
        if constexpr (F8) dst##8[m] = PG8_CAT2(f0_, f1_); else { dst[m][0] = f0_; dst[m][1] = f1_; } } } while (0)
#define PG8_LDB(dst, b, h) do { _Pragma("unroll") for (int n = 0; n < 2; ++n) { const bf16x8 f0_ = *(const PG8_LAS bf16x8*)(lds + PG8_SB(b, h) + boff + n * 2048), f1_ = *(const PG8_LAS bf16x8*)(lds + PG8_SB(b, h) + boff + n * 2048 + 1024); \
        if constexpr (F8) dst##8[n] = PG8_CAT2(f0_, f1_); else { dst[n][0] = f0_; dst[n][1] = f1_; } } } while (0)
#define PG8_MMA(ai, bj, At, Bt) do { __builtin_amdgcn_s_setprio(1); _Pragma("unroll") for (int m = 0; m < 4; ++m) _Pragma("unroll") for (int n = 0; n < 2; ++n) { \
        if constexpr (F8) asm volatile("v_mfma_f32_16x16x128_f8f6f4 %0, %1, %2, %0" : "+v"(acc[ai][bj][m][n]) : "v"(Bt##8[n]), "v"(At##8[m])); \
        else if constexpr (QM == 2) { _Pragma("unroll") for (int k = 0; k < 2; ++k) acc[ai][bj][m][n] = __builtin_bit_cast(f32x4, __builtin_amdgcn_mfma_i32_16x16x64_i8(__builtin_bit_cast(i32x4_t, Bt[n][k]), __builtin_bit_cast(i32x4_t, At[m][k]), __builtin_bit_cast(i32x4_t, acc[ai][bj][m][n]), 0, 0, 0)); } \
        else { _Pragma("unroll") for (int k = 0; k < 2; ++k) acc[ai][bj][m][n] = __builtin_amdgcn_mfma_f32_16x16x32_bf16(Bt[n][k], At[m][k], acc[ai][bj][m][n], 0, 0, 0); } } __builtin_amdgcn_s_setprio(0); } while (0)
#define PG8_WAIT_V(n) asm volatile("s_waitcnt vmcnt(" #n ")" ::: "memory")
#define PG8_WAIT_L(n) asm volatile("s_waitcnt lgkmcnt(" #n ")" ::: "memory")
#define PG8_BAR __builtin_amdgcn_s_barrier()
#define PG8_SCHED __builtin_amdgcn_sched_barrier(0)
    Unit cur, nxt; int ui = 0;
    if (!S.next(0, cur)) return;
    f32x4 acc[2][2][4][2];
#pragma unroll
    for (int a = 0; a < 2; ++a)
#pragma unroll
        for (int b = 0; b < 2; ++b)
#pragma unroll
            for (int m = 0; m < 4; ++m)
#pragma unroll
                for (int n = 0; n < 2; ++n) acc[a][b][m][n] = (f32x4){0.f, 0.f, 0.f, 0.f};
    bf16x8 At[4][2], B0[2][2], B1[2][2]; i32x8_t At8[4], B08[2], B18[2];
    const char* cA = (const char*)g.A + (size_t)cur.pm * tstep; const char* cB = (const char*)g.Bt + (size_t)cur.pn * tstep;
    S.a_ready(cur);
    if constexpr (SP2) {
        PG8_STAGE(PG8_SB(0, 0), cB, voffB); PG8_STAGE(PG8_SB(0, 1), cB + hstep, voffB); PG8_STAGE(PG8_SA(0, 0), cA, voffA); PG8_STAGE(PG8_SA(0, 1), cA + hstep, voffA);
        if (wr == 1) PG8_BAR;
        PG8_WAIT_V(2); PG8_BAR;
        PG8_STAGE(PG8_SB(1, 0), cB + kstep, voffB); PG8_STAGE(PG8_SA(1, 0), cA + kstep, voffA); PG8_STAGE(PG8_SB(1, 1), cB + hstep + kstep, voffB);
        PG8_WAIT_V(6); PG8_BAR;
    } else {
        PG8_STAGE(PG8_SB(0, 0), cB, voffB); PG8_STAGE(PG8_SA(0, 0), cA, voffA); PG8_STAGE(PG8_SB(0, 1), cB + hstep, voffB); PG8_STAGE(PG8_SA(0, 1), cA + hstep, voffA);
        if (wr == 1) PG8_BAR;
        PG8_WAIT_V(4); PG8_BAR;
        PG8_STAGE(PG8_SB(1, 0), cB + kstep, voffB); PG8_STAGE(PG8_SA(1, 0), cA + kstep, voffA); PG8_STAGE(PG8_SB(1, 1), cB + hstep + kstep, voffB);
        PG8_WAIT_V(6); PG8_BAR;
    }
    for (;;) {
        const bool has_next = S.next(ui + 1, nxt);
        const char* nA = has_next ? (const char*)g.A + (size_t)nxt.pm * tstep : cA; const char* nB = has_next ? (const char*)g.Bt + (size_t)nxt.pn * tstep : cB;
#pragma unroll 1
        for (int t = 0; t < nt; t += 2) {
            if constexpr (Epi::MID) { if (t == nt / 2) E.mid(acc, cur, wr, wc, fr, fq); }
            const bool last = (t == nt - 2);
            const char* a1 = cA + (size_t)(t + 1) * kstep;
            const char* a2 = last ? nA : cA + (size_t)(t + 2) * kstep; const char* b2 = last ? nB : cB + (size_t)(t + 2) * kstep;
            const char* a3 = a2 + kstep; const char* b3 = b2 + kstep;
            if (last && has_next) S.a_ready(nxt);
            if constexpr (SP2) {
            PG8_LDB(B0, 0, 0); PG8_LDB(B1, 0, 1); PG8_SCHED; PG8_LDA(At, 0, 0); PG8_STAGE(PG8_SA(1, 1), a1 + hstep, voffA);
            PG8_WAIT_V(8); PG8_WAIT_L(0); PG8_BAR; PG8_MMA(0, 0, At, B0); PG8_MMA(0, 1, At, B1); PG8_BAR; PG8_SCHED;
            PG8_LDA(At, 0, 1); PG8_STAGE(PG8_SB(0, 0), b2, voffB); PG8_STAGE(PG8_SB(0, 1), b2 + hstep, voffB); PG8_STAGE(PG8_SA(0, 0), a2, voffA);
            PG8_WAIT_V(8); PG8_WAIT_L(0); PG8_BAR; PG8_MMA(1, 0, At, B0); PG8_MMA(1, 1, At, B1); PG8_BAR; PG8_SCHED;
            PG8_LDB(B0, 1, 0); PG8_LDB(B1, 1, 1); PG8_SCHED; PG8_LDA(At, 1, 0); PG8_STAGE(PG8_SA(0, 1), a2 + hstep, voffA);
            PG8_WAIT_V(8); PG8_WAIT_L(0); PG8_BAR; PG8_MMA(0, 0, At, B0); PG8_MMA(0, 1, At, B1); PG8_BAR; PG8_SCHED;
            PG8_LDA(At, 1, 1); PG8_STAGE(PG8_SB(1, 0), b3, voffB); PG8_STAGE(PG8_SB(1, 1), b3 + hstep, voffB); PG8_STAGE(PG8_SA(1, 0), a3, voffA);
            PG8_WAIT_V(8); PG8_WAIT_L(0); PG8_BAR; PG8_MMA(1, 0, At, B0); PG8_MMA(1, 1, At, B1); PG8_BAR; PG8_SCHED;
            } else {
            PG8_LDB(B0, 0, 0); PG8_SCHED; PG8_LDA(At, 0, 0); PG8_STAGE(PG8_SA(1, 1), a1 + hstep, voffA);
            PG8_WAIT_L(8); PG8_BAR; PG8_WAIT_L(0); PG8_MMA(0, 0, At, B0); PG8_BAR; PG8_SCHED;
            PG8_LDB(B1, 0, 1); PG8_STAGE(PG8_SB(0, 0), b2, voffB);
            PG8_BAR; PG8_WAIT_L(0); PG8_MMA(0, 1, At, B1); PG8_BAR;
            PG8_LDA(At, 0, 1); PG8_STAGE(PG8_SA(0, 0), a2, voffA);
            PG8_BAR; PG8_WAIT_L(0); PG8_MMA(1, 0, At, B0); PG8_BAR; PG8_SCHED;
            PG8_STAGE(PG8_SB(0, 1), b2 + hstep, voffB);
            PG8_WAIT_V(6); PG8_BAR; PG8_MMA(1, 1, At, B1); PG8_BAR;
            PG8_LDB(B0, 1, 0); PG8_SCHED; PG8_LDA(At, 1, 0); PG8_STAGE(PG8_SA(0, 1), a2 + hstep, voffA);
            PG8_WAIT_L(8); PG8_BAR; PG8_WAIT_L(0); PG8_MMA(0, 0, At, B0); PG8_BAR; PG8_SCHED;
            PG8_LDB(B1, 1, 1); PG8_STAGE(PG8_SB(1, 0), b3, voffB);
            PG8_BAR; PG8_WAIT_L(0); PG8_MMA(0, 1, At, B1); PG8_BAR;
            PG8_LDA(At, 1, 1); PG8_STAGE(PG8_SA(1, 0), a3, voffA);
            PG8_BAR; PG8_WAIT_L(0); PG8_MMA(1, 0, At, B0); PG8_BAR; PG8_SCHED;
            PG8_STAGE(PG8_SB(1, 1), b3 + hstep, voffB);
            PG8_WAIT_V(6); PG8_BAR; PG8_MMA(1, 1, At, B1); PG8_BAR;
            }
        }
        if constexpr (ALIGN_EPI) { if (wr == 0) PG8_BAR; }
        if constexpr (F8) asm volatile("s_nop 15\n\ts_nop 15\n\ts_nop 15");
        if constexpr (!Epi::AFTER_DRAIN) { E(acc, cur, wr, wc, fr, fq); S.done(cur); }
        if (!has_next) break;
#pragma unroll
        for (int a = 0; a < 2; ++a)
#pragma unroll
            for (int b = 0; b < 2; ++b)
#pragma unroll
                for (int m = 0; m < 4; ++m)
#pragma unroll
                    for (int n = 0; n < 2; ++n) acc[a][b][m][n] = (f32x4){0.f, 0.f, 0.f, 0.f};
        cur = nxt; cA = nA; cB = nB; ++ui;
        if constexpr (ALIGN_EPI) { if (wr == 1) PG8_BAR; }
    }
    PG8_WAIT_V(0);
    if constexpr (!ALIGN_EPI) { if (wr == 0) PG8_BAR; }
    PG8_BAR;
    if constexpr (Epi::AFTER_DRAIN) { E.fused(acc, cur, wr, wc, fr, fq, lds, wid, lane); S.done(cur); }
#undef PG8_SA
#undef PG8_SB
#undef PG8_STAGE
#undef PG8_LDA
#undef PG8_LDB
#undef PG8_MMA
#undef PG8_CAT2
#undef PG8_WAIT_V
#undef PG8_WAIT_L
#undef PG8_BAR
#undef PG8_SCHED
}
}
DI int proj_group_base(int g) {
    if (g < 8) return 64 * g;
    if (g < 16) return 512 + 64 * (g - 8);
    if (g < 24) return 1024 + 64 * (g - 16);
    if (g < 32) return 1536 + 64 * (g - 24);
    if (g < 40) return 2176 + 64 * (g - 32);
    if (g == 40) return 2048;
    if (g == 41) return 2112;
    if (g == 42) return 2688;
    if (g == 43) return 2752;
    if (g < 60) return 2760 + 64 * (g - 44);
    return 3784 + 64 * (g - 60);
}

template <int QM> struct EpiProjT {
    static constexpr bool PERM = true, AFTER_DRAIN = false, MID = false;
    bf16_t *Qd, *Kd, *Vd, *Qs, *Qi, *Ks, *Vs, *Ki, *G0, *G1; float* Widx;
    const float *cosT, *sinT;
    const float *gq, *gk, *gsq, *gsk;
    const unsigned* wm;
    const float* rs;
    __device__ __forceinline__ void operator()(const pg8::f32x4 (&acc)[2][2][4][2], const pg8::Unit& u, int wr, int wc, int fr, int fq) const {
        const int g = kth_in(QM ? IN8_MASK : (~IN8_MASK & 0x7FFFFu), u.pn) * 4 + wc;
        const float asc = QM == 1 ? __builtin_bit_cast(float, *wm) * (1.f / (ASC8 * WTOP8)) : QM == 2 ? __builtin_bit_cast(float, *wm) * (1.f / 127.f) : 1.f;
        int kind; bf16_t* dst = nullptr; int ld = 512, col = 0; const float* gn = nullptr; float scale = 1.f;
        if (g < 8) { kind = 1; dst = Qd; col = 64 * g; gn = gq; scale = QSCALE; }
        else if (g < 16) { kind = 1; dst = Kd; col = 64 * (g - 8); gn = gk; }
        else if (g < 24) { kind = 0; dst = Vd; col = 64 * (g - 16); }
        else if (g < 32) { kind = 1; dst = Qs; col = 64 * (g - 24); gn = gsq; scale = QSCALE; }
        else if (g < 40) { kind = 2; dst = Qi; col = 64 * (g - 32); }
        else if (g == 40) { kind = 1; dst = Ks; ld = 64; gn = gsk; }
        else if (g == 41) { kind = 0; dst = Vs; ld = 64; }
        else if (g == 42) { kind = 2; dst = Ki; ld = 64; }
        else if (g == 43) { kind = 4; }
        else if (g < 60) { kind = 3; dst = G0; ld = 1024; col = 64 * (g - 44); }
        else { kind = 3; dst = G1; ld = 1024; col = 64 * (g - 60); }
        float gv[16];
#pragma unroll
        for (int i = 0; i < 16; ++i) gv[i] = 1.f;
        if (kind == 1) {
#pragma unroll
            for (int i = 0; i < 8; ++i) { gv[i] = gn[8 * fq + i]; gv[8 + i] = gn[32 + 8 * fq + i]; }
        }
        float rsv[8];
#pragma unroll
        for (int i = 0; i < 8; ++i) rsv[i] = (QM == 2) ? rs[u.pm * 256 + (i >> 2) * 128 + wr * 64 + (i & 3) * 16 + fr] : 1.f;
        f32x4 tcs[2][4];
        const bool roped = (kind == 1 || kind == 2);
#define EPI_LDTAB(i_) do { const size_t r_ = (size_t)(u.pm * 256 + ((i_) >> 2) * 128 + wr * 64 + ((i_) & 3) * 16 + fr) * 32 + 8 * fq; \
            tcs[(i_) & 1][0] = *(const f32x4*)(cosT + r_); tcs[(i_) & 1][1] = *(const f32x4*)(cosT + r_ + 4); tcs[(i_) & 1][2] = *(const f32x4*)(sinT + r_); tcs[(i_) & 1][3] = *(const f32x4*)(sinT + r_ + 4); } while (0)
        if (roped) EPI_LDTAB(0);
#pragma unroll
        for (int ai = 0; ai < 2; ++ai)
#pragma unroll
            for (int m = 0; m < 4; ++m) {
                const int row = u.pm * 256 + ai * 128 + wr * 64 + m * 16 + fr;
                if (roped && ai * 4 + m + 1 < 8) EPI_LDTAB(ai * 4 + m + 1);
                float v[16];
#pragma unroll
                for (int i = 0; i < 8; ++i) { v[i] = acc[ai][0][m][i >> 2][i & 3]; v[8 + i] = acc[ai][1][m][i >> 2][i & 3]; if (QM == 1) { v[i] *= asc; v[8 + i] *= asc; } }
                if (QM == 2) {
                    const float rsc = rsv[ai * 4 + m] * asc;
#pragma unroll
                    for (int i = 0; i < 16; ++i) v[i] = (float)__builtin_bit_cast(int, v[i]) * rsc;
                }
                if (kind == 1) {
                    float ss = 0.f;
#pragma unroll
                    for (int i = 0; i < 16; ++i) ss += v[i] * v[i];
                    ss += __shfl_xor(ss, 16); ss += __shfl_xor(ss, 32);
                    const float rn = __builtin_amdgcn_rsqf(ss * (1.f / 64.f) + EPS);
#pragma unroll
                    for (int i = 0; i < 16; ++i) v[i] = v[i] * rn * gv[i];
                }
                if (kind == 1 || kind == 2) {
                    const f32x4 c0 = tcs[(ai * 4 + m) & 1][0], c1 = tcs[(ai * 4 + m) & 1][1], s0 = tcs[(ai * 4 + m) & 1][2], s1 = tcs[(ai * 4 + m) & 1][3];
#pragma unroll
                    for (int i = 0; i < 8; ++i) {
                        const float cc = (i < 4) ? c0[i & 3] : c1[i & 3], sn = (i < 4) ? s0[i & 3] : s1[i & 3];
                        const float x1 = v[i], x2 = v[8 + i];
                        v[i] = (x1 * cc - x2 * sn) * scale; v[8 + i] = (x2 * cc + x1 * sn) * scale;
                    }
                }
                if (kind == 3) {
#pragma unroll
                    for (int i = 0; i < 16; ++i) v[i] = G8 ? __builtin_amdgcn_rcpf(__builtin_fmaf(__builtin_amdgcn_exp2f(v[i] * -1.4426950408889634f), 1.f / 255.f, 1.f / 255.f))
                                                           : __builtin_amdgcn_rcpf(1.f + __builtin_amdgcn_exp2f(v[i] * -1.4426950408889634f));
                }
                if (kind == 4) {
                    if (fq == 0) {
                        *(f32x4*)(Widx + (size_t)row * 8) = (f32x4){v[0], v[1], v[2], v[3]};
                        *(f32x4*)(Widx + (size_t)row * 8 + 4) = (f32x4){v[4], v[5], v[6], v[7]};
                    }
                } else if (kind == 3 && G8) {
                    unsigned b[4] = {0u, 0u, 0u, 0u};
#pragma unroll
                    for (int i = 0; i < 16; ++i) b[i >> 2] = __builtin_amdgcn_cvt_pk_u8_f32(__builtin_rintf(v[i]), i & 3, b[i >> 2]);
                    unsigned char* p = (unsigned char*)dst + (size_t)row * ld + col + 8 * fq;
                    *(u32x2*)p = (u32x2){b[0], b[1]}; *(u32x2*)(p + 32) = (u32x2){b[2], b[3]};
                } else {
                    u32x4 w0, w1;
                    w0.x = pk2(v[0], v[1]); w0.y = pk2(v[2], v[3]); w0.z = pk2(v[4], v[5]); w0.w = pk2(v[6], v[7]);
                    w1.x = pk2(v[8], v[9]); w1.y = pk2(v[10], v[11]); w1.z = pk2(v[12], v[13]); w1.w = pk2(v[14], v[15]);
                    bf16_t* p = dst + (size_t)row * ld + col + 8 * fq;
                    *(u32x4*)p = w0; *(u32x4*)(p + 32) = w1;
                }
                asm volatile("" ::: "memory");
            }
#undef EPI_LDTAB
    }
};

template <int MODE> struct EpiGate {
    static constexpr bool PERM = true, AFTER_DRAIN = false, MID = false;
    const bf16_t* G; bf16_t* O; const unsigned* wm; unsigned char* O8; const float* rs;
    __device__ __forceinline__ void operator()(const pg8::f32x4 (&acc)[2][2][4][2], const pg8::Unit& u, int wr, int wc, int fr, int fq) const {
        const int row0 = u.pm * 256 + wr * 64 + fr, col0 = u.pn * 256 + wc * 32 + 8 * fq;
        const float sc = F8_BR ? __builtin_bit_cast(float, *wm) * (1.f / (ASC8 * WTOP8)) : 1.f;
#pragma unroll
        for (int ai = 0; ai < 2; ++ai)
#pragma unroll
            for (int m = 0; m < 4; ++m)
#pragma unroll
                for (int bj = 0; bj < 2; ++bj) {
                    const size_t off = (size_t)(row0 + ai * 128 + m * 16) * 1024 + col0 + bj * 128;
                    float r[8];
                    pg8::f32x4 c0 = acc[ai][bj][m][0], c1 = acc[ai][bj][m][1];
                    float scr = sc;
                    if (BR8 && !F8_BR) {
                        typedef int i32x4 __attribute__((ext_vector_type(4)));
                        const i32x4 i0 = __builtin_bit_cast(i32x4, c0), i1 = __builtin_bit_cast(i32x4, c1);
                        c0 = (pg8::f32x4){(float)i0[0], (float)i0[1], (float)i0[2], (float)i0[3]}; c1 = (pg8::f32x4){(float)i1[0], (float)i1[1], (float)i1[2], (float)i1[3]};
                        scr = (rs ? rs[row0 + ai * 128 + m * 16] : OA_MAX * (1.f / 127.f)) * (__builtin_bit_cast(float, *wm) * (1.f / 127.f));
                    }
                    if (G8) {
                        const u32x2 gb = *(const u32x2*)((const unsigned char*)G + off);
                        const pg8::f32x4 a0 = c0 * (scr * (1.f / 255.f)), a1 = c1 * (scr * (1.f / 255.f));
                        r[0] = (float)(gb.x & 255u) * a0[0]; r[1] = (float)((gb.x >> 8) & 255u) * a0[1]; r[2] = (float)((gb.x >> 16) & 255u) * a0[2]; r[3] = (float)(gb.x >> 24) * a0[3];
                        r[4] = (float)(gb.y & 255u) * a1[0]; r[5] = (float)((gb.y >> 8) & 255u) * a1[1]; r[6] = (float)((gb.y >> 16) & 255u) * a1[2]; r[7] = (float)(gb.y >> 24) * a1[3];
                    } else {
                    const u32x4 gw = *(const u32x4*)(G + off);
                    const pg8::f32x4 a0 = c0 * scr, a1 = c1 * scr;
                    r[0] = bflo(gw.x) * a0[0]; r[1] = bfhi(gw.x) * a0[1]; r[2] = bflo(gw.y) * a0[2]; r[3] = bfhi(gw.y) * a0[3];
                    r[4] = bflo(gw.z) * a1[0]; r[5] = bfhi(gw.z) * a1[1]; r[6] = bflo(gw.w) * a1[2]; r[7] = bfhi(gw.w) * a1[3];
                    }
                    if (MODE == 1) {
                        const u32x4 ow = *(const u32x4*)(O + off);
                        r[0] += bflo(ow.x); r[1] += bfhi(ow.x); r[2] += bflo(ow.y); r[3] += bfhi(ow.y);
                        r[4] += bflo(ow.z); r[5] += bfhi(ow.z); r[6] += bflo(ow.w); r[7] += bfhi(ow.w);
                    }
                    if (MODE == 1 && F8_BR) {
                        u32x2 w8; w8.x = pack_fp8x4(r[0] * ASC8, r[1] * ASC8, r[2] * ASC8, r[3] * ASC8); w8.y = pack_fp8x4(r[4] * ASC8, r[5] * ASC8, r[6] * ASC8, r[7] * ASC8);
                        *(u32x2*)(O8 + off) = w8;
                    } else {
                        u32x4 w; w.x = pk2(r[0], r[1]); w.y = pk2(r[2], r[3]); w.z = pk2(r[4], r[5]); w.w = pk2(r[6], r[7]);
                        *(u32x4*)(O + off) = w;
                    }
                }
    }
};

struct EpiMerged {
    static constexpr bool PERM = true, AFTER_DRAIN = false, MID = true;
    const unsigned char* G0; const unsigned char* G1; bf16_t* O; unsigned char* O8;
    __device__ __forceinline__ void mid(pg8::f32x4 (&acc)[2][2][4][2], const pg8::Unit& u, int wr, int wc, int fr, int fq) const {
        int frl = fr; asm volatile("" : "+v"(frl));
        const int row0 = u.pm * 256 + wr * 64 + frl, col0 = u.pn * 256 + wc * 32 + 8 * fq;
        u32x2 gq[2][2];
#define EPI_LDG(i_) do { const unsigned o_ = (unsigned)(row0 + ((i_) >> 3) * 128 + (((i_) >> 1) & 3) * 16) * 1024u + (unsigned)(col0 + ((i_) & 1) * 128); \
            gq[(i_) & 1][0] = *(const u32x2*)(G0 + o_); gq[(i_) & 1][1] = *(const u32x2*)(G1 + o_); } while (0)
        EPI_LDG(0);
#pragma unroll
        for (int ai = 0; ai < 2; ++ai)
#pragma unroll
            for (int m = 0; m < 4; ++m)
#pragma unroll
                for (int bj = 0; bj < 2; ++bj) {
                    if (ai * 8 + m * 2 + bj + 1 < 16) EPI_LDG(ai * 8 + m * 2 + bj + 1);
                    const u32x2 ga = gq[(ai * 8 + m * 2 + bj) & 1][0], gb = gq[(ai * 8 + m * 2 + bj) & 1][1];
#pragma unroll
                    for (int e = 0; e < 8; ++e) {
                        const unsigned wa = e < 4 ? ga.x : ga.y, wb = e < 4 ? gb.x : gb.y;
                        const float g0 = (float)((wa >> (8 * (e & 3))) & 255u), g1 = fmaxf((float)((wb >> (8 * (e & 3))) & 255u), 1.f);
                        acc[ai][bj][m][e >> 2][e & 3] *= g0 * __builtin_amdgcn_rcpf(g1);
                    }
                    asm volatile("" ::: "memory");
                    __builtin_amdgcn_sched_barrier(0);
                }
#undef EPI_LDG
    }
    __device__ __forceinline__ void operator()(const pg8::f32x4 (&acc)[2][2][4][2], const pg8::Unit& u, int wr, int wc, int fr, int fq) const {
        const int row0 = u.pm * 256 + wr * 64 + fr, col0 = u.pn * 256 + wc * 32 + 8 * fq;
        u32x2 gq[2][2];
#define EPI_LDG1(i_) do { _Pragma("unroll") for (int bj = 0; bj < 2; ++bj) gq[(i_) & 1][bj] = *(const u32x2*)(G1 + (size_t)(row0 + ((i_) >> 2) * 128 + ((i_) & 3) * 16) * 1024 + col0 + bj * 128); } while (0)
        EPI_LDG1(0);
#pragma unroll
        for (int ai = 0; ai < 2; ++ai)
#pragma unroll
            for (int m = 0; m < 4; ++m) {
                if (ai * 4 + m + 1 < 8) EPI_LDG1(ai * 4 + m + 1);
#pragma unroll
                for (int bj = 0; bj < 2; ++bj) {
                    const size_t off = (size_t)(row0 + ai * 128 + m * 16) * 1024 + col0 + bj * 128;
                    const u32x2 gb = gq[(ai * 4 + m) & 1][bj];
                    float r[8];
#pragma unroll
                    for (int e = 0; e < 8; ++e) {
                        const unsigned wb = e < 4 ? gb.x : gb.y;
                        r[e] = acc[ai][bj][m][e >> 2][e & 3] * (fmaxf((float)((wb >> (8 * (e & 3))) & 255u), 1.f) * (1.f / 255.f));
                    }
                    if (F8_OUT) { u32x2 w8; w8.x = pack_fp8x4(r[0] * ASC8, r[1] * ASC8, r[2] * ASC8, r[3] * ASC8); w8.y = pack_fp8x4(r[4] * ASC8, r[5] * ASC8, r[6] * ASC8, r[7] * ASC8); *(u32x2*)(O8 + off) = w8; }
                    else { u32x4 w; w.x = pk2(r[0], r[1]); w.y = pk2(r[2], r[3]); w.z = pk2(r[4], r[5]); w.w = pk2(r[6], r[7]); *(u32x4*)(O + off) = w; }
                }
            }
#undef EPI_LDG1
    }
};

struct EpiResid {
    static constexpr bool PERM = false, AFTER_DRAIN = false, MID = false;
    const float* x; const float* mod; float* out; float sc;
    __device__ __forceinline__ void operator()(const pg8::f32x4 (&acc)[2][2][4][2], const pg8::Unit& u, int wr, int wc, int fr, int fq) const {
        const int b = u.pm >> 3; const float* g1 = mod + (size_t)b * 6144 + 2048;
        const int row0 = u.pm * 256 + wr * 64 + fr, col0 = u.pn * 256 + wc * 32 + 4 * fq;
        pg8::f32x4 gv[2][2];
#pragma unroll
        for (int bj = 0; bj < 2; ++bj)
#pragma unroll
            for (int n = 0; n < 2; ++n) gv[bj][n] = *(const pg8::f32x4*)(g1 + col0 + bj * 128 + n * 16) * sc;
        pg8::f32x4 xq[2][4];
#define EPI_LDX(i_) do { _Pragma("unroll") for (int bj = 0; bj < 2; ++bj) _Pragma("unroll") for (int n = 0; n < 2; ++n) \
            xq[(i_) & 1][bj * 2 + n] = *(const pg8::f32x4*)(x + (size_t)(row0 + ((i_) >> 2) * 128 + ((i_) & 3) * 16) * 1024 + col0 + bj * 128 + n * 16); } while (0)
        EPI_LDX(0);
#pragma unroll
        for (int ai = 0; ai < 2; ++ai)
#pragma unroll
            for (int m = 0; m < 4; ++m) {
                if (ai * 4 + m + 1 < 8) EPI_LDX(ai * 4 + m + 1);
#pragma unroll
                for (int bj = 0; bj < 2; ++bj)
#pragma unroll
                    for (int n = 0; n < 2; ++n) {
                        const size_t off = (size_t)(row0 + ai * 128 + m * 16) * 1024 + col0 + bj * 128 + n * 16;
                        *(pg8::f32x4*)(out + off) = xq[(ai * 4 + m) & 1][bj * 2 + n] + gv[bj][n] * acc[ai][bj][m][n];
                    }
            }
#undef EPI_LDX
    }
};

struct EpiPlain {
    static constexpr bool PERM = true, AFTER_DRAIN = false, MID = false;
    bf16_t* O; int ldc; float sc;
    __device__ __forceinline__ void operator()(const pg8::f32x4 (&acc)[2][2][4][2], const pg8::Unit& u, int wr, int wc, int fr, int fq) const {
        const int row0 = u.pm * 256 + wr * 64 + fr, col0 = u.pn * 256 + wc * 32 + 8 * fq;
#pragma unroll
        for (int ai = 0; ai < 2; ++ai)
#pragma unroll
            for (int m = 0; m < 4; ++m)
#pragma unroll
                for (int bj = 0; bj < 2; ++bj) {
                    const pg8::f32x4 a0 = acc[ai][bj][m][0] * sc, a1 = acc[ai][bj][m][1] * sc;
                    u32x4 w; w.x = pk2(a0[0], a0[1]); w.y = pk2(a0[2], a0[3]); w.z = pk2(a1[0], a1[1]); w.w = pk2(a1[2], a1[3]);
                    *(u32x4*)(O + (size_t)(row0 + ai * 128 + m * 16) * ldc + col0 + bj * 128) = w;
                }
    }
};

struct EpiPlainI8 {
    static constexpr bool PERM = true, AFTER_DRAIN = false, MID = false;
    bf16_t* O; int ldc; const float* rs; const unsigned* wm;
    __device__ __forceinline__ void operator()(const pg8::f32x4 (&acc)[2][2][4][2], const pg8::Unit& u, int wr, int wc, int fr, int fq) const {
        typedef int i32x4 __attribute__((ext_vector_type(4)));
        const int row0 = u.pm * 256 + wr * 64 + fr, col0 = u.pn * 256 + wc * 32 + 8 * fq;
        const float cs = __builtin_bit_cast(float, *wm) * (1.f / 127.f);
        float rsv[8];
#pragma unroll
        for (int i = 0; i < 8; ++i) rsv[i] = rs[row0 + (i >> 2) * 128 + (i & 3) * 16];
#pragma unroll
        for (int ai = 0; ai < 2; ++ai)
#pragma unroll
            for (int m = 0; m < 4; ++m) {
                const int row = row0 + ai * 128 + m * 16;
                const float sc = rsv[ai * 4 + m] * cs;
#pragma unroll
                for (int bj = 0; bj < 2; ++bj) {
                    const i32x4 i0 = __builtin_bit_cast(i32x4, acc[ai][bj][m][0]), i1 = __builtin_bit_cast(i32x4, acc[ai][bj][m][1]);
                    u32x4 w; w.x = pk2((float)i0[0] * sc, (float)i0[1] * sc); w.y = pk2((float)i0[2] * sc, (float)i0[3] * sc); w.z = pk2((float)i1[0] * sc, (float)i1[1] * sc); w.w = pk2((float)i1[2] * sc, (float)i1[3] * sc);
                    *(u32x4*)(O + (size_t)row * ldc + col0 + bj * 128) = w;
                }
            }
    }
};

struct EpiProbe {
    static constexpr bool PERM = true, AFTER_DRAIN = false, MID = false;
    bf16_t* O;
    __device__ __forceinline__ void operator()(const pg8::f32x4 (&acc)[2][2][4][2], const pg8::Unit& u, int wr, int wc, int fr, int fq) const {
        const int row0 = u.pm * 256 + wr * 64 + fr, col0 = wc * 32 + 8 * fq;
#pragma unroll
        for (int ai = 0; ai < 2; ++ai)
#pragma unroll
            for (int m = 0; m < 4; ++m)
#pragma unroll
                for (int bj = 0; bj < 2; ++bj) {
                    const pg8::f32x4 a0 = acc[ai][bj][m][0], a1 = acc[ai][bj][m][1];
                    u32x4 w; w.x = pk2(a0[0], a0[1]); w.y = pk2(a0[2], a0[3]); w.z = pk2(a1[0], a1[1]); w.w = pk2(a1[2], a1[3]);
                    *(u32x4*)(O + (size_t)(row0 + ai * 128 + m * 16) * 256 + col0 + bj * 128) = w;
                }
    }
};
#define XB_TMO      128
#define XB_XCNT(j)  (256  + 64 * (j))
#define XB_XSUB(j)  (1280 + 64 * (j))
#define XB_XGEN(j)  (2304 + 64 * (j))
#define XB_TOP      3328
#define XB_TOPGEN   3392
#define XCD_BAR_WORDS 3456
#define XB_SPIN_CAP (1u << 18)

__device__ __forceinline__ unsigned xb_ld(unsigned* p)              { return __hip_atomic_load(p, __ATOMIC_RELAXED, __HIP_MEMORY_SCOPE_AGENT); }
__device__ __forceinline__ unsigned xb_add(unsigned* p, unsigned v) { return __hip_atomic_fetch_add(p, v, __ATOMIC_RELAXED, __HIP_MEMORY_SCOPE_AGENT); }
__device__ __forceinline__ unsigned xb_xcc_id() { return (unsigned)__builtin_amdgcn_s_getreg((3 << 11) | 20) & 0xFu; }
#define XB_SPIN(cond, bar) do { unsigned _sp = 0; while (cond) { __builtin_amdgcn_s_sleep(1); \
    if ((++_sp & 255u) == 0u) { if (xb_ld(&(bar)[XB_TMO])) break; if (_sp > XB_SPIN_CAP) { atomicAdd(&(bar)[XB_TMO], 1u); break; } } } } while (0)

struct XcdBarrier {
    unsigned* bar; unsigned x;
    volatile LAS unsigned* st;
};

__device__ __forceinline__ XcdBarrier xcd_barrier_post(unsigned* bar, volatile LAS unsigned* st) {
    XcdBarrier b; b.bar = bar; b.x = xb_xcc_id(); b.st = st;
    if (threadIdx.x == 0) (void)xb_add(&bar[XB_XCNT(b.x)], 1u);
    return b;
}
__device__ __forceinline__ void xcd_barrier_complete(unsigned* bar, unsigned x, unsigned& nloc, unsigned& nx) {
    const unsigned G = gridDim.x * gridDim.y * gridDim.z;
    unsigned sum, cnt, mine, sp = 0u;
    for (;;) {
        sum = 0u; cnt = 0u; mine = 0u;
#pragma unroll
        for (unsigned j = 0; j < 16; ++j) { const unsigned c = xb_ld(&bar[XB_XCNT(j)]); sum += c; cnt += (c > 0u) ? 1u : 0u; mine = (j == x) ? c : mine; }
        if (sum == G) break;
        __builtin_amdgcn_s_sleep(1);
        if ((++sp & 255u) == 0u) { if (xb_ld(&bar[XB_TMO])) break; if (sp > XB_SPIN_CAP) { atomicAdd(&bar[XB_TMO], 1u); break; } }
    }
    nloc = mine > 0u ? mine : 1u; nx = cnt > 0u ? cnt : 1u;
}

__device__ __forceinline__ void xcd_barrier(const XcdBarrier& b) {
    asm volatile("s_waitcnt vmcnt(0)" ::: "memory");
    __syncthreads();
    if (threadIdx.x == 0) {
        unsigned* bar = b.bar;
        __builtin_amdgcn_s_waitcnt(0);
        unsigned nloc = b.st[0], nx = b.st[1];
        if (nloc == 0u) { xcd_barrier_complete(bar, b.x, nloc, nx); b.st[0] = nloc; b.st[1] = nx; }
        const unsigned old = xb_add(&bar[XB_XSUB(b.x)], 1u);
        const unsigned gen = old / nloc;
        if (old + 1u == (gen + 1u) * nloc) {
            __builtin_amdgcn_fence(__ATOMIC_RELEASE, "agent");
            asm volatile("s_waitcnt vmcnt(0)" ::: "memory");
            const unsigned og = xb_add(&bar[XB_TOP], 1u);
            const unsigned tg = og / nx;
            if (og + 1u == (tg + 1u) * nx) xb_add(&bar[XB_TOPGEN], 1u);
            else XB_SPIN(xb_ld(&bar[XB_TOPGEN]) == tg, bar);
            __builtin_amdgcn_fence(__ATOMIC_ACQUIRE, "agent");
            xb_add(&bar[XB_XGEN(b.x)], 1u);
            asm volatile("s_waitcnt vmcnt(0)" ::: "memory");
        } else {
            XB_SPIN(xb_ld(&bar[XB_XGEN(b.x)]) == gen, bar);
            __builtin_amdgcn_fence(__ATOMIC_ACQUIRE, "agent");
            asm volatile("s_waitcnt vmcnt(0)" ::: "memory");
        }
    }
    __syncthreads();
}
#define LDS_WAIT() asm volatile("s_waitcnt lgkmcnt(0)" ::: "memory")
#define VM_WAIT() asm volatile("s_waitcnt vmcnt(0)" ::: "memory")

DI void transpose_item(const float* W, int N, int K, bf16_t* WT, int prow0, int lcol0, int nvalid, int k0, LAS float* scr, int lane) {
    const int cl = lane & 31;
    float tw[32];
#pragma unroll
    for (int i = 0; i < 32; ++i) { const int kk = 2 * i + (lane >> 5); tw[i] = (cl < nvalid) ? W[(size_t)(k0 + kk) * N + lcol0 + cl] : 0.f; }
#pragma unroll
    for (int i = 0; i < 32; ++i) { const int kk = 2 * i + (lane >> 5); scr[kk * 33 + cl] = tw[i]; }
    LDS_WAIT();
    const int c = lane & 7;
#pragma unroll
    for (int j = 0; j < 4; ++j) {
        const int n = (lane >> 3) + 8 * j; const LAS float* s = scr + (8 * c) * 33 + n;
        u32x4 o; o.x = pk2(s[0 * 33], s[1 * 33]); o.y = pk2(s[2 * 33], s[3 * 33]); o.z = pk2(s[4 * 33], s[5 * 33]); o.w = pk2(s[6 * 33], s[7 * 33]);
        *(u32x4*)(WT + (size_t)(prow0 + n) * K + k0 + 8 * c) = o;
    }
    LDS_WAIT();
}

DI unsigned pack_i8x4(float a, float b, float c, float d) {
    const int ia = (int)__builtin_rintf(fminf(fmaxf(a, -127.f), 127.f)), ib = (int)__builtin_rintf(fminf(fmaxf(b, -127.f), 127.f));
    const int ic = (int)__builtin_rintf(fminf(fmaxf(c, -127.f), 127.f)), id = (int)__builtin_rintf(fminf(fmaxf(d, -127.f), 127.f));
    return (unsigned)(ia & 255) | ((unsigned)(ib & 255) << 8) | ((unsigned)(ic & 255) << 16) | ((unsigned)(id & 255) << 24);
}
template <bool INT8 = false>
DI void transpose_item8(const float* W, int N, int K, unsigned char* WT, int prow0, int lcol0, int nvalid, int k0, float scale, LAS float* scr, int lane) {
    const int cl = lane & 31;
    float tw[32];
#pragma unroll
    for (int i = 0; i < 32; ++i) { const int kk = 2 * i + (lane >> 5); tw[i] = (cl < nvalid) ? W[(size_t)(k0 + kk) * N + lcol0 + cl] * scale : 0.f; }
#pragma unroll
    for (int i = 0; i < 32; ++i) { const int kk = 2 * i + (lane >> 5); scr[kk * 33 + cl] = tw[i]; }
    LDS_WAIT();
    const int c = lane & 3;
#pragma unroll
    for (int j = 0; j < 2; ++j) {
        const int n = (lane >> 2) + 16 * j; const LAS float* s = scr + (16 * c) * 33 + n;
        u32x4 o;
#pragma unroll
        for (int q = 0; q < 4; ++q) o[q] = INT8 ? pack_i8x4(s[(4 * q) * 33], s[(4 * q + 1) * 33], s[(4 * q + 2) * 33], s[(4 * q + 3) * 33]) : pack_fp8x4(s[(4 * q) * 33], s[(4 * q + 1) * 33], s[(4 * q + 2) * 33], s[(4 * q + 3) * 33]);
        *(u32x4*)(WT + (size_t)(prow0 + n) * K + k0 + 16 * c) = o;
    }
    LDS_WAIT();
}
DI void absmax_to(const float* p, size_t n, unsigned* word, size_t gtid, size_t gth, int lane, LAS float* red, int wave, int tid) {
    float mx = 0.f;
    for (size_t i = gtid * 4; i < n; i += gth * 16) {
        f32x4 v[4];
#pragma unroll
        for (int q = 0; q < 4; ++q) { const size_t j = i + (size_t)q * gth * 4; v[q] = (j < n) ? *(const f32x4*)(p + j) : (f32x4){0.f, 0.f, 0.f, 0.f}; }
#pragma unroll
        for (int q = 0; q < 4; ++q) mx = fmaxf(fmaxf(mx, fmaxf(fabsf(v[q][0]), fabsf(v[q][1]))), fmaxf(fabsf(v[q][2]), fabsf(v[q][3])));
    }
#pragma unroll
    for (int o = 1; o < 64; o <<= 1) mx = fmaxf(mx, __shfl_xor(mx, o));
    if (lane == 0) red[wave] = mx;
    __syncthreads();
    if (tid == 0) { float m8 = red[0];
#pragma unroll
        for (int w = 1; w < 8; ++w) m8 = fmaxf(m8, red[w]);
        if (m8 > 0.f) atomicMax(word, __builtin_bit_cast(unsigned, m8)); }
    __syncthreads();
}
DI float absmax_part(const float* p, size_t n, size_t gtid, size_t gth) {
    float mx = 0.f;
    for (size_t i = gtid * 4; i < n; i += gth * 16) {
        f32x4 v[4];
#pragma unroll
        for (int q = 0; q < 4; ++q) { const size_t j = i + (size_t)q * gth * 4; v[q] = (j < n) ? *(const f32x4*)(p + j) : (f32x4){0.f, 0.f, 0.f, 0.f}; }
#pragma unroll
        for (int q = 0; q < 4; ++q) mx = fmaxf(fmaxf(mx, fmaxf(fabsf(v[q][0]), fabsf(v[q][1]))), fmaxf(fabsf(v[q][2]), fabsf(v[q][3])));
    }
#pragma unroll
    for (int o = 1; o < 64; o <<= 1) mx = fmaxf(mx, __shfl_xor(mx, o));
    return mx;
}
DI float wscale8(const unsigned char* ws, int which) { return WTOP8 / fmaxf(__builtin_bit_cast(float, ((const unsigned*)(ws + WS_CTL))[CW_WMAX + 32 * which]), 1e-30f); }

DI void conv_bf16(const float* src, bf16_t* dst, size_t n, size_t gtid, size_t gthreads) {
    for (size_t i = gtid * 8; i < n; i += gthreads * 8) {
        const f32x4 a = *(const f32x4*)(src + i), b = *(const f32x4*)(src + i + 4);
        u32x4 o; o.x = pk2(a[0], a[1]); o.y = pk2(a[2], a[3]); o.z = pk2(b[0], b[1]); o.w = pk2(b[2], b[3]);
        *(u32x4*)(dst + i) = o;
    }
}

DI void conv_fp8(const float* src, unsigned char* dst, size_t n, float scale, size_t gtid, size_t gthreads) {
    for (size_t i = gtid * 16; i < n; i += gthreads * 16) {
        const size_t e = i >> 10, c = i & 1023;
        u32x4 o;
#pragma unroll
        for (int q = 0; q < 4; ++q) {
            const f32x4 v = *(const f32x4*)(src + i + 4 * q) * scale;
            int w = 0; w = __builtin_amdgcn_cvt_pk_fp8_f32(v[0], v[1], w, false); w = __builtin_amdgcn_cvt_pk_fp8_f32(v[2], v[3], w, true);
            o[q] = (unsigned)w;
        }
        *(u32x4*)(dst + ((c >> 7) * 16384 + e) * 128 + (c & 127)) = o;
    }
}

DI void conv_u_i8(const float* src, unsigned char* dst, float scale, size_t gtid, size_t gthreads) {
    for (size_t i0 = gtid * 16; i0 < (size_t)16384 * 1024; i0 += gthreads * 32) {
        f32x4 v[2][4];
#pragma unroll
        for (int h = 0; h < 2; ++h)
#pragma unroll
            for (int q = 0; q < 4; ++q) v[h][q] = *(const f32x4*)(src + i0 + (size_t)h * gthreads * 16 + 4 * q);
#pragma unroll
        for (int h = 0; h < 2; ++h) {
            const size_t i = i0 + (size_t)h * gthreads * 16, e = i >> 10, c = i & 1023;
            u32x4 o;
#pragma unroll
            for (int q = 0; q < 4; ++q) { const f32x4 w = v[h][q] * scale; o[q] = pack_i8x4(w[0], w[1], w[2], w[3]); }
            *(u32x4*)(dst + ((c >> 7) * 16384 + e) * 128 + (c & 127)) = o;
        }
    }
}

DI int q4(float x) { return (int)__builtin_rintf(fminf(fmaxf(x, -8.f), 7.f)) & 15; }
DI void conv_u_i4(const float* src, unsigned char* dst, float inv_step, size_t gtid, size_t gthreads) {
    for (size_t i = gtid * 32; i < (size_t)16384 * 1024; i += gthreads * 32) {
        f32x4 v[8];
#pragma unroll
        for (int q = 0; q < 8; ++q) v[q] = *(const f32x4*)(src + i + 4 * q) * inv_step;
        u32x4 o;
#pragma unroll
        for (int j = 0; j < 4; ++j) {
            unsigned w = 0;
#pragma unroll
            for (int b = 0; b < 4; ++b) {
                if (UD8) w |= (unsigned)(q4(v[2 * j + (b >> 1)][2 * (b & 1)]) | (q4(v[2 * j + (b >> 1)][2 * (b & 1) + 1]) << 4)) << (8 * b);
                else w |= (unsigned)(q4(v[j][b]) | (q4(v[4 + j][b]) << 4)) << (8 * b);
            }
            o[j] = w;
        }
        const size_t e = i >> 10, c = i & 1023;
        *(u32x4*)(dst + ((c >> 8) * 16384 + e) * 128 + ((c & 255) >> 1)) = o;
    }
}

DI void conv_v_fp4(const float* src, unsigned char* dst, float inv_s, size_t gtid, size_t gthreads) {
    for (size_t i = gtid * 32; i < (size_t)16384 * 1024; i += gthreads * 32) {
        u32x4 o;
#pragma unroll
        for (int j = 0; j < 4; ++j) {
            f32x4 p = *(const f32x4*)(src + i + 8 * j) * inv_s, q = *(const f32x4*)(src + i + 8 * j + 4) * inv_s;
#pragma unroll
            for (int k = 0; k < 4; ++k) { p[k] = __builtin_amdgcn_fmed3f(p[k], -6.f, 6.f); q[k] = __builtin_amdgcn_fmed3f(q[k], -6.f, 6.f); }
            unsigned w = 0;
            w = __builtin_amdgcn_cvt_scalef32_pk_fp4_f32(w, p[0], p[1], 1.0f, 0); w = __builtin_amdgcn_cvt_scalef32_pk_fp4_f32(w, p[2], p[3], 1.0f, 1);
            w = __builtin_amdgcn_cvt_scalef32_pk_fp4_f32(w, q[0], q[1], 1.0f, 2); w = __builtin_amdgcn_cvt_scalef32_pk_fp4_f32(w, q[2], q[3], 1.0f, 3);
            o[j] = w;
        }
        const size_t e = i >> 10, c = i & 1023;
        *(u32x4*)(dst + ((c >> 8) * 16384 + e) * 128 + ((c & 255) >> 1)) = o;
    }
}

DI void ph_prologue(const KArgs& a, LAS unsigned char* lds, int tid, int lane, int wave, int blk, int nblk) {
    unsigned char* ws = a.ws;
    const int gw = blk * 8 + wave, ngw = nblk * 8;
    if (blk < 192) {
        LAS float* sc = (LAS float*)lds;
#pragma unroll 16
        for (int i = tid; i < 32 * 1024; i += 512) { const int b = i >> 10, k = i & 1023; const float v = a.c[i]; sc[k * 36 + b] = v * __builtin_amdgcn_rcpf(1.f + __expf(-v)); }
        __syncthreads();
        float acc[32];
#pragma unroll
        for (int b = 0; b < 32; ++b) acc[b] = 0.f;
        const int cl = lane & 31, kh = lane >> 5, col = blk * 32 + cl;
#pragma unroll 16
        for (int i = 0; i < 64; ++i) {
            const int k = wave * 128 + 2 * i + kh;
            const float wv = a.w_ada[(size_t)k * 6144 + col];
            const LAS f32x4* sp = (const LAS f32x4*)(sc + k * 36);
#pragma unroll
            for (int q = 0; q < 8; ++q) { const f32x4 s4 = sp[q]; acc[4 * q] += s4[0] * wv; acc[4 * q + 1] += s4[1] * wv; acc[4 * q + 2] += s4[2] * wv; acc[4 * q + 3] += s4[3] * wv; }
        }
        __syncthreads();
        LAS float* red = (LAS float*)lds;
#pragma unroll
        for (int b = 0; b < 32; ++b) red[((wave * 2 + kh) * 32 + b) * 32 + cl] = acc[b];
        __syncthreads();
        for (int o = tid; o < 1024; o += 512) {
            float s = 0.f;
#pragma unroll
            for (int p = 0; p < 16; ++p) s += red[p * 1024 + o];
            const int b = o >> 5, c2 = o & 31;
            ((float*)(ws + WS_MOD))[(size_t)b * 6144 + blk * 32 + c2] = s + a.b_ada[blk * 32 + c2];
        }
        __syncthreads();
    }
    {
        LAS float* scr = (LAS float*)(lds + wave * 8704);
        constexpr int I_WIN = 16 * 152, I_WB = 8 * 32, I_WO = 16 * 32, I_WPQ = 16 * 64;
        constexpr int NITEMS = I_WIN + 2 * I_WB + I_WO + I_WPQ;
        for (int it = gw; it < NITEMS; it += ngw) {
            int r = it;
            if (r < I_WIN) {
                const int pb = r % 152, kb = r / 152, pn = pb >> 3, bj = (pb >> 2) & 1, wc = pb & 3, g = pn * 4 + wc;
                const int nvalid = (g == 43) ? (bj == 0 ? 8 : 0) : 32;
                if (!((IN8_MASK >> pn) & 1u)) transpose_item(a.w_in, WIN_COLS, 1024, (bf16_t*)(ws + WS_WIN), rank_in(~IN8_MASK, pn) * 256 + (pb & 7) * 32, proj_group_base(g) + 32 * bj, nvalid, kb * 64, scr, lane);
                continue;
            }
            r -= I_WIN;
            if (r < I_WB) { if (!F8_BR && !BR8) transpose_item(a.w_ba, 1024, FUSE56 ? 1024 : 512, (bf16_t*)(ws + WS_WBA), (r % 32) * 32, (r % 32) * 32, 32, (r / 32) * 64, scr, lane); continue; }
            r -= I_WB;
            if (r < I_WB) { if (!F8_BR && !BR8) transpose_item(a.w_bb, 1024, FUSE56 ? 1024 : 512, FUSE56 ? (bf16_t*)(ws + WS_WBA) + 512 : (bf16_t*)(ws + WS_WBB), (r % 32) * 32, (r % 32) * 32, 32, (r / 32) * 64, scr, lane); continue; }
            r -= I_WB;
            if (r < I_WO) { if (!F8_BR && !F8_OUT) transpose_item(a.w_out, 1024, 1024, (bf16_t*)(ws + WS_WOUT), (r % 32) * 32, (r % 32) * 32, 32, (r / 32) * 64, scr, lane); continue; }
            r -= I_WO;
            if (PQ_MODE == 0) transpose_item(a.peer_wq, 2048, 1024, (bf16_t*)(ws + WS_WPQ), (r % 64) * 32, (r % 64) * 32, 32, (r / 64) * 64, scr, lane);
        }
    }
    {
        const size_t gtid = (size_t)blk * 512 + tid, gth = (size_t)nblk * 512;
        conv_bf16(a.sub_keys, (bf16_t*)(ws + WS_SKB), (size_t)8 * 2 * 128 * 128, gtid, gth);
        constexpr bool BATCH5 = U4 && V4 && PQ_MODE != 0 && N8_IN > 0 && F8_OUT && !F8_BR && !BR8;
        if (BATCH5) {
            const float m0 = absmax_part(a.peer_u, (size_t)1 << 21, gtid, gth), m1 = absmax_part(a.peer_wq, (size_t)1024 * 2048, gtid, gth), m2 = absmax_part(a.w_in, (size_t)1024 * WIN_COLS, gtid, gth),
                        m3 = absmax_part(a.w_out, (size_t)1024 * 1024, gtid, gth), m4 = absmax_part(a.peer_v, (size_t)1 << 21, gtid, gth);
            LAS float* red = (LAS float*)lds;
            if (lane == 0) { red[wave * 8 + 0] = m0; red[wave * 8 + 1] = m1; red[wave * 8 + 2] = m2; red[wave * 8 + 3] = m3; red[wave * 8 + 4] = m4; }
            __syncthreads();
            if (tid < 5) {
                float m8 = red[tid];
#pragma unroll
                for (int w = 1; w < 8; ++w) m8 = fmaxf(m8, red[w * 8 + tid]);
                const int wo = tid == 0 ? CW_UMAX : tid == 1 ? CW_WMAX + 32 * 4 : tid == 2 ? CW_WMAX : tid == 3 ? CW_WMAX + 32 * 3 : CW_VMAX;
                if (m8 > 0.f) atomicMax((unsigned*)(ws + WS_CTL) + wo, __builtin_bit_cast(unsigned, m8));
            }
            __syncthreads();
        } else {
        if (U4) absmax_to(a.peer_u, (size_t)1 << 21, (unsigned*)(ws + WS_CTL) + CW_UMAX, gtid, gth, lane, (LAS float*)lds, wave, tid);
        else {
            float mx = 0.f;
            for (size_t i = gtid * 4; i < (size_t)16384 * 1024; i += gth * 16) {
                f32x4 v[4];
#pragma unroll
                for (int q = 0; q < 4; ++q) v[q] = *(const f32x4*)(a.peer_u + i + (size_t)q * gth * 4);
#pragma unroll
                for (int q = 0; q < 4; ++q) mx = fmaxf(fmaxf(mx, fmaxf(fabsf(v[q][0]), fabsf(v[q][1]))), fmaxf(fabsf(v[q][2]), fabsf(v[q][3])));
            }
#pragma unroll
            for (int o = 1; o < 64; o <<= 1) mx = fmaxf(mx, __shfl_xor(mx, o));
            if (lane == 0) atomicMax((unsigned*)(ws + WS_CTL) + CW_UMAX, __builtin_bit_cast(unsigned, mx));
        }
        if (PQ_MODE != 0) absmax_to(a.peer_wq, (size_t)1024 * 2048, (unsigned*)(ws + WS_CTL) + CW_WMAX + 32 * 4, gtid, gth, lane, (LAS float*)lds, wave, tid);
        if (N8_IN > 0) absmax_to(a.w_in, (size_t)1024 * WIN_COLS, (unsigned*)(ws + WS_CTL) + CW_WMAX + 32 * 0, gtid, gth, lane, (LAS float*)lds, wave, tid);
        if (F8_OUT && !F8_BR && !BR8) absmax_to(a.w_out, (size_t)1024 * 1024, (unsigned*)(ws + WS_CTL) + CW_WMAX + 32 * 3, gtid, gth, lane, (LAS float*)lds, wave, tid);
        if (F8_BR || BR8) {
            absmax_to(a.w_ba, (size_t)512 * 1024, (unsigned*)(ws + WS_CTL) + CW_WMAX + 32 * 1, gtid, gth, lane, (LAS float*)lds, wave, tid);
            absmax_to(a.w_bb, (size_t)512 * 1024, (unsigned*)(ws + WS_CTL) + CW_WMAX + 32 * 2, gtid, gth, lane, (LAS float*)lds, wave, tid);
            if (F8_BR || F8_OUT) absmax_to(a.w_out, (size_t)1024 * 1024, (unsigned*)(ws + WS_CTL) + CW_WMAX + 32 * 3, gtid, gth, lane, (LAS float*)lds, wave, tid);
        }
        if (V4) absmax_to(a.peer_v, (size_t)1 << 21, (unsigned*)(ws + WS_CTL) + CW_VMAX, gtid, gth, lane, (LAS float*)lds, wave, tid);
        else conv_fp8(a.peer_v, ws + WS_VB, (size_t)16384 * 1024, VSCALE, gtid, gth);
        }
        for (size_t t = gtid; t < (size_t)NTOK; t += gth) {
            const float p = (float)a.pos[t];
            float cs[32], sn[32];
            double f = 0.15915494309189535;
#pragma unroll
            for (int k = 0; k < 32; ++k) {
                const float fh = (float)f, fl = (float)(f - (double)fh);
                const float r = p * fh;
                const float e = __builtin_fmaf(p, fh, -r) + p * fl;
                const float fr = (r - __builtin_floorf(r)) + e;
                cs[k] = __builtin_amdgcn_cosf(fr); sn[k] = __builtin_amdgcn_sinf(fr);
                f *= 0.7498942093324559;
            }
            float* cp = (float*)(ws + WS_COS) + t * 32; float* sp = (float*)(ws + WS_SIN) + t * 32;
#pragma unroll
            for (int k = 0; k < 8; ++k) { *(f32x4*)(cp + 4 * k) = (f32x4){cs[4 * k], cs[4 * k + 1], cs[4 * k + 2], cs[4 * k + 3]}; *(f32x4*)(sp + 4 * k) = (f32x4){sn[4 * k], sn[4 * k + 1], sn[4 * k + 2], sn[4 * k + 3]}; }
        }
    }
}

DI void ph_weights8(const KArgs& a, LAS unsigned char* lds, int lane, int wave, int blk, int nblk) {
    unsigned char* ws = a.ws;
    const int gw = blk * 8 + wave, ngw = nblk * 8;
    LAS float* scr = (LAS float*)(lds + wave * 8704);
    if (PQ_MODE != 0) {
        const float spq = wscale8(ws, 4) * (PQ_MODE == 2 ? 127.f / WTOP8 : 1.f);
        for (int r = gw; r < 16 * 64; r += ngw) transpose_item8<PQ_MODE == 2>(a.peer_wq, 2048, 1024, ws + WS_WPQ, (r % 64) * 32, (r % 64) * 32, 32, (r / 64) * 64, spq, scr, lane);
    }
    if (N8_IN > 0) {
        const float si = wscale8(ws, 0) * (IN_MODE == 2 ? 127.f / WTOP8 : 1.f);
        for (int r = gw; r < 16 * 152; r += ngw) {
            const int pb = r % 152, kb = r / 152, pn = pb >> 3, bj = (pb >> 2) & 1, wc = pb & 3, g = pn * 4 + wc;
            if ((IN8_MASK >> pn) & 1u) transpose_item8<IN_MODE == 2>(a.w_in, WIN_COLS, 1024, ws + WS_WIN8, rank_in(IN8_MASK, pn) * 256 + (pb & 7) * 32, proj_group_base(g) + 32 * bj, (g == 43) ? (bj == 0 ? 8 : 0) : 32, kb * 64, si, scr, lane);
        }
    }
    if (BR8 && !F8_BR) {
        const float sa = wscale8(ws, 1) * (127.f / WTOP8), sb = wscale8(ws, 2) * (127.f / WTOP8);
        for (int it = gw; it < 2 * 256; it += ngw) {
            const int r = it & 255;
            if (it < 256) transpose_item8<true>(a.w_ba, 1024, 512, ws + WS_WBA, (r % 32) * 32, (r % 32) * 32, 32, (r / 32) * 64, sa, scr, lane);
            else transpose_item8<true>(a.w_bb, 1024, 512, ws + WS_WBB, (r % 32) * 32, (r % 32) * 32, 32, (r / 32) * 64, sb, scr, lane);
        }
    }
    if (F8_OUT && !F8_BR) {
        const float so = wscale8(ws, 3);
        for (int r = gw; r < 512; r += ngw) transpose_item8(a.w_out, 1024, 1024, ws + WS_WOUT, (r % 32) * 32, (r % 32) * 32, 32, (r / 32) * 64, so, scr, lane);
    }
    if (F8_BR) {
        const float sa = wscale8(ws, 1), sb = wscale8(ws, 2), so = wscale8(ws, 3);
        for (int it = gw; it < 2 * 256 + 512; it += ngw) {
            int r = it;
            if (r < 256) { transpose_item8(a.w_ba, 1024, 512, ws + WS_WBA, (r % 32) * 32, (r % 32) * 32, 32, (r / 32) * 64, sa, scr, lane); continue; }
            r -= 256;
            if (r < 256) { transpose_item8(a.w_bb, 1024, 512, ws + WS_WBB, (r % 32) * 32, (r % 32) * 32, 32, (r / 32) * 64, sb, scr, lane); continue; }
            r -= 256;
            transpose_item8(a.w_out, 1024, 1024, ws + WS_WOUT, (r % 32) * 32, (r % 32) * 32, 32, (r / 32) * 64, so, scr, lane);
        }
    }
}

template <bool I8, bool WB16, bool WF8, bool NIB = false>
DI void ph_norm(const float* src, const float* gain, const float* mod, int sh_off, int sc_off, bf16_t* dst, unsigned char* dstf, unsigned char* dst8, float* hs, int lane, int wave, int blk, int nblk, unsigned char* ha = nullptr, unsigned char* hb = nullptr) {
    const int gw = blk * 8 + wave, ngw = nblk * 8;
    const int rows_per = NTOK / ngw;
    for (int r0 = gw * rows_per; r0 < NTOK; r0 += ngw * rows_per) {
        const int b = r0 / NT;
        f32x4 mul[4], add[4];
#pragma unroll
        for (int j = 0; j < 4; ++j) {
            const int col = 4 * lane + 256 * j;
            const f32x4 g = *(const f32x4*)(gain + col), s = *(const f32x4*)(mod + (size_t)b * 6144 + sc_off + col);
            mul[j] = g * (s + 1.f); add[j] = *(const f32x4*)(mod + (size_t)b * 6144 + sh_off + col);
        }
        f32x4 vn[4][4];
#pragma unroll
        for (int q = 0; q < 4; ++q) {
            const f32x4* xr = (const f32x4*)(src + (size_t)(r0 + q) * 1024) + lane;
#pragma unroll
            for (int j = 0; j < 4; ++j) vn[q][j] = xr[64 * j];
        }
#pragma unroll 2
        for (int r = r0; r < r0 + rows_per; r += 4) {
            f32x4 v[4][4]; float s[4];
#pragma unroll
            for (int q = 0; q < 4; ++q)
#pragma unroll
                for (int j = 0; j < 4; ++j) v[q][j] = vn[q][j];
            if (r + 4 < r0 + rows_per) {
#pragma unroll
                for (int q = 0; q < 4; ++q) {
                    const f32x4* xr = (const f32x4*)(src + (size_t)(r + 4 + q) * 1024) + lane;
#pragma unroll
                    for (int j = 0; j < 4; ++j) vn[q][j] = xr[64 * j];
                }
            }
#pragma unroll
            for (int q = 0; q < 4; ++q) {
                s[q] = 0.f;
#pragma unroll
                for (int j = 0; j < 4; ++j) s[q] += (v[q][j][0] * v[q][j][0] + v[q][j][1] * v[q][j][1]) + (v[q][j][2] * v[q][j][2] + v[q][j][3] * v[q][j][3]);
            }
#pragma unroll
            for (int o = 1; o < 64; o <<= 1) {
#pragma unroll
                for (int q = 0; q < 4; ++q) s[q] += __shfl_xor(s[q], o);
            }
#pragma unroll
            for (int q = 0; q < 4; ++q) {
                const float rn = __builtin_amdgcn_rsqf(s[q] * (1.f / 1024.f) + EPS);
                u32x2* o = (u32x2*)(dst + (size_t)(r + q) * 1024) + lane;
                f32x4 y[4]; float am = 0.f;
#pragma unroll
                for (int j = 0; j < 4; ++j) { y[j] = v[q][j] * rn * mul[j] + add[j];
                    if (WF8) { ((unsigned*)(dstf + (size_t)(r + q) * 1024) + lane)[64 * j] = pack_fp8x4(y[j][0] * ASC8, y[j][1] * ASC8, y[j][2] * ASC8, y[j][3] * ASC8); }
                    if (WB16) { u32x2 w; w.x = pk2(y[j][0], y[j][1]); w.y = pk2(y[j][2], y[j][3]); o[64 * j] = w; }
                    if (I8) am = fmaxf(fmaxf(am, fmaxf(fabsf(y[j][0]), fabsf(y[j][1]))), fmaxf(fabsf(y[j][2]), fabsf(y[j][3]))); }
                if (I8) {
#pragma unroll
                    for (int oo = 1; oo < 64; oo <<= 1) am = fmaxf(am, __shfl_xor(am, oo));
                    am = fmaxf(am, 1e-20f);
                    const float qs = (NIB ? 119.f : 127.f) / am;
                    unsigned* o8 = (unsigned*)(dst8 + (size_t)(r + q) * 1024) + lane;
#pragma unroll
                    for (int j = 0; j < 4; ++j) {
                        o8[64 * j] = pack_i8x4(y[j][0] * qs, y[j][1] * qs, y[j][2] * qs, y[j][3] * qs);
                        if (NIB) {
                            unsigned na = 0, nb = 0;
#pragma unroll
                            for (int e = 0; e < 4; ++e) { const int qi = (int)__builtin_rintf(y[j][e] * qs); nb |= (unsigned)(qi & 15) << (4 * e); na |= (unsigned)(((qi + 8) >> 4) & 15) << (4 * e); }
                            const unsigned na2 = __shfl_xor(na, 1), nb2 = __shfl_xor(nb, 1);
                            if (!(lane & 1)) {
                                *(unsigned*)(ha + (size_t)(r + q) * 512 + 2 * lane + 128 * j) = na | (na2 << 16);
                                *(unsigned*)(hb + (size_t)(r + q) * 512 + 2 * lane + 128 * j) = nb | (nb2 << 16);
                            }
                        }
                    }
                    if (lane == 0) hs[r + q] = am * (1.f / (NIB ? 119.f : 127.f));
                }
            }
        }
    }
}
typedef short v4i16_t __attribute__((ext_vector_type(4)));
DI s16x4 tr_read(const LAS char* p) { return __builtin_bit_cast(s16x4, __builtin_amdgcn_ds_read_tr16_b64_v4i16((LAS v4i16_t*)p)); }
DI bf16x8 pack8(float x0, float x1, float x2, float x3, float x4, float x5, float x6, float x7) {
    u32x4 p; p.x = pk2(x0, x1); p.y = pk2(x2, x3); p.z = pk2(x4, x5); p.w = pk2(x6, x7); return __builtin_bit_cast(bf16x8, p);
}
#define MFMA32(a, b, c) __builtin_amdgcn_mfma_f32_32x32x16_bf16((a), (b), (c), 0, 0, 0)
#define MFMA16(a, b, c) __builtin_amdgcn_mfma_f32_16x16x32_bf16((a), (b), (c), 0, 0, 0)

DI float max3f(float a, float b, float c) { float r; asm("v_max3_f32 %0, %1, %2, %3" : "=v"(r) : "v"(a), "v"(b), "v"(c)); return r; }
template <int BP> DI int bfe1s(int w) { int r; asm("v_bfe_i32 %0, %1, %2, 1" : "=v"(r) : "v"(w), "n"(BP)); return r; }
template <int NDB, int KST, int VST, bool MASK, bool ASMMAX = true>
DI void attn_tile(const LAS char* kb, const LAS char* vb, f32x16 (&o)[NDB], float& m, float& l, const bf16x8 (&qf)[4], unsigned mw0, unsigned mw1, int lane) {
    const int r32 = lane & 31, hi = lane >> 5;
    f32x16 p0, p1;
#pragma unroll
    for (int r = 0; r < 16; ++r) { p0[r] = 0.f; p1[r] = 0.f; }
    const LAS char* ka = kb + r32 * KST + hi * 16;
#pragma unroll
    for (int ks = 0; ks < 4; ++ks) {
        const bf16x8 a0 = *(const LAS bf16x8*)(ka + ks * 32), a1 = *(const LAS bf16x8*)(ka + 32 * KST + ks * 32);
        p0 = MFMA32(a0, qf[ks], p0); p1 = MFMA32(a1, qf[ks], p1);
    }
    float tm;
    {
        float t[16];
        if (ASMMAX) {
            asm volatile("s_nop 15\n\ts_nop 7" : "+v"(p0), "+v"(p1));
#pragma unroll
            for (int r = 0; r < 16; ++r) asm("v_max_f32 %0, %1, %2" : "=v"(t[r]) : "v"(p0[r]), "v"(p1[r]));
        } else {
#pragma unroll
            for (int r = 0; r < 16; ++r) t[r] = fmaxf(p0[r], p1[r]);
        }
        const float u0 = max3f(t[0], t[1], t[2]), u1 = max3f(t[3], t[4], t[5]), u2 = max3f(t[6], t[7], t[8]), u3 = max3f(t[9], t[10], t[11]), u4 = max3f(t[12], t[13], t[14]);
        tm = fmaxf(max3f(u0, u1, u2), max3f(u3, u4, t[15]));
    }
    tm = fmaxf(tm, __shfl_xor(tm, 32));
    const float mn = fmaxf(m, tm);
    const float alpha = fexp2(m - mn);
    float rs = 0.f;
    if (MASK) {
        const int w0 = (int)(mw0 >> (4 * hi)), w1 = (int)(mw1 >> (4 * hi));
#define ATT_MASKED(r_) { constexpr int bp = ((r_) & 3) + 8 * ((r_) >> 2); \
            p0[r_] = __builtin_bit_cast(float, __builtin_bit_cast(int, fexp2(p0[r_] - mn)) & bfe1s<bp>(w0)); \
            p1[r_] = __builtin_bit_cast(float, __builtin_bit_cast(int, fexp2(p1[r_] - mn)) & bfe1s<bp>(w1)); rs += p0[r_] + p1[r_]; }
        ATT_MASKED(0) ATT_MASKED(1) ATT_MASKED(2) ATT_MASKED(3) ATT_MASKED(4) ATT_MASKED(5) ATT_MASKED(6) ATT_MASKED(7)
        ATT_MASKED(8) ATT_MASKED(9) ATT_MASKED(10) ATT_MASKED(11) ATT_MASKED(12) ATT_MASKED(13) ATT_MASKED(14) ATT_MASKED(15)
#undef ATT_MASKED
    } else {
#pragma unroll
        for (int r = 0; r < 16; ++r) { p0[r] = fexp2(p0[r] - mn); p1[r] = fexp2(p1[r] - mn); rs += p0[r] + p1[r]; }
    }
    rs += __shfl_xor(rs, 32);
    l = l * alpha + rs; m = mn;
    if (__ballot(alpha != 1.0f)) {
#pragma unroll
        for (int db = 0; db < NDB; ++db)
#pragma unroll
            for (int r = 0; r < 16; ++r) o[db][r] *= alpha;
    }
    bf16x8 pf[4];
    pf[0] = pack8(p0[0], p0[1], p0[2], p0[3], p0[4], p0[5], p0[6], p0[7]);
    pf[1] = pack8(p0[8], p0[9], p0[10], p0[11], p0[12], p0[13], p0[14], p0[15]);
    pf[2] = pack8(p1[0], p1[1], p1[2], p1[3], p1[4], p1[5], p1[6], p1[7]);
    pf[3] = pack8(p1[8], p1[9], p1[10], p1[11], p1[12], p1[13], p1[14], p1[15]);
    const int i16 = lane & 15, q4 = i16 >> 2, pp = i16 & 3, g = lane >> 4;
    const LAS char* va = vb + (4 * (g >> 1) + q4) * VST + (16 * (g & 1) + 4 * pp) * 2;
#pragma unroll
    for (int db = 0; db < NDB; ++db)
#pragma unroll
        for (int s = 0; s < 4; ++s) {
            const s16x4 lo = tr_read(va + (16 * s) * VST + db * 64), h4 = tr_read(va + (16 * s + 8) * VST + db * 64);
            const bf16x8 vf = __builtin_shufflevector(lo, h4, 0, 1, 2, 3, 4, 5, 6, 7);
            o[db] = MFMA32(vf, pf[s], o[db]);
        }
}

template <int NDB, int KST, int VST, bool MASK>
DI void attn_tile_nm(const LAS char* kb, const LAS char* vb, f32x16 (&o)[NDB], float& l, const bf16x8 (&qf)[4], unsigned mw0, unsigned mw1, int lane) {
    const int r32 = lane & 31, hi = lane >> 5;
    f32x16 p0, p1;
#pragma unroll
    for (int r = 0; r < 16; ++r) { p0[r] = 0.f; p1[r] = 0.f; }
    const LAS char* ka = kb + r32 * KST + hi * 16;
#pragma unroll
    for (int ks = 0; ks < 4; ++ks) {
        const bf16x8 a0 = *(const LAS bf16x8*)(ka + ks * 32), a1 = *(const LAS bf16x8*)(ka + 32 * KST + ks * 32);
        p0 = MFMA32(a0, qf[ks], p0); p1 = MFMA32(a1, qf[ks], p1);
    }
    float rs = 0.f;
    if (MASK) {
        const int w0 = (int)(mw0 >> (4 * hi)), w1 = (int)(mw1 >> (4 * hi));
#define ATT_MASKED(r_) { constexpr int bp = ((r_) & 3) + 8 * ((r_) >> 2); \
            p0[r_] = __builtin_bit_cast(float, __builtin_bit_cast(int, fexp2(p0[r_])) & bfe1s<bp>(w0)); \
            p1[r_] = __builtin_bit_cast(float, __builtin_bit_cast(int, fexp2(p1[r_])) & bfe1s<bp>(w1)); rs += p0[r_] + p1[r_]; }
        ATT_MASKED(0) ATT_MASKED(1) ATT_MASKED(2) ATT_MASKED(3) ATT_MASKED(4) ATT_MASKED(5) ATT_MASKED(6) ATT_MASKED(7)
        ATT_MASKED(8) ATT_MASKED(9) ATT_MASKED(10) ATT_MASKED(11) ATT_MASKED(12) ATT_MASKED(13) ATT_MASKED(14) ATT_MASKED(15)
#undef ATT_MASKED
    } else {
#pragma unroll
        for (int r = 0; r < 16; ++r) { p0[r] = fexp2(p0[r]); p1[r] = fexp2(p1[r]); rs += p0[r] + p1[r]; }
    }
    l += rs;
    bf16x8 pf[4];
    pf[0] = pack8(p0[0], p0[1], p0[2], p0[3], p0[4], p0[5], p0[6], p0[7]);
    pf[1] = pack8(p0[8], p0[9], p0[10], p0[11], p0[12], p0[13], p0[14], p0[15]);
    pf[2] = pack8(p1[0], p1[1], p1[2], p1[3], p1[4], p1[5], p1[6], p1[7]);
    pf[3] = pack8(p1[8], p1[9], p1[10], p1[11], p1[12], p1[13], p1[14], p1[15]);
    const int i16 = lane & 15, q4 = i16 >> 2, pp = i16 & 3, g = lane >> 4;
    const LAS char* va = vb + (4 * (g >> 1) + q4) * VST + (16 * (g & 1) + 4 * pp) * 2;
#pragma unroll
    for (int db = 0; db < NDB; ++db)
#pragma unroll
        for (int s = 0; s < 4; ++s) {
            const s16x4 lo = tr_read(va + (16 * s) * VST + db * 64), h4 = tr_read(va + (16 * s + 8) * VST + db * 64);
            const bf16x8 vf = __builtin_shufflevector(lo, h4, 0, 1, 2, 3, 4, 5, 6, 7);
            o[db] = MFMA32(vf, pf[s], o[db]);
        }
}
DI float logit_bound(const float* gq, const float* gk, int lane) {
    float a = fabsf(gq[lane]), b = fabsf(gk[lane]);
#pragma unroll
    for (int o = 1; o < 64; o <<= 1) { a = fmaxf(a, __shfl_xor(a, o)); b = fmaxf(b, __shfl_xor(b, o)); }
    return 64.f * a * b * QSCALE * 1.02f;
}

template <bool nomax>
DI void ph_diff_body(const KArgs& a, LAS unsigned char* lds, int tid, int lane, int wave, int blk, int nblk) {
    unsigned char* ws = a.ws;
    const bf16_t* Qd = (const bf16_t*)(ws + WS_QD); const bf16_t* Kd = (const bf16_t*)(ws + WS_KD); const bf16_t* Vd = (const bf16_t*)(ws + WS_VD);
    bf16_t* OAB = (bf16_t*)(ws + WS_OAB);
    float lam;
    { const float d1 = wave_sum(a.lq1[lane] * a.lk1[lane]), d2 = wave_sum(a.lq2[lane] * a.lk2[lane]); lam = expf(d1) - expf(d2) + LAMBDA_INIT; }
    constexpr int KST = 272, VST = 320, KBYTES = 64 * KST, BUF = KBYTES + 64 * VST;
    const int mp = wave >> 2, qg = wave & 3, r32 = lane & 31, hi = lane >> 5;
    for (int idx = blk; idx < 2048; idx += nblk) {
        const int j = idx & 255, i = idx >> 8, pr = j & 127, half = j >> 7, kq = half * 4 + (i >> 1), qb = (i & 1) ? 15 - kq : kq;
        const int b = pr >> 2, h = pr & 3;
        const size_t rb = (size_t)b * NT;
        const int q0 = qb * 128 + 32 * qg, nT = 2 * qb + 2, myT = 2 * qb + 1 + (qg >> 1);
        bf16x8 qf[4];
        { const bf16_t* qp = Qd + (rb + q0 + r32) * 512 + h * 128 + mp * 64 + 8 * hi;
#pragma unroll
          for (int ks = 0; ks < 4; ++ks) qf[ks] = *(const bf16x8*)(qp + 16 * ks); }
        f32x16 o[4]; float m = -INFINITY, l = 0.f;
#pragma unroll
        for (int db = 0; db < 4; ++db)
#pragma unroll
            for (int r = 0; r < 16; ++r) o[db][r] = 0.f;
        const int key0 = tid >> 4, ch = tid & 15;
        const bf16_t* kg = Kd + (rb + key0) * 512 + h * 128 + ch * 8;
        const bf16_t* vg = Vd + (rb + key0) * 512 + h * 128 + ch * 8;
        const int loff = key0 * KST + ch * 16, loffv = KBYTES + key0 * VST + ch * 16;
        u32x4 sk0 = *(const u32x4*)kg, sk1 = *(const u32x4*)(kg + 32 * 512), sv0 = *(const u32x4*)vg, sv1 = *(const u32x4*)(vg + 32 * 512);
        *(LAS u32x4*)(lds + loff) = sk0; *(LAS u32x4*)(lds + loff + 32 * KST) = sk1;
        *(LAS u32x4*)(lds + loffv) = sv0; *(LAS u32x4*)(lds + loffv + 32 * VST) = sv1;
        if (nT > 1) { const size_t go = (size_t)64 * 512; sk0 = *(const u32x4*)(kg + go); sk1 = *(const u32x4*)(kg + go + 32 * 512); sv0 = *(const u32x4*)(vg + go); sv1 = *(const u32x4*)(vg + go + 32 * 512); }
        __syncthreads();
        for (int t = 0; t < nT; ++t) {
            const bool more = (t + 1 < nT), more2 = (t + 2 < nT);
            u32x4 nk0 = sk0, nk1 = sk1, nv0 = sv0, nv1 = sv1;
            if (more2) {
                const size_t go = (size_t)(t + 2) * 64 * 512;
                nk0 = *(const u32x4*)(kg + go); nk1 = *(const u32x4*)(kg + go + 32 * 512); nv0 = *(const u32x4*)(vg + go); nv1 = *(const u32x4*)(vg + go + 32 * 512);
            }
            if (t < myT) {
                const LAS char* bufp = (const LAS char*)lds + (t & 1) * BUF;
                if (nomax) attn_tile_nm<4, KST, VST, false>(bufp + mp * 128, bufp + KBYTES, o, l, qf, 0u, 0u, lane);
                else attn_tile<4, KST, VST, false>(bufp + mp * 128, bufp + KBYTES, o, m, l, qf, 0u, 0u, lane);
            }
            if (more) {
                LAS unsigned char* nb = lds + ((t + 1) & 1) * BUF;
                *(LAS u32x4*)(nb + loff) = sk0; *(LAS u32x4*)(nb + loff + 32 * KST) = sk1;
                *(LAS u32x4*)(nb + loffv) = sv0; *(LAS u32x4*)(nb + loffv + 32 * VST) = sv1;
            }
            __syncthreads();
            sk0 = nk0; sk1 = nk1; sv0 = nv0; sv1 = nv1;
        }
        if (nomax) l += __shfl_xor(l, 32);
        const float il = 1.f / l;
        LAS float* scr = (LAS float*)lds;
        if (mp == 1) {
#pragma unroll
            for (int db = 0; db < 4; ++db)
#pragma unroll
                for (int r = 0; r < 16; ++r) scr[((qg * 4 + db) * 16 + r) * 64 + lane] = o[db][r] * il;
        }
        __syncthreads();
        if (mp == 0) {
            float ss = 0.f;
#pragma unroll
            for (int db = 0; db < 4; ++db)
#pragma unroll
                for (int r = 0; r < 16; ++r) { const float v = o[db][r] * il - lam * scr[((qg * 4 + db) * 16 + r) * 64 + lane]; o[db][r] = v; ss += v * v; }
            ss += __shfl_xor(ss, 32);
            const float rn = __builtin_amdgcn_rsqf(ss * (1.f / 128.f) + EPS) * (1.f - LAMBDA_INIT);
            const size_t oo = (rb + q0 + r32) * (FUSE56 ? 1024 : 512) + h * 128 + 4 * hi;
            bf16_t* op = OAB + oo; unsigned char* op8 = (unsigned char*)OAB + oo;
            const float rn8 = rn * ASC8;
            f32x4 gall[16];
#pragma unroll
            for (int i = 0; i < 16; ++i) gall[i] = *(const f32x4*)(a.diff_out_g + 32 * (i >> 2) + 8 * (i & 3) + 4 * hi);
#pragma unroll
            for (int db = 0; db < 4; ++db)
#pragma unroll
                for (int r4 = 0; r4 < 4; ++r4) {
                    const int d0 = 32 * db + 8 * r4;
                    const f32x4 g4 = gall[db * 4 + r4];
                    if (BR8 && !F8_BR) { const float q8 = rn * (127.f / OA_MAX); *(unsigned*)(op8 + d0) = pack_i8x4(o[db][4 * r4] * q8 * g4[0], o[db][4 * r4 + 1] * q8 * g4[1], o[db][4 * r4 + 2] * q8 * g4[2], o[db][4 * r4 + 3] * q8 * g4[3]); }
                    else if (F8_BR) { *(unsigned*)(op8 + d0) = pack_fp8x4(o[db][4 * r4] * rn8 * g4[0], o[db][4 * r4 + 1] * rn8 * g4[1], o[db][4 * r4 + 2] * rn8 * g4[2], o[db][4 * r4 + 3] * rn8 * g4[3]); }
                    else {
                    u32x2 w; w.x = pk2(o[db][4 * r4] * rn * g4[0], o[db][4 * r4 + 1] * rn * g4[1]); w.y = pk2(o[db][4 * r4 + 2] * rn * g4[2], o[db][4 * r4 + 3] * rn * g4[3]);
                    *(u32x2*)(op + d0) = w; }
                }
        }
        __syncthreads();
    }
}

DI void ph_diff_attn(const KArgs& a, LAS unsigned char* lds, int tid, int lane, int wave, int blk, int nblk) {
    if (logit_bound(a.diff_q_g, a.diff_k_g, lane) < 64.f) ph_diff_body<true>(a, lds, tid, lane, wave, blk, nblk);
    else ph_diff_body<false>(a, lds, tid, lane, wave, blk, nblk);
}

template <int VARIANT, bool nomax>
DI void ph_dsa_body(const KArgs& a, LAS unsigned char* lds, int tid, int lane, int wave, int blk, int nblk) {
    unsigned char* ws = a.ws;
    const bf16_t* Qs = (const bf16_t*)(ws + WS_QS); const bf16_t* Ks = (const bf16_t*)(ws + WS_KS); const bf16_t* Vs = (const bf16_t*)(ws + WS_VS);
    const unsigned* BM = (const unsigned*)(ws + WS_BM);
    bf16_t* OAB = (bf16_t*)(ws + WS_OAB);
    constexpr int KST = 144, VST = 192, KBYTES = 64 * KST, BUF = KBYTES + 64 * VST;
    const int r32 = lane & 31, hi = lane >> 5;
    for (int idx = blk; idx < 1024; idx += nblk) {
        const int j = idx & 255, i = idx >> 8, b = j >> 3, rr = j & 7, cq = (i & 1) ? 16 * (i >> 1) + 15 - rr : 16 * (i >> 1) + rr;
        const size_t rb = (size_t)b * NT;
        const int q0 = 64 * cq, nT = cq + 1;
        bf16x8 qfA[4], qfB[4];
        const bf16_t* qp = Qs + (rb + q0 + r32) * 512 + wave * 64 + 8 * hi;
        {
#pragma unroll
          for (int ks = 0; ks < 4; ++ks) { qfA[ks] = *(const bf16x8*)(qp + 16 * ks); qfB[ks] = *(const bf16x8*)(qp + 32 * 512 + 16 * ks); } }
        f32x16 oA[2], oB[2]; float mA = -INFINITY, lA = 0.f, mB = -INFINITY, lB = 0.f;
#pragma unroll
        for (int db = 0; db < 2; ++db)
#pragma unroll
            for (int r = 0; r < 16; ++r) { oA[db][r] = 0.f; oB[db][r] = 0.f; }
        const int key0 = tid >> 3, ch = tid & 7;
        const bf16_t* kg = Ks + (rb + key0) * 64 + ch * 8;
        const bf16_t* vg = Vs + (rb + key0) * 64 + ch * 8;
        const int loff = key0 * KST + ch * 16, loffv = KBYTES + key0 * VST + ch * 16;
        const unsigned* bmpA = BM + (rb + q0 + r32) * 64;
        const unsigned* bmpB = bmpA + 32 * 64;
        u32x4 sk0 = *(const u32x4*)kg, sv0 = *(const u32x4*)vg;
        u32x2 mwA = *(const u32x2*)bmpA, mwB = *(const u32x2*)bmpB, mnA = mwA, mnB = mwB;
        *(LAS u32x4*)(lds + loff) = sk0; *(LAS u32x4*)(lds + loffv) = sv0;
        __syncthreads();
        for (int t = 0; t < nT; ++t) {
            const bool more = (t + 1 < nT);
            if (more && !nomax) {
                const size_t go = (size_t)(t + 1) * 64 * 64;
                sk0 = *(const u32x4*)(kg + go); sv0 = *(const u32x4*)(vg + go); mnA = *(const u32x2*)(bmpA + 2 * (t + 1)); mnB = *(const u32x2*)(bmpB + 2 * (t + 1));
            }
            {
                const LAS char* bufp = (const LAS char*)lds + (t & 1) * BUF;
                if (nomax) {
                    attn_tile_nm<2, KST, VST, true>(bufp, bufp + KBYTES, oA, lA, qfA, mwA.x, mwA.y, lane);
                    if (more) { const size_t go = (size_t)(t + 1) * 64 * 64; sk0 = *(const u32x4*)(kg + go); sv0 = *(const u32x4*)(vg + go); mnA = *(const u32x2*)(bmpA + 2 * (t + 1)); mnB = *(const u32x2*)(bmpB + 2 * (t + 1)); }
                    attn_tile_nm<2, KST, VST, true>(bufp, bufp + KBYTES, oB, lB, qfB, mwB.x, mwB.y, lane);
                } else {
                    attn_tile<2, KST, VST, true>(bufp, bufp + KBYTES, oA, mA, lA, qfA, mwA.x, mwA.y, lane);
                    attn_tile<2, KST, VST, true>(bufp, bufp + KBYTES, oB, mB, lB, qfB, mwB.x, mwB.y, lane);
                }
            }
            if (more) {
                LAS unsigned char* nb = lds + ((t + 1) & 1) * BUF;
                *(LAS u32x4*)(nb + loff) = sk0; *(LAS u32x4*)(nb + loffv) = sv0;
                mwA = mnA; mwB = mnB;
            }
            __syncthreads();
        }
        {
            if (nomax) { lA += __shfl_xor(lA, 32); lB += __shfl_xor(lB, 32); }
            float ilA = (F8_BR ? ASC8 : 1.f) / lA, ilB = (F8_BR ? ASC8 : 1.f) / lB;
            if (BR8 && !F8_BR) {
                float mA = 0.f, mB = 0.f;
#pragma unroll
                for (int db = 0; db < 2; ++db)
#pragma unroll
                    for (int r = 0; r < 16; ++r) { mA = fmaxf(mA, fabsf(oA[db][r])); mB = fmaxf(mB, fabsf(oB[db][r])); }
                mA *= ilA; mB *= ilB;
                mA = fmaxf(mA, __shfl_xor(mA, 32)); mB = fmaxf(mB, __shfl_xor(mB, 32));
                LAS float* xm = (LAS float*)lds;
                if (hi == 0) { xm[wave * 64 + r32] = mA; xm[wave * 64 + 32 + r32] = mB; }
                __syncthreads();
                float rA = 1e-20f, rB = 1e-20f;
#pragma unroll
                for (int w8 = 0; w8 < 8; ++w8) { rA = fmaxf(rA, xm[w8 * 64 + r32]); rB = fmaxf(rB, xm[w8 * 64 + 32 + r32]); }
                __syncthreads();
                ilA *= 127.f / rA; ilB *= 127.f / rB;
                if (wave == 0 && hi == 0) { float* obs = (float*)(ws + WS_OBS); obs[rb + q0 + r32] = rA * (1.f / 127.f); obs[rb + q0 + 32 + r32] = rB * (1.f / 127.f); }
            }
            const size_t oo = FUSE56 ? (rb + q0 + r32) * 1024 + 512 + wave * 64 + 4 * hi : (size_t)NTOK * 512 + (rb + q0 + r32) * 512 + wave * 64 + 4 * hi;
            constexpr int OST = FUSE56 ? 1024 : 512;
            bf16_t* op = OAB + oo; unsigned char* op8 = (unsigned char*)OAB + oo;
#pragma unroll
            for (int db = 0; db < 2; ++db)
#pragma unroll
                for (int r4 = 0; r4 < 4; ++r4) {
                    if (BR8 && !F8_BR) {
                        *(unsigned*)(op8 + 32 * db + 8 * r4) = pack_i8x4(oA[db][4 * r4] * ilA, oA[db][4 * r4 + 1] * ilA, oA[db][4 * r4 + 2] * ilA, oA[db][4 * r4 + 3] * ilA);
                        *(unsigned*)(op8 + 32 * OST + 32 * db + 8 * r4) = pack_i8x4(oB[db][4 * r4] * ilB, oB[db][4 * r4 + 1] * ilB, oB[db][4 * r4 + 2] * ilB, oB[db][4 * r4 + 3] * ilB);
                    } else if (F8_BR) {
                        *(unsigned*)(op8 + 32 * db + 8 * r4) = pack_fp8x4(oA[db][4 * r4] * ilA, oA[db][4 * r4 + 1] * ilA, oA[db][4 * r4 + 2] * ilA, oA[db][4 * r4 + 3] * ilA);
                        *(unsigned*)(op8 + 32 * OST + 32 * db + 8 * r4) = pack_fp8x4(oB[db][4 * r4] * ilB, oB[db][4 * r4 + 1] * ilB, oB[db][4 * r4 + 2] * ilB, oB[db][4 * r4 + 3] * ilB);
                    } else {
                    u32x2 w; w.x = pk2(oA[db][4 * r4] * ilA, oA[db][4 * r4 + 1] * ilA); w.y = pk2(oA[db][4 * r4 + 2] * ilA, oA[db][4 * r4 + 3] * ilA);
                    *(u32x2*)(op + 32 * db + 8 * r4) = w;
                    u32x2 w2; w2.x = pk2(oB[db][4 * r4] * ilB, oB[db][4 * r4 + 1] * ilB); w2.y = pk2(oB[db][4 * r4 + 2] * ilB, oB[db][4 * r4 + 3] * ilB);
                    *(u32x2*)(op + 32 * OST + 32 * db + 8 * r4) = w2; }
                }
        }
    }
}

DI void ph_dsa_fallback(const KArgs& a, LAS unsigned char* lds, int tid, int lane, int wave, int blk, int nblk) {
    static_assert(!F8_BR && !BR8, "the fallback writes bf16 o_b");
    unsigned char* ws = a.ws;
    const bf16_t* Qs = (const bf16_t*)(ws + WS_QS); const bf16_t* Ks = (const bf16_t*)(ws + WS_KS); const bf16_t* Vs = (const bf16_t*)(ws + WS_VS);
    const unsigned* BM = (const unsigned*)(ws + WS_BM);
    bf16_t* OAB = (bf16_t*)(ws + WS_OAB);
    constexpr int KST = 144, VST = 192, KBYTES = 64 * KST;
    const int r32 = lane & 31, hi = lane >> 5;
    for (int idx = blk; idx < 1024; idx += nblk) {
        const int j = idx & 255, i = idx >> 8, b = j >> 3, rr = j & 7, cq = (i & 1) ? 16 * (i >> 1) + 15 - rr : 16 * (i >> 1) + rr;
        const size_t rb = (size_t)b * NT;
        const int nT = cq + 1;
        const int key0 = tid >> 3, ch = tid & 7;
        const bf16_t* kg = Ks + (rb + key0) * 64 + ch * 8;
        const bf16_t* vg = Vs + (rb + key0) * 64 + ch * 8;
        const int loff = key0 * KST + ch * 16, loffv = KBYTES + key0 * VST + ch * 16;
#pragma unroll 1
        for (int gs = 0; gs < 2; ++gs) {
            const int q0 = 64 * cq + 32 * gs;
            bf16x8 qf[4];
            { const bf16_t* qp = Qs + (rb + q0 + r32) * 512 + wave * 64 + 8 * hi;
#pragma unroll
              for (int ks = 0; ks < 4; ++ks) qf[ks] = *(const bf16x8*)(qp + 16 * ks); }
            f32x16 o[2]; float m = -INFINITY, l = 0.f;
#pragma unroll
            for (int db = 0; db < 2; ++db)
#pragma unroll
                for (int r = 0; r < 16; ++r) o[db][r] = 0.f;
            const unsigned* bmp = BM + (rb + q0 + r32) * 64;
#pragma unroll 1
            for (int t = 0; t < nT; ++t) {
                __syncthreads();
                { const size_t go = (size_t)t * 64 * 64; const u32x4 k4 = *(const u32x4*)(kg + go), v4 = *(const u32x4*)(vg + go); *(LAS u32x4*)(lds + loff) = k4; *(LAS u32x4*)(lds + loffv) = v4; }
                const u32x2 mw = *(const u32x2*)(bmp + 2 * t);
                __syncthreads();
                attn_tile<2, KST, VST, true, false>((const LAS char*)lds, (const LAS char*)lds + KBYTES, o, m, l, qf, mw.x, mw.y, lane);
            }
            const float il = 1.f / l;
            bf16_t* op = OAB + (FUSE56 ? (rb + q0 + r32) * 1024 + 512 + wave * 64 + 4 * hi : (size_t)NTOK * 512 + (rb + q0 + r32) * 512 + wave * 64 + 4 * hi);
#pragma unroll
            for (int db = 0; db < 2; ++db)
#pragma unroll
                for (int r4 = 0; r4 < 4; ++r4) {
                    u32x2 w; w.x = pk2(o[db][4 * r4] * il, o[db][4 * r4 + 1] * il); w.y = pk2(o[db][4 * r4 + 2] * il, o[db][4 * r4 + 3] * il);
                    *(u32x2*)(op + 32 * db + 8 * r4) = w;
                }
        }
        __syncthreads();
    }
}

template <int VARIANT = 0>
DI void ph_dsa_attn(const KArgs& a, LAS unsigned char* lds, int tid, int lane, int wave, int blk, int nblk) {
    if (logit_bound(a.dsa_q_g, a.dsa_k_g, lane) < 64.f) ph_dsa_body<VARIANT, true>(a, lds, tid, lane, wave, blk, nblk);
    else ph_dsa_fallback(a, lds, tid, lane, wave, blk, nblk);
}

template <bool DO_SEL = true>
DI void ph_indexer(const KArgs& a, LAS unsigned char* lds, int tid, int lane, int wave, int blk, int nblk) {
    unsigned char* ws = a.ws;
    const bf16_t* Qi = (const bf16_t*)(ws + WS_QI); const bf16_t* Ki = (const bf16_t*)(ws + WS_KI); const float* Widx = (const float*)(ws + WS_WIDX);
    unsigned long long* BM = (unsigned long long*)(ws + WS_BM);
    constexpr int SCS = 2052;
    LAS float* sc = (LAS float*)lds;
    const int l15 = lane & 15, l4 = lane >> 4;
    bf16x8 qfr[8][2]; f32x4 w0, w1;
#define IDX_DECODE(idx_, b_, qi_) const int b_ = (idx_) >> 7, qi_ = (((idx_) & 127) + 8 * ((idx_) >> 8)) & 127
#define IDX_LOADQ(idx_) do { IDX_DECODE(idx_, b__, qi__); const bf16_t* qp = Qi + ((size_t)b__ * NT + 16 * qi__ + l15) * 512 + 8 * l4; \
        _Pragma("unroll") for (int h = 0; h < 8; ++h) { qfr[h][0] = *(const bf16x8*)(qp + h * 64); qfr[h][1] = *(const bf16x8*)(qp + h * 64 + 32); } \
        w0 = *(const f32x4*)(Widx + ((size_t)b__ * NT + 16 * qi__ + l15) * 8); w1 = *(const f32x4*)(Widx + ((size_t)b__ * NT + 16 * qi__ + l15) * 8 + 4); } while (0)
    if (blk < 4096) IDX_LOADQ(blk);
    for (int idx = blk; idx < 4096; idx += nblk) {
        IDX_DECODE(idx, b, qi);
        const size_t rb = (size_t)b * NT;
        const int q0 = 16 * qi, chunk = qi >> 2, nj = chunk + 1, nt16 = 4 * nj;
        constexpr float IS = 0.044194173824159216f;
        const float w[8] = {w0[0] * IS, w0[1] * IS, w0[2] * IS, w0[3] * IS, w1[0] * IS, w1[1] * IS, w1[2] * IS, w1[3] * IS};
        {
            int tile = wave;
            const bf16_t* kp = Ki + (rb + 16 * tile + l15) * 64 + 8 * l4;
            bf16x8 ka0 = *(const bf16x8*)kp, ka1 = *(const bf16x8*)(kp + 32);
            for (; tile < nt16; tile += 8) {
                const int ntile = (tile + 8 < nt16) ? tile + 8 : tile;
                const bf16_t* np = Ki + (rb + 16 * ntile + l15) * 64 + 8 * l4;
                const bf16x8 nk0 = *(const bf16x8*)np, nk1 = *(const bf16x8*)(np + 32);
                f32x4 s4 = {0.f, 0.f, 0.f, 0.f};
                f32x4 c[8];
#pragma unroll
                for (int h = 0; h < 8; ++h) { c[h] = (f32x4){0.f, 0.f, 0.f, 0.f}; c[h] = MFMA16(ka0, qfr[h][0], c[h]); c[h] = MFMA16(ka1, qfr[h][1], c[h]); }
                asm volatile("s_nop 11" : "+v"(c[0]), "+v"(c[1]), "+v"(c[2]), "+v"(c[3]), "+v"(c[4]), "+v"(c[5]), "+v"(c[6]), "+v"(c[7]));
#pragma unroll
                for (int h = 0; h < 8; ++h)
#pragma unroll
                    for (int r = 0; r < 4; ++r) { float tr; asm("v_max_f32 %0, 0, %1" : "=v"(tr) : "v"(c[h][r])); s4[r] += tr * w[h]; }
                *(LAS f32x4*)(sc + l15 * SCS + 16 * tile + 4 * l4) = s4;
                ka0 = nk0; ka1 = nk1;
            }
        }
        __syncthreads();
        if (idx + nblk < 4096) IDX_LOADQ(idx + nblk);
        if (DO_SEL) {
            const int qa = 2 * wave, qb = qa + 1;
            unsigned ua[32], ub[32];
#pragma unroll
            for (int jj = 0; jj < 32; ++jj) {
                ua[jj] = 0u; ub[jj] = 0u;
                if (jj < nj) {
                    const float sa = sc[qa * SCS + lane + 64 * jj] + 24.0f, sb = sc[qb * SCS + lane + 64 * jj] + 24.0f;
                    const unsigned ba = __builtin_bit_cast(unsigned, sa), bb = __builtin_bit_cast(unsigned, sb);
                    ua[jj] = (ba & 0x80000000u) ? ~ba : (ba | 0x80000000u); ub[jj] = (bb & 0x80000000u) ? ~bb : (bb | 0x80000000u);
                }
            }
            unsigned long long maska = 0ull, maskb = 0ull;
            if (nj <= 4) { maska = ~0ull; maskb = ~0ull; }
            else {
                unsigned pa = 0u, pb = 0u; bool da = false, db = false;
                int start = 31;
                {
                    unsigned ora = 0u, anda = ~0u, orb = 0u, andb = ~0u;
#pragma unroll
                    for (int jj = 0; jj < 32; ++jj) if (jj < nj) { ora |= ua[jj]; anda &= ua[jj]; orb |= ub[jj]; andb &= ub[jj]; }
#pragma unroll
                    for (int o = 1; o < 64; o <<= 1) { ora |= __shfl_xor(ora, o); anda &= __shfl_xor(anda, o); orb |= __shfl_xor(orb, o); andb &= __shfl_xor(andb, o); }
                    const unsigned dd = __builtin_amdgcn_readfirstlane((ora ^ anda) | (orb ^ andb));
                    start = dd ? 31 - __builtin_clz(dd) : -1;
                    const unsigned keep = (start >= 31) ? 0u : (0xFFFFFFFFu << (start + 1));
                    pa = anda & keep; pb = andb & keep;
                }
#pragma unroll 1
                for (int bit = start; bit >= 0; --bit) {
                    const unsigned ca = da ? pa : (pa | (1u << bit)), cb = db ? pb : (pb | (1u << bit));
                    int cnta = 0, cntb = 0;
                    if (!da && !db) {
#pragma unroll
                        for (int g = 0; g < 8; ++g) if (4 * g < nj) {
#pragma unroll
                            for (int jj = 0; jj < 4; ++jj) { cnta += __popcll(__ballot(ua[4 * g + jj] >= ca)); cntb += __popcll(__ballot(ub[4 * g + jj] >= cb)); }
                        }
                    } else if (!da) {
#pragma unroll
                        for (int g = 0; g < 8; ++g) if (4 * g < nj) {
#pragma unroll
                            for (int jj = 0; jj < 4; ++jj) cnta += __popcll(__ballot(ua[4 * g + jj] >= ca));
                        }
                    } else {
#pragma unroll
                        for (int g = 0; g < 8; ++g) if (4 * g < nj) {
#pragma unroll
                            for (int jj = 0; jj < 4; ++jj) cntb += __popcll(__ballot(ub[4 * g + jj] >= cb));
                        }
                    }
                    if (!da && cnta >= 256) { pa = ca; da = (cnta == 256); }
                    if (!db && cntb >= 256) { pb = cb; db = (cntb == 256); }
                    if (da && db) break;
                }
                if (da && db) {
#pragma unroll
                    for (int g = 0; g < 8; ++g) if (4 * g < nj) {
#pragma unroll
                        for (int jj = 0; jj < 4; ++jj) {
                            const int e = 4 * g + jj;
                            const unsigned long long sa2 = __ballot(ua[e] >= pa), sb2 = __ballot(ub[e] >= pb);
                            if (lane == e) { maska = sa2; maskb = sb2; }
                        }
                    }
                } else {
                int cga = 0, cgb = 0;
#pragma unroll
                for (int g = 0; g < 8; ++g) if (4 * g < nj) {
#pragma unroll
                    for (int jj = 0; jj < 4; ++jj) { cga += __popcll(__ballot(ua[4 * g + jj] > pa)); cgb += __popcll(__ballot(ub[4 * g + jj] > pb)); }
                }
                const int needa = 256 - cga, needb = 256 - cgb; int runa = 0, runb = 0;
                const unsigned long long lt = (1ull << lane) - 1ull;
#pragma unroll
                for (int g = 0; g < 8; ++g) if (4 * g < nj) {
#pragma unroll
                    for (int jj = 0; jj < 4; ++jj) {
                        const int e = 4 * g + jj;
                        { const bool eq = (ua[e] == pa); const unsigned long long em = __ballot(eq); const int rank = runa + __popcll(em & lt);
                          const unsigned long long sb2 = __ballot((ua[e] > pa) || (eq && rank < needa)); if (lane == e) maska = sb2; runa += __popcll(em); }
                        { const bool eq = (ub[e] == pb); const unsigned long long em = __ballot(eq); const int rank = runb + __popcll(em & lt);
                          const unsigned long long sb2 = __ballot((ub[e] > pb) || (eq && rank < needb)); if (lane == e) maskb = sb2; runb += __popcll(em); }
                    }
                }
                }
            }
            if (lane < nj) { BM[(rb + q0 + qa) * 32 + lane] = maska; BM[(rb + q0 + qb) * 32 + lane] = maskb; }
        }
        __syncthreads();
    }
#undef IDX_DECODE
#undef IDX_LOADQ
}
DI int mono_i(float f) { const int i = __builtin_bit_cast(int, f); return i ^ ((i >> 31) & 0x7fffffff); }
DI float mono_f(int i) { return __builtin_bit_cast(float, i ^ ((i >> 31) & 0x7fffffff)); }
constexpr int IMIN = (int)0x80000000;

DI void ce_desc(int& a, int& b) { const int hi = max(a, b), lo = min(a, b); a = hi; b = lo; }
template <int B, bool DESC> DI void bitonic_merge16(int (&x)[64]) {
#pragma unroll
    for (int j = 8; j > 0; j >>= 1)
#pragma unroll
        for (int i = 0; i < 16; ++i) { const int l = i ^ j; if (l > i) { if (DESC) ce_desc(x[B + i], x[B + l]); else ce_desc(x[B + l], x[B + i]); } }
}
template <int B, bool DESC> DI void sort16(int (&x)[64]) {
#define CE_(i_, j_) { if (DESC) ce_desc(x[B + (i_)], x[B + (j_)]); else ce_desc(x[B + (j_)], x[B + (i_)]); }
    CE_(0, 1) CE_(2, 3) CE_(0, 2) CE_(1, 3) CE_(1, 2) CE_(4, 5) CE_(6, 7) CE_(4, 6) CE_(5, 7) CE_(5, 6) CE_(0, 4) CE_(2, 6) CE_(2, 4) CE_(1, 5) CE_(3, 7) CE_(3, 5) CE_(1, 2) CE_(3, 4) CE_(5, 6) CE_(8, 9) CE_(10, 11) CE_(8, 10) CE_(9, 11) CE_(9, 10) CE_(12, 13) CE_(14, 15) CE_(12, 14) CE_(13, 15) CE_(13, 14) CE_(8, 12) CE_(10, 14) CE_(10, 12) CE_(9, 13) CE_(11, 15) CE_(11, 13) CE_(9, 10) CE_(11, 12) CE_(13, 14) CE_(0, 8) CE_(4, 12) CE_(4, 8) CE_(2, 10) CE_(6, 14) CE_(6, 10) CE_(2, 4) CE_(6, 8) CE_(10, 12) CE_(1, 9) CE_(5, 13) CE_(5, 9) CE_(3, 11) CE_(7, 15) CE_(7, 11) CE_(3, 5) CE_(7, 9) CE_(11, 13) CE_(1, 2) CE_(3, 4) CE_(5, 6) CE_(7, 8) CE_(9, 10) CE_(11, 12) CE_(13, 14)
#undef CE_
}
DI void top16_of_64(int (&x)[64]) {
    sort16<0, true>(x); sort16<16, false>(x); sort16<32, true>(x); sort16<48, false>(x);
#pragma unroll
    for (int i = 0; i < 16; ++i) { x[i] = max(x[i], x[16 + i]); x[32 + i] = max(x[32 + i], x[48 + i]); }
    bitonic_merge16<0, true>(x); bitonic_merge16<32, false>(x);
#pragma unroll
    for (int i = 0; i < 16; ++i) x[i] = max(x[i], x[32 + i]);
    bitonic_merge16<0, true>(x);
}

DI void ph_peer_route(const KArgs& a, LAS unsigned char* lds, int tid, int lane, int wave, int blk, int nblk) {
    unsigned char* ws = a.ws;
    const bf16_t* QP = (const bf16_t*)(ws + WS_QP); const bf16_t* SKB = (const bf16_t*)(ws + WS_SKB);
    int* EIDX = (int*)(ws + WS_EIDX); float* GW = (float*)(ws + WS_GW);
    constexpr int SST = 272, SHALF = 128 * SST;
    const int r32 = lane & 31, hi = lane >> 5;
    for (int vb = blk; vb < 256; vb += nblk) {
        const int head = vb & 7, tg = vb >> 3;
        __syncthreads();
        for (int c = tid; c < 4096; c += 512) {
            const int p = c >> 11, key = (c >> 4) & 127, chn = c & 15;
            *(LAS u32x4*)(lds + p * SHALF + key * SST + chn * 16) = *(const u32x4*)(SKB + ((size_t)(head * 2 + p) * 128 + key) * 128 + chn * 8);
        }
        __syncthreads();
        LAS int* Ll = (LAS int*)(lds + 2 * SHALF) + wave * 2048;
        for (int tile = wave; tile < 64; tile += 8) {
            const size_t n0 = (size_t)tg * 2048 + tile * 32;
#pragma unroll 1
            for (int p = 0; p < 2; ++p) {
                int hi4 = 4 * hi; asm volatile("" : "+v"(hi4));
                bf16x8 qf[8];
                { const bf16_t* qp = QP + (n0 + r32) * 2048 + head * 256 + p * 128 + 8 * hi;
#pragma unroll
                  for (int ks = 0; ks < 8; ++ks) qf[ks] = *(const bf16x8*)(qp + 16 * ks); }
                int xi[64];
#pragma unroll
                for (int mt = 0; mt < 4; ++mt) {
                    f32x16 acc;
#pragma unroll
                    for (int r = 0; r < 16; ++r) acc[r] = 0.f;
                    const LAS char* ka = (const LAS char*)lds + p * SHALF + (32 * mt + r32) * SST + hi * 16;
#pragma unroll
                    for (int ks = 0; ks < 8; ++ks) acc = MFMA32(*(const LAS bf16x8*)(ka + ks * 32), qf[ks], acc);
#pragma unroll
                    for (int r = 0; r < 16; ++r) xi[mt * 16 + r] = ((mono_i(acc[r]) & ~127) | hi4) | (32 * mt + (r & 3) + 8 * (r >> 2));
                }
                top16_of_64(xi);
                {
                    int pr[16];
#pragma unroll
                    for (int i = 0; i < 16; ++i) pr[i] = __shfl_xor(xi[15 - i], 32);
#pragma unroll
                    for (int i = 0; i < 16; ++i) xi[i] = max(xi[i], pr[i]);
                    bitonic_merge16<0, true>(xi);
                }
#pragma unroll
                for (int it = 0; it < 16; ++it) Ll[(p * 16 + it) * 64 + lane] = xi[it];
            }
            int cs[64];
            {
                int l0[16], l1[16];
#pragma unroll
                for (int k = 0; k < 16; ++k) { l0[k] = Ll[k * 64 + lane]; l1[k] = Ll[(16 + k) * 64 + lane]; }
                int nc = 0;
#pragma unroll
                for (int ra = 0; ra < 16; ++ra)
#pragma unroll
                    for (int rb2 = 0; rb2 < 16; ++rb2)
                        if ((ra + 1) * (rb2 + 1) <= 16) {
                            const float s = mono_f(l0[ra] & ~127) + mono_f(l1[rb2] & ~127);
                            cs[nc] = (mono_i(s) & ~255) | (255 - (ra * 16 + rb2)); ++nc;
                        }
#pragma unroll
                for (int k = 50; k < 64; ++k) cs[k] = IMIN;
            }
            top16_of_64(cs);
            float sv[16]; int se[16];
#pragma unroll
            for (int it = 0; it < 16; ++it) {
                const int flat = 255 - (cs[it] & 255);
                se[it] = (Ll[(flat >> 4) * 64 + lane] & 127) * 128 + (Ll[(16 + (flat & 15)) * 64 + lane] & 127);
                sv[it] = mono_f(cs[it] & ~255);
            }
            const float smax = sv[0];
            float sum = 0.f;
#pragma unroll
            for (int it = 0; it < 16; ++it) { sv[it] = __expf(sv[it] - smax); sum += sv[it]; }
            const float inv = 1.f / sum;
            if (hi == 0) {
                unsigned short* ep = (unsigned short*)EIDX + (n0 + r32) * 128 + head * 16;
                _Float16* gp = (_Float16*)GW + (n0 + r32) * 128 + head * 16;
#pragma unroll
                for (int k = 0; k < 4; ++k) {
                    *(u32x2*)(ep + 4 * k) = (u32x2){(unsigned)se[4 * k] | ((unsigned)se[4 * k + 1] << 16), (unsigned)se[4 * k + 2] | ((unsigned)se[4 * k + 3] << 16)};
                    *(h16x4*)(gp + 4 * k) = (h16x4){(_Float16)(sv[4 * k] * inv), (_Float16)(sv[4 * k + 1] * inv), (_Float16)(sv[4 * k + 2] * inv), (_Float16)(sv[4 * k + 3] * inv)};
                }
            }
        }
    }
}

DI int dot4z(int a, int b) { int r; asm("v_dot4_i32_i8 %0, %1, %2, 0" : "=v"(r) : "v"(a), "v"(b)); return r; }
DI f32x2 fp8lo(unsigned w) { return __builtin_amdgcn_cvt_pk_f32_fp8((int)w, false); }
DI f32x2 fp8hi(unsigned w) { return __builtin_amdgcn_cvt_pk_f32_fp8((int)w, true); }
constexpr int PEER_CH = 8, PEER_NCH = NTOK / PEER_CH;
constexpr size_t SLICE_BYTES = (size_t)16384 * 128;

template <int STEP>
DI void peer_issue(const unsigned char* tb, unsigned lo16, const LAS int* et, int g, u32x4 (&tv)[16], u32x4 (&hx)[2], f32x4& xr, const unsigned char* hrow, const float* xrow, const float* hsp = nullptr) {
#pragma unroll
    for (int it = 0; it < 16; ++it) tv[it] = *(const u32x4*)(tb + ((unsigned)et[8 * it + g] + lo16));
    if (STEP == 0) { hx[0] = *(const u32x4*)hrow; if (U4) hx[1] = *(const u32x4*)(hrow + (UD8 ? (WS_HB4 - WS_HA4) : 16)); xr.x = *hsp; }
    else if (V4) xr = *(const f32x4*)xrow;
    else { const f32x2 t2 = *(const f32x2*)xrow; xr.x = t2.x; xr.y = t2.y; }
    __builtin_amdgcn_sched_barrier(0);
}

template <int STEP, bool HALFROW = false>
DI void ph_peer_slices(const KArgs& a, LAS unsigned char* lds, int lane, int wave, unsigned xcc) {
    unsigned char* ws = a.ws;
    const unsigned char* H8 = ws + WS_H8; const float* HS = (const float*)(ws + WS_HS); const unsigned char* U8 = ws + WS_UB; const unsigned char* V8 = ws + WS_VB;
    const float usc = __builtin_bit_cast(float, ((const unsigned*)(ws + WS_CTL))[CW_UMAX]) * (U4 ? (UD8 ? U4_STEP : U4_STEP * (1.f / 16.f)) : 1.f / 127.f);
    constexpr bool UQ = (STEP == 0) && U4, VQ = (STEP == 2) && V4, Q4 = UQ || VQ;
    const unsigned short* EIDX = (const unsigned short*)(ws + WS_EIDX); const float* mod = (const float*)(ws + WS_MOD);
    _Float16* PART = (_Float16*)(ws + WS_PART); const _Float16* W = (const _Float16*)(ws + WS_WGT);
    unsigned* ctr = (unsigned*)(ws + WS_CTL) + 8192 + (STEP ? 1024 : 0);
    float* out = a.out;
    LAS int* e_l = (LAS int*)(lds + wave * 16896);
    LAS _Float16* w_l = (LAS _Float16*)(e_l + 1024);
    LAS float* a_l = (LAS float*)(e_l + 2048);
    LAS float* red = a_l + 128;
    const int g = lane >> 3, s8 = lane & 7;
    for (int ds = 0; ds < (Q4 ? 4 : 8); ++ds) {
        const int s = (int)((xcc + ds) & (Q4 ? 3u : 7u));
        const unsigned char* tb = (STEP ? V8 : U8) + (size_t)s * SLICE_BYTES;
        const unsigned lo16 = (unsigned)(HALFROW ? (s8 & 3) : s8) * 16u;
        unsigned cn = 0;
        if (lane == 0) cn = __hip_atomic_fetch_add(ctr + 64 * s, 1u, __ATOMIC_RELAXED, __HIP_MEMORY_SCOPE_AGENT);
        cn = __builtin_amdgcn_readfirstlane(cn);
        u32x2 pe[4], pw[4];
        if (cn < (unsigned)PEER_NCH) {
#pragma unroll
            for (int q = 0; q < 4; ++q) { pe[q] = *(const u32x2*)(EIDX + (size_t)cn * PEER_CH * 128 + lane * 4 + 256 * q); if (STEP) pw[q] = *(const u32x2*)(W + (size_t)cn * PEER_CH * 128 + lane * 4 + 256 * q); }
        }
        for (;;) {
            const unsigned c = cn;
            if (c >= (unsigned)PEER_NCH) break;
#pragma unroll
            for (int q = 0; q < 4; ++q) { *(LAS u32x4*)(e_l + lane * 4 + 256 * q) = (u32x4){(pe[q].x & 0xffffu) << 7, (pe[q].x >> 16) << 7, (pe[q].y & 0xffffu) << 7, (pe[q].y >> 16) << 7}; if (STEP) *(LAS u32x2*)(w_l + lane * 4 + 256 * q) = pw[q]; }
            if (lane == 0) cn = __hip_atomic_fetch_add(ctr + 64 * s, 1u, __ATOMIC_RELAXED, __HIP_MEMORY_SCOPE_AGENT);
            cn = __builtin_amdgcn_readfirstlane(cn);
            if (cn < (unsigned)PEER_NCH) {
#pragma unroll
                for (int q = 0; q < 4; ++q) { pe[q] = *(const u32x2*)(EIDX + (size_t)cn * PEER_CH * 128 + lane * 4 + 256 * q); if (STEP) pw[q] = *(const u32x2*)(W + (size_t)cn * PEER_CH * 128 + lane * 4 + 256 * q); }
            }
            LDS_WAIT();
            const int n0 = (int)c * PEER_CH;
            const int b = n0 / NT;
            f32x2 gv2 = {0.f, 0.f}; f32x4 gv4 = {0.f, 0.f, 0.f, 0.f};
            if (VQ) gv4 = *(const f32x4*)(mod + (size_t)b * 6144 + 5120 + s * 256 + 4 * lane) * (1.f / V4_WSC);
            else if (STEP) gv2 = *(const f32x2*)(mod + (size_t)b * 6144 + 5120 + s * 128 + 2 * lane);
            u32x4 tvA[16], tvB[16], hA[2], hB[2]; f32x4 xA = {0.f, 0.f, 0.f, 0.f}, xB = {0.f, 0.f, 0.f, 0.f};
#define PEER_HROW(t) ((UQ && UD8) ? (ws + WS_HA4 + (size_t)(n0 + (t)) * 512 + s * 128 + s8 * 16) : (H8 + (size_t)(n0 + (t)) * 1024 + s * (UQ ? 256 : 128) + s8 * (UQ ? 32 : 16)))
#define PEER_XROW(t) (out + (size_t)(n0 + (t)) * 1024 + (VQ ? s * 256 + 4 * lane : s * 128 + 2 * lane))
#define PEER_COMPUTE(t, tv, hx, xr) do { \
            if (UQ) { \
                LAS int* redi = (LAS int*)red; \
                if (UD8) { \
                _Pragma("unroll") for (int it = 0; it < 16; ++it) {     \
                    int da = __builtin_amdgcn_sdot8((int)tv[it].x, (int)hx[0].x, 0, false), db = __builtin_amdgcn_sdot8((int)tv[it].x, (int)hx[1].x, 0, false); \
                    da = __builtin_amdgcn_sdot8((int)tv[it].y, (int)hx[0].y, da, false); db = __builtin_amdgcn_sdot8((int)tv[it].y, (int)hx[1].y, db, false); \
                    da = __builtin_amdgcn_sdot8((int)tv[it].z, (int)hx[0].z, da, false); db = __builtin_amdgcn_sdot8((int)tv[it].z, (int)hx[1].z, db, false); \
                    da = __builtin_amdgcn_sdot8((int)tv[it].w, (int)hx[0].w, da, false); db = __builtin_amdgcn_sdot8((int)tv[it].w, (int)hx[1].w, db, false); \
                    redi[it * 64 + lane] = 16 * da + db; \
                } \
                } else \
                _Pragma("unroll") for (int it = 0; it < 16; ++it) { \
                    int d0 = dot4z((int)((tv[it].x << 4) & 0xF0F0F0F0u), (int)hx[0].x), d1 = dot4z((int)((tv[it].y << 4) & 0xF0F0F0F0u), (int)hx[0].y); \
                    d0 = __builtin_amdgcn_sdot4((int)((tv[it].z << 4) & 0xF0F0F0F0u), (int)hx[0].z, d0, false); d1 = __builtin_amdgcn_sdot4((int)((tv[it].w << 4) & 0xF0F0F0F0u), (int)hx[0].w, d1, false); \
                    d0 = __builtin_amdgcn_sdot4((int)(tv[it].x & 0xF0F0F0F0u), (int)hx[1].x, d0, false); d1 = __builtin_amdgcn_sdot4((int)(tv[it].y & 0xF0F0F0F0u), (int)hx[1].y, d1, false); \
                    d0 = __builtin_amdgcn_sdot4((int)(tv[it].z & 0xF0F0F0F0u), (int)hx[1].z, d0, false); d1 = __builtin_amdgcn_sdot4((int)(tv[it].w & 0xF0F0F0F0u), (int)hx[1].w, d1, false); \
                    redi[it * 64 + lane] = d0 + d1;                      \
                } \
                LDS_WAIT(); \
                _Float16* pp = PART + ((size_t)s * NTOK + n0 + (t)) * 128; \
                { typedef int i32x4 __attribute__((ext_vector_type(4))); \
                  const i32x4 r0 = *(const LAS i32x4*)(redi + 8 * lane), r1 = *(const LAS i32x4*)(redi + 8 * lane + 4), r2 = *(const LAS i32x4*)(redi + 512 + 8 * lane), r3 = *(const LAS i32x4*)(redi + 512 + 8 * lane + 4); \
                  const float sc_ = xr.x * usc; \
                  pp[lane] = (_Float16)((float)(((r0[0] + r0[1]) + (r0[2] + r0[3])) + ((r1[0] + r1[1]) + (r1[2] + r1[3]))) * sc_); \
                  pp[64 + lane] = (_Float16)((float)(((r2[0] + r2[1]) + (r2[2] + r2[3])) + ((r3[0] + r3[1]) + (r3[2] + r3[3]))) * sc_); } \
                LDS_WAIT(); \
            } else if (STEP == 0) { \
                LAS int* redi = (LAS int*)red; \
                _Pragma("unroll") for (int it = 0; it < 16; ++it) { \
                    int d0 = dot4z((int)tv[it].x, (int)hx[0].x), d1 = dot4z((int)tv[it].y, (int)hx[0].y);        \
                    d0 = __builtin_amdgcn_sdot4((int)tv[it].z, (int)hx[0].z, d0, false); d1 = __builtin_amdgcn_sdot4((int)tv[it].w, (int)hx[0].w, d1, false); \
                    redi[it * 64 + lane] = d0 + d1;                      \
                } \
                LDS_WAIT(); \
                _Float16* pp = PART + ((size_t)s * NTOK + n0 + (t)) * 128; \
                { typedef int i32x4 __attribute__((ext_vector_type(4))); \
                  const i32x4 r0 = *(const LAS i32x4*)(redi + 8 * lane), r1 = *(const LAS i32x4*)(redi + 8 * lane + 4), r2 = *(const LAS i32x4*)(redi + 512 + 8 * lane), r3 = *(const LAS i32x4*)(redi + 512 + 8 * lane + 4); \
                  const float sc_ = xr.x * usc; \
                  pp[lane] = (_Float16)((float)(((r0[0] + r0[1]) + (r0[2] + r0[3])) + ((r1[0] + r1[1]) + (r1[2] + r1[3]))) * sc_); \
                  pp[64 + lane] = (_Float16)((float)(((r2[0] + r2[1]) + (r2[2] + r2[3])) + ((r3[0] + r3[1]) + (r3[2] + r3[3]))) * sc_); } \
                LDS_WAIT(); \
            } else if (VQ) { \
                h16x2 acc[16]; \
                _Pragma("unroll") for (int k = 0; k < 16; ++k) acc[k] = (h16x2){(_Float16)0.f, (_Float16)0.f}; \
                _Pragma("unroll") for (int it = 0; it < 16; ++it) { \
                    const _Float16 wh = w_l[(t) * 128 + 8 * it + g]; const h16x2 w2 = {wh, wh}; \
                    _Pragma("unroll") for (int k = 0; k < 4; ++k) { \
                        acc[4 * k] += __builtin_amdgcn_cvt_scalef32_pk_f16_fp4(tv[it][k], 1.0f, 0) * w2; acc[4 * k + 1] += __builtin_amdgcn_cvt_scalef32_pk_f16_fp4(tv[it][k], 1.0f, 1) * w2; \
                        acc[4 * k + 2] += __builtin_amdgcn_cvt_scalef32_pk_f16_fp4(tv[it][k], 1.0f, 2) * w2; acc[4 * k + 3] += __builtin_amdgcn_cvt_scalef32_pk_f16_fp4(tv[it][k], 1.0f, 3) * w2; } \
                } \
                LAS _Float16* redh = (LAS _Float16*)red;                  \
                LAS h16x8* rp = (LAS h16x8*)(redh + g * 256 + s8 * 32); \
                _Pragma("unroll") for (int i = 0; i < 4; ++i) rp[i] = (h16x8){acc[4 * i].x, acc[4 * i].y, acc[4 * i + 1].x, acc[4 * i + 1].y, acc[4 * i + 2].x, acc[4 * i + 2].y, acc[4 * i + 3].x, acc[4 * i + 3].y}; \
                LDS_WAIT(); \
                f32x4 sum = {0.f, 0.f, 0.f, 0.f}; \
                _Pragma("unroll") for (int q = 0; q < 8; ++q) { const h16x4 p4 = *(const LAS h16x4*)(redh + q * 256 + 4 * lane); sum += (f32x4){(float)p4.x, (float)p4.y, (float)p4.z, (float)p4.w}; } \
                *(f32x4*)(out + (size_t)(n0 + (t)) * 1024 + s * 256 + 4 * lane) = xr + gv4 * sum; \
                LDS_WAIT(); \
            } else { \
                f32x2 acc[8]; \
                _Pragma("unroll") for (int k = 0; k < 8; ++k) acc[k] = (f32x2){0.f, 0.f}; \
                _Pragma("unroll") for (int it = 0; it < 16; ++it) { \
                    const float w = (float)w_l[(t) * 128 + 8 * it + g]; \
                    acc[0] += fp8lo(tv[it].x) * w; acc[1] += fp8hi(tv[it].x) * w; acc[2] += fp8lo(tv[it].y) * w; acc[3] += fp8hi(tv[it].y) * w; \
                    acc[4] += fp8lo(tv[it].z) * w; acc[5] += fp8hi(tv[it].z) * w; acc[6] += fp8lo(tv[it].w) * w; acc[7] += fp8hi(tv[it].w) * w; \
                } \
                LAS f32x4* rp = (LAS f32x4*)(red + g * 128 + s8 * 16); \
                rp[0] = (f32x4){acc[0].x, acc[0].y, acc[1].x, acc[1].y}; rp[1] = (f32x4){acc[2].x, acc[2].y, acc[3].x, acc[3].y}; \
                rp[2] = (f32x4){acc[4].x, acc[4].y, acc[5].x, acc[5].y}; rp[3] = (f32x4){acc[6].x, acc[6].y, acc[7].x, acc[7].y}; \
                LDS_WAIT(); \
                f32x2 sum = {0.f, 0.f}; \
                _Pragma("unroll") for (int q = 0; q < 8; ++q) sum += *(const LAS f32x2*)(red + q * 128 + 2 * lane); \
                *(f32x2*)(out + (size_t)(n0 + (t)) * 1024 + s * 128 + 2 * lane) = (f32x2){xr.x, xr.y} + gv2 * sum; \
                LDS_WAIT(); \
            } \
            __builtin_amdgcn_sched_barrier(0); } while (0)
            peer_issue<STEP>(tb, lo16, e_l, g, tvA, hA, xA, PEER_HROW(0), PEER_XROW(0), HS + n0);
#pragma unroll 1
            for (int t = 0; t < PEER_CH - 2; t += 2) {
                peer_issue<STEP>(tb, lo16, e_l + (t + 1) * 128, g, tvB, hB, xB, PEER_HROW(t + 1), PEER_XROW(t + 1), HS + n0 + t + 1);
                PEER_COMPUTE(t, tvA, hA, xA);
                peer_issue<STEP>(tb, lo16, e_l + (t + 2) * 128, g, tvA, hA, xA, PEER_HROW(t + 2), PEER_XROW(t + 2), HS + n0 + t + 2);
                PEER_COMPUTE(t + 1, tvB, hB, xB);
            }
            peer_issue<STEP>(tb, lo16, e_l + (PEER_CH - 1) * 128, g, tvB, hB, xB, PEER_HROW(PEER_CH - 1), PEER_XROW(PEER_CH - 1), HS + n0 + PEER_CH - 1);
            PEER_COMPUTE(PEER_CH - 2, tvA, hA, xA);
            PEER_COMPUTE(PEER_CH - 1, tvB, hB, xB);
#undef PEER_HROW
#undef PEER_XROW
#undef PEER_COMPUTE
        }
    }
}

DI void ph_peer_combine(const KArgs& a, int tid, int blk, int nblk) {
    unsigned char* ws = a.ws;
    const _Float16* PART = (const _Float16*)(ws + WS_PART); const float* GW = (const float*)(ws + WS_GW); _Float16* W = (_Float16*)(ws + WS_WGT);
    const size_t total = (size_t)NTOK * 128 / 4;
    const float vsc = V4 ? __builtin_bit_cast(float, ((const unsigned*)(ws + WS_CTL))[CW_VMAX]) * (V4_S * V4_WSC) : 1.f / VSCALE;
    constexpr int NS = U4 ? 4 : 8;
    h16x4 pn[NS]; h16x4 gn = {(_Float16)0.f, (_Float16)0.f, (_Float16)0.f, (_Float16)0.f};
    const size_t i0 = (size_t)blk * 512 + tid, st = (size_t)nblk * 512;
    if (i0 < total) {
#pragma unroll
        for (int k = 0; k < NS; ++k) pn[k] = *(const h16x4*)(PART + (size_t)k * NTOK * 128 + 4 * i0);
        gn = *(const h16x4*)((const _Float16*)GW + 4 * i0);
    }
    for (size_t i = i0; i < total; i += st) {
        f32x4 s = {0.f, 0.f, 0.f, 0.f};
#pragma unroll
        for (int k = 0; k < NS; ++k) s += (f32x4){(float)pn[k].x, (float)pn[k].y, (float)pn[k].z, (float)pn[k].w};
        const f32x4 gq = {(float)gn.x, (float)gn.y, (float)gn.z, (float)gn.w};
        if (i + st < total) {
#pragma unroll
            for (int k = 0; k < NS; ++k) pn[k] = *(const h16x4*)(PART + (size_t)k * NTOK * 128 + 4 * (i + st));
            gn = *(const h16x4*)((const _Float16*)GW + 4 * (i + st));
        }
        f32x4 r;
#pragma unroll
        for (int k = 0; k < 4; ++k) r[k] = gq[k] * 0.5f * s[k] * (1.f + erff(s[k] * 0.70710678118654752f)) * vsc;
        *(h16x4*)(W + 4 * i) = (h16x4){(_Float16)r[0], (_Float16)r[1], (_Float16)r[2], (_Float16)r[3]};
    }
}
#ifndef MK_ONE_LAUNCH
#define MK_ONE_LAUNCH 1
#endif
constexpr int N_PHASES = 12;
#ifndef MK_DUP
#define MK_DUP 0
#endif
#ifndef MK_PREFIX
#define MK_PREFIX -1
#endif
#define PROGRAM() \
    if (IN(0)) { LAUNDER ph_prologue(a, lds, tid, lane, wave, blk, nblk); } \
    SEAM(0); \
    if (IN(1)) { LAUNDER { const float um = __builtin_bit_cast(float, ((const unsigned*)(ws + WS_CTL))[CW_UMAX]); if (U4) conv_u_i4(a.peer_u, ws + WS_UB, 1.f / (U4_STEP * fmaxf(um, 1e-30f)), (size_t)blk * 512 + tid, (size_t)nblk * 512); else conv_u_i8(a.peer_u, ws + WS_UB, 127.f / fmaxf(um, 1e-30f), (size_t)blk * 512 + tid, (size_t)nblk * 512); } if (V4) { const float vm = __builtin_bit_cast(float, ((const unsigned*)(ws + WS_CTL))[CW_VMAX]); conv_v_fp4(a.peer_v, ws + WS_VB, 1.f / (V4_S * fmaxf(vm, 1e-30f)), (size_t)blk * 512 + tid, (size_t)nblk * 512); } ph_weights8(a, lds, lane, wave, blk, nblk); ph_norm<(N8_IN > 0 && IN_MODE == 2), (NB_IN > 0), (N8_IN > 0 && IN_MODE == 1)>(a.x, a.norm1_g, mod, 0, 1024, (bf16_t*)(ws + WS_H), ws + WS_HF8, ws + WS_HF8, (float*)(ws + WS_HS1), lane, wave, blk, nblk); } \
    SEAM(1); \
    if (IN(2)) { LAUNDER \
        if (N8_IN > 0) { \
            pg8::Gemm g{(const bf16_t*)(ws + WS_HF8), (const bf16_t*)(ws + WS_WIN8), NTOK, N8_IN * 256, 512}; \
            pg8::StaticOrder S; S.init(NTOK, N8_IN * 256, nblk, blk); \
            EpiProjT<IN_MODE> E{(bf16_t*)(ws + WS_QD), (bf16_t*)(ws + WS_KD), (bf16_t*)(ws + WS_VD), (bf16_t*)(ws + WS_QS), (bf16_t*)(ws + WS_QI), (bf16_t*)(ws + WS_KS), (bf16_t*)(ws + WS_VS), \
                      (bf16_t*)(ws + WS_KI), (bf16_t*)(ws + WS_G0), (bf16_t*)(ws + WS_G1), (float*)(ws + WS_WIDX), (const float*)(ws + WS_COS), (const float*)(ws + WS_SIN), \
                      a.diff_q_g, a.diff_k_g, a.dsa_q_g, a.dsa_k_g, (const unsigned*)(ws + WS_CTL) + CW_WMAX + 32 * 0, (const float*)(ws + WS_HS1)}; \
            pg8::gemm_phase<EpiProjT<IN_MODE>, pg8::StaticOrder, true, true, IN_MODE>(lds, g, S, E); \
        } \
        if (NB_IN > 0) { \
            pg8::Gemm g{(const bf16_t*)(ws + WS_H), (const bf16_t*)(ws + WS_WIN), NTOK, NB_IN * 256, 1024}; \
            pg8::StaticOrder S; S.init(NTOK, NB_IN * 256, nblk, blk); \
            EpiProjT<0> E{(bf16_t*)(ws + WS_QD), (bf16_t*)(ws + WS_KD), (bf16_t*)(ws + WS_VD), (bf16_t*)(ws + WS_QS), (bf16_t*)(ws + WS_QI), (bf16_t*)(ws + WS_KS), (bf16_t*)(ws + WS_VS), \
                      (bf16_t*)(ws + WS_KI), (bf16_t*)(ws + WS_G0), (bf16_t*)(ws + WS_G1), (float*)(ws + WS_WIDX), (const float*)(ws + WS_COS), (const float*)(ws + WS_SIN), \
                      a.diff_q_g, a.diff_k_g, a.dsa_q_g, a.dsa_k_g, nullptr, nullptr}; \
            pg8::gemm_phase<EpiProjT<0>, pg8::StaticOrder, true, true, 0>(lds, g, S, E); \
        } \
    } \
    SEAM(2); \
    if (IN(3)) { LAUNDER ph_indexer(a, lds, tid, lane, wave, blk, nblk); if (MK_DUP == 30) ph_indexer(a, lds, tid, lane, wave, blk, nblk); if (MK_DUP == 31) ph_indexer<false>(a, lds, tid, lane, wave, blk, nblk); ph_diff_attn(a, lds, tid, lane, wave, blk, nblk); } \
    SEAM(3); \
    if (IN(4)) { LAUNDER if (MK_DUP == 41) ph_dsa_attn<1>(a, lds, tid, lane, wave, blk, nblk); if (MK_DUP == 42) ph_dsa_attn<2>(a, lds, tid, lane, wave, blk, nblk); ph_dsa_attn<0>(a, lds, tid, lane, wave, blk, nblk); } \
    SEAM(4); \
    if (IN(5) && FUSE56) { LAUNDER \
        pg8::Gemm g{(const bf16_t*)(ws + WS_OAB), (const bf16_t*)(ws + WS_WBA), NTOK, 1024, 1024}; \
        pg8::StaticOrder S; S.init(NTOK, 1024, nblk, blk); \
        EpiMerged E{ws + WS_G0, ws + WS_G1, (bf16_t*)(ws + WS_MERGED), ws + WS_MERGED8}; \
        pg8::gemm_phase<EpiMerged, pg8::StaticOrder, true, true, 0>(lds, g, S, E); \
    } \
    if (IN(5) && !FUSE56) { LAUNDER \
        pg8::Gemm g{(const bf16_t*)(ws + WS_OAB), (const bf16_t*)(ws + WS_WBA), NTOK, 1024, (F8_BR || BR8) ? 256 : 512}; \
        pg8::StaticOrder S; S.init(NTOK, 1024, nblk, blk); \
        EpiGate<0> E{(const bf16_t*)(ws + WS_G0), (bf16_t*)(ws + WS_MERGED), (const unsigned*)(ws + WS_CTL) + CW_WMAX + 32 * 1, nullptr, nullptr}; \
        pg8::gemm_phase<EpiGate<0>, pg8::StaticOrder, true, true, F8_BR ? 1 : BR8 ? 2 : 0>(lds, g, S, E); \
    } \
    SEAM(5); \
    if (IN(6) && !FUSE56) { LAUNDER \
        pg8::Gemm g{(const bf16_t*)(ws + WS_OAB + (size_t)NTOK * 512 * ((F8_BR || BR8) ? 1 : 2)), (const bf16_t*)(ws + WS_WBB), NTOK, 1024, (F8_BR || BR8) ? 256 : 512}; \
        pg8::StaticOrder S; S.init(NTOK, 1024, nblk, blk); \
        EpiGate<1> E{(const bf16_t*)(ws + WS_G1), (bf16_t*)(ws + WS_MERGED), (const unsigned*)(ws + WS_CTL) + CW_WMAX + 32 * 2, ws + WS_MERGED8, (const float*)(ws + WS_OBS)}; \
        pg8::gemm_phase<EpiGate<1>, pg8::StaticOrder, true, true, F8_BR ? 1 : BR8 ? 2 : 0>(lds, g, S, E); \
    } \
    SEAM(6); \
    if (IN(7)) { LAUNDER \
        pg8::Gemm g{(const bf16_t*)(ws + ((F8_BR || F8_OUT) ? WS_MERGED8 : WS_MERGED)), (const bf16_t*)(ws + WS_WOUT), NTOK, 1024, (F8_BR || F8_OUT) ? 512 : 1024}; \
        pg8::StaticOrder S; S.init(NTOK, 1024, nblk, blk); \
        EpiResid E{a.x, mod, a.out, (F8_BR || F8_OUT) ? 1.f / (ASC8 * wscale8(ws, 3)) : 1.f}; \
        pg8::gemm_phase<EpiResid, pg8::StaticOrder, true, true, (F8_BR || F8_OUT) ? 1 : 0>(lds, g, S, E); \
    } \
    SEAM(7); \
    if (IN(8)) { LAUNDER ph_norm<true, PQ_MODE == 0, PQ_MODE == 1, UD8>(a.out, a.norm2_g, mod, 3072, 4096, (bf16_t*)(ws + WS_H), ws + WS_H, ws + WS_H8, (float*)(ws + WS_HS), lane, wave, blk, nblk, ws + WS_HA4, ws + WS_HB4); } \
    SEAM(8); \
    if (IN(9)) { LAUNDER \
        pg8::Gemm g{(const bf16_t*)(ws + (PQ_MODE == 2 ? WS_H8 : WS_H)), (const bf16_t*)(ws + WS_WPQ), NTOK, 2048, PQ_MODE ? 512 : 1024}; \
        pg8::StaticOrder S; S.init(NTOK, 2048, nblk, blk); \
        if (PQ_MODE == 2) { EpiPlainI8 E{(bf16_t*)(ws + WS_QP), 2048, (const float*)(ws + WS_HS), (const unsigned*)(ws + WS_CTL) + CW_WMAX + 32 * 4}; pg8::gemm_phase<EpiPlainI8, pg8::StaticOrder, true, true, 2>(lds, g, S, E); } \
        else { EpiPlain E{(bf16_t*)(ws + WS_QP), 2048, F8_PQ ? 1.f / (ASC8 * wscale8(ws, 4)) : 1.f}; pg8::gemm_phase<EpiPlain, pg8::StaticOrder, true, true, (PQ_MODE == 1 ? 1 : 0)>(lds, g, S, E); } \
    } \
    SEAM(9); \
    if (IN(10)) { LAUNDER ph_peer_route(a, lds, tid, lane, wave, blk, nblk); } \
    SEAM(10); \
    if (IN(11)) { LAUNDER if (MK_DUP == 111 || MK_DUP == 112) { if (MK_DUP == 111) ph_peer_slices<0, true>(a, lds, lane, wave, xbar.x); else ph_peer_slices<0, false>(a, lds, lane, wave, xbar.x); xcd_barrier(xbar); if (tid == 0 && blk == 0) { for (int q = 0; q < 8; ++q) ((unsigned*)(ws + WS_CTL))[8192 + 64 * q] = 0u; } xcd_barrier(xbar); } ph_peer_slices<0>(a, lds, lane, wave, xbar.x); xcd_barrier(xbar); if (MK_DUP == 110) { if (tid == 0 && blk == 0) { for (int q = 0; q < 8; ++q) ((unsigned*)(ws + WS_CTL))[8192 + 64 * q] = 0u; } xcd_barrier(xbar); ph_peer_slices<0>(a, lds, lane, wave, xbar.x); xcd_barrier(xbar); } ph_peer_combine(a, tid, blk, nblk); xcd_barrier(xbar); ph_peer_slices<2>(a, lds, lane, wave, xbar.x); }
__global__ void __launch_bounds__(512, 2) mk_fwd(KArgs a) {
    extern __shared__ __attribute__((aligned(16))) unsigned char lds_raw[];
    LAS unsigned char* lds = (LAS unsigned char*)lds_raw;
    const int tid0 = threadIdx.x, wave = __builtin_amdgcn_readfirstlane(tid0 >> 6);
    const int blk = blockIdx.x, nblk = gridDim.x;
    unsigned char* ws = a.ws;
    int lo = a.ph_lo, hi = a.ph_hi;
    volatile LAS unsigned* xst = (volatile LAS unsigned*)(lds + LDS_BYTES - 64);
    if (tid0 < 2) xst[tid0] = 0u;
    __syncthreads();
    XcdBarrier xbar = xcd_barrier_post((unsigned*)(ws + WS_CTL) + 4096, xst);
#ifndef MK_ONLY
#define MK_ONLY -1
#endif
#ifndef MK_MASK
#define MK_MASK 0xFFF
#endif
#define IN(k) ((MK_ONLY < 0 || MK_ONLY == (k)) && ((MK_MASK >> (k)) & 1) && lo <= (k) && (k) < hi)
#define LAUNDER int tid_l = tid0; asm volatile("" : "+v"(tid_l)); const int tid = tid_l, lane = tid_l & 63; (void)tid; (void)lane;
#define SEAM(k) do { if (IN(k) && IN((k) + 1) && !(FUSE56 && (k) == 5)) { if ((k) == 0) cg::this_grid().sync(); else xcd_barrier(xbar); } } while (0)
    const float* mod = (const float*)(ws + WS_MOD);
#if MK_PREFIX >= 0
    hi = MK_PREFIX + 1;
    PROGRAM()
    xcd_barrier(xbar);
    hi = a.ph_hi;
#endif
    PROGRAM()
#undef IN
#undef SEAM
}

extern "C" void kernel_launch(void* const* d_in, const int* in_sizes, int n_in, void* d_out, int out_size, void* d_ws, size_t ws_size, hipStream_t stream) {
    static int grid = 0;
    if (grid == 0) {
        if (n_in != 24 || in_sizes[0] != NTOK * DM || out_size != NTOK * DM || ws_size < WS_END) {
            fprintf(stderr, "kernel_launch: unexpected problem (n_in %d, in0 %d, out %d, ws %zu)\n", n_in, n_in > 0 ? in_sizes[0] : -1, out_size, ws_size); grid = -1; return; }
        int dev = 0, cus = 0, per_cu = 0;
        if (hipGetDevice(&dev) != hipSuccess || hipDeviceGetAttribute(&cus, hipDeviceAttributeMultiprocessorCount, dev) != hipSuccess) { grid = -1; return; }
        if (hipFuncSetAttribute((const void*)mk_fwd, hipFuncAttributeMaxDynamicSharedMemorySize, LDS_BYTES) != hipSuccess) { fprintf(stderr, "kernel_launch: hipFuncSetAttribute failed\n"); grid = -1; return; }
        if (hipOccupancyMaxActiveBlocksPerMultiprocessor(&per_cu, (const void*)mk_fwd, 512, LDS_BYTES) != hipSuccess || per_cu < 1) { fprintf(stderr, "kernel_launch: occupancy query says %d\n", per_cu); }
        (void)hipGetLastError();
        grid = cus;
    }
    if (grid < 0) return;
    if (hipMemsetAsync((char*)d_ws + WS_CTL, 0, 65536, stream) != hipSuccess) { fprintf(stderr, "kernel_launch: memset of the control words failed\n"); return; }
    KArgs a{};
    const float** fp = (const float**)&a;
    for (int i = 0; i < 24; ++i) fp[i] = (const float*)d_in[i];
    a.out = (float*)d_out; a.ws = (unsigned char*)d_ws;
#if MK_ONE_LAUNCH
    a.ph_lo = 0; a.ph_hi = N_PHASES;
    void* args[] = {&a};
    hipError_t e = hipLaunchCooperativeKernel((const void*)mk_fwd, dim3(grid), dim3(512), args, LDS_BYTES, stream);
    if (e != hipSuccess) fprintf(stderr, "kernel_launch: cooperative launch failed: %s (grid %d)\n", hipGetErrorString(e), grid);
#else
    for (int p = 0; p < N_PHASES; ++p) {
        a.ph_lo = p; a.ph_hi = p + 1;
        hipLaunchKernelGGL(mk_fwd, dim3(grid), dim3(512), LDS_BYTES, stream, a);
    }
#endif
}
```
